# Optimizing an MI355X kernel written in HIP

```python
import math
import jax, jax.numpy as jnp
from jax import lax
import numpy as np

D_MODEL = 1024
BATCH = 8
SEQ = 2048
DEPTH = 2

CTX_LEN = 256
GRID_W = 64
INNER = D_MODEL
HEAD_DIM = 64
A_WIDTH = INNER // 2
B_WIDTH = INNER - A_WIDTH
B_HEADS = B_WIDTH // HEAD_DIM
B_KV_HEADS = B_HEADS // 4
KV_WIDTH = B_KV_HEADS * HEAD_DIM
CONV_WIDTH = 31
Q_BLOCK = 128
ROPE_THETA = 10000.0
C_WIDTH = INNER // 2
C_GROUPS = 4
C_GROUP_DIM = C_WIDTH // C_GROUPS
D_WIDTH = INNER - C_WIDTH
D_HEADS = D_WIDTH // HEAD_DIM
NA_ROWS = 8
NA_COLS = 16
EPS = 1e-6
NEG_INF = -1e30
N_AB = (DEPTH + 1) // 2
N_CD = DEPTH // 2

AB_Q_OFF = 2 * A_WIDTH
AB_K_OFF = AB_Q_OFF + B_WIDTH
AB_V_OFF = AB_K_OFF + KV_WIDTH
AB_Z_OFF = AB_V_OFF + KV_WIDTH
AB_IN = AB_Z_OFF + INNER
CD_Q_OFF = C_WIDTH
CD_K_OFF = CD_Q_OFF + D_WIDTH
CD_V_OFF = CD_K_OFF + D_WIDTH
CD_Z_OFF = CD_V_OFF + D_WIDTH
CD_IN = CD_Z_OFF + INNER

kernel_name = "hybrid_prefix_dit_conv_gqa_fnet_natten"


def rms_norm(x, g):
    x32 = x.astype(jnp.float32)
    y = x32 * lax.rsqrt(jnp.mean(x32 * x32, axis=-1, keepdims=True) + EPS)
    return (y * g.astype(jnp.float32)).astype(x.dtype)


def layer_norm(x, g, b):
    x32 = x.astype(jnp.float32)
    mu = jnp.mean(x32, axis=-1, keepdims=True)
    xc = x32 - mu
    y = xc * lax.rsqrt(jnp.mean(xc * xc, axis=-1, keepdims=True) + EPS)
    return (y * g.astype(jnp.float32) + b.astype(jnp.float32)).astype(x.dtype)


def adaln(cond, w, b):
    m = jax.nn.silu(cond) @ w + b
    return jnp.split(m, 3, axis=-1)


def axial_rope(x):
    S = x.shape[1]
    t = jnp.arange(S)
    row = (t // GRID_W).astype(jnp.float32)
    col = (t % GRID_W).astype(jnp.float32)
    nf = HEAD_DIM // 4
    inv = ROPE_THETA ** (-jnp.arange(nf, dtype=jnp.float32) / nf)
    ang = jnp.concatenate([row[:, None] * inv, col[:, None] * inv], axis=-1)
    cos = jnp.cos(ang)[None, :, None, :]
    sin = jnp.sin(ang)[None, :, None, :]
    xp = x.astype(jnp.float32).reshape(x.shape[:-1] + (HEAD_DIM // 2, 2))
    a, b = xp[..., 0], xp[..., 1]
    out = jnp.stack([a * cos - b * sin, a * sin + b * cos], axis=-1)
    return out.reshape(x.shape).astype(x.dtype)


def dense_attn(q, k, v):
    Bq, Lq, Hq, dh = q.shape
    Hk = k.shape[2]
    qg = q.reshape(Bq, Lq, Hk, Hq // Hk, dh)
    s = jnp.einsum('bqkgd,bskd->bkgqs', qg, k).astype(jnp.float32) * (dh ** -0.5)
    p = jax.nn.softmax(s, axis=-1).astype(v.dtype)
    o = jnp.einsum('bkgqs,bskd->bqkgd', p, v)
    return o.reshape(Bq, Lq, Hq * dh)


def blocked_attn(q, k, v):
    Bq, S, Hq, dh = q.shape
    nb = S // Q_BLOCK
    qb = q.reshape(Bq, nb, Q_BLOCK, Hq, dh).transpose(1, 0, 2, 3, 4)
    ob = lax.map(lambda qi: dense_attn(qi, k, v), qb)
    return ob.transpose(1, 0, 2, 3).reshape(Bq, S, Hq * dh)


def dwconv(x, w, b):
    K = w.shape[0]
    y = lax.conv_general_dilated(x, w[:, None, :].astype(x.dtype), (1,), [(K // 2, K // 2)],
                                 dimension_numbers=('NWC', 'WIO', 'NWC'),
                                 feature_group_count=x.shape[-1])
    return y + b


def conformer_conv(a_val, a_gate, conv_w, conv_b, ln_g, ln_b):
    u = a_val * jax.nn.sigmoid(a_gate)
    u = dwconv(u, conv_w, conv_b)
    return jax.nn.silu(layer_norm(u, ln_g, ln_b))


def fourier_mix(f, w_c):
    Bf, L, _ = f.shape
    fg = f.reshape(Bf, L, C_GROUPS, C_GROUP_DIM).astype(jnp.float32)
    fr = jnp.fft.fft2(fg, axes=(1, 3), norm='ortho').real.astype(f.dtype)
    return jnp.einsum('blgc,gce->blge', fr, w_c).reshape(Bf, L, C_WIDTH)


def neighborhood_attn(q, k, v, kc, vc, rpb):
    Bq, S, H, dh = q.shape
    rows = S // GRID_W
    kr = min(NA_ROWS, rows)
    qg = q.reshape(Bq, rows, GRID_W, H, dh)
    kg = k.reshape(Bq, rows, GRID_W, H, dh)
    vg = v.reshape(Bq, rows, GRID_W, H, dh)
    r = jnp.arange(rows)
    rs = jnp.clip(r - kr // 2, 0, rows - kr)
    row_idx = rs[:, None] + jnp.arange(kr)[None, :]
    kb = kg[:, row_idx]
    vb = vg[:, row_idx]
    wq = jnp.arange(GRID_W)
    cs = jnp.clip(wq - NA_COLS // 2, 0, GRID_W - NA_COLS)
    col_ok = (wq[None, :] >= cs[:, None]) & (wq[None, :] < cs[:, None] + NA_COLS)
    dr_idx = row_idx - r[:, None] + (NA_ROWS - 1)
    dc_idx = jnp.clip(wq[None, :] - wq[:, None] + (NA_COLS - 1), 0, 2 * NA_COLS - 2)
    bias = rpb[:, dr_idx[:, None, :, None], dc_idx[None, :, None, :]]
    scale = dh ** -0.5
    s_win = jnp.einsum('brqhd,brkwhd->bhrqkw', qg, kb).astype(jnp.float32) * scale \
        + bias.astype(jnp.float32)[None]
    s_win = jnp.where(col_ok[:, None, :], s_win, NEG_INF).reshape(Bq, H, rows, GRID_W, kr * GRID_W)
    s_ctx = jnp.einsum('brqhd,bchd->bhrqc', qg, kc).astype(jnp.float32) * scale
    p = jax.nn.softmax(jnp.concatenate([s_win, s_ctx], axis=-1), axis=-1).astype(v.dtype)
    p_win = p[..., :kr * GRID_W].reshape(Bq, H, rows, GRID_W, kr, GRID_W)
    p_ctx = p[..., kr * GRID_W:]
    o = jnp.einsum('bhrqkw,brkwhd->brqhd', p_win, vb) + jnp.einsum('bhrqc,bchd->brqhd', p_ctx, vc)
    return o.reshape(Bq, S, H * dh)


def layer_ab(x, xc, c, c_ctx, w_ada, b_ada, norm_g, w_in, conv_w, conv_b, ln_g, ln_b,
             qn_g, kn_g, w_out, need_ctx):
    Bx, S, _ = x.shape
    L = xc.shape[1]
    shift, scale, gate = adaln(c[:, None, :], w_ada, b_ada)
    cshift, cscale, cgate = adaln(c_ctx, w_ada, b_ada)
    h = rms_norm(x, norm_g) * (1 + scale) + shift
    hc = rms_norm(xc, norm_g) * (1 + cscale) + cshift
    u = h @ w_in
    a_val, a_gate = u[..., :A_WIDTH], u[..., A_WIDTH:AB_Q_OFF]
    q = u[..., AB_Q_OFF:AB_K_OFF].reshape(Bx, S, B_HEADS, HEAD_DIM)
    k = u[..., AB_K_OFF:AB_V_OFF].reshape(Bx, S, B_KV_HEADS, HEAD_DIM)
    v = u[..., AB_V_OFF:AB_Z_OFF].reshape(Bx, S, B_KV_HEADS, HEAD_DIM)
    z = u[..., AB_Z_OFF:]
    uc = hc @ (w_in if need_ctx else w_in[:, AB_K_OFF:AB_Z_OFF])
    kv_off = AB_K_OFF if need_ctx else 0
    ck = uc[..., kv_off:kv_off + KV_WIDTH].reshape(Bx, L, B_KV_HEADS, HEAD_DIM)
    cv = uc[..., kv_off + KV_WIDTH:kv_off + 2 * KV_WIDTH].reshape(Bx, L, B_KV_HEADS, HEAD_DIM)
    ck = rms_norm(ck, kn_g)
    q = axial_rope(rms_norm(q, qn_g))
    k = axial_rope(rms_norm(k, kn_g))
    y_b = blocked_attn(q, jnp.concatenate([ck, k], axis=1), jnp.concatenate([cv, v], axis=1))
    y_a = conformer_conv(a_val, a_gate, conv_w, conv_b, ln_g, ln_b)
    y = jnp.concatenate([y_a, y_b], axis=-1) * jax.nn.silu(z)
    x = x + gate * (y @ w_out)
    if need_ctx:
        cq = rms_norm(uc[..., AB_Q_OFF:AB_K_OFF].reshape(Bx, L, B_HEADS, HEAD_DIM), qn_g)
        yc_b = dense_attn(cq, ck, cv)
        yc_a = conformer_conv(uc[..., :A_WIDTH], uc[..., A_WIDTH:AB_Q_OFF], conv_w, conv_b, ln_g, ln_b)
        yc = jnp.concatenate([yc_a, yc_b], axis=-1) * jax.nn.silu(uc[..., AB_Z_OFF:])
        xc = xc + cgate * (yc @ w_out)
    return x, xc


def layer_cd(x, xc, c, c_ctx, w_ada, b_ada, norm_g, w_in, w_fourier, rpb, w_out, need_ctx):
    Bx, S, _ = x.shape
    L = xc.shape[1]
    shift, scale, gate = adaln(c[:, None, :], w_ada, b_ada)
    cshift, cscale, cgate = adaln(c_ctx, w_ada, b_ada)
    h = rms_norm(x, norm_g) * (1 + scale) + shift
    hc = rms_norm(xc, norm_g) * (1 + cscale) + cshift
    u = h @ w_in
    f = u[..., :C_WIDTH]
    q = u[..., CD_Q_OFF:CD_K_OFF].reshape(Bx, S, D_HEADS, HEAD_DIM)
    k = u[..., CD_K_OFF:CD_V_OFF].reshape(Bx, S, D_HEADS, HEAD_DIM)
    v = u[..., CD_V_OFF:CD_Z_OFF].reshape(Bx, S, D_HEADS, HEAD_DIM)
    z = u[..., CD_Z_OFF:]
    uc = hc @ (w_in if need_ctx else w_in[:, CD_K_OFF:CD_Z_OFF])
    kv_off = CD_K_OFF if need_ctx else 0
    ck = uc[..., kv_off:kv_off + D_WIDTH].reshape(Bx, L, D_HEADS, HEAD_DIM)
    cv = uc[..., kv_off + D_WIDTH:kv_off + 2 * D_WIDTH].reshape(Bx, L, D_HEADS, HEAD_DIM)
    y_c = fourier_mix(f, w_fourier)
    y_d = neighborhood_attn(q, k, v, ck, cv, rpb)
    y = jnp.concatenate([y_c, y_d], axis=-1) * jax.nn.silu(z)
    x = x + gate * (y @ w_out)
    if need_ctx:
        cq = uc[..., CD_Q_OFF:CD_K_OFF].reshape(Bx, L, D_HEADS, HEAD_DIM)
        yc_d = dense_attn(cq, ck, cv)
        yc_c = fourier_mix(uc[..., :C_WIDTH], w_fourier)
        yc = jnp.concatenate([yc_c, yc_d], axis=-1) * jax.nn.silu(uc[..., CD_Z_OFF:])
        xc = xc + cgate * (yc @ w_out)
    return x, xc


def setup_inputs(seed: int = 0) -> dict:
    key = jax.random.key(seed)
    ks = iter(jax.random.split(key, 32))
    nrm = lambda shape, s: jax.random.normal(next(ks), shape, jnp.float32) * s
    gain = lambda shape: 1.0 + nrm(shape, 0.05)
    return {
        "x": nrm((BATCH, SEQ, D_MODEL), 1.0),
        "c": nrm((BATCH, D_MODEL), 1.0),
        "ctx": nrm((BATCH, CTX_LEN, D_MODEL), 1.0),
        "c_ctx": nrm((D_MODEL,), 1.0),
        "ab_w_ada": nrm((N_AB, D_MODEL, 3 * D_MODEL), 0.5 * D_MODEL ** -0.5),
        "ab_b_ada": nrm((N_AB, 3 * D_MODEL), 0.01),
        "ab_norm_g": gain((N_AB, D_MODEL)),
        "ab_w_in": nrm((N_AB, D_MODEL, AB_IN), D_MODEL ** -0.5),
        "ab_conv_w": nrm((N_AB, CONV_WIDTH, A_WIDTH), CONV_WIDTH ** -0.5),
        "ab_conv_b": nrm((N_AB, A_WIDTH), 0.01),
        "ab_ln_g": gain((N_AB, A_WIDTH)),
        "ab_ln_b": nrm((N_AB, A_WIDTH), 0.01),
        "ab_q_norm_g": gain((N_AB, HEAD_DIM)),
        "ab_k_norm_g": gain((N_AB, HEAD_DIM)),
        "ab_w_out": nrm((N_AB, INNER, D_MODEL), INNER ** -0.5),
        "cd_w_ada": nrm((N_CD, D_MODEL, 3 * D_MODEL), 0.5 * D_MODEL ** -0.5),
        "cd_b_ada": nrm((N_CD, 3 * D_MODEL), 0.01),
        "cd_norm_g": gain((N_CD, D_MODEL)),
        "cd_w_in": nrm((N_CD, D_MODEL, CD_IN), D_MODEL ** -0.5),
        "cd_w_fourier": nrm((N_CD, C_GROUPS, C_GROUP_DIM, C_GROUP_DIM), C_GROUP_DIM ** -0.5),
        "cd_rpb": nrm((N_CD, D_HEADS, 2 * NA_ROWS - 1, 2 * NA_COLS - 1), 0.1),
        "cd_w_out": nrm((N_CD, INNER, D_MODEL), INNER ** -0.5),
        "final_norm_g": gain((D_MODEL,)),
    }


def reference(x, c, ctx, c_ctx, ab_w_ada, ab_b_ada, ab_norm_g, ab_w_in, ab_conv_w, ab_conv_b,
              ab_ln_g, ab_ln_b, ab_q_norm_g, ab_k_norm_g, ab_w_out, cd_w_ada, cd_b_ada, cd_norm_g,
              cd_w_in, cd_w_fourier, cd_rpb, cd_w_out, final_norm_g):
    xc = ctx
    for layer in range(DEPTH):
        need_ctx = layer < DEPTH - 1
        i = layer // 2
        if layer % 2 == 0:
            x, xc = layer_ab(x, xc, c, c_ctx, ab_w_ada[i], ab_b_ada[i], ab_norm_g[i], ab_w_in[i],
                             ab_conv_w[i], ab_conv_b[i], ab_ln_g[i], ab_ln_b[i],
                             ab_q_norm_g[i], ab_k_norm_g[i], ab_w_out[i], need_ctx)
        else:
            x, xc = layer_cd(x, xc, c, c_ctx, cd_w_ada[i], cd_b_ada[i], cd_norm_g[i], cd_w_in[i],
                             cd_w_fourier[i], cd_rpb[i], cd_w_out[i], need_ctx)
    return rms_norm(x, final_norm_g)
```

```cpp
#include <hip/hip_runtime.h>
#include <cstdio>
#include <cstdint>

#ifndef MK_N_LAUNCHES
#define MK_N_LAUNCHES 10
#endif

#define GAS __attribute__((address_space(1)))
#define LAS __attribute__((address_space(3)))
typedef unsigned short bf16;
typedef unsigned v4u __attribute__((ext_vector_type(4)));
typedef float f32x4 __attribute__((ext_vector_type(4)));
typedef GAS unsigned gu32;
#define RLX_AGENT __ATOMIC_RELAXED, __HIP_MEMORY_SCOPE_AGENT
#define LDS_WAIT() asm volatile("s_waitcnt lgkmcnt(0)" ::: "memory")
#define DEVI __device__ __forceinline__

constexpr int NB = 8, SEQ = 2048, DM = 1024, CTXL = 256, GRIDW = 64;
constexpr int MX = NB * SEQ, MC = NB * CTXL, MT = MX + MC;
constexpr int AB_IN = 2816, CD_IN = 3072, N1 = 3584;
constexpr int NKEY0 = CTXL + SEQ;
constexpr float EPS = 1e-6f;
constexpr float LOG2E = 1.4426950408889634f, C2 = 0.125f * LOG2E;
constexpr int NWAVES = 8, NTHR = 512;
constexpr int NPHASES = 10;

constexpr size_t MiB = 1u << 20;
constexpr size_t WS_CTL = 0, CTL_ZERO_BYTES = 1 * MiB;
constexpr size_t WS_ADA = 256 * 1024;
constexpr size_t WS_ROPE = 1 * MiB;
constexpr size_t WS_MCS = 1 * MiB + 512 * 1024;
constexpr size_t WS_WIN0 = 3 * MiB, WS_WOUT0 = 9 * MiB, WS_WIN1 = 11 * MiB, WS_WOUT1 = 18 * MiB;
constexpr size_t WS_DFT = 20 * MiB;
constexpr size_t WS_H = 36 * MiB;
constexpr size_t WS_X1C = 72 * MiB;
constexpr size_t WS_R = 80 * MiB;
constexpr size_t WS_GLU = WS_R, WS_Q0 = WS_R + 18 * MiB, WS_K0 = WS_R + 36 * MiB, WS_V0 = WS_K0 + 4608 * 1024, WS_SZ0 = WS_R + 45 * MiB, WS_Y0 = WS_R + 81 * MiB;
constexpr size_t WS_PT = WS_R, WS_Q1 = WS_R + 32 * MiB, WS_K1 = WS_R + 48 * MiB, WS_V1 = WS_R + 66 * MiB, WS_SZ1 = WS_R + 84 * MiB, WS_Y1 = WS_R + 116 * MiB;
constexpr size_t WS_END = WS_R + 148 * MiB;
static_assert(WS_END <= 256 * MiB, "d_ws map");
constexpr int CW_BAR = 4096;

constexpr int LDS_BYTES = 147456;
constexpr int MISC_OFF = 131072 + 320;

DEVI unsigned f2bf(float f) { unsigned u = __builtin_bit_cast(unsigned, f); return (u + 0x7fffu + ((u >> 16) & 1u)) >> 16; }
DEVI unsigned pk2(float lo, float hi) { return f2bf(lo) | (f2bf(hi) << 16); }
DEVI float bf2f(unsigned b) { return __builtin_bit_cast(float, (b & 0xffffu) << 16); }
DEVI float bflo(unsigned w) { return __builtin_bit_cast(float, w << 16); }
DEVI float bfhi(unsigned w) { return __builtin_bit_cast(float, w & 0xffff0000u); }
DEVI float siluf(float v) { return v / (1.f + expf(-v)); }
DEVI float sigmf(float v) { return 1.f / (1.f + expf(-v)); }
DEVI float wave_sum(float v) {
#pragma unroll
    for (int o = 1; o < 64; o <<= 1) v += __shfl_xor(v, o);
    return v;
}

#define XB_TMO      128
#define XB_XCNT(j)  (256  + 64 * (j))
#define XB_XSUB(j)  (1280 + 64 * (j))
#define XB_XGEN(j)  (2304 + 64 * (j))
#define XB_TOP      3328
#define XB_TOPGEN   3392
#define XCD_BAR_WORDS 3456
#define XB_SPIN_CAP (1u << 22)
DEVI unsigned xb_ld(unsigned* p)              { return __hip_atomic_load(p, __ATOMIC_RELAXED, __HIP_MEMORY_SCOPE_AGENT); }
DEVI unsigned xb_add(unsigned* p, unsigned v) { return __hip_atomic_fetch_add(p, v, __ATOMIC_RELAXED, __HIP_MEMORY_SCOPE_AGENT); }
DEVI unsigned xb_xcc_id() { return (unsigned)__builtin_amdgcn_s_getreg((3 << 11) | 20) & 0xFu; }
#define XB_SPIN(cond, bar) do { unsigned _sp = 0; while (cond) { __builtin_amdgcn_s_sleep(1); \
    if ((++_sp & 255u) == 0u) { if (xb_ld(&(bar)[XB_TMO])) break; if (_sp > XB_SPIN_CAP) { atomicAdd(&(bar)[XB_TMO], 1u); break; } } } } while (0)
struct XcdBarrier { unsigned* bar; unsigned x; volatile LAS unsigned* st; };
DEVI XcdBarrier xcd_barrier_post(unsigned* bar, volatile LAS unsigned* st) {
    XcdBarrier b; b.bar = bar; b.x = xb_xcc_id(); b.st = st;
    if (threadIdx.x == 0) (void)xb_add(&bar[XB_XCNT(b.x)], 1u);
    return b;
}
DEVI void xcd_barrier_complete(unsigned* bar, unsigned x, unsigned& nloc, unsigned& nx) {
    const unsigned G = gridDim.x * gridDim.y * gridDim.z;
    unsigned sum, cnt, mine, sp = 0u;
    for (;;) {
        sum = 0u; cnt = 0u; mine = 0u;
#pragma unroll
        for (unsigned j = 0; j < 16; ++j) { const unsigned c = xb_ld(&bar[XB_XCNT(j)]); sum += c; cnt += (c > 0u) ? 1u : 0u; mine = (j == x) ? c : mine; }
        if (sum == G) break;
        __builtin_amdgcn_s_sleep(1);
        if ((++sp & 255u) == 0u) { if (xb_ld(&bar[XB_TMO])) break; if (sp > XB_SPIN_CAP) { atomicAdd(&bar[XB_TMO], 1u); break; } }
    }
    nloc = mine > 0u ? mine : 1u; nx = cnt > 0u ? cnt : 1u;
}
DEVI void xcd_barrier(const XcdBarrier& b) {
    asm volatile("s_waitcnt vmcnt(0)" ::: "memory");
    __syncthreads();
    if (threadIdx.x == 0) {
        unsigned* bar = b.bar;
        __builtin_amdgcn_s_waitcnt(0);
        unsigned nloc = b.st[0], nx = b.st[1];
        if (nloc == 0u) { xcd_barrier_complete(bar, b.x, nloc, nx); b.st[0] = nloc; b.st[1] = nx; }
        const unsigned old = xb_add(&bar[XB_XSUB(b.x)], 1u);
        const unsigned gen = old / nloc;
        if (old + 1u == (gen + 1u) * nloc) {
            __builtin_amdgcn_fence(__ATOMIC_RELEASE, "agent");
            asm volatile("s_waitcnt vmcnt(0)" ::: "memory");
            const unsigned og = xb_add(&bar[XB_TOP], 1u);
            const unsigned tg = og / nx;
            if (og + 1u == (tg + 1u) * nx) xb_add(&bar[XB_TOPGEN], 1u);
            else XB_SPIN(xb_ld(&bar[XB_TOPGEN]) == tg, bar);
            __builtin_amdgcn_fence(__ATOMIC_ACQUIRE, "agent");
            xb_add(&bar[XB_XGEN(b.x)], 1u);
            asm volatile("s_waitcnt vmcnt(0)" ::: "memory");
        } else {
            XB_SPIN(xb_ld(&bar[XB_XGEN(b.x)]) == gen, bar);
            __builtin_amdgcn_fence(__ATOMIC_ACQUIRE, "agent");
            asm volatile("s_waitcnt vmcnt(0)" ::: "memory");
        }
    }
    __syncthreads();
}

struct Args { const float* in[23]; float* out; unsigned char* ws; int ph_lo, ph_hi, li, pad; };
enum { I_X = 0, I_C, I_CTX, I_CCTX, I_AB_WADA, I_AB_BADA, I_AB_NORMG, I_AB_WIN, I_AB_CONVW, I_AB_CONVB, I_AB_LNG, I_AB_LNB, I_AB_QNG, I_AB_KNG, I_AB_WOUT,
       I_CD_WADA, I_CD_BADA, I_CD_NORMG, I_CD_WIN, I_CD_WF, I_CD_RPB, I_CD_WOUT, I_FNG };

struct Frame {
    LAS unsigned char* lds;
    int tid, lane, wave, G, bid;
    const float* in[23]; float* out; unsigned char* ws;
};
DEVI bf16* wsb(const Frame& F, size_t off) { return (bf16*)(F.ws + off); }
DEVI float* wsf(const Frame& F, size_t off) { return (float*)(F.ws + off); }

DEVI float block_sum(float v, LAS float* red, int lane, int wave) {
    v = wave_sum(v);
    __syncthreads();
    if (lane == 0) red[wave] = v;
    __syncthreads();
    float s = 0.f;
#pragma unroll
    for (int i = 0; i < NWAVES; ++i) s += red[i];
    return s;
}

template <class Map>
DEVI void transpose_item(const float* W, int ldw, int c0, int ncols, int K, bf16* WT, Map map32, LAS float* scr, int item, int lane) {
    const int nblk = ncols / 32, kb = item / nblk, nb = item % nblk, k0 = 64 * kb, n0 = 32 * nb;
#pragma unroll 8
    for (int i = 0; i < 32; ++i) { const int kk = 2 * i + (lane >> 5); scr[kk * 33 + (lane & 31)] = W[(size_t)(k0 + kk) * ldw + c0 + n0 + (lane & 31)]; }
    LDS_WAIT(); asm volatile("" ::: "memory");
    const int c = lane & 7;
    const int drow0 = map32(nb) * 32;
#pragma unroll
    for (int j = 0; j < 4; ++j) { const int n = (lane >> 3) + 8 * j; const LAS float* s = scr + (8 * c) * 33 + n;
        v4u o; o.x = pk2(s[0 * 33], s[1 * 33]); o.y = pk2(s[2 * 33], s[3 * 33]); o.z = pk2(s[4 * 33], s[5 * 33]); o.w = pk2(s[6 * 33], s[7 * 33]);
        *(v4u*)(WT + (size_t)(drow0 + n) * K + k0 + 8 * c) = o; }
    LDS_WAIT(); asm volatile("" ::: "memory");
}
struct MapId { int off; DEVI int operator()(int nb) const { return nb + off; } };
struct MapIn0 { DEVI int operator()(int nb) const {
    if (nb < 32) { const int isg = nb >> 4, cb = nb & 15;
                   const int t = cb >> 1, h = cb & 1; return t * 4 + isg * 2 + h; }
    return nb; } };

DEVI void p0_prologue(Frame& F) {
    LAS float* scr = (LAS float*)(F.lds + F.wave * 16384);
    const int gw = F.bid * NWAVES + F.wave, NGW = F.G * NWAVES;
    constexpr int I0 = 16 * (AB_IN / 32), I1 = 16 * 32, I2 = 16 * ((CD_IN - 512) / 32), I3 = 16 * 32;
    for (int it = gw; it < I0 + I1 + I2 + I3; it += NGW) {
        int r = it;
        if (r < I0) { transpose_item(F.in[I_AB_WIN], AB_IN, 0, AB_IN, DM, wsb(F, WS_WIN0), MapIn0{}, scr, r, F.lane); continue; } r -= I0;
        if (r < I1) { transpose_item(F.in[I_AB_WOUT], DM, 0, DM, DM, wsb(F, WS_WOUT0), MapId{0}, scr, r, F.lane); continue; } r -= I1;
        if (r < I2) { transpose_item(F.in[I_CD_WIN], CD_IN, 512, CD_IN - 512, DM, wsb(F, WS_WIN1), MapId{32}, scr, r, F.lane); continue; } r -= I2;
        transpose_item(F.in[I_CD_WOUT], DM, 0, DM, DM, wsb(F, WS_WOUT1), MapId{0}, scr, r, F.lane);
    }
    __syncthreads();
    {
        LAS float* sl = (LAS float*)F.lds;
        for (int i = F.tid; i < 9 * 1024; i += NTHR) { const int r = i >> 10, k = i & 1023; const float cv = (r < 8) ? F.in[I_C][r * 1024 + k] : F.in[I_CCTX][k]; sl[i] = siluf(cv); }
        __syncthreads();
        float* ada = wsf(F, WS_ADA);
        for (int it = gw; it < 2 * 48 * 8; it += NGW) {
            const int l = it / 384, rem = it % 384, cc = rem >> 3, kc = rem & 7;
            const float* W = l ? F.in[I_CD_WADA] : F.in[I_AB_WADA]; const float* bb = l ? F.in[I_CD_BADA] : F.in[I_AB_BADA];
            const int col = cc * 64 + F.lane;
            float s[9];
#pragma unroll
            for (int r = 0; r < 9; ++r) s[r] = 0.f;
            for (int k = kc * 128; k < kc * 128 + 128; ++k) { const float w = W[(size_t)k * 3072 + col];
#pragma unroll
                for (int r = 0; r < 9; ++r) s[r] += sl[r * 1024 + k] * w; }
            const float bv = (kc == 0) ? bb[col] : 0.f;
#pragma unroll
            for (int r = 0; r < 9; ++r) atomicAdd(&ada[(l * 9 + r) * 3072 + col], s[r] + bv);
        }
        __syncthreads();
    }
    {
        float* rope = wsf(F, WS_ROPE);
        for (int i = F.bid * NTHR + F.tid; i < SEQ * 32; i += F.G * NTHR) {
            const int t = i >> 5, p = i & 31; const int fi = p & 15;
            const float inv = (float)pow(10000.0, -(double)fi / 16.0);
            const float pos = (float)((p < 16) ? (t / GRIDW) : (t % GRIDW));
            const float ang = pos * inv;
            rope[2 * i] = (float)cos((double)ang); rope[2 * i + 1] = (float)sin((double)ang);
        }
    }
    {
        LAS float* t128 = (LAS float*)F.lds;
        if (F.tid < 128) { t128[F.tid] = (float)cospi((double)F.tid / 64.0); t128[128 + F.tid] = (float)sinpi((double)F.tid / 64.0); }
        __syncthreads();
        float* mcs = wsf(F, WS_MCS); const float* wf = F.in[I_CD_WF];
        for (int i = F.bid * NTHR + F.tid; i < 2 * 4 * 128 * 128; i += F.G * NTHR) {
            const int e = i & 127, c = (i >> 7) & 127, g = (i >> 14) & 3, cs = i >> 16;
            float s = 0.f;
            for (int cp = 0; cp < 128; ++cp) s += t128[cs * 128 + ((c * cp) & 127)] * wf[(g * 128 + cp) * 128 + e];
            mcs[i] = s * (1.f / 512.f);
        }
        __syncthreads();
    }
    {
        LAS float* t2k = (LAS float*)F.lds;
        for (int i = F.tid; i < 2048; i += NTHR) { t2k[i] = (float)cospi((double)i / 1024.0); t2k[2048 + i] = (float)sinpi((double)i / 1024.0); }
        __syncthreads();
        bf16* A = wsb(F, WS_DFT);
        for (int i = F.bid * NTHR + F.tid; i < 2048 * 512; i += F.G * NTHR) {
            const int lp = i >> 9, k0 = (i & 511) * 8; float v[8];
#pragma unroll
            for (int j = 0; j < 8; ++j) { const int k = k0 + j; const int idx = (lp * (k & 2047)) & 2047; v[j] = (k < 2048) ? t2k[idx] : -t2k[2048 + idx]; }
            v4u o; o.x = pk2(v[0], v[1]); o.y = pk2(v[2], v[3]); o.z = pk2(v[4], v[5]); o.w = pk2(v[6], v[7]);
            *(v4u*)(A + (size_t)lp * 4096 + k0) = o;
        }
        __syncthreads();
    }
}

DEVI void modnorm_row(const float* xrow, bf16* orow, const float* g, const float* shift, const float* scale, int lane) {
    f32x4 v[4]; float ss = 0.f;
#pragma unroll
    for (int j = 0; j < 4; ++j) { v[j] = *(const f32x4*)(xrow + 4 * lane + 256 * j); ss += (v[j].x * v[j].x + v[j].y * v[j].y) + (v[j].z * v[j].z + v[j].w * v[j].w); }
    const float rinv = 1.0f / sqrtf(wave_sum(ss) * (1.f / DM) + EPS);
#pragma unroll
    for (int j = 0; j < 4; ++j) {
        const int c = 4 * lane + 256 * j;
        const f32x4 gg = *(const f32x4*)(g + c), sh = *(const f32x4*)(shift + c), sc = *(const f32x4*)(scale + c);
        const float o0 = v[j].x * rinv * gg.x * (1.f + sc.x) + sh.x, o1 = v[j].y * rinv * gg.y * (1.f + sc.y) + sh.y;
        const float o2 = v[j].z * rinv * gg.z * (1.f + sc.z) + sh.z, o3 = v[j].w * rinv * gg.w * (1.f + sc.w) + sh.w;
        *(unsigned long long*)(orow + c) = (unsigned long long)pk2(o0, o1) | ((unsigned long long)pk2(o2, o3) << 32);
    }
}
DEVI void phase_modnorm(Frame& F, int layer) {
    const int gw = F.bid * NWAVES + F.wave, NGW = F.G * NWAVES;
    const float* ada = wsf(F, WS_ADA) + layer * 9 * 3072;
    const float* g = layer ? F.in[I_CD_NORMG] : F.in[I_AB_NORMG];
    bf16* H = wsb(F, WS_H);
    for (int m = gw; m < MT; m += NGW) {
        const float* xr; int r;
        if (m < MX) { r = m >> 11; xr = (layer ? (const float*)F.out : F.in[I_X]) + (size_t)m * DM; }
        else { r = 8; xr = (layer ? (const float*)wsf(F, WS_X1C) : F.in[I_CTX]) + (size_t)(m - MX) * DM; }
        modnorm_row(xr, H + (size_t)m * DM, g, ada + r * 3072, ada + r * 3072 + 1024, F.lane);
    }
}
DEVI void phase_fold(Frame& F) {
    const float* mcs = wsf(F, WS_MCS); const float* W = F.in[I_CD_WIN]; bf16* WT = wsb(F, WS_WIN1);
    for (int i = F.bid * NTHR + F.tid; i < 1024 * 128; i += F.G * NTHR) {
        const int k0 = (i & 127) * 8, jj = i >> 7; const int cs = jj >> 9, g = (jj >> 7) & 3, e = jj & 127;
        float s[8];
#pragma unroll
        for (int j = 0; j < 8; ++j) s[j] = 0.f;
        const float* mp = mcs + ((size_t)(cs * 4 + g) * 128) * 128 + e;
        for (int c = 0; c < 128; ++c) { const float mv = mp[c * 128];
#pragma unroll
            for (int j = 0; j < 8; ++j) s[j] += W[(size_t)(k0 + j) * CD_IN + g * 128 + c] * mv; }
        v4u o; o.x = pk2(s[0], s[1]); o.y = pk2(s[2], s[3]); o.z = pk2(s[4], s[5]); o.w = pk2(s[6], s[7]);
        *(v4u*)(WT + (size_t)jj * DM + k0) = o;
    }
}

template <class Epi, class Skip>
DEVI void gemm_naive(Frame& F, const bf16* A, const bf16* Bt, int M, int N, int K, const Epi& epi, const Skip& skip) {
    LAS float* As = (LAS float*)F.lds; LAS float* Bs = As + 128 * 33;
    const int tx = F.tid & 31, ty = F.tid >> 5;
    const int ntn = N / 128, ntiles = (M / 128) * ntn;
    for (int t = F.bid; t < ntiles; t += F.G) {
        const int tm = t / ntn, tn = t % ntn;
        if (skip(tm, tn)) continue;
        float acc[8][4];
#pragma unroll
        for (int i = 0; i < 8; ++i)
#pragma unroll
            for (int j = 0; j < 4; ++j) acc[i][j] = 0.f;
        const int lr = F.tid >> 2, lk = (F.tid & 3) * 8;
        const bf16* ap = A + (size_t)(tm * 128 + lr) * K + lk;
        const bf16* bp = Bt + (size_t)(tn * 128 + lr) * K + lk;
        for (int k0 = 0; k0 < K; k0 += 32) {
            const v4u av = *(const v4u*)(ap + k0), bv = *(const v4u*)(bp + k0);
            __syncthreads();
            LAS float* ad = As + lr * 33 + lk; LAS float* bd = Bs + lr * 33 + lk;
            ad[0] = bflo(av.x); ad[1] = bfhi(av.x); ad[2] = bflo(av.y); ad[3] = bfhi(av.y); ad[4] = bflo(av.z); ad[5] = bfhi(av.z); ad[6] = bflo(av.w); ad[7] = bfhi(av.w);
            bd[0] = bflo(bv.x); bd[1] = bfhi(bv.x); bd[2] = bflo(bv.y); bd[3] = bfhi(bv.y); bd[4] = bflo(bv.z); bd[5] = bfhi(bv.z); bd[6] = bflo(bv.w); bd[7] = bfhi(bv.w);
            __syncthreads();
#pragma unroll 8
            for (int k = 0; k < 32; ++k) {
                float a[8], b[4];
#pragma unroll
                for (int i = 0; i < 8; ++i) a[i] = As[(ty * 8 + i) * 33 + k];
#pragma unroll
                for (int j = 0; j < 4; ++j) b[j] = Bs[(tx * 4 + j) * 33 + k];
#pragma unroll
                for (int i = 0; i < 8; ++i)
#pragma unroll
                    for (int j = 0; j < 4; ++j) acc[i][j] += a[i] * b[j];
            }
        }
        epi(tm * 128 + ty * 8, tn * 128 + tx * 4, acc);
    }
    __syncthreads();
}
struct NoSkip { DEVI bool operator()(int, int) const { return false; } };

DEVI void row_info(int row, int& b, int& key, bool& isx) {
    if (row < MX) { b = row >> 11; key = CTXL + (row & 2047); isx = true; }
    else { const int rc = row - MX; b = rc >> 8; key = rc & 255; isx = false; }
}

struct EpiIn0 {
    bf16 *GLU, *Q0, *K0, *V0, *SZ; const float *qng, *kng, *rope;
    DEVI void operator()(int row0, int col0, float (&acc)[8][4]) const {
        const int tn = col0 >> 7, cl = col0 & 127;
        if (tn < 8) {
#pragma unroll
            for (int i = 0; i < 8; ++i) {
                float o[4];
#pragma unroll
                for (int j = 0; j < 4; ++j) { const float pr = __shfl_xor(acc[i][j], 16); o[j] = acc[i][j] * sigmf(pr); }
                if (cl < 64) *(unsigned long long*)(GLU + (size_t)(row0 + i) * 512 + tn * 64 + cl) = (unsigned long long)pk2(o[0], o[1]) | ((unsigned long long)pk2(o[2], o[3]) << 32);
            }
        } else if (tn < 13) {
            const bool isq = tn < 12; const int d0 = cl & 63; const float* gn = isq ? qng : kng;
#pragma unroll
            for (int i = 0; i < 8; ++i) {
                const int row = row0 + i; int b, key; bool isx; row_info(row, b, key, isx);
                float ss = acc[i][0] * acc[i][0] + acc[i][1] * acc[i][1] + acc[i][2] * acc[i][2] + acc[i][3] * acc[i][3];
                ss += __shfl_xor(ss, 1); ss += __shfl_xor(ss, 2); ss += __shfl_xor(ss, 4); ss += __shfl_xor(ss, 8);
                const float rinv = 1.0f / sqrtf(ss * (1.f / 64.f) + EPS);
                float v[4];
#pragma unroll
                for (int j = 0; j < 4; ++j) v[j] = acc[i][j] * rinv * gn[d0 + j];
                if (isx) { const int l = row & 2047;
#pragma unroll
                    for (int p = 0; p < 2; ++p) { const int pi = (d0 >> 1) + p; const float cs = rope[(l * 32 + pi) * 2], sn = rope[(l * 32 + pi) * 2 + 1];
                        const float a = v[2 * p], bq = v[2 * p + 1]; v[2 * p] = a * cs - bq * sn; v[2 * p + 1] = a * sn + bq * cs; } }
                if (isq) { const int head = (tn - 8) * 2 + (cl >> 6);
                    *(unsigned long long*)(Q0 + (size_t)row * 512 + head * 64 + d0) = (unsigned long long)pk2(v[0] * C2, v[1] * C2) | ((unsigned long long)pk2(v[2] * C2, v[3] * C2) << 32); }
                else { const int kvh = cl >> 6;
                    *(unsigned long long*)(K0 + ((size_t)b * NKEY0 + key) * 128 + kvh * 64 + d0) = (unsigned long long)pk2(v[0], v[1]) | ((unsigned long long)pk2(v[2], v[3]) << 32); }
            }
        } else if (tn == 13) {
#pragma unroll
            for (int i = 0; i < 8; ++i) { const int row = row0 + i; int b, key; bool isx; row_info(row, b, key, isx);
                *(unsigned long long*)(V0 + ((size_t)b * NKEY0 + key) * 128 + cl) = (unsigned long long)pk2(acc[i][0], acc[i][1]) | ((unsigned long long)pk2(acc[i][2], acc[i][3]) << 32); }
        } else {
            const int c = (tn - 14) * 128 + cl;
#pragma unroll
            for (int i = 0; i < 8; ++i)
                *(unsigned long long*)(SZ + (size_t)(row0 + i) * 1024 + c) = (unsigned long long)pk2(siluf(acc[i][0]), siluf(acc[i][1])) | ((unsigned long long)pk2(siluf(acc[i][2]), siluf(acc[i][3])) << 32);
        }
    }
};
struct EpiOut0 { const float *x, *ctx, *ada; float *o_x, *o_c;
    DEVI void operator()(int row0, int col0, float (&acc)[8][4]) const {
#pragma unroll
        for (int i = 0; i < 8; ++i) { const int row = row0 + i; const bool isx = row < MX; const int r = isx ? (row >> 11) : 8;
            const float* xin = isx ? x + (size_t)row * DM : ctx + (size_t)(row - MX) * DM; float* op = isx ? o_x + (size_t)row * DM : o_c + (size_t)(row - MX) * DM;
            const f32x4 xv = *(const f32x4*)(xin + col0), gv = *(const f32x4*)(ada + r * 3072 + 2048 + col0);
            f32x4 o; o.x = xv.x + gv.x * acc[i][0]; o.y = xv.y + gv.y * acc[i][1]; o.z = xv.z + gv.z * acc[i][2]; o.w = xv.w + gv.w * acc[i][3];
            *(f32x4*)(op + col0) = o; }
    } };
struct EpiOut1 { const float* ada; float* o_x;
    DEVI void operator()(int row0, int col0, float (&acc)[8][4]) const {
#pragma unroll
        for (int i = 0; i < 8; ++i) { const int row = row0 + i; const int r = row >> 11; float* op = o_x + (size_t)row * DM + col0;
            const f32x4 xv = *(const f32x4*)op, gv = *(const f32x4*)(ada + r * 3072 + 2048 + col0);
            f32x4 o; o.x = xv.x + gv.x * acc[i][0]; o.y = xv.y + gv.y * acc[i][1]; o.z = xv.z + gv.z * acc[i][2]; o.w = xv.w + gv.w * acc[i][3];
            *(f32x4*)op = o; }
    } };
struct EpiIn1 { bf16 *PT, *Q1, *K1, *V1, *SZ1;
    DEVI void operator()(int row0, int col0, float (&acc)[8][4]) const {
        const int tn = col0 >> 7;
#pragma unroll
        for (int i = 0; i < 8; ++i) { const int row = row0 + i;
            if (tn < 8) { const int b = row >> 11, l = row & 2047;
#pragma unroll
                for (int j = 0; j < 4; ++j) { const int jj = col0 + j, cs = jj >> 9, jc = jj & 511; PT[((size_t)(b * 512 + jc) * 2 + cs) * 2048 + l] = (bf16)f2bf(acc[i][j]); } }
            else if (tn < 12) *(unsigned long long*)(Q1 + (size_t)row * 512 + (col0 - 1024)) = (unsigned long long)pk2(acc[i][0] * C2, acc[i][1] * C2) | ((unsigned long long)pk2(acc[i][2] * C2, acc[i][3] * C2) << 32);
            else if (tn < 16) *(unsigned long long*)(K1 + (size_t)row * 512 + (col0 - 1536)) = (unsigned long long)pk2(acc[i][0], acc[i][1]) | ((unsigned long long)pk2(acc[i][2], acc[i][3]) << 32);
            else if (tn < 20) *(unsigned long long*)(V1 + (size_t)row * 512 + (col0 - 2048)) = (unsigned long long)pk2(acc[i][0], acc[i][1]) | ((unsigned long long)pk2(acc[i][2], acc[i][3]) << 32);
            else *(unsigned long long*)(SZ1 + (size_t)row * 1024 + (col0 - 2560)) = (unsigned long long)pk2(siluf(acc[i][0]), siluf(acc[i][1])) | ((unsigned long long)pk2(siluf(acc[i][2]), siluf(acc[i][3])) << 32);
        }
    } };
struct SkipIn1 { DEVI bool operator()(int tm, int tn) const { return tm >= MX / 128 && (tn < 12 || tn >= 20); } };
struct EpiDft { bf16* Y1; const bf16* SZ1;
    DEVI void operator()(int row0, int col0, float (&acc)[8][4]) const {
        const int b = col0 >> 9, j = col0 & 511;
#pragma unroll
        for (int i = 0; i < 8; ++i) { const size_t off = (size_t)(b * 2048 + row0 + i) * 1024 + j;
            const unsigned long long z = *(const unsigned long long*)(SZ1 + off); const unsigned zl = (unsigned)z, zh = (unsigned)(z >> 32);
            *(unsigned long long*)(Y1 + off) = (unsigned long long)pk2(acc[i][0] * bflo(zl), acc[i][1] * bfhi(zl)) | ((unsigned long long)pk2(acc[i][2] * bflo(zh), acc[i][3] * bfhi(zh)) << 32); }
    } };

DEVI void phase_attn0_naive(Frame& F) {
    LAS float* Ks = (LAS float*)F.lds; LAS float* Vs = Ks + 64 * 64;
    const bf16* Q0 = wsb(F, WS_Q0); const bf16* K0 = wsb(F, WS_K0); const bf16* V0 = wsb(F, WS_V0); const bf16* SZ = wsb(F, WS_SZ0); bf16* Y = wsb(F, WS_Y0);
    for (int it = F.bid; it < 256 + 32; it += F.G) {
        int b, kvh, row0, nkeys;
        if (it < 256) { b = it >> 5; kvh = (it >> 4) & 1; row0 = b * 2048 + (it & 15) * 128; nkeys = NKEY0; }
        else { const int jt = it - 256; b = jt >> 2; kvh = (jt >> 1) & 1; row0 = MX + b * 256 + (jt & 1) * 128; nkeys = CTXL; }
        const int g = F.tid >> 7, qi = F.tid & 127, head = kvh * 4 + g, row = row0 + qi;
        float q[64], o[64];
        { const v4u* qp = (const v4u*)(Q0 + (size_t)row * 512 + head * 64);
#pragma unroll
          for (int c = 0; c < 8; ++c) { const v4u w = qp[c]; q[8 * c] = bflo(w.x); q[8 * c + 1] = bfhi(w.x); q[8 * c + 2] = bflo(w.y); q[8 * c + 3] = bfhi(w.y); q[8 * c + 4] = bflo(w.z); q[8 * c + 5] = bfhi(w.z); q[8 * c + 6] = bflo(w.w); q[8 * c + 7] = bfhi(w.w); } }
#pragma unroll
        for (int d = 0; d < 64; ++d) o[d] = 0.f;
        float m = -1e30f, l = 0.f;
        const int lk = F.tid >> 3, lc = (F.tid & 7) * 8;
        for (int k0 = 0; k0 < nkeys; k0 += 64) {
            const size_t goff = ((size_t)b * NKEY0 + k0 + lk) * 128 + kvh * 64 + lc;
            const v4u kw = *(const v4u*)(K0 + goff), vw = *(const v4u*)(V0 + goff);
            __syncthreads();
            { LAS float* kd = Ks + lk * 64 + lc; LAS float* vd = Vs + lk * 64 + lc;
              kd[0] = bflo(kw.x); kd[1] = bfhi(kw.x); kd[2] = bflo(kw.y); kd[3] = bfhi(kw.y); kd[4] = bflo(kw.z); kd[5] = bfhi(kw.z); kd[6] = bflo(kw.w); kd[7] = bfhi(kw.w);
              vd[0] = bflo(vw.x); vd[1] = bfhi(vw.x); vd[2] = bflo(vw.y); vd[3] = bfhi(vw.y); vd[4] = bflo(vw.z); vd[5] = bfhi(vw.z); vd[6] = bflo(vw.w); vd[7] = bfhi(vw.w); }
            __syncthreads();
            for (int kk = 0; kk < 64; ++kk) {
                const LAS f32x4* kp = (const LAS f32x4*)(Ks + kk * 64);
                float s = 0.f;
#pragma unroll
                for (int c = 0; c < 16; ++c) { const f32x4 kv = kp[c]; s += q[4 * c] * kv.x + q[4 * c + 1] * kv.y + q[4 * c + 2] * kv.z + q[4 * c + 3] * kv.w; }
                if (s > m) { const float al = exp2f(m - s); l *= al;
#pragma unroll
                    for (int d = 0; d < 64; ++d) o[d] *= al;
                    m = s; }
                const float p = exp2f(s - m); l += p;
                const LAS f32x4* vp = (const LAS f32x4*)(Vs + kk * 64);
#pragma unroll
                for (int c = 0; c < 16; ++c) { const f32x4 vv = vp[c]; o[4 * c] += p * vv.x; o[4 * c + 1] += p * vv.y; o[4 * c + 2] += p * vv.z; o[4 * c + 3] += p * vv.w; }
            }
        }
        const float il = 1.f / l;
        const size_t yoff = (size_t)row * 1024 + 512 + head * 64;
#pragma unroll
        for (int c = 0; c < 8; ++c) { const v4u zw = *(const v4u*)(SZ + yoff + 8 * c); v4u w;
            w.x = pk2(o[8 * c] * il * bflo(zw.x), o[8 * c + 1] * il * bfhi(zw.x)); w.y = pk2(o[8 * c + 2] * il * bflo(zw.y), o[8 * c + 3] * il * bfhi(zw.y));
            w.z = pk2(o[8 * c + 4] * il * bflo(zw.z), o[8 * c + 5] * il * bfhi(zw.z)); w.w = pk2(o[8 * c + 6] * il * bflo(zw.w), o[8 * c + 7] * il * bfhi(zw.w));
            *(v4u*)(Y + yoff + 8 * c) = w; }
        __syncthreads();
    }
}
DEVI void phase_conv_naive(Frame& F) {
    LAS float* red = (LAS float*)(F.lds + 65536);
    const bf16* GLU = wsb(F, WS_GLU); const bf16* SZ = wsb(F, WS_SZ0); bf16* Y = wsb(F, WS_Y0);
    const float* cw = F.in[I_AB_CONVW]; const float* cb = F.in[I_AB_CONVB]; const float* lg = F.in[I_AB_LNG]; const float* lb = F.in[I_AB_LNB];
    const int c = F.tid;
    float w[31];
#pragma unroll
    for (int t = 0; t < 31; ++t) w[t] = cw[t * 512 + c];
    const float cbv = cb[c], lgv = lg[c], lbv = lb[c];
    for (int row = F.bid; row < MT; row += F.G) {
        int base, len, pos;
        if (row < MX) { base = row & ~2047; len = SEQ; pos = row & 2047; } else { const int rc = row - MX; base = MX + (rc & ~255); len = CTXL; pos = rc & 255; }
        float u = cbv;
#pragma unroll
        for (int t = 0; t < 31; ++t) { const int p = pos + t - 15; if (p >= 0 && p < len) u += bf2f(GLU[(size_t)(base + p) * 512 + c]) * w[t]; }
        const float mean = block_sum(u, red, F.lane, F.wave) * (1.f / 512.f);
        const float dv = u - mean;
        const float var = block_sum(dv * dv, red + 8, F.lane, F.wave) * (1.f / 512.f);
        const float y = dv * (1.0f / sqrtf(var + EPS)) * lgv + lbv;
        Y[(size_t)row * 1024 + c] = (bf16)f2bf(siluf(y) * bf2f(SZ[(size_t)row * 1024 + c]));
    }
    __syncthreads();
}
DEVI void phase_na_naive(Frame& F) {
    const bf16* Q1 = wsb(F, WS_Q1); const bf16* K1 = wsb(F, WS_K1); const bf16* V1 = wsb(F, WS_V1); const bf16* SZ1 = wsb(F, WS_SZ1); bf16* Y1 = wsb(F, WS_Y1);
    const float* rpb = F.in[I_CD_RPB];
    for (int gid = F.bid * NTHR + F.tid; gid < NB * 8 * SEQ; gid += F.G * NTHR) {
        const int l = gid & 2047, h = (gid >> 11) & 7, b = gid >> 14;
        const int r = l >> 6, qc = l & 63;
        const int rs = min(max(r - 4, 0), 24), cs = min(max(qc - 8, 0), 48);
        const int row = b * 2048 + l;
        float q[64], o[64];
        { const v4u* qp = (const v4u*)(Q1 + (size_t)row * 512 + h * 64);
#pragma unroll
          for (int c = 0; c < 8; ++c) { const v4u w = qp[c]; q[8 * c] = bflo(w.x); q[8 * c + 1] = bfhi(w.x); q[8 * c + 2] = bflo(w.y); q[8 * c + 3] = bfhi(w.y); q[8 * c + 4] = bflo(w.z); q[8 * c + 5] = bfhi(w.z); q[8 * c + 6] = bflo(w.w); q[8 * c + 7] = bfhi(w.w); } }
#pragma unroll
        for (int d = 0; d < 64; ++d) o[d] = 0.f;
        float m = -1e30f, lsum = 0.f;
        for (int kidx = 0; kidx < 128 + 256; ++kidx) {
            int tok; float bias = 0.f;
            if (kidx < 128) { const int kr = rs + (kidx >> 4), kc = cs + (kidx & 15); tok = b * 2048 + kr * 64 + kc; bias = rpb[(h * 15 + (kr - r + 7)) * 31 + (kc - qc + 15)] * LOG2E; }
            else tok = MX + b * 256 + (kidx - 128);
            const v4u* kp = (const v4u*)(K1 + (size_t)tok * 512 + h * 64);
            float s = bias;
#pragma unroll
            for (int c = 0; c < 8; ++c) { const v4u w = kp[c]; s += q[8 * c] * bflo(w.x) + q[8 * c + 1] * bfhi(w.x) + q[8 * c + 2] * bflo(w.y) + q[8 * c + 3] * bfhi(w.y) + q[8 * c + 4] * bflo(w.z) + q[8 * c + 5] * bfhi(w.z) + q[8 * c + 6] * bflo(w.w) + q[8 * c + 7] * bfhi(w.w); }
            if (s > m) { const float al = exp2f(m - s); lsum *= al;
#pragma unroll
                for (int d = 0; d < 64; ++d) o[d] *= al;
                m = s; }
            const float p = exp2f(s - m); lsum += p;
            const v4u* vp = (const v4u*)(V1 + (size_t)tok * 512 + h * 64);
#pragma unroll
            for (int c = 0; c < 8; ++c) { const v4u w = vp[c]; o[8 * c] += p * bflo(w.x); o[8 * c + 1] += p * bfhi(w.x); o[8 * c + 2] += p * bflo(w.y); o[8 * c + 3] += p * bfhi(w.y); o[8 * c + 4] += p * bflo(w.z); o[8 * c + 5] += p * bfhi(w.z); o[8 * c + 6] += p * bflo(w.w); o[8 * c + 7] += p * bfhi(w.w); }
        }
        const float il = 1.f / lsum;
        const size_t yoff = (size_t)row * 1024 + 512 + h * 64;
#pragma unroll
        for (int c = 0; c < 8; ++c) { const v4u zw = *(const v4u*)(SZ1 + yoff + 8 * c); v4u w;
            w.x = pk2(o[8 * c] * il * bflo(zw.x), o[8 * c + 1] * il * bfhi(zw.x)); w.y = pk2(o[8 * c + 2] * il * bflo(zw.y), o[8 * c + 3] * il * bfhi(zw.y));
            w.z = pk2(o[8 * c + 4] * il * bflo(zw.z), o[8 * c + 5] * il * bfhi(zw.z)); w.w = pk2(o[8 * c + 6] * il * bflo(zw.w), o[8 * c + 7] * il * bfhi(zw.w));
            *(v4u*)(Y1 + yoff + 8 * c) = w; }
    }
}
DEVI void phase_final(Frame& F) {
    const int gw = F.bid * NWAVES + F.wave, NGW = F.G * NWAVES; const float* g = F.in[I_FNG];
    for (int m = gw; m < MX; m += NGW) {
        float* xr = F.out + (size_t)m * DM; f32x4 v[4]; float ss = 0.f;
#pragma unroll
        for (int j = 0; j < 4; ++j) { v[j] = *(const f32x4*)(xr + 4 * F.lane + 256 * j); ss += (v[j].x * v[j].x + v[j].y * v[j].y) + (v[j].z * v[j].z + v[j].w * v[j].w); }
        const float rinv = 1.0f / sqrtf(wave_sum(ss) * (1.f / DM) + EPS);
#pragma unroll
        for (int j = 0; j < 4; ++j) { const f32x4 gg = *(const f32x4*)(g + 4 * F.lane + 256 * j); f32x4 o; o.x = v[j].x * rinv * gg.x; o.y = v[j].y * rinv * gg.y; o.z = v[j].z * rinv * gg.z; o.w = v[j].w * rinv * gg.w;
            *(f32x4*)(xr + 4 * F.lane + 256 * j) = o; }
    }
}

__global__ void __launch_bounds__(NTHR, 2) mk_fwd(Args args) {
    extern __shared__ __attribute__((aligned(16))) unsigned char lds[];
    Frame F;
    F.lds = (LAS unsigned char*)lds;
    F.tid = threadIdx.x; F.lane = F.tid & 63; F.wave = __builtin_amdgcn_readfirstlane(F.tid >> 6);
    F.G = gridDim.x; F.bid = blockIdx.x;
#pragma unroll
    for (int i = 0; i < 23; ++i) F.in[i] = args.in[i];
    F.out = args.out; F.ws = args.ws;
    volatile LAS unsigned* MISC = (volatile LAS unsigned*)(F.lds + MISC_OFF);
    if (F.tid < 32) MISC[F.tid] = 0u;
    __syncthreads();
    unsigned* ctl = (unsigned*)(F.ws + WS_CTL);
    XcdBarrier bar; bar.bar = ctl + CW_BAR; bar.x = 0; bar.st = nullptr;
    if (MK_N_LAUNCHES == 1) bar = xcd_barrier_post(ctl + CW_BAR, MISC + 8);
    const int lo = args.ph_lo, hi = args.ph_hi;
#define IN(k) (lo <= (k) && (k) < hi)
#define SEAM(k) do { if (IN(k) && IN((k) + 1)) xcd_barrier(bar); } while (0)

    if (IN(0)) { p0_prologue(F); } SEAM(0);
    if (IN(1)) { phase_modnorm(F, 0); phase_fold(F); } SEAM(1);
    if (IN(2)) {
        EpiIn0 E{wsb(F, WS_GLU), wsb(F, WS_Q0), wsb(F, WS_K0), wsb(F, WS_V0), wsb(F, WS_SZ0), F.in[I_AB_QNG], F.in[I_AB_KNG], wsf(F, WS_ROPE)};
        gemm_naive(F, wsb(F, WS_H), wsb(F, WS_WIN0), MT, AB_IN, DM, E, NoSkip{});
    } SEAM(2);
    if (IN(3)) { phase_attn0_naive(F); phase_conv_naive(F); } SEAM(3);
    if (IN(4)) {
        EpiOut0 E{F.in[I_X], F.in[I_CTX], wsf(F, WS_ADA), F.out, wsf(F, WS_X1C)};
        gemm_naive(F, wsb(F, WS_Y0), wsb(F, WS_WOUT0), MT, DM, DM, E, NoSkip{});
    } SEAM(4);
    if (IN(5)) { phase_modnorm(F, 1); } SEAM(5);
    if (IN(6)) {
        EpiIn1 E{wsb(F, WS_PT), wsb(F, WS_Q1), wsb(F, WS_K1), wsb(F, WS_V1), wsb(F, WS_SZ1)};
        gemm_naive(F, wsb(F, WS_H), wsb(F, WS_WIN1), MT, N1, DM, E, SkipIn1{});
    } SEAM(6);
    if (IN(7)) {
        EpiDft E{wsb(F, WS_Y1), wsb(F, WS_SZ1)};
        gemm_naive(F, wsb(F, WS_DFT), wsb(F, WS_PT), 2048, 4096, 4096, E, NoSkip{});
        phase_na_naive(F);
    } SEAM(7);
    if (IN(8)) {
        EpiOut1 E{wsf(F, WS_ADA) + 9 * 3072, F.out};
        gemm_naive(F, wsb(F, WS_Y1), wsb(F, WS_WOUT1), MX, DM, DM, E, NoSkip{});
    } SEAM(8);
    if (IN(9)) { phase_final(F); }
#undef IN
#undef SEAM
}

extern "C" void kernel_launch(void* const* d_in, const int* in_sizes, int n_in, void* d_out, int out_size, void* d_ws, size_t ws_size, hipStream_t stream) {
    static int grid = 0;
    if (grid == 0) {
        if (n_in != 23 || out_size != MX * DM || ws_size < WS_END) { fprintf(stderr, "kernel_launch: unexpected shapes (n_in %d out %d ws %zu)\n", n_in, out_size, ws_size); grid = -1; return; }
        int dev = 0, cus = 0, per_cu = 0;
        if (hipGetDevice(&dev) != hipSuccess || hipDeviceGetAttribute(&cus, hipDeviceAttributeMultiprocessorCount, dev) != hipSuccess) { grid = -1; return; }
        if (hipFuncSetAttribute((const void*)mk_fwd, hipFuncAttributeMaxDynamicSharedMemorySize, LDS_BYTES) != hipSuccess) { fprintf(stderr, "kernel_launch: hipFuncSetAttribute failed\n"); grid = -1; return; }
        if (hipOccupancyMaxActiveBlocksPerMultiprocessor(&per_cu, (const void*)mk_fwd, NTHR, LDS_BYTES) != hipSuccess || per_cu < 1) { fprintf(stderr, "kernel_launch: occupancy query says %d\n", per_cu); per_cu = 1; }
        (void)hipGetLastError();
        grid = cus;
    }
    if (grid < 0) return;
    if (hipMemsetAsync((char*)d_ws + WS_CTL, 0, CTL_ZERO_BYTES, stream) != hipSuccess) { fprintf(stderr, "kernel_launch: memset failed\n"); return; }
    Args a{};
    for (int i = 0; i < 23; ++i) a.in[i] = (const float*)d_in[i];
    a.out = (float*)d_out; a.ws = (unsigned char*)d_ws;
    for (int li = 0; li < MK_N_LAUNCHES; ++li) {
        if (MK_N_LAUNCHES == 1) { a.ph_lo = 0; a.ph_hi = NPHASES; } else { a.ph_lo = li; a.ph_hi = li + 1; }
        a.li = li;
        hipLaunchKernelGGL(mk_fwd, dim3(grid), dim3(NTHR), LDS_BYTES, stream, a);
        const hipError_t le = hipPeekAtLastError();
        if (le != hipSuccess) { fprintf(stderr, "kernel_launch: launch %d failed: %s\n", li, hipGetErrorName(le)); break; }
    }
}
```

```cpp
#include <hip/hip_runtime.h>
#include <cstdio>
#include <cstdint>

#ifndef MK_N_LAUNCHES
#define MK_N_LAUNCHES 1
#endif

#define GAS __attribute__((address_space(1)))
#define LAS __attribute__((address_space(3)))
typedef unsigned short bf16;
typedef unsigned v4u __attribute__((ext_vector_type(4)));
typedef float f32x4 __attribute__((ext_vector_type(4)));
typedef GAS unsigned gu32;
#define RLX_AGENT __ATOMIC_RELAXED, __HIP_MEMORY_SCOPE_AGENT
#define LDS_WAIT() asm volatile("s_waitcnt lgkmcnt(0)" ::: "memory")
#define DEVI __device__ __forceinline__

constexpr int NB = 8, SEQ = 2048, DM = 1024, CTXL = 256, GRIDW = 64;
constexpr int MX = NB * SEQ, MC = NB * CTXL, MT = MX + MC;
constexpr int AB_IN = 2816, CD_IN = 3072, N1 = 3584;
constexpr int NKEY0 = CTXL + SEQ;
constexpr float EPS = 1e-6f;
constexpr float LOG2E = 1.4426950408889634f, C2 = 0.125f * LOG2E;
constexpr int NWAVES = 8, NTHR = 512;
constexpr int NPHASES = 10;

constexpr size_t MiB = 1u << 20;
constexpr size_t WS_CTL = 0, CTL_ZERO_BYTES = 1 * MiB;
constexpr size_t WS_ADA = 256 * 1024;
constexpr size_t WS_ROPE = 1 * MiB;
constexpr size_t WS_MCS = 1 * MiB + 512 * 1024;
constexpr size_t WS_WIN0 = 3 * MiB, WS_WOUT0 = 9 * MiB, WS_WIN1 = 11 * MiB, WS_WOUT1 = 18 * MiB;
constexpr size_t WS_DFT = 20 * MiB;
constexpr size_t WS_H = 36 * MiB;
constexpr size_t WS_X1C = 72 * MiB;
constexpr size_t WS_R = 80 * MiB;
constexpr size_t WS_GLU = WS_R, WS_Q0 = WS_R + 18 * MiB, WS_K0 = WS_R + 36 * MiB, WS_V0 = WS_K0 + 4608 * 1024, WS_SZ0 = WS_R + 45 * MiB, WS_Y0 = WS_R + 81 * MiB;
constexpr size_t WS_PT = WS_R, WS_Q1 = WS_R + 32 * MiB, WS_K1 = WS_R + 48 * MiB, WS_V1 = WS_R + 66 * MiB, WS_SZ1 = WS_R + 84 * MiB, WS_Y1 = WS_R + 116 * MiB;
constexpr size_t WS_END = WS_R + 148 * MiB;
static_assert(WS_END <= 256 * MiB, "d_ws map");
constexpr int CW_BAR = 4096;

constexpr int LDS_BYTES = 147456;
constexpr int MISC_OFF = 131072 + 320;

DEVI unsigned f2bf(float f) { unsigned u = __builtin_bit_cast(unsigned, f); return (u + 0x7fffu + ((u >> 16) & 1u)) >> 16; }
DEVI unsigned pk2(float lo, float hi) { return f2bf(lo) | (f2bf(hi) << 16); }
DEVI float bf2f(unsigned b) { return __builtin_bit_cast(float, (b & 0xffffu) << 16); }
DEVI float bflo(unsigned w) { return __builtin_bit_cast(float, w << 16); }
DEVI float bfhi(unsigned w) { return __builtin_bit_cast(float, w & 0xffff0000u); }
DEVI float siluf(float v) { return v / (1.f + expf(-v)); }
DEVI float sigmf(float v) { return 1.f / (1.f + expf(-v)); }
DEVI float wave_sum(float v) {
#pragma unroll
    for (int o = 1; o < 64; o <<= 1) v += __shfl_xor(v, o);
    return v;
}

#define XB_TMO      128
#define XB_XCNT(j)  (256  + 64 * (j))
#define XB_XSUB(j)  (1280 + 64 * (j))
#define XB_XGEN(j)  (2304 + 64 * (j))
#define XB_TOP      3328
#define XB_TOPGEN   3392
#define XCD_BAR_WORDS 3456
#define XB_SPIN_CAP (1u << 22)
DEVI unsigned xb_ld(unsigned* p)              { return __hip_atomic_load(p, __ATOMIC_RELAXED, __HIP_MEMORY_SCOPE_AGENT); }
DEVI unsigned xb_add(unsigned* p, unsigned v) { return __hip_atomic_fetch_add(p, v, __ATOMIC_RELAXED, __HIP_MEMORY_SCOPE_AGENT); }
DEVI unsigned xb_xcc_id() { return (unsigned)__builtin_amdgcn_s_getreg((3 << 11) | 20) & 0xFu; }
#define XB_SPIN(cond, bar) do { unsigned _sp = 0; while (cond) { __builtin_amdgcn_s_sleep(1); \
    if ((++_sp & 255u) == 0u) { if (xb_ld(&(bar)[XB_TMO])) break; if (_sp > XB_SPIN_CAP) { atomicAdd(&(bar)[XB_TMO], 1u); break; } } } } while (0)
struct XcdBarrier { unsigned* bar; unsigned x; volatile LAS unsigned* st; };
DEVI XcdBarrier xcd_barrier_post(unsigned* bar, volatile LAS unsigned* st) {
    XcdBarrier b; b.bar = bar; b.x = xb_xcc_id(); b.st = st;
    if (threadIdx.x == 0) (void)xb_add(&bar[XB_XCNT(b.x)], 1u);
    return b;
}
DEVI void xcd_barrier_complete(unsigned* bar, unsigned x, unsigned& nloc, unsigned& nx) {
    const unsigned G = gridDim.x * gridDim.y * gridDim.z;
    unsigned sum, cnt, mine, sp = 0u;
    for (;;) {
        sum = 0u; cnt = 0u; mine = 0u;
#pragma unroll
        for (unsigned j = 0; j < 16; ++j) { const unsigned c = xb_ld(&bar[XB_XCNT(j)]); sum += c; cnt += (c > 0u) ? 1u : 0u; mine = (j == x) ? c : mine; }
        if (sum == G) break;
        __builtin_amdgcn_s_sleep(1);
        if ((++sp & 255u) == 0u) { if (xb_ld(&bar[XB_TMO])) break; if (sp > XB_SPIN_CAP) { atomicAdd(&bar[XB_TMO], 1u); break; } }
    }
    nloc = mine > 0u ? mine : 1u; nx = cnt > 0u ? cnt : 1u;
}
DEVI void xcd_barrier(const XcdBarrier& b) {
    asm volatile("s_waitcnt vmcnt(0)" ::: "memory");
    __syncthreads();
    if (threadIdx.x == 0) {
        unsigned* bar = b.bar;
        __builtin_amdgcn_s_waitcnt(0);
        unsigned nloc = b.st[0], nx = b.st[1];
        if (nloc == 0u) { xcd_barrier_complete(bar, b.x, nloc, nx); b.st[0] = nloc; b.st[1] = nx; }
        const unsigned old = xb_add(&bar[XB_XSUB(b.x)], 1u);
        const unsigned gen = old / nloc;
        if (old + 1u == (gen + 1u) * nloc) {
            __builtin_amdgcn_fence(__ATOMIC_RELEASE, "agent");
            asm volatile("s_waitcnt vmcnt(0)" ::: "memory");
            const unsigned og = xb_add(&bar[XB_TOP], 1u);
            const unsigned tg = og / nx;
            if (og + 1u == (tg + 1u) * nx) xb_add(&bar[XB_TOPGEN], 1u);
            else XB_SPIN(xb_ld(&bar[XB_TOPGEN]) == tg, bar);
            __builtin_amdgcn_fence(__ATOMIC_ACQUIRE, "agent");
            xb_add(&bar[XB_XGEN(b.x)], 1u);
            asm volatile("s_waitcnt vmcnt(0)" ::: "memory");
        } else {
            XB_SPIN(xb_ld(&bar[XB_XGEN(b.x)]) == gen, bar);
            __builtin_amdgcn_fence(__ATOMIC_ACQUIRE, "agent");
            asm volatile("s_waitcnt vmcnt(0)" ::: "memory");
        }
    }
    __syncthreads();
}

struct Args { const float* in[23]; float* out; unsigned char* ws; int ph_lo, ph_hi, li, pad; };
enum { I_X = 0, I_C, I_CTX, I_CCTX, I_AB_WADA, I_AB_BADA, I_AB_NORMG, I_AB_WIN, I_AB_CONVW, I_AB_CONVB, I_AB_LNG, I_AB_LNB, I_AB_QNG, I_AB_KNG, I_AB_WOUT,
       I_CD_WADA, I_CD_BADA, I_CD_NORMG, I_CD_WIN, I_CD_WF, I_CD_RPB, I_CD_WOUT, I_FNG };

struct Frame {
    LAS unsigned char* lds;
    int tid, lane, wave, G, bid;
    const float* in[23]; float* out; unsigned char* ws;
};
DEVI bf16* wsb(const Frame& F, size_t off) { return (bf16*)(F.ws + off); }
DEVI float* wsf(const Frame& F, size_t off) { return (float*)(F.ws + off); }

DEVI float block_sum(float v, LAS float* red, int lane, int wave) {
    v = wave_sum(v);
    __syncthreads();
    if (lane == 0) red[wave] = v;
    __syncthreads();
    float s = 0.f;
#pragma unroll
    for (int i = 0; i < NWAVES; ++i) s += red[i];
    return s;
}

template <class Map>
DEVI void transpose_item(const float* W, int ldw, int c0, int ncols, int K, bf16* WT, Map map32, LAS float* scr, int item, int lane) {
    const int nblk = ncols / 32, kb = item / nblk, nb = item % nblk, k0 = 64 * kb, n0 = 32 * nb;
#pragma unroll 8
    for (int i = 0; i < 32; ++i) { const int kk = 2 * i + (lane >> 5); scr[kk * 33 + (lane & 31)] = W[(size_t)(k0 + kk) * ldw + c0 + n0 + (lane & 31)]; }
    LDS_WAIT(); asm volatile("" ::: "memory");
    const int c = lane & 7;
    const int drow0 = map32(nb) * 32;
#pragma unroll
    for (int j = 0; j < 4; ++j) { const int n = (lane >> 3) + 8 * j; const LAS float* s = scr + (8 * c) * 33 + n;
        v4u o; o.x = pk2(s[0 * 33], s[1 * 33]); o.y = pk2(s[2 * 33], s[3 * 33]); o.z = pk2(s[4 * 33], s[5 * 33]); o.w = pk2(s[6 * 33], s[7 * 33]);
        *(v4u*)(WT + (size_t)(drow0 + n) * K + k0 + 8 * c) = o; }
    LDS_WAIT(); asm volatile("" ::: "memory");
}
struct MapId { int off; DEVI int operator()(int nb) const { return nb + off; } };
struct MapIn0 { DEVI int operator()(int nb) const {
    if (nb < 32) { const int isg = nb >> 4, cb = nb & 15;
                   const int t = cb >> 1, h = cb & 1; return t * 4 + isg * 2 + h; }
    return nb; } };

DEVI void p0_prologue(Frame& F) {
    LAS float* scr = (LAS float*)(F.lds + F.wave * 16384);
    const int gw = F.bid * NWAVES + F.wave, NGW = F.G * NWAVES;
    constexpr int I0 = 16 * (AB_IN / 32), I1 = 16 * 32, I2 = 16 * ((CD_IN - 512) / 32), I3 = 16 * 32;
    for (int it = gw; it < I0 + I1 + I2 + I3; it += NGW) {
        int r = it;
        if (r < I0) { transpose_item(F.in[I_AB_WIN], AB_IN, 0, AB_IN, DM, wsb(F, WS_WIN0), MapIn0{}, scr, r, F.lane); continue; } r -= I0;
        if (r < I1) { transpose_item(F.in[I_AB_WOUT], DM, 0, DM, DM, wsb(F, WS_WOUT0), MapId{0}, scr, r, F.lane); continue; } r -= I1;
        if (r < I2) { transpose_item(F.in[I_CD_WIN], CD_IN, 512, CD_IN - 512, DM, wsb(F, WS_WIN1), MapId{32}, scr, r, F.lane); continue; } r -= I2;
        transpose_item(F.in[I_CD_WOUT], DM, 0, DM, DM, wsb(F, WS_WOUT1), MapId{0}, scr, r, F.lane);
    }
    __syncthreads();
    {
        LAS float* sl = (LAS float*)F.lds;
        for (int i = F.tid; i < 9 * 1024; i += NTHR) { const int r = i >> 10, k = i & 1023; const float cv = (r < 8) ? F.in[I_C][r * 1024 + k] : F.in[I_CCTX][k]; sl[i] = siluf(cv); }
        __syncthreads();
        float* ada = wsf(F, WS_ADA);
        for (int it = gw; it < 2 * 48 * 8; it += NGW) {
            const int l = it / 384, rem = it % 384, cc = rem >> 3, kc = rem & 7;
            const float* W = l ? F.in[I_CD_WADA] : F.in[I_AB_WADA]; const float* bb = l ? F.in[I_CD_BADA] : F.in[I_AB_BADA];
            const int col = cc * 64 + F.lane;
            float s[9];
#pragma unroll
            for (int r = 0; r < 9; ++r) s[r] = 0.f;
            for (int k = kc * 128; k < kc * 128 + 128; ++k) { const float w = W[(size_t)k * 3072 + col];
#pragma unroll
                for (int r = 0; r < 9; ++r) s[r] += sl[r * 1024 + k] * w; }
            const float bv = (kc == 0) ? bb[col] : 0.f;
#pragma unroll
            for (int r = 0; r < 9; ++r) atomicAdd(&ada[(l * 9 + r) * 3072 + col], s[r] + bv);
        }
        __syncthreads();
    }
    {
        float* rope = wsf(F, WS_ROPE);
        for (int i = F.bid * NTHR + F.tid; i < SEQ * 32; i += F.G * NTHR) {
            const int t = i >> 5, p = i & 31; const int fi = p & 15;
            const float inv = (float)pow(10000.0, -(double)fi / 16.0);
            const float pos = (float)((p < 16) ? (t / GRIDW) : (t % GRIDW));
            const float ang = pos * inv;
            rope[2 * i] = (float)cos((double)ang); rope[2 * i + 1] = (float)sin((double)ang);
        }
    }
    {
        LAS float* t128 = (LAS float*)F.lds;
        if (F.tid < 128) { t128[F.tid] = (float)cospi((double)F.tid / 64.0); t128[128 + F.tid] = (float)sinpi((double)F.tid / 64.0); }
        __syncthreads();
        float* mcs = wsf(F, WS_MCS); const float* wf = F.in[I_CD_WF];
        for (int i = F.bid * NTHR + F.tid; i < 2 * 4 * 128 * 128; i += F.G * NTHR) {
            const int e = i & 127, c = (i >> 7) & 127, g = (i >> 14) & 3, cs = i >> 16;
            float s = 0.f;
            for (int cp = 0; cp < 128; ++cp) s += t128[cs * 128 + ((c * cp) & 127)] * wf[(g * 128 + cp) * 128 + e];
            mcs[i] = s * (1.f / 512.f);
        }
        __syncthreads();
    }
    {
        LAS float* t2k = (LAS float*)F.lds;
        for (int i = F.tid; i < 2048; i += NTHR) { t2k[i] = (float)cospi((double)i / 1024.0); t2k[2048 + i] = (float)sinpi((double)i / 1024.0); }
        __syncthreads();
        bf16* A = wsb(F, WS_DFT);
        for (int i = F.bid * NTHR + F.tid; i < 2048 * 512; i += F.G * NTHR) {
            const int lp = i >> 9, k0 = (i & 511) * 8; float v[8];
#pragma unroll
            for (int j = 0; j < 8; ++j) { const int k = k0 + j; const int idx = (lp * (k & 2047)) & 2047; v[j] = (k < 2048) ? t2k[idx] : -t2k[2048 + idx]; }
            v4u o; o.x = pk2(v[0], v[1]); o.y = pk2(v[2], v[3]); o.z = pk2(v[4], v[5]); o.w = pk2(v[6], v[7]);
            *(v4u*)(A + (size_t)lp * 4096 + k0) = o;
        }
        __syncthreads();
    }
}

DEVI void modnorm_row(const float* xrow, bf16* orow, const float* g, const float* shift, const float* scale, int lane) {
    f32x4 v[4]; float ss = 0.f;
#pragma unroll
    for (int j = 0; j < 4; ++j) { v[j] = *(const f32x4*)(xrow + 4 * lane + 256 * j); ss += (v[j].x * v[j].x + v[j].y * v[j].y) + (v[j].z * v[j].z + v[j].w * v[j].w); }
    const float rinv = 1.0f / sqrtf(wave_sum(ss) * (1.f / DM) + EPS);
#pragma unroll
    for (int j = 0; j < 4; ++j) {
        const int c = 4 * lane + 256 * j;
        const f32x4 gg = *(const f32x4*)(g + c), sh = *(const f32x4*)(shift + c), sc = *(const f32x4*)(scale + c);
        const float o0 = v[j].x * rinv * gg.x * (1.f + sc.x) + sh.x, o1 = v[j].y * rinv * gg.y * (1.f + sc.y) + sh.y;
        const float o2 = v[j].z * rinv * gg.z * (1.f + sc.z) + sh.z, o3 = v[j].w * rinv * gg.w * (1.f + sc.w) + sh.w;
        *(unsigned long long*)(orow + c) = (unsigned long long)pk2(o0, o1) | ((unsigned long long)pk2(o2, o3) << 32);
    }
}
DEVI void phase_modnorm(Frame& F, int layer) {
    const int gw = F.bid * NWAVES + F.wave, NGW = F.G * NWAVES;
    const float* ada = wsf(F, WS_ADA) + layer * 9 * 3072;
    const float* g = layer ? F.in[I_CD_NORMG] : F.in[I_AB_NORMG];
    bf16* H = wsb(F, WS_H);
    for (int m = gw; m < MT; m += NGW) {
        const float* xr; int r;
        if (m < MX) { r = m >> 11; xr = (layer ? (const float*)F.out : F.in[I_X]) + (size_t)m * DM; }
        else { r = 8; xr = (layer ? (const float*)wsf(F, WS_X1C) : F.in[I_CTX]) + (size_t)(m - MX) * DM; }
        modnorm_row(xr, H + (size_t)m * DM, g, ada + r * 3072, ada + r * 3072 + 1024, F.lane);
    }
}
DEVI void phase_fold(Frame& F) {
    const float* mcs = wsf(F, WS_MCS); const float* W = F.in[I_CD_WIN]; bf16* WT = wsb(F, WS_WIN1);
    for (int i = F.bid * NTHR + F.tid; i < 1024 * 128; i += F.G * NTHR) {
        const int k0 = (i & 127) * 8, jj = i >> 7; const int cs = jj >> 9, g = (jj >> 7) & 3, e = jj & 127;
        float s[8];
#pragma unroll
        for (int j = 0; j < 8; ++j) s[j] = 0.f;
        const float* mp = mcs + ((size_t)(cs * 4 + g) * 128) * 128 + e;
        for (int c = 0; c < 128; ++c) { const float mv = mp[c * 128];
#pragma unroll
            for (int j = 0; j < 8; ++j) s[j] += W[(size_t)(k0 + j) * CD_IN + g * 128 + c] * mv; }
        v4u o; o.x = pk2(s[0], s[1]); o.y = pk2(s[2], s[3]); o.z = pk2(s[4], s[5]); o.w = pk2(s[6], s[7]);
        *(v4u*)(WT + (size_t)jj * DM + k0) = o;
    }
}

template <class Epi, class Skip>
DEVI void gemm_naive(Frame& F, const bf16* A, const bf16* Bt, int M, int N, int K, const Epi& epi, const Skip& skip) {
    LAS float* As = (LAS float*)F.lds; LAS float* Bs = As + 128 * 33;
    const int tx = F.tid & 31, ty = F.tid >> 5;
    const int ntn = N / 128, ntiles = (M / 128) * ntn;
    for (int t = F.bid; t < ntiles; t += F.G) {
        const int tm = t / ntn, tn = t % ntn;
        if (skip(tm, tn)) continue;
        float acc[8][4];
#pragma unroll
        for (int i = 0; i < 8; ++i)
#pragma unroll
            for (int j = 0; j < 4; ++j) acc[i][j] = 0.f;
        const int lr = F.tid >> 2, lk = (F.tid & 3) * 8;
        const bf16* ap = A + (size_t)(tm * 128 + lr) * K + lk;
        const bf16* bp = Bt + (size_t)(tn * 128 + lr) * K + lk;
        for (int k0 = 0; k0 < K; k0 += 32) {
            const v4u av = *(const v4u*)(ap + k0), bv = *(const v4u*)(bp + k0);
            __syncthreads();
            LAS float* ad = As + lr * 33 + lk; LAS float* bd = Bs + lr * 33 + lk;
            ad[0] = bflo(av.x); ad[1] = bfhi(av.x); ad[2] = bflo(av.y); ad[3] = bfhi(av.y); ad[4] = bflo(av.z); ad[5] = bfhi(av.z); ad[6] = bflo(av.w); ad[7] = bfhi(av.w);
            bd[0] = bflo(bv.x); bd[1] = bfhi(bv.x); bd[2] = bflo(bv.y); bd[3] = bfhi(bv.y); bd[4] = bflo(bv.z); bd[5] = bfhi(bv.z); bd[6] = bflo(bv.w); bd[7] = bfhi(bv.w);
            __syncthreads();
#pragma unroll 8
            for (int k = 0; k < 32; ++k) {
                float a[8], b[4];
#pragma unroll
                for (int i = 0; i < 8; ++i) a[i] = As[(ty * 8 + i) * 33 + k];
#pragma unroll
                for (int j = 0; j < 4; ++j) b[j] = Bs[(tx * 4 + j) * 33 + k];
#pragma unroll
                for (int i = 0; i < 8; ++i)
#pragma unroll
                    for (int j = 0; j < 4; ++j) acc[i][j] += a[i] * b[j];
            }
        }
        epi(tm * 128 + ty * 8, tn * 128 + tx * 4, acc);
    }
    __syncthreads();
}
struct NoSkip { DEVI bool operator()(int, int) const { return false; } };

DEVI void row_info(int row, int& b, int& key, bool& isx) {
    if (row < MX) { b = row >> 11; key = CTXL + (row & 2047); isx = true; }
    else { const int rc = row - MX; b = rc >> 8; key = rc & 255; isx = false; }
}

struct EpiIn0 {
    bf16 *GLU, *Q0, *K0, *V0, *SZ; const float *qng, *kng, *rope;
    DEVI void operator()(int row0, int col0, float (&acc)[8][4]) const {
        const int tn = col0 >> 7, cl = col0 & 127;
        if (tn < 8) {
#pragma unroll
            for (int i = 0; i < 8; ++i) {
                float o[4];
#pragma unroll
                for (int j = 0; j < 4; ++j) { const float pr = __shfl_xor(acc[i][j], 16); o[j] = acc[i][j] * sigmf(pr); }
                if (cl < 64) *(unsigned long long*)(GLU + (size_t)(row0 + i) * 512 + tn * 64 + cl) = (unsigned long long)pk2(o[0], o[1]) | ((unsigned long long)pk2(o[2], o[3]) << 32);
            }
        } else if (tn < 13) {
            const bool isq = tn < 12; const int d0 = cl & 63; const float* gn = isq ? qng : kng;
#pragma unroll
            for (int i = 0; i < 8; ++i) {
                const int row = row0 + i; int b, key; bool isx; row_info(row, b, key, isx);
                float ss = acc[i][0] * acc[i][0] + acc[i][1] * acc[i][1] + acc[i][2] * acc[i][2] + acc[i][3] * acc[i][3];
                ss += __shfl_xor(ss, 1); ss += __shfl_xor(ss, 2); ss += __shfl_xor(ss, 4); ss += __shfl_xor(ss, 8);
                const float rinv = 1.0f / sqrtf(ss * (1.f / 64.f) + EPS);
                float v[4];
#pragma unroll
                for (int j = 0; j < 4; ++j) v[j] = acc[i][j] * rinv * gn[d0 + j];
                if (isx) { const int l = row & 2047;
#pragma unroll
                    for (int p = 0; p < 2; ++p) { const int pi = (d0 >> 1) + p; const float cs = rope[(l * 32 + pi) * 2], sn = rope[(l * 32 + pi) * 2 + 1];
                        const float a = v[2 * p], bq = v[2 * p + 1]; v[2 * p] = a * cs - bq * sn; v[2 * p + 1] = a * sn + bq * cs; } }
                if (isq) { const int head = (tn - 8) * 2 + (cl >> 6);
                    *(unsigned long long*)(Q0 + (size_t)row * 512 + head * 64 + d0) = (unsigned long long)pk2(v[0] * C2, v[1] * C2) | ((unsigned long long)pk2(v[2] * C2, v[3] * C2) << 32); }
                else { const int kvh = cl >> 6;
                    *(unsigned long long*)(K0 + ((size_t)b * NKEY0 + key) * 128 + kvh * 64 + d0) = (unsigned long long)pk2(v[0], v[1]) | ((unsigned long long)pk2(v[2], v[3]) << 32); }
            }
        } else if (tn == 13) {
#pragma unroll
            for (int i = 0; i < 8; ++i) { const int row = row0 + i; int b, key; bool isx; row_info(row, b, key, isx);
                *(unsigned long long*)(V0 + ((size_t)b * NKEY0 + key) * 128 + cl) = (unsigned long long)pk2(acc[i][0], acc[i][1]) | ((unsigned long long)pk2(acc[i][2], acc[i][3]) << 32); }
        } else {
            const int c = (tn - 14) * 128 + cl;
#pragma unroll
            for (int i = 0; i < 8; ++i)
                *(unsigned long long*)(SZ + (size_t)(row0 + i) * 1024 + c) = (unsigned long long)pk2(siluf(acc[i][0]), siluf(acc[i][1])) | ((unsigned long long)pk2(siluf(acc[i][2]), siluf(acc[i][3])) << 32);
        }
    }
};
struct EpiOut0 { const float *x, *ctx, *ada; float *o_x, *o_c;
    DEVI void operator()(int row0, int col0, float (&acc)[8][4]) const {
#pragma unroll
        for (int i = 0; i < 8; ++i) { const int row = row0 + i; const bool isx = row < MX; const int r = isx ? (row >> 11) : 8;
            const float* xin = isx ? x + (size_t)row * DM : ctx + (size_t)(row - MX) * DM; float* op = isx ? o_x + (size_t)row * DM : o_c + (size_t)(row - MX) * DM;
            const f32x4 xv = *(const f32x4*)(xin + col0), gv = *(const f32x4*)(ada + r * 3072 + 2048 + col0);
            f32x4 o; o.x = xv.x + gv.x * acc[i][0]; o.y = xv.y + gv.y * acc[i][1]; o.z = xv.z + gv.z * acc[i][2]; o.w = xv.w + gv.w * acc[i][3];
            *(f32x4*)(op + col0) = o; }
    } };
struct EpiOut1 { const float* ada; float* o_x;
    DEVI void operator()(int row0, int col0, float (&acc)[8][4]) const {
#pragma unroll
        for (int i = 0; i < 8; ++i) { const int row = row0 + i; const int r = row >> 11; float* op = o_x + (size_t)row * DM + col0;
            const f32x4 xv = *(const f32x4*)op, gv = *(const f32x4*)(ada + r * 3072 + 2048 + col0);
            f32x4 o; o.x = xv.x + gv.x * acc[i][0]; o.y = xv.y + gv.y * acc[i][1]; o.z = xv.z + gv.z * acc[i][2]; o.w = xv.w + gv.w * acc[i][3];
            *(f32x4*)op = o; }
    } };
struct EpiIn1 { bf16 *PT, *Q1, *K1, *V1, *SZ1;
    DEVI void operator()(int row0, int col0, float (&acc)[8][4]) const {
        const int tn = col0 >> 7;
#pragma unroll
        for (int i = 0; i < 8; ++i) { const int row = row0 + i;
            if (tn < 8) { const int b = row >> 11, l = row & 2047;
#pragma unroll
                for (int j = 0; j < 4; ++j) { const int jj = col0 + j, cs = jj >> 9, jc = jj & 511; PT[((size_t)(b * 512 + jc) * 2 + cs) * 2048 + l] = (bf16)f2bf(acc[i][j]); } }
            else if (tn < 12) *(unsigned long long*)(Q1 + (size_t)row * 512 + (col0 - 1024)) = (unsigned long long)pk2(acc[i][0] * C2, acc[i][1] * C2) | ((unsigned long long)pk2(acc[i][2] * C2, acc[i][3] * C2) << 32);
            else if (tn < 16) *(unsigned long long*)(K1 + (size_t)row * 512 + (col0 - 1536)) = (unsigned long long)pk2(acc[i][0], acc[i][1]) | ((unsigned long long)pk2(acc[i][2], acc[i][3]) << 32);
            else if (tn < 20) *(unsigned long long*)(V1 + (size_t)row * 512 + (col0 - 2048)) = (unsigned long long)pk2(acc[i][0], acc[i][1]) | ((unsigned long long)pk2(acc[i][2], acc[i][3]) << 32);
            else *(unsigned long long*)(SZ1 + (size_t)row * 1024 + (col0 - 2560)) = (unsigned long long)pk2(siluf(acc[i][0]), siluf(acc[i][1])) | ((unsigned long long)pk2(siluf(acc[i][2]), siluf(acc[i][3])) << 32);
        }
    } };
struct SkipIn1 { DEVI bool operator()(int tm, int tn) const { return tm >= MX / 128 && (tn < 12 || tn >= 20); } };
struct EpiDft { bf16* Y1; const bf16* SZ1;
    DEVI void operator()(int row0, int col0, float (&acc)[8][4]) const {
        const int b = col0 >> 9, j = col0 & 511;
#pragma unroll
        for (int i = 0; i < 8; ++i) { const size_t off = (size_t)(b * 2048 + row0 + i) * 1024 + j;
            const unsigned long long z = *(const unsigned long long*)(SZ1 + off); const unsigned zl = (unsigned)z, zh = (unsigned)(z >> 32);
            *(unsigned long long*)(Y1 + off) = (unsigned long long)pk2(acc[i][0] * bflo(zl), acc[i][1] * bfhi(zl)) | ((unsigned long long)pk2(acc[i][2] * bflo(zh), acc[i][3] * bfhi(zh)) << 32); }
    } };

DEVI void phase_attn0_naive(Frame& F) {
    LAS float* Ks = (LAS float*)F.lds; LAS float* Vs = Ks + 64 * 64;
    const bf16* Q0 = wsb(F, WS_Q0); const bf16* K0 = wsb(F, WS_K0); const bf16* V0 = wsb(F, WS_V0); const bf16* SZ = wsb(F, WS_SZ0); bf16* Y = wsb(F, WS_Y0);
    for (int it = F.bid; it < 256 + 32; it += F.G) {
        int b, kvh, row0, nkeys;
        if (it < 256) { b = it >> 5; kvh = (it >> 4) & 1; row0 = b * 2048 + (it & 15) * 128; nkeys = NKEY0; }
        else { const int jt = it - 256; b = jt >> 2; kvh = (jt >> 1) & 1; row0 = MX + b * 256 + (jt & 1) * 128; nkeys = CTXL; }
        const int g = F.tid >> 7, qi = F.tid & 127, head = kvh * 4 + g, row = row0 + qi;
        float q[64], o[64];
        { const v4u* qp = (const v4u*)(Q0 + (size_t)row * 512 + head * 64);
#pragma unroll
          for (int c = 0; c < 8; ++c) { const v4u w = qp[c]; q[8 * c] = bflo(w.x); q[8 * c + 1] = bfhi(w.x); q[8 * c + 2] = bflo(w.y); q[8 * c + 3] = bfhi(w.y); q[8 * c + 4] = bflo(w.z); q[8 * c + 5] = bfhi(w.z); q[8 * c + 6] = bflo(w.w); q[8 * c + 7] = bfhi(w.w); } }
#pragma unroll
        for (int d = 0; d < 64; ++d) o[d] = 0.f;
        float m = -1e30f, l = 0.f;
        const int lk = F.tid >> 3, lc = (F.tid & 7) * 8;
        for (int k0 = 0; k0 < nkeys; k0 += 64) {
            const size_t goff = ((size_t)b * NKEY0 + k0 + lk) * 128 + kvh * 64 + lc;
            const v4u kw = *(const v4u*)(K0 + goff), vw = *(const v4u*)(V0 + goff);
            __syncthreads();
            { LAS float* kd = Ks + lk * 64 + lc; LAS float* vd = Vs + lk * 64 + lc;
              kd[0] = bflo(kw.x); kd[1] = bfhi(kw.x); kd[2] = bflo(kw.y); kd[3] = bfhi(kw.y); kd[4] = bflo(kw.z); kd[5] = bfhi(kw.z); kd[6] = bflo(kw.w); kd[7] = bfhi(kw.w);
              vd[0] = bflo(vw.x); vd[1] = bfhi(vw.x); vd[2] = bflo(vw.y); vd[3] = bfhi(vw.y); vd[4] = bflo(vw.z); vd[5] = bfhi(vw.z); vd[6] = bflo(vw.w); vd[7] = bfhi(vw.w); }
            __syncthreads();
            for (int kk = 0; kk < 64; ++kk) {
                const LAS f32x4* kp = (const LAS f32x4*)(Ks + kk * 64);
                float s = 0.f;
#pragma unroll
                for (int c = 0; c < 16; ++c) { const f32x4 kv = kp[c]; s += q[4 * c] * kv.x + q[4 * c + 1] * kv.y + q[4 * c + 2] * kv.z + q[4 * c + 3] * kv.w; }
                if (s > m) { const float al = exp2f(m - s); l *= al;
#pragma unroll
                    for (int d = 0; d < 64; ++d) o[d] *= al;
                    m = s; }
                const float p = exp2f(s - m); l += p;
                const LAS f32x4* vp = (const LAS f32x4*)(Vs + kk * 64);
#pragma unroll
                for (int c = 0; c < 16; ++c) { const f32x4 vv = vp[c]; o[4 * c] += p * vv.x; o[4 * c + 1] += p * vv.y; o[4 * c + 2] += p * vv.z; o[4 * c + 3] += p * vv.w; }
            }
        }
        const float il = 1.f / l;
        const size_t yoff = (size_t)row * 1024 + 512 + head * 64;
#pragma unroll
        for (int c = 0; c < 8; ++c) { const v4u zw = *(const v4u*)(SZ + yoff + 8 * c); v4u w;
            w.x = pk2(o[8 * c] * il * bflo(zw.x), o[8 * c + 1] * il * bfhi(zw.x)); w.y = pk2(o[8 * c + 2] * il * bflo(zw.y), o[8 * c + 3] * il * bfhi(zw.y));
            w.z = pk2(o[8 * c + 4] * il * bflo(zw.z), o[8 * c + 5] * il * bfhi(zw.z)); w.w = pk2(o[8 * c + 6] * il * bflo(zw.w), o[8 * c + 7] * il * bfhi(zw.w));
            *(v4u*)(Y + yoff + 8 * c) = w; }
        __syncthreads();
    }
}
DEVI void phase_conv_naive(Frame& F) {
    LAS float* red = (LAS float*)(F.lds + 65536);
    const bf16* GLU = wsb(F, WS_GLU); const bf16* SZ = wsb(F, WS_SZ0); bf16* Y = wsb(F, WS_Y0);
    const float* cw = F.in[I_AB_CONVW]; const float* cb = F.in[I_AB_CONVB]; const float* lg = F.in[I_AB_LNG]; const float* lb = F.in[I_AB_LNB];
    const int c = F.tid;
    float w[31];
#pragma unroll
    for (int t = 0; t < 31; ++t) w[t] = cw[t * 512 + c];
    const float cbv = cb[c], lgv = lg[c], lbv = lb[c];
    for (int row = F.bid; row < MT; row += F.G) {
        int base, len, pos;
        if (row < MX) { base = row & ~2047; len = SEQ; pos = row & 2047; } else { const int rc = row - MX; base = MX + (rc & ~255); len = CTXL; pos = rc & 255; }
        float u = cbv;
#pragma unroll
        for (int t = 0; t < 31; ++t) { const int p = pos + t - 15; if (p >= 0 && p < len) u += bf2f(GLU[(size_t)(base + p) * 512 + c]) * w[t]; }
        const float mean = block_sum(u, red, F.lane, F.wave) * (1.f / 512.f);
        const float dv = u - mean;
        const float var = block_sum(dv * dv, red + 8, F.lane, F.wave) * (1.f / 512.f);
        const float y = dv * (1.0f / sqrtf(var + EPS)) * lgv + lbv;
        Y[(size_t)row * 1024 + c] = (bf16)f2bf(siluf(y) * bf2f(SZ[(size_t)row * 1024 + c]));
    }
    __syncthreads();
}
DEVI void phase_na_naive(Frame& F) {
    const bf16* Q1 = wsb(F, WS_Q1); const bf16* K1 = wsb(F, WS_K1); const bf16* V1 = wsb(F, WS_V1); const bf16* SZ1 = wsb(F, WS_SZ1); bf16* Y1 = wsb(F, WS_Y1);
    const float* rpb = F.in[I_CD_RPB];
    for (int gid = F.bid * NTHR + F.tid; gid < NB * 8 * SEQ; gid += F.G * NTHR) {
        const int l = gid & 2047, h = (gid >> 11) & 7, b = gid >> 14;
        const int r = l >> 6, qc = l & 63;
        const int rs = min(max(r - 4, 0), 24), cs = min(max(qc - 8, 0), 48);
        const int row = b * 2048 + l;
        float q[64], o[64];
        { const v4u* qp = (const v4u*)(Q1 + (size_t)row * 512 + h * 64);
#pragma unroll
          for (int c = 0; c < 8; ++c) { const v4u w = qp[c]; q[8 * c] = bflo(w.x); q[8 * c + 1] = bfhi(w.x); q[8 * c + 2] = bflo(w.y); q[8 * c + 3] = bfhi(w.y); q[8 * c + 4] = bflo(w.z); q[8 * c + 5] = bfhi(w.z); q[8 * c + 6] = bflo(w.w); q[8 * c + 7] = bfhi(w.w); } }
#pragma unroll
        for (int d = 0; d < 64; ++d) o[d] = 0.f;
        float m = -1e30f, lsum = 0.f;
        for (int kidx = 0; kidx < 128 + 256; ++kidx) {
            int tok; float bias = 0.f;
            if (kidx < 128) { const int kr = rs + (kidx >> 4), kc = cs + (kidx & 15); tok = b * 2048 + kr * 64 + kc; bias = rpb[(h * 15 + (kr - r + 7)) * 31 + (kc - qc + 15)] * LOG2E; }
            else tok = MX + b * 256 + (kidx - 128);
            const v4u* kp = (const v4u*)(K1 + (size_t)tok * 512 + h * 64);
            float s = bias;
#pragma unroll
            for (int c = 0; c < 8; ++c) { const v4u w = kp[c]; s += q[8 * c] * bflo(w.x) + q[8 * c + 1] * bfhi(w.x) + q[8 * c + 2] * bflo(w.y) + q[8 * c + 3] * bfhi(w.y) + q[8 * c + 4] * bflo(w.z) + q[8 * c + 5] * bfhi(w.z) + q[8 * c + 6] * bflo(w.w) + q[8 * c + 7] * bfhi(w.w); }
            if (s > m) { const float al = exp2f(m - s); lsum *= al;
#pragma unroll
                for (int d = 0; d < 64; ++d) o[d] *= al;
                m = s; }
            const float p = exp2f(s - m); lsum += p;
            const v4u* vp = (const v4u*)(V1 + (size_t)tok * 512 + h * 64);
#pragma unroll
            for (int c = 0; c < 8; ++c) { const v4u w = vp[c]; o[8 * c] += p * bflo(w.x); o[8 * c + 1] += p * bfhi(w.x); o[8 * c + 2] += p * bflo(w.y); o[8 * c + 3] += p * bfhi(w.y); o[8 * c + 4] += p * bflo(w.z); o[8 * c + 5] += p * bfhi(w.z); o[8 * c + 6] += p * bflo(w.w); o[8 * c + 7] += p * bfhi(w.w); }
        }
        const float il = 1.f / lsum;
        const size_t yoff = (size_t)row * 1024 + 512 + h * 64;
#pragma unroll
        for (int c = 0; c < 8; ++c) { const v4u zw = *(const v4u*)(SZ1 + yoff + 8 * c); v4u w;
            w.x = pk2(o[8 * c] * il * bflo(zw.x), o[8 * c + 1] * il * bfhi(zw.x)); w.y = pk2(o[8 * c + 2] * il * bflo(zw.y), o[8 * c + 3] * il * bfhi(zw.y));
            w.z = pk2(o[8 * c + 4] * il * bflo(zw.z), o[8 * c + 5] * il * bfhi(zw.z)); w.w = pk2(o[8 * c + 6] * il * bflo(zw.w), o[8 * c + 7] * il * bfhi(zw.w));
            *(v4u*)(Y1 + yoff + 8 * c) = w; }
    }
}
DEVI void phase_final(Frame& F) {
    const int gw = F.bid * NWAVES + F.wave, NGW = F.G * NWAVES; const float* g = F.in[I_FNG];
    for (int m = gw; m < MX; m += NGW) {
        float* xr = F.out + (size_t)m * DM; f32x4 v[4]; float ss = 0.f;
#pragma unroll
        for (int j = 0; j < 4; ++j) { v[j] = *(const f32x4*)(xr + 4 * F.lane + 256 * j); ss += (v[j].x * v[j].x + v[j].y * v[j].y) + (v[j].z * v[j].z + v[j].w * v[j].w); }
        const float rinv = 1.0f / sqrtf(wave_sum(ss) * (1.f / DM) + EPS);
#pragma unroll
        for (int j = 0; j < 4; ++j) { const f32x4 gg = *(const f32x4*)(g + 4 * F.lane + 256 * j); f32x4 o; o.x = v[j].x * rinv * gg.x; o.y = v[j].y * rinv * gg.y; o.z = v[j].z * rinv * gg.z; o.w = v[j].w * rinv * gg.w;
            *(f32x4*)(xr + 4 * F.lane + 256 * j) = o; }
    }
}

__global__ void __launch_bounds__(NTHR, 2) mk_fwd(Args args) {
    extern __shared__ __attribute__((aligned(16))) unsigned char lds[];
    Frame F;
    F.lds = (LAS unsigned char*)lds;
    F.tid = threadIdx.x; F.lane = F.tid & 63; F.wave = __builtin_amdgcn_readfirstlane(F.tid >> 6);
    F.G = gridDim.x; F.bid = blockIdx.x;
#pragma unroll
    for (int i = 0; i < 23; ++i) F.in[i] = args.in[i];
    F.out = args.out; F.ws = args.ws;
    volatile LAS unsigned* MISC = (volatile LAS unsigned*)(F.lds + MISC_OFF);
    if (F.tid < 32) MISC[F.tid] = 0u;
    __syncthreads();
    unsigned* ctl = (unsigned*)(F.ws + WS_CTL);
    XcdBarrier bar; bar.bar = ctl + CW_BAR; bar.x = 0; bar.st = nullptr;
    if (MK_N_LAUNCHES == 1) bar = xcd_barrier_post(ctl + CW_BAR, MISC + 8);
    const int lo = args.ph_lo, hi = args.ph_hi;
#define IN(k) (lo <= (k) && (k) < hi)
#define SEAM(k) do { if (IN(k) && IN((k) + 1)) xcd_barrier(bar); } while (0)

    if (IN(0)) { p0_prologue(F); } SEAM(0);
    if (IN(1)) { phase_modnorm(F, 0); phase_fold(F); } SEAM(1);
    if (IN(2)) {
        EpiIn0 E{wsb(F, WS_GLU), wsb(F, WS_Q0), wsb(F, WS_K0), wsb(F, WS_V0), wsb(F, WS_SZ0), F.in[I_AB_QNG], F.in[I_AB_KNG], wsf(F, WS_ROPE)};
        gemm_naive(F, wsb(F, WS_H), wsb(F, WS_WIN0), MT, AB_IN, DM, E, NoSkip{});
    } SEAM(2);
    if (IN(3)) { phase_attn0_naive(F); phase_conv_naive(F); } SEAM(3);
    if (IN(4)) {
        EpiOut0 E{F.in[I_X], F.in[I_CTX], wsf(F, WS_ADA), F.out, wsf(F, WS_X1C)};
        gemm_naive(F, wsb(F, WS_Y0), wsb(F, WS_WOUT0), MT, DM, DM, E, NoSkip{});
    } SEAM(4);
    if (IN(5)) { phase_modnorm(F, 1); } SEAM(5);
    if (IN(6)) {
        EpiIn1 E{wsb(F, WS_PT), wsb(F, WS_Q1), wsb(F, WS_K1), wsb(F, WS_V1), wsb(F, WS_SZ1)};
        gemm_naive(F, wsb(F, WS_H), wsb(F, WS_WIN1), MT, N1, DM, E, SkipIn1{});
    } SEAM(6);
    if (IN(7)) {
        EpiDft E{wsb(F, WS_Y1), wsb(F, WS_SZ1)};
        gemm_naive(F, wsb(F, WS_DFT), wsb(F, WS_PT), 2048, 4096, 4096, E, NoSkip{});
        phase_na_naive(F);
    } SEAM(7);
    if (IN(8)) {
        EpiOut1 E{wsf(F, WS_ADA) + 9 * 3072, F.out};
        gemm_naive(F, wsb(F, WS_Y1), wsb(F, WS_WOUT1), MX, DM, DM, E, NoSkip{});
    } SEAM(8);
    if (IN(9)) { phase_final(F); }
#undef IN
#undef SEAM
}

extern "C" void kernel_launch(void* const* d_in, const int* in_sizes, int n_in, void* d_out, int out_size, void* d_ws, size_t ws_size, hipStream_t stream) {
    static int grid = 0;
    if (grid == 0) {
        if (n_in != 23 || out_size != MX * DM || ws_size < WS_END) { fprintf(stderr, "kernel_launch: unexpected shapes (n_in %d out %d ws %zu)\n", n_in, out_size, ws_size); grid = -1; return; }
        int dev = 0, cus = 0, per_cu = 0;
        if (hipGetDevice(&dev) != hipSuccess || hipDeviceGetAttribute(&cus, hipDeviceAttributeMultiprocessorCount, dev) != hipSuccess) { grid = -1; return; }
        if (hipFuncSetAttribute((const void*)mk_fwd, hipFuncAttributeMaxDynamicSharedMemorySize, LDS_BYTES) != hipSuccess) { fprintf(stderr, "kernel_launch: hipFuncSetAttribute failed\n"); grid = -1; return; }
        if (hipOccupancyMaxActiveBlocksPerMultiprocessor(&per_cu, (const void*)mk_fwd, NTHR, LDS_BYTES) != hipSuccess || per_cu < 1) { fprintf(stderr, "kernel_launch: occupancy query says %d\n", per_cu); per_cu = 1; }
        (void)hipGetLastError();
        grid = cus;
    }
    if (grid < 0) return;
    if (hipMemsetAsync((char*)d_ws + WS_CTL, 0, CTL_ZERO_BYTES, stream) != hipSuccess) { fprintf(stderr, "kernel_launch: memset failed\n"); return; }
    Args a{};
    for (int i = 0; i < 23; ++i) a.in[i] = (const float*)d_in[i];
    a.out = (float*)d_out; a.ws = (unsigned char*)d_ws;
    for (int li = 0; li < MK_N_LAUNCHES; ++li) {
        if (MK_N_LAUNCHES == 1) { a.ph_lo = 0; a.ph_hi = NPHASES; } else { a.ph_lo = li; a.ph_hi = li + 1; }
        a.li = li;
        hipLaunchKernelGGL(mk_fwd, dim3(grid), dim3(NTHR), LDS_BYTES, stream, a);
        const hipError_t le = hipPeekAtLastError();
        if (le != hipSuccess) { fprintf(stderr, "kernel_launch: launch %d failed: %s\n", li, hipGetErrorName(le)); break; }
    }
}
```

```cpp
#include <hip/hip_runtime.h>
#include <cstdio>
#include <cstdint>

#ifndef MK_N_LAUNCHES
#define MK_N_LAUNCHES 1
#endif

#define GAS __attribute__((address_space(1)))
#define LAS __attribute__((address_space(3)))
typedef unsigned short bf16;
typedef unsigned v4u __attribute__((ext_vector_type(4)));
typedef float f32x4 __attribute__((ext_vector_type(4)));
typedef GAS unsigned gu32;
#define RLX_AGENT __ATOMIC_RELAXED, __HIP_MEMORY_SCOPE_AGENT
#define LDS_WAIT() asm volatile("s_waitcnt lgkmcnt(0)" ::: "memory")
#define DEVI __device__ __forceinline__

constexpr int NB = 8, SEQ = 2048, DM = 1024, CTXL = 256, GRIDW = 64;
constexpr int MX = NB * SEQ, MC = NB * CTXL, MT = MX + MC;
constexpr int AB_IN = 2816, CD_IN = 3072, N1 = 3584;
constexpr int NKEY0 = CTXL + SEQ;
constexpr float EPS = 1e-6f;
constexpr float LOG2E = 1.4426950408889634f, C2 = 0.125f * LOG2E;
constexpr int NWAVES = 8, NTHR = 512;
constexpr int NPHASES = 10;

constexpr size_t MiB = 1u << 20;
constexpr size_t WS_CTL = 0, CTL_ZERO_BYTES = 1 * MiB;
constexpr size_t WS_ADA = 256 * 1024;
constexpr size_t WS_ROPE = 1 * MiB;
constexpr size_t WS_MCS = 1 * MiB + 512 * 1024;
constexpr size_t WS_WIN0 = 3 * MiB, WS_WOUT0 = 9 * MiB, WS_WIN1 = 11 * MiB, WS_WOUT1 = 18 * MiB;
constexpr size_t WS_DFT = 20 * MiB;
constexpr size_t WS_H = 36 * MiB;
constexpr size_t WS_X1C = 72 * MiB;
constexpr size_t WS_R = 80 * MiB;
constexpr size_t WS_GLU = WS_R, WS_Q0 = WS_R + 18 * MiB, WS_K0 = WS_R + 36 * MiB, WS_V0 = WS_K0 + 4608 * 1024, WS_SZ0 = WS_R + 45 * MiB, WS_Y0 = WS_R + 81 * MiB;
constexpr size_t WS_PT = WS_R, WS_Q1 = WS_R + 32 * MiB, WS_K1 = WS_R + 48 * MiB, WS_V1 = WS_R + 66 * MiB, WS_SZ1 = WS_R + 84 * MiB, WS_Y1 = WS_R + 116 * MiB;
constexpr size_t WS_END = WS_R + 148 * MiB;
static_assert(WS_END <= 256 * MiB, "d_ws map");
constexpr int CW_BAR = 4096;

constexpr int LDS_BYTES = 147456;
constexpr int MISC_OFF = 131072 + 320;

DEVI unsigned f2bf(float f) { unsigned u = __builtin_bit_cast(unsigned, f); return (u + 0x7fffu + ((u >> 16) & 1u)) >> 16; }
DEVI unsigned pk2(float lo, float hi) { return f2bf(lo) | (f2bf(hi) << 16); }
DEVI float bf2f(unsigned b) { return __builtin_bit_cast(float, (b & 0xffffu) << 16); }
DEVI float bflo(unsigned w) { return __builtin_bit_cast(float, w << 16); }
DEVI float bfhi(unsigned w) { return __builtin_bit_cast(float, w & 0xffff0000u); }
DEVI float siluf(float v) { return v / (1.f + expf(-v)); }
DEVI float sigmf(float v) { return 1.f / (1.f + expf(-v)); }
DEVI float wave_sum(float v) {
#pragma unroll
    for (int o = 1; o < 64; o <<= 1) v += __shfl_xor(v, o);
    return v;
}

#define XB_TMO      128
#define XB_XCNT(j)  (256  + 64 * (j))
#define XB_XSUB(j)  (1280 + 64 * (j))
#define XB_XGEN(j)  (2304 + 64 * (j))
#define XB_TOP      3328
#define XB_TOPGEN   3392
#define XCD_BAR_WORDS 3456
#define XB_SPIN_CAP (1u << 22)
DEVI unsigned xb_ld(unsigned* p)              { return __hip_atomic_load(p, __ATOMIC_RELAXED, __HIP_MEMORY_SCOPE_AGENT); }
DEVI unsigned xb_add(unsigned* p, unsigned v) { return __hip_atomic_fetch_add(p, v, __ATOMIC_RELAXED, __HIP_MEMORY_SCOPE_AGENT); }
DEVI unsigned xb_xcc_id() { return (unsigned)__builtin_amdgcn_s_getreg((3 << 11) | 20) & 0xFu; }
#define XB_SPIN(cond, bar) do { unsigned _sp = 0; while (cond) { __builtin_amdgcn_s_sleep(1); \
    if ((++_sp & 255u) == 0u) { if (xb_ld(&(bar)[XB_TMO])) break; if (_sp > XB_SPIN_CAP) { atomicAdd(&(bar)[XB_TMO], 1u); break; } } } } while (0)
struct XcdBarrier { unsigned* bar; unsigned x; volatile LAS unsigned* st; };
DEVI XcdBarrier xcd_barrier_post(unsigned* bar, volatile LAS unsigned* st) {
    XcdBarrier b; b.bar = bar; b.x = xb_xcc_id(); b.st = st;
    if (threadIdx.x == 0) (void)xb_add(&bar[XB_XCNT(b.x)], 1u);
    return b;
}
DEVI void xcd_barrier_complete(unsigned* bar, unsigned x, unsigned& nloc, unsigned& nx) {
    const unsigned G = gridDim.x * gridDim.y * gridDim.z;
    unsigned sum, cnt, mine, sp = 0u;
    for (;;) {
        sum = 0u; cnt = 0u; mine = 0u;
#pragma unroll
        for (unsigned j = 0; j < 16; ++j) { const unsigned c = xb_ld(&bar[XB_XCNT(j)]); sum += c; cnt += (c > 0u) ? 1u : 0u; mine = (j == x) ? c : mine; }
        if (sum == G) break;
        __builtin_amdgcn_s_sleep(1);
        if ((++sp & 255u) == 0u) { if (xb_ld(&bar[XB_TMO])) break; if (sp > XB_SPIN_CAP) { atomicAdd(&bar[XB_TMO], 1u); break; } }
    }
    nloc = mine > 0u ? mine : 1u; nx = cnt > 0u ? cnt : 1u;
}
DEVI void xcd_barrier(const XcdBarrier& b) {
    asm volatile("s_waitcnt vmcnt(0)" ::: "memory");
    __syncthreads();
    if (threadIdx.x == 0) {
        unsigned* bar = b.bar;
        __builtin_amdgcn_s_waitcnt(0);
        unsigned nloc = b.st[0], nx = b.st[1];
        if (nloc == 0u) { xcd_barrier_complete(bar, b.x, nloc, nx); b.st[0] = nloc; b.st[1] = nx; }
        const unsigned old = xb_add(&bar[XB_XSUB(b.x)], 1u);
        const unsigned gen = old / nloc;
        if (old + 1u == (gen + 1u) * nloc) {
            __builtin_amdgcn_fence(__ATOMIC_RELEASE, "agent");
            asm volatile("s_waitcnt vmcnt(0)" ::: "memory");
            const unsigned og = xb_add(&bar[XB_TOP], 1u);
            const unsigned tg = og / nx;
            if (og + 1u == (tg + 1u) * nx) xb_add(&bar[XB_TOPGEN], 1u);
            else XB_SPIN(xb_ld(&bar[XB_TOPGEN]) == tg, bar);
            __builtin_amdgcn_fence(__ATOMIC_ACQUIRE, "agent");
            xb_add(&bar[XB_XGEN(b.x)], 1u);
            asm volatile("s_waitcnt vmcnt(0)" ::: "memory");
        } else {
            XB_SPIN(xb_ld(&bar[XB_XGEN(b.x)]) == gen, bar);
            __builtin_amdgcn_fence(__ATOMIC_ACQUIRE, "agent");
            asm volatile("s_waitcnt vmcnt(0)" ::: "memory");
        }
    }
    __syncthreads();
}

struct Args { const float* in[23]; float* out; unsigned char* ws; int ph_lo, ph_hi, li, pad; };
enum { I_X = 0, I_C, I_CTX, I_CCTX, I_AB_WADA, I_AB_BADA, I_AB_NORMG, I_AB_WIN, I_AB_CONVW, I_AB_CONVB, I_AB_LNG, I_AB_LNB, I_AB_QNG, I_AB_KNG, I_AB_WOUT,
       I_CD_WADA, I_CD_BADA, I_CD_NORMG, I_CD_WIN, I_CD_WF, I_CD_RPB, I_CD_WOUT, I_FNG };

struct Frame {
    LAS unsigned char* lds;
    int tid, lane, wave, G, bid;
    const float* in[23]; float* out; unsigned char* ws;
};
DEVI bf16* wsb(const Frame& F, size_t off) { return (bf16*)(F.ws + off); }
DEVI float* wsf(const Frame& F, size_t off) { return (float*)(F.ws + off); }

DEVI float block_sum(float v, LAS float* red, int lane, int wave) {
    v = wave_sum(v);
    __syncthreads();
    if (lane == 0) red[wave] = v;
    __syncthreads();
    float s = 0.f;
#pragma unroll
    for (int i = 0; i < NWAVES; ++i) s += red[i];
    return s;
}

template <class Map>
DEVI void transpose_item(const float* W, int ldw, int c0, int ncols, int K, bf16* WT, Map map32, LAS float* scr, int item, int lane) {
    const int nblk = ncols / 32, kb = item / nblk, nb = item % nblk, k0 = 64 * kb, n0 = 32 * nb;
#pragma unroll 8
    for (int i = 0; i < 32; ++i) { const int kk = 2 * i + (lane >> 5); scr[kk * 33 + (lane & 31)] = W[(size_t)(k0 + kk) * ldw + c0 + n0 + (lane & 31)]; }
    LDS_WAIT(); asm volatile("" ::: "memory");
    const int c = lane & 7;
    const int drow0 = map32(nb) * 32;
#pragma unroll
    for (int j = 0; j < 4; ++j) { const int n = (lane >> 3) + 8 * j; const LAS float* s = scr + (8 * c) * 33 + n;
        v4u o; o.x = pk2(s[0 * 33], s[1 * 33]); o.y = pk2(s[2 * 33], s[3 * 33]); o.z = pk2(s[4 * 33], s[5 * 33]); o.w = pk2(s[6 * 33], s[7 * 33]);
        *(v4u*)(WT + (size_t)(drow0 + n) * K + k0 + 8 * c) = o; }
    LDS_WAIT(); asm volatile("" ::: "memory");
}
struct MapId { int off; DEVI int operator()(int nb) const { return nb + off; } };
struct MapIn0 { DEVI int operator()(int sb) const {
    if (sb < 16) return 8 * (sb >> 2) + (sb & 3);
    if (sb < 32) { const int cb = sb - 16; return 8 * (cb >> 2) + 4 + (cb & 3); }
    if (sb < 48) { const int qb = sb - 32, head = qb >> 1, bj = qb & 1; return 8 * (4 + (head >> 2)) + 4 * bj + (head & 3); }
    if (sb < 52) { const int kb = sb - 48; return 48 + 4 * (kb & 1) + (kb >> 1); }
    if (sb < 56) { const int vb = sb - 52; return 48 + 4 * (vb & 1) + 2 + (vb >> 1); }
    return sb; } };

DEVI void p0_prologue(Frame& F) {
    LAS float* scr = (LAS float*)(F.lds + F.wave * 16384);
    const int gw = F.bid * NWAVES + F.wave, NGW = F.G * NWAVES;
    constexpr int I0 = 16 * (AB_IN / 32), I1 = 16 * 32, I2 = 16 * ((CD_IN - 512) / 32), I3 = 16 * 32;
    for (int it = gw; it < I0 + I1 + I2 + I3; it += NGW) {
        int r = it;
        if (r < I0) { transpose_item(F.in[I_AB_WIN], AB_IN, 0, AB_IN, DM, wsb(F, WS_WIN0), MapIn0{}, scr, r, F.lane); continue; } r -= I0;
        if (r < I1) { transpose_item(F.in[I_AB_WOUT], DM, 0, DM, DM, wsb(F, WS_WOUT0), MapId{0}, scr, r, F.lane); continue; } r -= I1;
        if (r < I2) { transpose_item(F.in[I_CD_WIN], CD_IN, 512, CD_IN - 512, DM, wsb(F, WS_WIN1), MapId{32}, scr, r, F.lane); continue; } r -= I2;
        transpose_item(F.in[I_CD_WOUT], DM, 0, DM, DM, wsb(F, WS_WOUT1), MapId{0}, scr, r, F.lane);
    }
    __syncthreads();
    {
        LAS float* sl = (LAS float*)F.lds;
        for (int i = F.tid; i < 9 * 1024; i += NTHR) { const int r = i >> 10, k = i & 1023; const float cv = (r < 8) ? F.in[I_C][r * 1024 + k] : F.in[I_CCTX][k]; sl[i] = siluf(cv); }
        __syncthreads();
        float* ada = wsf(F, WS_ADA);
        for (int it = gw; it < 2 * 48 * 8; it += NGW) {
            const int l = it / 384, rem = it % 384, cc = rem >> 3, kc = rem & 7;
            const float* W = l ? F.in[I_CD_WADA] : F.in[I_AB_WADA]; const float* bb = l ? F.in[I_CD_BADA] : F.in[I_AB_BADA];
            const int col = cc * 64 + F.lane;
            float s[9];
#pragma unroll
            for (int r = 0; r < 9; ++r) s[r] = 0.f;
            for (int k = kc * 128; k < kc * 128 + 128; ++k) { const float w = W[(size_t)k * 3072 + col];
#pragma unroll
                for (int r = 0; r < 9; ++r) s[r] += sl[r * 1024 + k] * w; }
            const float bv = (kc == 0) ? bb[col] : 0.f;
#pragma unroll
            for (int r = 0; r < 9; ++r) atomicAdd(&ada[(l * 9 + r) * 3072 + col], s[r] + bv);
        }
        __syncthreads();
    }
    {
        float* rope = wsf(F, WS_ROPE);
        for (int i = F.bid * NTHR + F.tid; i < SEQ * 32; i += F.G * NTHR) {
            const int t = i >> 5, p = i & 31; const int fi = p & 15;
            const float inv = (float)pow(10000.0, -(double)fi / 16.0);
            const float pos = (float)((p < 16) ? (t / GRIDW) : (t % GRIDW));
            const float ang = pos * inv;
            rope[2 * i] = (float)cos((double)ang); rope[2 * i + 1] = (float)sin((double)ang);
        }
    }
    {
        LAS float* t128 = (LAS float*)F.lds;
        if (F.tid < 128) { t128[F.tid] = (float)cospi((double)F.tid / 64.0); t128[128 + F.tid] = (float)sinpi((double)F.tid / 64.0); }
        __syncthreads();
        float* mcs = wsf(F, WS_MCS); const float* wf = F.in[I_CD_WF];
        for (int i = F.bid * NTHR + F.tid; i < 2 * 4 * 128 * 128; i += F.G * NTHR) {
            const int e = i & 127, c = (i >> 7) & 127, g = (i >> 14) & 3, cs = i >> 16;
            float s = 0.f;
            for (int cp = 0; cp < 128; ++cp) s += t128[cs * 128 + ((c * cp) & 127)] * wf[(g * 128 + cp) * 128 + e];
            mcs[i] = s * (1.f / 512.f);
        }
        __syncthreads();
    }
    {
        LAS float* t2k = (LAS float*)F.lds;
        for (int i = F.tid; i < 2048; i += NTHR) { t2k[i] = (float)cospi((double)i / 1024.0); t2k[2048 + i] = (float)sinpi((double)i / 1024.0); }
        __syncthreads();
        bf16* A = wsb(F, WS_DFT);
        for (int i = F.bid * NTHR + F.tid; i < 2048 * 512; i += F.G * NTHR) {
            const int lp = i >> 9, k0 = (i & 511) * 8; float v[8];
#pragma unroll
            for (int j = 0; j < 8; ++j) { const int k = k0 + j; const int idx = (lp * (k & 2047)) & 2047; v[j] = (k < 2048) ? t2k[idx] : -t2k[2048 + idx]; }
            v4u o; o.x = pk2(v[0], v[1]); o.y = pk2(v[2], v[3]); o.z = pk2(v[4], v[5]); o.w = pk2(v[6], v[7]);
            *(v4u*)(A + (size_t)lp * 4096 + k0) = o;
        }
        __syncthreads();
    }
}

DEVI void modnorm_row(const float* xrow, bf16* orow, const float* g, const float* shift, const float* scale, int lane) {
    f32x4 v[4]; float ss = 0.f;
#pragma unroll
    for (int j = 0; j < 4; ++j) { v[j] = *(const f32x4*)(xrow + 4 * lane + 256 * j); ss += (v[j].x * v[j].x + v[j].y * v[j].y) + (v[j].z * v[j].z + v[j].w * v[j].w); }
    const float rinv = 1.0f / sqrtf(wave_sum(ss) * (1.f / DM) + EPS);
#pragma unroll
    for (int j = 0; j < 4; ++j) {
        const int c = 4 * lane + 256 * j;
        const f32x4 gg = *(const f32x4*)(g + c), sh = *(const f32x4*)(shift + c), sc = *(const f32x4*)(scale + c);
        const float o0 = v[j].x * rinv * gg.x * (1.f + sc.x) + sh.x, o1 = v[j].y * rinv * gg.y * (1.f + sc.y) + sh.y;
        const float o2 = v[j].z * rinv * gg.z * (1.f + sc.z) + sh.z, o3 = v[j].w * rinv * gg.w * (1.f + sc.w) + sh.w;
        *(unsigned long long*)(orow + c) = (unsigned long long)pk2(o0, o1) | ((unsigned long long)pk2(o2, o3) << 32);
    }
}
DEVI void phase_modnorm(Frame& F, int layer) {
    const int gw = F.bid * NWAVES + F.wave, NGW = F.G * NWAVES;
    const float* ada = wsf(F, WS_ADA) + layer * 9 * 3072;
    const float* g = layer ? F.in[I_CD_NORMG] : F.in[I_AB_NORMG];
    bf16* H = wsb(F, WS_H);
    for (int m = gw; m < MT; m += NGW) {
        const float* xr; int r;
        if (m < MX) { r = m >> 11; xr = (layer ? (const float*)F.out : F.in[I_X]) + (size_t)m * DM; }
        else { r = 8; xr = (layer ? (const float*)wsf(F, WS_X1C) : F.in[I_CTX]) + (size_t)(m - MX) * DM; }
        modnorm_row(xr, H + (size_t)m * DM, g, ada + r * 3072, ada + r * 3072 + 1024, F.lane);
    }
}
DEVI void phase_fold(Frame& F) {
    const float* mcs = wsf(F, WS_MCS); const float* W = F.in[I_CD_WIN]; bf16* WT = wsb(F, WS_WIN1);
    for (int i = F.bid * NTHR + F.tid; i < 1024 * 128; i += F.G * NTHR) {
        const int k0 = (i & 127) * 8, jj = i >> 7; const int cs = jj >> 9, g = (jj >> 7) & 3, e = jj & 127;
        float s[8];
#pragma unroll
        for (int j = 0; j < 8; ++j) s[j] = 0.f;
        const float* mp = mcs + ((size_t)(cs * 4 + g) * 128) * 128 + e;
        for (int c = 0; c < 128; ++c) { const float mv = mp[c * 128];
#pragma unroll
            for (int j = 0; j < 8; ++j) s[j] += W[(size_t)(k0 + j) * CD_IN + g * 128 + c] * mv; }
        v4u o; o.x = pk2(s[0], s[1]); o.y = pk2(s[2], s[3]); o.z = pk2(s[4], s[5]); o.w = pk2(s[6], s[7]);
        *(v4u*)(WT + (size_t)jj * DM + k0) = o;
    }
}

namespace pg8 {
#define PG8_LAS __attribute__((address_space(3)))
typedef unsigned short bf16_t;
typedef short bf16x8 __attribute__((ext_vector_type(8)));
typedef unsigned u32x4 __attribute__((ext_vector_type(4)));
constexpr int BM = 256, BK = 64, HALF = 128, HTB = HALF * BK * 2, STAGE_BYTES = 8 * HTB, NXCD = 8, WGM = 8;
__host__ __device__ __forceinline__ int lds_byte(int r, int c) { const int st = (r >> 4) * 2 + (c >> 5), rr = r & 15, cc = c & 31, ob = rr * 64 + cc * 2; return st * 1024 + (ob ^ (((ob >> 9) & 1) << 5)); }
__host__ __device__ __forceinline__ void stage_rc(int b, int& R, int& C) { const int st = b / 1024, sb = b % 1024, swz = sb ^ (((sb >> 9) & 1) << 5); R = (st >> 1) * 16 + swz / 64; C = (st & 1) * 32 + (swz % 64) / 2; }
__host__ __device__ __forceinline__ int perm32(int rho) { const int n = rho >> 4, i = rho & 15; return 8 * (i >> 2) + 4 * n + (i & 3); }

struct Unit { int pm, pn, kind; const char* A; const char* B; };

struct Seg { const bf16_t* A; const bf16_t* Bt; int nM, nN, kind; };
struct SegOrder {
    Seg s0, s1, s2; int n0, n1, n2, G, c; size_t tstep;
    __device__ __forceinline__ void init(const Seg& a, const Seg& b, const Seg& d, int K, int G_, int c_) { s0 = a; s1 = b; s2 = d; n0 = a.nM * a.nN; n1 = b.nM * b.nN; n2 = d.nM * d.nN; G = G_; c = c_; tstep = (size_t)BM * K * 2; }
    __device__ __forceinline__ void map(const Seg& s, int nwg, int wgid, Unit& u) const {
        { const int q = nwg / NXCD, xcd = wgid % NXCD, off = wgid / NXCD; wgid = xcd * q + off; }
        const int nig = WGM * s.nN, gid = wgid / nig, fm = gid * WGM, gsz = (s.nM - fm) < WGM ? (s.nM - fm) : WGM;
        u.pm = fm + ((wgid % nig) % gsz); u.pn = (wgid % nig) / gsz; u.kind = s.kind;
        u.A = (const char*)s.A + (size_t)u.pm * tstep; u.B = (const char*)s.Bt + (size_t)u.pn * tstep;
    }
    __device__ __forceinline__ bool next(int i, Unit& u) const {
        int L = i * G + c;
        if (L < n0) { map(s0, n0, L, u); return true; } L -= n0;
        if (L < n1) { map(s1, n1, L, u); return true; } L -= n1;
        if (L < n2) { map(s2, n2, L, u); return true; }
        return false;
    }
};

__device__ __forceinline__ unsigned cvt_pk_bf16(float lo, float hi) { unsigned r; asm volatile("v_cvt_pk_bf16_f32 %0, %1, %2" : "=v"(r) : "v"(lo), "v"(hi)); return r; }

template <class Epi, class Sched, bool ALIGN_EPI = true>
__device__ __forceinline__ void gemm_phase(PG8_LAS unsigned char* lds, const int K, const Sched& S, const Epi& E) {
    const int tid = threadIdx.x, wid = __builtin_amdgcn_readfirstlane(tid >> 6), lane = tid & 63, wr = wid >> 2, wc = wid & 3, fr = lane & 15, fq = lane >> 4;
    const int nt = K / BK;
    unsigned voffA[2], voffB[2];
#pragma unroll
    for (int i = 0; i < 2; ++i) { int R, C; stage_rc(tid * 16 + i * 8192, R, C); const int Rb = Epi::PERM ? ((R & ~31) + perm32(R & 31)) : R;
        voffA[i] = (unsigned)(R * K + C) * 2u; voffB[i] = (unsigned)(Rb * K + C) * 2u; }
    const size_t kstep = (size_t)(BK * 2);
    const size_t hstep = (size_t)HALF * K * 2;
    const unsigned ldsw = (unsigned)wid * 1024u;
    const int aoff = lds_byte(wr * 64 + fr, fq * 8), boff = lds_byte(wc * 32 + fr, fq * 8);
#define PG8_SA(b, h) (((b) * 2 + (h)) * HTB)
#define PG8_SB(b, h) ((4 + (b) * 2 + (h)) * HTB)
#define PG8_STAGE(bufoff, gbase, voff) do { _Pragma("unroll") for (int _i = 0; _i < 2; ++_i) \
        __builtin_amdgcn_global_load_lds((const unsigned*)((const char*)(gbase) + (voff)[_i]), (PG8_LAS unsigned*)(lds + (bufoff) + ldsw + _i * 8192), 16, 0, 0); } while (0)
#define PG8_LDA(dst, b, h) do { _Pragma("unroll") for (int m = 0; m < 4; ++m) _Pragma("unroll") for (int k = 0; k < 2; ++k) dst[m][k] = *(const PG8_LAS bf16x8*)(lds + PG8_SA(b, h) + aoff + m * 2048 + k * 1024); } while (0)
#define PG8_LDB(dst, b, h) do { _Pragma("unroll") for (int n = 0; n < 2; ++n) _Pragma("unroll") for (int k = 0; k < 2; ++k) dst[n][k] = *(const PG8_LAS bf16x8*)(lds + PG8_SB(b, h) + boff + n * 2048 + k * 1024); } while (0)
#define PG8_MMA(ai, bj, At, Bt) do { __builtin_amdgcn_s_setprio(1); _Pragma("unroll") for (int m = 0; m < 4; ++m) _Pragma("unroll") for (int n = 0; n < 2; ++n) _Pragma("unroll") for (int k = 0; k < 2; ++k) \
        acc[ai][bj][m][n] = __builtin_amdgcn_mfma_f32_16x16x32_bf16(Bt[n][k], At[m][k], acc[ai][bj][m][n], 0, 0, 0); __builtin_amdgcn_s_setprio(0); } while (0)
#define PG8_WAIT_V(n) asm volatile("s_waitcnt vmcnt(" #n ")" ::: "memory")
#define PG8_WAIT_L(n) asm volatile("s_waitcnt lgkmcnt(" #n ")" ::: "memory")
#define PG8_BAR __builtin_amdgcn_s_barrier()
#define PG8_SCHED __builtin_amdgcn_sched_barrier(0)
    Unit cur, nxt; int ui = 0;
    if (!S.next(0, cur)) return;
    f32x4 acc[2][2][4][2];
#pragma unroll
    for (int a = 0; a < 2; ++a)
#pragma unroll
        for (int b = 0; b < 2; ++b)
#pragma unroll
            for (int m = 0; m < 4; ++m)
#pragma unroll
                for (int n = 0; n < 2; ++n) acc[a][b][m][n] = (f32x4){0.f, 0.f, 0.f, 0.f};
    bf16x8 At[4][2], B0[2][2], B1[2][2];
    const char* cA = cur.A; const char* cB = cur.B;
    PG8_STAGE(PG8_SB(0, 0), cB, voffB); PG8_STAGE(PG8_SB(0, 1), cB + hstep, voffB); PG8_STAGE(PG8_SA(0, 0), cA, voffA); PG8_STAGE(PG8_SA(0, 1), cA + hstep, voffA);
    if (wr == 1) PG8_BAR;
    PG8_WAIT_V(2); PG8_BAR;
    PG8_STAGE(PG8_SB(1, 0), cB + kstep, voffB); PG8_STAGE(PG8_SA(1, 0), cA + kstep, voffA); PG8_STAGE(PG8_SB(1, 1), cB + hstep + kstep, voffB);
    PG8_WAIT_V(6); PG8_BAR;
    for (;;) {
        const bool has_next = S.next(ui + 1, nxt);
        const char* nA = has_next ? nxt.A : cA; const char* nB = has_next ? nxt.B : cB;
        for (int t = 0; t < nt; t += 2) {
            const bool last = (t == nt - 2);
            const char* a1 = cA + (size_t)(t + 1) * kstep;
            const char* a2 = last ? nA : cA + (size_t)(t + 2) * kstep; const char* b2 = last ? nB : cB + (size_t)(t + 2) * kstep;
            const char* a3 = a2 + kstep; const char* b3 = b2 + kstep;
            PG8_LDB(B0, 0, 0); PG8_LDB(B1, 0, 1); PG8_SCHED; PG8_LDA(At, 0, 0); PG8_STAGE(PG8_SA(1, 1), a1 + hstep, voffA);
            PG8_WAIT_V(8); PG8_WAIT_L(0); PG8_BAR; PG8_MMA(0, 0, At, B0); PG8_MMA(0, 1, At, B1); PG8_BAR; PG8_SCHED;
            PG8_LDA(At, 0, 1); PG8_STAGE(PG8_SB(0, 0), b2, voffB); PG8_STAGE(PG8_SB(0, 1), b2 + hstep, voffB); PG8_STAGE(PG8_SA(0, 0), a2, voffA);
            PG8_WAIT_V(8); PG8_WAIT_L(0); PG8_BAR; PG8_MMA(1, 0, At, B0); PG8_MMA(1, 1, At, B1); PG8_BAR; PG8_SCHED;
            PG8_LDB(B0, 1, 0); PG8_LDB(B1, 1, 1); PG8_SCHED; PG8_LDA(At, 1, 0); PG8_STAGE(PG8_SA(0, 1), a2 + hstep, voffA);
            PG8_WAIT_V(8); PG8_WAIT_L(0); PG8_BAR; PG8_MMA(0, 0, At, B0); PG8_MMA(0, 1, At, B1); PG8_BAR; PG8_SCHED;
            PG8_LDA(At, 1, 1); PG8_STAGE(PG8_SB(1, 0), b3, voffB); PG8_STAGE(PG8_SB(1, 1), b3 + hstep, voffB); PG8_STAGE(PG8_SA(1, 0), a3, voffA);
            PG8_WAIT_V(8); PG8_WAIT_L(0); PG8_BAR; PG8_MMA(1, 0, At, B0); PG8_MMA(1, 1, At, B1); PG8_BAR; PG8_SCHED;
        }
        if constexpr (ALIGN_EPI) { if (wr == 0) PG8_BAR; }
        E(acc, cur, wr, wc, fr, fq);
        if (!has_next) break;
#pragma unroll
        for (int a = 0; a < 2; ++a)
#pragma unroll
            for (int b = 0; b < 2; ++b)
#pragma unroll
                for (int m = 0; m < 4; ++m)
#pragma unroll
                    for (int n = 0; n < 2; ++n) acc[a][b][m][n] = (f32x4){0.f, 0.f, 0.f, 0.f};
        cur = nxt; cA = nA; cB = nB; ++ui;
        if constexpr (ALIGN_EPI) { if (wr == 1) PG8_BAR; }
    }
    PG8_WAIT_V(0);
    if constexpr (!ALIGN_EPI) { if (wr == 0) PG8_BAR; }
    PG8_BAR;
#undef PG8_SA
#undef PG8_SB
#undef PG8_STAGE
#undef PG8_LDA
#undef PG8_LDB
#undef PG8_MMA
#undef PG8_WAIT_V
#undef PG8_WAIT_L
#undef PG8_BAR
#undef PG8_SCHED
}
}

typedef float f32x4acc[2][2][4][2];
DEVI float fsilu(float v) { return v * __builtin_amdgcn_rcpf(1.f + __builtin_amdgcn_exp2f(-LOG2E * v)); }
DEVI float fsigm(float v) { return __builtin_amdgcn_rcpf(1.f + __builtin_amdgcn_exp2f(-LOG2E * v)); }
DEVI v4u pack8(const f32x4& a, const f32x4& b) { v4u w; w.x = pg8::cvt_pk_bf16(a[0], a[1]); w.y = pg8::cvt_pk_bf16(a[2], a[3]); w.z = pg8::cvt_pk_bf16(b[0], b[1]); w.w = pg8::cvt_pk_bf16(b[2], b[3]); return w; }

struct EpiIn0 {
    static constexpr bool PERM = true;
    bf16 *GLU, *Q0, *K0, *V0, *SZ; const float *qng, *kng, *rope;
    DEVI void operator()(const f32x4 (&acc)[2][2][4][2], const pg8::Unit& u, int wr, int wc, int fr, int fq) const {
        const int pn = u.pn, pm = u.pm; const bool isx = pm < 64;
        const int cw = 32 * wc + 8 * fq;
        float g8[2][8];
        if (pn >= 4 && pn < 7) { const float* gn = (pn < 6) ? qng : kng;
#pragma unroll
            for (int bj = 0; bj < 2; ++bj) { const f32x4 a = *(const f32x4*)(gn + 32 * bj + 8 * fq), b = *(const f32x4*)(gn + 32 * bj + 8 * fq + 4);
                g8[bj][0] = a[0]; g8[bj][1] = a[1]; g8[bj][2] = a[2]; g8[bj][3] = a[3]; g8[bj][4] = b[0]; g8[bj][5] = b[1]; g8[bj][6] = b[2]; g8[bj][7] = b[3]; } }
#pragma unroll
        for (int ai = 0; ai < 2; ++ai)
#pragma unroll
            for (int m = 0; m < 4; ++m) {
                const int lr = 128 * ai + 64 * wr + 16 * m + fr;
                const int row = 256 * pm + lr;
                if (pn < 4) {
                    f32x4 o0, o1;
#pragma unroll
                    for (int e = 0; e < 4; ++e) { o0[e] = acc[ai][0][m][0][e] * fsigm(acc[ai][1][m][0][e]); o1[e] = acc[ai][0][m][1][e] * fsigm(acc[ai][1][m][1][e]); }
                    *(v4u*)(GLU + (size_t)row * 512 + 128 * pn + cw) = pack8(o0, o1);
                } else if (pn < 7) {
                    const bool isv = (pn == 6) && (wc >= 2);
                    int b, key, l;
                    if (isx) { b = pm >> 3; l = (pm & 7) * 256 + lr; key = CTXL + l; } else { b = pm - 64; l = 0; key = lr; }
                    if (isv) {
#pragma unroll
                        for (int bj = 0; bj < 2; ++bj) *(v4u*)(V0 + ((size_t)b * NKEY0 + key) * 128 + (wc - 2) * 64 + 32 * bj + 8 * fq) = pack8(acc[ai][bj][m][0], acc[ai][bj][m][1]);
                    } else {
                        float ss = 0.f;
#pragma unroll
                        for (int bj = 0; bj < 2; ++bj)
#pragma unroll
                            for (int n = 0; n < 2; ++n) { const f32x4 x = acc[ai][bj][m][n]; ss += (x[0] * x[0] + x[1] * x[1]) + (x[2] * x[2] + x[3] * x[3]); }
                        ss += __shfl_xor(ss, 16); ss += __shfl_xor(ss, 32);
                        const float rinv = 1.0f / sqrtf(ss * (1.f / 64.f) + EPS);
                        const float osc = (pn < 6) ? C2 : 1.f;
#pragma unroll
                        for (int bj = 0; bj < 2; ++bj) {
                            f32x4 v[2];
#pragma unroll
                            for (int n = 0; n < 2; ++n)
#pragma unroll
                                for (int e = 0; e < 4; ++e) v[n][e] = acc[ai][bj][m][n][e] * rinv * g8[bj][4 * n + e];
                            if (isx) {
#pragma unroll
                                for (int n = 0; n < 2; ++n) { const f32x4 cs = *(const f32x4*)(rope + ((size_t)l * 32 + 16 * bj + 4 * fq + 2 * n) * 2);
                                    const float a0 = v[n][0], b0 = v[n][1], a1 = v[n][2], b1 = v[n][3];
                                    v[n][0] = a0 * cs[0] - b0 * cs[1]; v[n][1] = a0 * cs[1] + b0 * cs[0]; v[n][2] = a1 * cs[2] - b1 * cs[3]; v[n][3] = a1 * cs[3] + b1 * cs[2]; } }
                            v[0] = v[0] * osc; v[1] = v[1] * osc;
                            if (pn < 6) *(v4u*)(Q0 + (size_t)row * 512 + (4 * (pn - 4) + wc) * 64 + 32 * bj + 8 * fq) = pack8(v[0], v[1]);
                            else *(v4u*)(K0 + ((size_t)b * NKEY0 + key) * 128 + wc * 64 + 32 * bj + 8 * fq) = pack8(v[0], v[1]);
                        }
                    }
                } else {
#pragma unroll
                    for (int bj = 0; bj < 2; ++bj) { f32x4 o0, o1;
#pragma unroll
                        for (int e = 0; e < 4; ++e) { o0[e] = fsilu(acc[ai][bj][m][0][e]); o1[e] = fsilu(acc[ai][bj][m][1][e]); }
                        *(v4u*)(SZ + (size_t)row * 1024 + 256 * (pn - 7) + 128 * bj + cw) = pack8(o0, o1); }
                }
            }
    }
};
struct EpiOut {
    static constexpr bool PERM = false;
    const float *xin_x, *xin_c, *ada; float *o_x, *o_c;
    DEVI void operator()(const f32x4 (&acc)[2][2][4][2], const pg8::Unit& u, int wr, int wc, int fr, int fq) const {
        const int pm = u.pm; const bool isx = pm < 64; const int r = isx ? (pm >> 3) : 8;
        const float* xin = isx ? xin_x + (size_t)pm * 256 * DM : xin_c + (size_t)(pm - 64) * 256 * DM; float* op = isx ? o_x + (size_t)pm * 256 * DM : o_c + (size_t)(pm - 64) * 256 * DM;
        const int col0 = 256 * u.pn + 32 * wc + 4 * fq;
        f32x4 gv[2][2];
#pragma unroll
        for (int bj = 0; bj < 2; ++bj)
#pragma unroll
            for (int n = 0; n < 2; ++n) gv[bj][n] = *(const f32x4*)(ada + r * 3072 + 2048 + col0 + 128 * bj + 16 * n);
#pragma unroll
        for (int ai = 0; ai < 2; ++ai)
#pragma unroll
            for (int m = 0; m < 4; ++m) { const size_t off = (size_t)(128 * ai + 64 * wr + 16 * m + fr) * DM + col0;
#pragma unroll
                for (int bj = 0; bj < 2; ++bj)
#pragma unroll
                    for (int n = 0; n < 2; ++n) { const f32x4 xv = *(const f32x4*)(xin + off + 128 * bj + 16 * n);
                        *(f32x4*)(op + off + 128 * bj + 16 * n) = xv + gv[bj][n] * acc[ai][bj][m][n]; } }
    }
};
struct EpiIn1 {
    static constexpr bool PERM = true;
    bf16 *PT, *Q1, *K1, *V1, *SZ1;
    DEVI void operator()(const f32x4 (&acc)[2][2][4][2], const pg8::Unit& u, int wr, int wc, int fr, int fq) const {
        const int pn = u.pn, pm = u.pm, kind = u.kind; const int cw = 32 * wc + 8 * fq;
#pragma unroll
        for (int ai = 0; ai < 2; ++ai)
#pragma unroll
            for (int m = 0; m < 4; ++m) {
                const int lr = 128 * ai + 64 * wr + 16 * m + fr;
#pragma unroll
                for (int bj = 0; bj < 2; ++bj) {
                    const f32x4 a0 = acc[ai][bj][m][0], a1 = acc[ai][bj][m][1];
                    if (kind == 2) {
                        const int jj = 256 * pm + lr, cs = jj >> 9, jc = jj & 511; const int tok = 256 * pn + 128 * bj + cw, b = tok >> 11, l = tok & 2047;
                        *(v4u*)(PT + ((size_t)(b * 512 + jc) * 2 + cs) * 2048 + l) = pack8(a0, a1);
                    } else if (kind == 1) {
                        const size_t row = (size_t)MX + 256 * pm + lr; bf16* dst = (pn < 2) ? K1 : V1;
                        *(v4u*)(dst + row * 512 + 256 * (pn & 1) + 128 * bj + cw) = pack8(a0, a1);
                    } else {
                        const size_t row = (size_t)256 * pm + lr;
                        if (pn < 2) *(v4u*)(Q1 + row * 512 + 256 * pn + 128 * bj + cw) = pack8(a0 * C2, a1 * C2);
                        else if (pn < 4) *(v4u*)(K1 + row * 512 + 256 * (pn - 2) + 128 * bj + cw) = pack8(a0, a1);
                        else if (pn < 6) *(v4u*)(V1 + row * 512 + 256 * (pn - 4) + 128 * bj + cw) = pack8(a0, a1);
                        else { f32x4 o0, o1;
#pragma unroll
                            for (int e = 0; e < 4; ++e) { o0[e] = fsilu(a0[e]); o1[e] = fsilu(a1[e]); }
                            *(v4u*)(SZ1 + row * 1024 + 256 * (pn - 6) + 128 * bj + cw) = pack8(o0, o1); }
                    }
                }
            }
    }
};
struct EpiDft {
    static constexpr bool PERM = true;
    bf16* Y1; const bf16* SZ1;
    DEVI void operator()(const f32x4 (&acc)[2][2][4][2], const pg8::Unit& u, int wr, int wc, int fr, int fq) const {
#pragma unroll
        for (int ai = 0; ai < 2; ++ai)
#pragma unroll
            for (int m = 0; m < 4; ++m) { const int lp = 256 * u.pm + 128 * ai + 64 * wr + 16 * m + fr;
#pragma unroll
                for (int bj = 0; bj < 2; ++bj) { const int n = 256 * u.pn + 128 * bj + 32 * wc + 8 * fq, b = n >> 9, j = n & 511;
                    const size_t off = (size_t)(b * 2048 + lp) * 1024 + j; const v4u z = *(const v4u*)(SZ1 + off);
                    f32x4 o0 = acc[ai][bj][m][0], o1 = acc[ai][bj][m][1];
                    o0[0] *= bflo(z.x); o0[1] *= bfhi(z.x); o0[2] *= bflo(z.y); o0[3] *= bfhi(z.y); o1[0] *= bflo(z.z); o1[1] *= bfhi(z.z); o1[2] *= bflo(z.w); o1[3] *= bfhi(z.w);
                    *(v4u*)(Y1 + off) = pack8(o0, o1); } }
    }
};

DEVI void phase_attn0_naive(Frame& F) {
    LAS float* Ks = (LAS float*)F.lds; LAS float* Vs = Ks + 64 * 64;
    const bf16* Q0 = wsb(F, WS_Q0); const bf16* K0 = wsb(F, WS_K0); const bf16* V0 = wsb(F, WS_V0); const bf16* SZ = wsb(F, WS_SZ0); bf16* Y = wsb(F, WS_Y0);
    for (int it = F.bid; it < 256 + 32; it += F.G) {
        int b, kvh, row0, nkeys;
        if (it < 256) { b = it >> 5; kvh = (it >> 4) & 1; row0 = b * 2048 + (it & 15) * 128; nkeys = NKEY0; }
        else { const int jt = it - 256; b = jt >> 2; kvh = (jt >> 1) & 1; row0 = MX + b * 256 + (jt & 1) * 128; nkeys = CTXL; }
        const int g = F.tid >> 7, qi = F.tid & 127, head = kvh * 4 + g, row = row0 + qi;
        float q[64], o[64];
        { const v4u* qp = (const v4u*)(Q0 + (size_t)row * 512 + head * 64);
#pragma unroll
          for (int c = 0; c < 8; ++c) { const v4u w = qp[c]; q[8 * c] = bflo(w.x); q[8 * c + 1] = bfhi(w.x); q[8 * c + 2] = bflo(w.y); q[8 * c + 3] = bfhi(w.y); q[8 * c + 4] = bflo(w.z); q[8 * c + 5] = bfhi(w.z); q[8 * c + 6] = bflo(w.w); q[8 * c + 7] = bfhi(w.w); } }
#pragma unroll
        for (int d = 0; d < 64; ++d) o[d] = 0.f;
        float m = -1e30f, l = 0.f;
        const int lk = F.tid >> 3, lc = (F.tid & 7) * 8;
        for (int k0 = 0; k0 < nkeys; k0 += 64) {
            const size_t goff = ((size_t)b * NKEY0 + k0 + lk) * 128 + kvh * 64 + lc;
            const v4u kw = *(const v4u*)(K0 + goff), vw = *(const v4u*)(V0 + goff);
            __syncthreads();
            { LAS float* kd = Ks + lk * 64 + lc; LAS float* vd = Vs + lk * 64 + lc;
              kd[0] = bflo(kw.x); kd[1] = bfhi(kw.x); kd[2] = bflo(kw.y); kd[3] = bfhi(kw.y); kd[4] = bflo(kw.z); kd[5] = bfhi(kw.z); kd[6] = bflo(kw.w); kd[7] = bfhi(kw.w);
              vd[0] = bflo(vw.x); vd[1] = bfhi(vw.x); vd[2] = bflo(vw.y); vd[3] = bfhi(vw.y); vd[4] = bflo(vw.z); vd[5] = bfhi(vw.z); vd[6] = bflo(vw.w); vd[7] = bfhi(vw.w); }
            __syncthreads();
            for (int kk = 0; kk < 64; ++kk) {
                const LAS f32x4* kp = (const LAS f32x4*)(Ks + kk * 64);
                float s = 0.f;
#pragma unroll
                for (int c = 0; c < 16; ++c) { const f32x4 kv = kp[c]; s += q[4 * c] * kv.x + q[4 * c + 1] * kv.y + q[4 * c + 2] * kv.z + q[4 * c + 3] * kv.w; }
                if (s > m) { const float al = exp2f(m - s); l *= al;
#pragma unroll
                    for (int d = 0; d < 64; ++d) o[d] *= al;
                    m = s; }
                const float p = exp2f(s - m); l += p;
                const LAS f32x4* vp = (const LAS f32x4*)(Vs + kk * 64);
#pragma unroll
                for (int c = 0; c < 16; ++c) { const f32x4 vv = vp[c]; o[4 * c] += p * vv.x; o[4 * c + 1] += p * vv.y; o[4 * c + 2] += p * vv.z; o[4 * c + 3] += p * vv.w; }
            }
        }
        const float il = 1.f / l;
        const size_t yoff = (size_t)row * 1024 + 512 + head * 64;
#pragma unroll
        for (int c = 0; c < 8; ++c) { const v4u zw = *(const v4u*)(SZ + yoff + 8 * c); v4u w;
            w.x = pk2(o[8 * c] * il * bflo(zw.x), o[8 * c + 1] * il * bfhi(zw.x)); w.y = pk2(o[8 * c + 2] * il * bflo(zw.y), o[8 * c + 3] * il * bfhi(zw.y));
            w.z = pk2(o[8 * c + 4] * il * bflo(zw.z), o[8 * c + 5] * il * bfhi(zw.z)); w.w = pk2(o[8 * c + 6] * il * bflo(zw.w), o[8 * c + 7] * il * bfhi(zw.w));
            *(v4u*)(Y + yoff + 8 * c) = w; }
        __syncthreads();
    }
}
DEVI void phase_conv_naive(Frame& F) {
    LAS float* red = (LAS float*)(F.lds + 65536);
    const bf16* GLU = wsb(F, WS_GLU); const bf16* SZ = wsb(F, WS_SZ0); bf16* Y = wsb(F, WS_Y0);
    const float* cw = F.in[I_AB_CONVW]; const float* cb = F.in[I_AB_CONVB]; const float* lg = F.in[I_AB_LNG]; const float* lb = F.in[I_AB_LNB];
    const int c = F.tid;
    float w[31];
#pragma unroll
    for (int t = 0; t < 31; ++t) w[t] = cw[t * 512 + c];
    const float cbv = cb[c], lgv = lg[c], lbv = lb[c];
    for (int row = F.bid; row < MT; row += F.G) {
        int base, len, pos;
        if (row < MX) { base = row & ~2047; len = SEQ; pos = row & 2047; } else { const int rc = row - MX; base = MX + (rc & ~255); len = CTXL; pos = rc & 255; }
        float u = cbv;
#pragma unroll
        for (int t = 0; t < 31; ++t) { const int p = pos + t - 15; if (p >= 0 && p < len) u += bf2f(GLU[(size_t)(base + p) * 512 + c]) * w[t]; }
        const float mean = block_sum(u, red, F.lane, F.wave) * (1.f / 512.f);
        const float dv = u - mean;
        const float var = block_sum(dv * dv, red + 8, F.lane, F.wave) * (1.f / 512.f);
        const float y = dv * (1.0f / sqrtf(var + EPS)) * lgv + lbv;
        Y[(size_t)row * 1024 + c] = (bf16)f2bf(siluf(y) * bf2f(SZ[(size_t)row * 1024 + c]));
    }
    __syncthreads();
}
DEVI void phase_na_naive(Frame& F) {
    const bf16* Q1 = wsb(F, WS_Q1); const bf16* K1 = wsb(F, WS_K1); const bf16* V1 = wsb(F, WS_V1); const bf16* SZ1 = wsb(F, WS_SZ1); bf16* Y1 = wsb(F, WS_Y1);
    const float* rpb = F.in[I_CD_RPB];
    for (int gid = F.bid * NTHR + F.tid; gid < NB * 8 * SEQ; gid += F.G * NTHR) {
        const int l = gid & 2047, h = (gid >> 11) & 7, b = gid >> 14;
        const int r = l >> 6, qc = l & 63;
        const int rs = min(max(r - 4, 0), 24), cs = min(max(qc - 8, 0), 48);
        const int row = b * 2048 + l;
        float q[64], o[64];
        { const v4u* qp = (const v4u*)(Q1 + (size_t)row * 512 + h * 64);
#pragma unroll
          for (int c = 0; c < 8; ++c) { const v4u w = qp[c]; q[8 * c] = bflo(w.x); q[8 * c + 1] = bfhi(w.x); q[8 * c + 2] = bflo(w.y); q[8 * c + 3] = bfhi(w.y); q[8 * c + 4] = bflo(w.z); q[8 * c + 5] = bfhi(w.z); q[8 * c + 6] = bflo(w.w); q[8 * c + 7] = bfhi(w.w); } }
#pragma unroll
        for (int d = 0; d < 64; ++d) o[d] = 0.f;
        float m = -1e30f, lsum = 0.f;
        for (int kidx = 0; kidx < 128 + 256; ++kidx) {
            int tok; float bias = 0.f;
            if (kidx < 128) { const int kr = rs + (kidx >> 4), kc = cs + (kidx & 15); tok = b * 2048 + kr * 64 + kc; bias = rpb[(h * 15 + (kr - r + 7)) * 31 + (kc - qc + 15)] * LOG2E; }
            else tok = MX + b * 256 + (kidx - 128);
            const v4u* kp = (const v4u*)(K1 + (size_t)tok * 512 + h * 64);
            float s = bias;
#pragma unroll
            for (int c = 0; c < 8; ++c) { const v4u w = kp[c]; s += q[8 * c] * bflo(w.x) + q[8 * c + 1] * bfhi(w.x) + q[8 * c + 2] * bflo(w.y) + q[8 * c + 3] * bfhi(w.y) + q[8 * c + 4] * bflo(w.z) + q[8 * c + 5] * bfhi(w.z) + q[8 * c + 6] * bflo(w.w) + q[8 * c + 7] * bfhi(w.w); }
            if (s > m) { const float al = exp2f(m - s); lsum *= al;
#pragma unroll
                for (int d = 0; d < 64; ++d) o[d] *= al;
                m = s; }
            const float p = exp2f(s - m); lsum += p;
            const v4u* vp = (const v4u*)(V1 + (size_t)tok * 512 + h * 64);
#pragma unroll
            for (int c = 0; c < 8; ++c) { const v4u w = vp[c]; o[8 * c] += p * bflo(w.x); o[8 * c + 1] += p * bfhi(w.x); o[8 * c + 2] += p * bflo(w.y); o[8 * c + 3] += p * bfhi(w.y); o[8 * c + 4] += p * bflo(w.z); o[8 * c + 5] += p * bfhi(w.z); o[8 * c + 6] += p * bflo(w.w); o[8 * c + 7] += p * bfhi(w.w); }
        }
        const float il = 1.f / lsum;
        const size_t yoff = (size_t)row * 1024 + 512 + h * 64;
#pragma unroll
        for (int c = 0; c < 8; ++c) { const v4u zw = *(const v4u*)(SZ1 + yoff + 8 * c); v4u w;
            w.x = pk2(o[8 * c] * il * bflo(zw.x), o[8 * c + 1] * il * bfhi(zw.x)); w.y = pk2(o[8 * c + 2] * il * bflo(zw.y), o[8 * c + 3] * il * bfhi(zw.y));
            w.z = pk2(o[8 * c + 4] * il * bflo(zw.z), o[8 * c + 5] * il * bfhi(zw.z)); w.w = pk2(o[8 * c + 6] * il * bflo(zw.w), o[8 * c + 7] * il * bfhi(zw.w));
            *(v4u*)(Y1 + yoff + 8 * c) = w; }
    }
}
DEVI void phase_final(Frame& F) {
    const int gw = F.bid * NWAVES + F.wave, NGW = F.G * NWAVES; const float* g = F.in[I_FNG];
    for (int m = gw; m < MX; m += NGW) {
        float* xr = F.out + (size_t)m * DM; f32x4 v[4]; float ss = 0.f;
#pragma unroll
        for (int j = 0; j < 4; ++j) { v[j] = *(const f32x4*)(xr + 4 * F.lane + 256 * j); ss += (v[j].x * v[j].x + v[j].y * v[j].y) + (v[j].z * v[j].z + v[j].w * v[j].w); }
        const float rinv = 1.0f / sqrtf(wave_sum(ss) * (1.f / DM) + EPS);
#pragma unroll
        for (int j = 0; j < 4; ++j) { const f32x4 gg = *(const f32x4*)(g + 4 * F.lane + 256 * j); f32x4 o; o.x = v[j].x * rinv * gg.x; o.y = v[j].y * rinv * gg.y; o.z = v[j].z * rinv * gg.z; o.w = v[j].w * rinv * gg.w;
            *(f32x4*)(xr + 4 * F.lane + 256 * j) = o; }
    }
}

__global__ void __launch_bounds__(NTHR, 2) mk_fwd(Args args) {
    extern __shared__ __attribute__((aligned(16))) unsigned char lds[];
    Frame F;
    F.lds = (LAS unsigned char*)lds;
    F.tid = threadIdx.x; F.lane = F.tid & 63; F.wave = __builtin_amdgcn_readfirstlane(F.tid >> 6);
    F.G = gridDim.x; F.bid = blockIdx.x;
#pragma unroll
    for (int i = 0; i < 23; ++i) F.in[i] = args.in[i];
    F.out = args.out; F.ws = args.ws;
    volatile LAS unsigned* MISC = (volatile LAS unsigned*)(F.lds + MISC_OFF);
    if (F.tid < 32) MISC[F.tid] = 0u;
    __syncthreads();
    unsigned* ctl = (unsigned*)(F.ws + WS_CTL);
    XcdBarrier bar; bar.bar = ctl + CW_BAR; bar.x = 0; bar.st = nullptr;
    if (MK_N_LAUNCHES == 1) bar = xcd_barrier_post(ctl + CW_BAR, MISC + 8);
    const int lo = args.ph_lo, hi = args.ph_hi;
#define IN(k) (lo <= (k) && (k) < hi)
#define SEAM(k) do { if (IN(k) && IN((k) + 1)) xcd_barrier(bar); } while (0)

    if (IN(0)) { p0_prologue(F); } SEAM(0);
    if (IN(1)) { phase_modnorm(F, 0); phase_fold(F); } SEAM(1);
    if (IN(2)) {
        EpiIn0 E{wsb(F, WS_GLU), wsb(F, WS_Q0), wsb(F, WS_K0), wsb(F, WS_V0), wsb(F, WS_SZ0), F.in[I_AB_QNG], F.in[I_AB_KNG], wsf(F, WS_ROPE)};
        pg8::SegOrder S; S.init(pg8::Seg{wsb(F, WS_H), wsb(F, WS_WIN0), 72, 11, 0}, pg8::Seg{nullptr, nullptr, 0, 0, 0}, pg8::Seg{nullptr, nullptr, 0, 0, 0}, DM, F.G, F.bid);
        pg8::gemm_phase<EpiIn0, pg8::SegOrder>(F.lds, DM, S, E);
    } SEAM(2);
    if (IN(3)) { phase_attn0_naive(F); phase_conv_naive(F); } SEAM(3);
    if (IN(4)) {
        EpiOut E{F.in[I_X], F.in[I_CTX], wsf(F, WS_ADA), F.out, wsf(F, WS_X1C)};
        pg8::SegOrder S; S.init(pg8::Seg{wsb(F, WS_Y0), wsb(F, WS_WOUT0), 72, 4, 0}, pg8::Seg{nullptr, nullptr, 0, 0, 0}, pg8::Seg{nullptr, nullptr, 0, 0, 0}, DM, F.G, F.bid);
        pg8::gemm_phase<EpiOut, pg8::SegOrder>(F.lds, DM, S, E);
    } SEAM(4);
    if (IN(5)) { phase_modnorm(F, 1); } SEAM(5);
    if (IN(6)) {
        EpiIn1 E{wsb(F, WS_PT), wsb(F, WS_Q1), wsb(F, WS_K1), wsb(F, WS_V1), wsb(F, WS_SZ1)};
        pg8::SegOrder S; S.init(pg8::Seg{wsb(F, WS_H), wsb(F, WS_WIN1) + (size_t)1024 * DM, 64, 10, 0},
                                pg8::Seg{wsb(F, WS_WIN1), wsb(F, WS_H), 4, 64, 2},
                                pg8::Seg{wsb(F, WS_H) + (size_t)MX * DM, wsb(F, WS_WIN1) + (size_t)1536 * DM, 8, 4, 1}, DM, F.G, F.bid);
        pg8::gemm_phase<EpiIn1, pg8::SegOrder>(F.lds, DM, S, E);
    } SEAM(6);
    if (IN(7)) {
        EpiDft E{wsb(F, WS_Y1), wsb(F, WS_SZ1)};
        pg8::SegOrder S; S.init(pg8::Seg{wsb(F, WS_DFT), wsb(F, WS_PT), 8, 16, 0}, pg8::Seg{nullptr, nullptr, 0, 0, 0}, pg8::Seg{nullptr, nullptr, 0, 0, 0}, 4096, F.G, F.bid);
        pg8::gemm_phase<EpiDft, pg8::SegOrder>(F.lds, 4096, S, E);
        phase_na_naive(F);
    } SEAM(7);
    if (IN(8)) {
        EpiOut E{F.out, nullptr, wsf(F, WS_ADA) + 9 * 3072, F.out, nullptr};
        pg8::SegOrder S; S.init(pg8::Seg{wsb(F, WS_Y1), wsb(F, WS_WOUT1), 64, 4, 0}, pg8::Seg{nullptr, nullptr, 0, 0, 0}, pg8::Seg{nullptr, nullptr, 0, 0, 0}, DM, F.G, F.bid);
        pg8::gemm_phase<EpiOut, pg8::SegOrder>(F.lds, DM, S, E);
    } SEAM(8);
    if (IN(9)) { phase_final(F); }
#undef IN
#undef SEAM
}

extern "C" void kernel_launch(void* const* d_in, const int* in_sizes, int n_in, void* d_out, int out_size, void* d_ws, size_t ws_size, hipStream_t stream) {
    static int grid = 0;
    if (grid == 0) {
        if (n_in != 23 || out_size != MX * DM || ws_size < WS_END) { fprintf(stderr, "kernel_launch: unexpected shapes (n_in %d out %d ws %zu)\n", n_in, out_size, ws_size); grid = -1; return; }
        int dev = 0, cus = 0, per_cu = 0;
        if (hipGetDevice(&dev) != hipSuccess || hipDeviceGetAttribute(&cus, hipDeviceAttributeMultiprocessorCount, dev) != hipSuccess) { grid = -1; return; }
        if (hipFuncSetAttribute((const void*)mk_fwd, hipFuncAttributeMaxDynamicSharedMemorySize, LDS_BYTES) != hipSuccess) { fprintf(stderr, "kernel_launch: hipFuncSetAttribute failed\n"); grid = -1; return; }
        if (hipOccupancyMaxActiveBlocksPerMultiprocessor(&per_cu, (const void*)mk_fwd, NTHR, LDS_BYTES) != hipSuccess || per_cu < 1) { fprintf(stderr, "kernel_launch: occupancy query says %d\n", per_cu); per_cu = 1; }
        (void)hipGetLastError();
        grid = cus;
    }
    if (grid < 0) return;
    if (hipMemsetAsync((char*)d_ws + WS_CTL, 0, CTL_ZERO_BYTES, stream) != hipSuccess) { fprintf(stderr, "kernel_launch: memset failed\n"); return; }
    Args a{};
    for (int i = 0; i < 23; ++i) a.in[i] = (const float*)d_in[i];
    a.out = (float*)d_out; a.ws = (unsigned char*)d_ws;
    for (int li = 0; li < MK_N_LAUNCHES; ++li) {
        if (MK_N_LAUNCHES == 1) { a.ph_lo = 0; a.ph_hi = NPHASES; } else { a.ph_lo = li; a.ph_hi = li + 1; }
        a.li = li;
        hipLaunchKernelGGL(mk_fwd, dim3(grid), dim3(NTHR), LDS_BYTES, stream, a);
        const hipError_t le = hipPeekAtLastError();
        if (le != hipSuccess) { fprintf(stderr, "kernel_launch: launch %d failed: %s\n", li, hipGetErrorName(le)); break; }
    }
}
```

```cpp
#include <hip/hip_runtime.h>
#include <cstdio>
#include <cstdint>
#include <hip/hip_bf16.h>

#ifndef MK_N_LAUNCHES
#define MK_N_LAUNCHES 1
#endif

#define GAS __attribute__((address_space(1)))
#define LAS __attribute__((address_space(3)))
typedef unsigned short bf16;
typedef unsigned v4u __attribute__((ext_vector_type(4)));
typedef float f32x4 __attribute__((ext_vector_type(4)));
typedef GAS unsigned gu32;
#define RLX_AGENT __ATOMIC_RELAXED, __HIP_MEMORY_SCOPE_AGENT
#define LDS_WAIT() asm volatile("s_waitcnt lgkmcnt(0)" ::: "memory")
#define DEVI __device__ __forceinline__

constexpr int NB = 8, SEQ = 2048, DM = 1024, CTXL = 256, GRIDW = 64;
constexpr int MX = NB * SEQ, MC = NB * CTXL, MT = MX + MC;
constexpr int AB_IN = 2816, CD_IN = 3072, N1 = 3584;
constexpr int NKEY0 = CTXL + SEQ;
constexpr float EPS = 1e-6f;
constexpr float LOG2E = 1.4426950408889634f, C2 = 0.125f * LOG2E;
constexpr int NWAVES = 8, NTHR = 512;
constexpr int NPHASES = 10;

constexpr size_t MiB = 1u << 20;
constexpr size_t WS_CTL = 0, CTL_ZERO_BYTES = 1 * MiB;
constexpr size_t WS_ADA = 256 * 1024;
constexpr size_t WS_ROPE = 1 * MiB;
constexpr size_t WS_MCS = 1 * MiB + 512 * 1024;
constexpr size_t WS_WIN0 = 3 * MiB, WS_WOUT0 = 9 * MiB, WS_WIN1 = 11 * MiB, WS_WOUT1 = 18 * MiB;
constexpr size_t WS_DFT = 20 * MiB;
constexpr size_t WS_H = 36 * MiB;
constexpr size_t WS_X1C = 72 * MiB;
constexpr size_t WS_R = 80 * MiB;
constexpr size_t WS_GLU = WS_R, WS_Q0 = WS_R + 18 * MiB, WS_K0 = WS_R + 36 * MiB, WS_V0 = WS_K0 + 4608 * 1024, WS_SZ0 = WS_R + 45 * MiB, WS_Y0 = WS_R + 81 * MiB;
constexpr size_t WS_PT = WS_R, WS_Q1 = WS_R + 32 * MiB, WS_K1 = WS_R + 48 * MiB, WS_V1 = WS_R + 66 * MiB, WS_SZ1 = WS_R + 84 * MiB, WS_Y1 = WS_R + 116 * MiB;
constexpr size_t WS_END = WS_R + 148 * MiB;
static_assert(WS_END <= 256 * MiB, "d_ws map");
constexpr int CW_BAR = 4096;

constexpr int LDS_BYTES = 147456;
constexpr int MISC_OFF = 131072 + 320;

DEVI unsigned f2bf(float f) { unsigned u = __builtin_bit_cast(unsigned, f); return (u + 0x7fffu + ((u >> 16) & 1u)) >> 16; }
DEVI unsigned pk2(float lo, float hi) { return f2bf(lo) | (f2bf(hi) << 16); }
DEVI float bf2f(unsigned b) { return __builtin_bit_cast(float, (b & 0xffffu) << 16); }
DEVI float bflo(unsigned w) { return __builtin_bit_cast(float, w << 16); }
DEVI float bfhi(unsigned w) { return __builtin_bit_cast(float, w & 0xffff0000u); }
DEVI float siluf(float v) { return v / (1.f + expf(-v)); }
DEVI float sigmf(float v) { return 1.f / (1.f + expf(-v)); }
DEVI float wave_sum(float v) {
#pragma unroll
    for (int o = 1; o < 64; o <<= 1) v += __shfl_xor(v, o);
    return v;
}

#define XB_TMO      128
#define XB_XCNT(j)  (256  + 64 * (j))
#define XB_XSUB(j)  (1280 + 64 * (j))
#define XB_XGEN(j)  (2304 + 64 * (j))
#define XB_TOP      3328
#define XB_TOPGEN   3392
#define XCD_BAR_WORDS 3456
#define XB_SPIN_CAP (1u << 22)
DEVI unsigned xb_ld(unsigned* p)              { return __hip_atomic_load(p, __ATOMIC_RELAXED, __HIP_MEMORY_SCOPE_AGENT); }
DEVI unsigned xb_add(unsigned* p, unsigned v) { return __hip_atomic_fetch_add(p, v, __ATOMIC_RELAXED, __HIP_MEMORY_SCOPE_AGENT); }
DEVI unsigned xb_xcc_id() { return (unsigned)__builtin_amdgcn_s_getreg((3 << 11) | 20) & 0xFu; }
#define XB_SPIN(cond, bar) do { unsigned _sp = 0; while (cond) { __builtin_amdgcn_s_sleep(1); \
    if ((++_sp & 255u) == 0u) { if (xb_ld(&(bar)[XB_TMO])) break; if (_sp > XB_SPIN_CAP) { atomicAdd(&(bar)[XB_TMO], 1u); break; } } } } while (0)
struct XcdBarrier { unsigned* bar; unsigned x; volatile LAS unsigned* st; };
DEVI XcdBarrier xcd_barrier_post(unsigned* bar, volatile LAS unsigned* st) {
    XcdBarrier b; b.bar = bar; b.x = xb_xcc_id(); b.st = st;
    if (threadIdx.x == 0) (void)xb_add(&bar[XB_XCNT(b.x)], 1u);
    return b;
}
DEVI void xcd_barrier_complete(unsigned* bar, unsigned x, unsigned& nloc, unsigned& nx) {
    const unsigned G = gridDim.x * gridDim.y * gridDim.z;
    unsigned sum, cnt, mine, sp = 0u;
    for (;;) {
        sum = 0u; cnt = 0u; mine = 0u;
#pragma unroll
        for (unsigned j = 0; j < 16; ++j) { const unsigned c = xb_ld(&bar[XB_XCNT(j)]); sum += c; cnt += (c > 0u) ? 1u : 0u; mine = (j == x) ? c : mine; }
        if (sum == G) break;
        __builtin_amdgcn_s_sleep(1);
        if ((++sp & 255u) == 0u) { if (xb_ld(&bar[XB_TMO])) break; if (sp > XB_SPIN_CAP) { atomicAdd(&bar[XB_TMO], 1u); break; } }
    }
    nloc = mine > 0u ? mine : 1u; nx = cnt > 0u ? cnt : 1u;
}
DEVI void xcd_barrier(const XcdBarrier& b) {
    asm volatile("s_waitcnt vmcnt(0)" ::: "memory");
    __syncthreads();
    if (threadIdx.x == 0) {
        unsigned* bar = b.bar;
        __builtin_amdgcn_s_waitcnt(0);
        unsigned nloc = b.st[0], nx = b.st[1];
        if (nloc == 0u) { xcd_barrier_complete(bar, b.x, nloc, nx); b.st[0] = nloc; b.st[1] = nx; }
        const unsigned old = xb_add(&bar[XB_XSUB(b.x)], 1u);
        const unsigned gen = old / nloc;
        if (old + 1u == (gen + 1u) * nloc) {
            __builtin_amdgcn_fence(__ATOMIC_RELEASE, "agent");
            asm volatile("s_waitcnt vmcnt(0)" ::: "memory");
            const unsigned og = xb_add(&bar[XB_TOP], 1u);
            const unsigned tg = og / nx;
            if (og + 1u == (tg + 1u) * nx) xb_add(&bar[XB_TOPGEN], 1u);
            else XB_SPIN(xb_ld(&bar[XB_TOPGEN]) == tg, bar);
            __builtin_amdgcn_fence(__ATOMIC_ACQUIRE, "agent");
            xb_add(&bar[XB_XGEN(b.x)], 1u);
            asm volatile("s_waitcnt vmcnt(0)" ::: "memory");
        } else {
            XB_SPIN(xb_ld(&bar[XB_XGEN(b.x)]) == gen, bar);
            __builtin_amdgcn_fence(__ATOMIC_ACQUIRE, "agent");
            asm volatile("s_waitcnt vmcnt(0)" ::: "memory");
        }
    }
    __syncthreads();
}

struct Args { const float* in[23]; float* out; unsigned char* ws; int ph_lo, ph_hi, li, pad; };
enum { I_X = 0, I_C, I_CTX, I_CCTX, I_AB_WADA, I_AB_BADA, I_AB_NORMG, I_AB_WIN, I_AB_CONVW, I_AB_CONVB, I_AB_LNG, I_AB_LNB, I_AB_QNG, I_AB_KNG, I_AB_WOUT,
       I_CD_WADA, I_CD_BADA, I_CD_NORMG, I_CD_WIN, I_CD_WF, I_CD_RPB, I_CD_WOUT, I_FNG };

struct Frame {
    LAS unsigned char* lds;
    int tid, lane, wave, G, bid;
    const float* in[23]; float* out; unsigned char* ws;
};
DEVI bf16* wsb(const Frame& F, size_t off) { return (bf16*)(F.ws + off); }
DEVI float* wsf(const Frame& F, size_t off) { return (float*)(F.ws + off); }

DEVI float block_sum(float v, LAS float* red, int lane, int wave) {
    v = wave_sum(v);
    __syncthreads();
    if (lane == 0) red[wave] = v;
    __syncthreads();
    float s = 0.f;
#pragma unroll
    for (int i = 0; i < NWAVES; ++i) s += red[i];
    return s;
}

template <class Map>
DEVI void transpose_item(const float* W, int ldw, int c0, int ncols, int K, bf16* WT, Map map32, LAS float* scr, int item, int lane) {
    const int nblk = ncols / 32, kb = item / nblk, nb = item % nblk, k0 = 64 * kb, n0 = 32 * nb;
#pragma unroll 8
    for (int i = 0; i < 32; ++i) { const int kk = 2 * i + (lane >> 5); scr[kk * 33 + (lane & 31)] = W[(size_t)(k0 + kk) * ldw + c0 + n0 + (lane & 31)]; }
    LDS_WAIT(); asm volatile("" ::: "memory");
    const int c = lane & 7;
    const int drow0 = map32(nb) * 32;
#pragma unroll
    for (int j = 0; j < 4; ++j) { const int n = (lane >> 3) + 8 * j; const LAS float* s = scr + (8 * c) * 33 + n;
        v4u o; o.x = pk2(s[0 * 33], s[1 * 33]); o.y = pk2(s[2 * 33], s[3 * 33]); o.z = pk2(s[4 * 33], s[5 * 33]); o.w = pk2(s[6 * 33], s[7 * 33]);
        *(v4u*)(WT + (size_t)(drow0 + n) * K + k0 + 8 * c) = o; }
    LDS_WAIT(); asm volatile("" ::: "memory");
}
struct MapId { int off; DEVI int operator()(int nb) const { return nb + off; } };
struct MapIn0 { DEVI int operator()(int sb) const {
    if (sb < 16) return 8 * (sb >> 2) + (sb & 3);
    if (sb < 32) { const int cb = sb - 16; return 8 * (cb >> 2) + 4 + (cb & 3); }
    if (sb < 48) { const int qb = sb - 32, head = qb >> 1, bj = qb & 1; return 8 * (4 + (head >> 2)) + 4 * bj + (head & 3); }
    if (sb < 52) { const int kb = sb - 48; return 48 + 4 * (kb & 1) + (kb >> 1); }
    if (sb < 56) { const int vb = sb - 52; return 48 + 4 * (vb & 1) + 2 + (vb >> 1); }
    return sb; } };

DEVI void p0_prologue(Frame& F) {
    LAS float* scr = (LAS float*)(F.lds + F.wave * 16384);
    const int gw = F.bid * NWAVES + F.wave, NGW = F.G * NWAVES;
    constexpr int I0 = 16 * (AB_IN / 32), I1 = 16 * 32, I2 = 16 * ((CD_IN - 512) / 32), I3 = 16 * 32;
    for (int it = gw; it < I0 + I1 + I2 + I3; it += NGW) {
        int r = it;
        if (r < I0) { transpose_item(F.in[I_AB_WIN], AB_IN, 0, AB_IN, DM, wsb(F, WS_WIN0), MapIn0{}, scr, r, F.lane); continue; } r -= I0;
        if (r < I1) { transpose_item(F.in[I_AB_WOUT], DM, 0, DM, DM, wsb(F, WS_WOUT0), MapId{0}, scr, r, F.lane); continue; } r -= I1;
        if (r < I2) { transpose_item(F.in[I_CD_WIN], CD_IN, 512, CD_IN - 512, DM, wsb(F, WS_WIN1), MapId{32}, scr, r, F.lane); continue; } r -= I2;
        transpose_item(F.in[I_CD_WOUT], DM, 0, DM, DM, wsb(F, WS_WOUT1), MapId{0}, scr, r, F.lane);
    }
    __syncthreads();
    {
        LAS float* sl = (LAS float*)F.lds;
        for (int i = F.tid; i < 9 * 1024; i += NTHR) { const int r = i >> 10, k = i & 1023; const float cv = (r < 8) ? F.in[I_C][r * 1024 + k] : F.in[I_CCTX][k]; sl[i] = siluf(cv); }
        __syncthreads();
        float* ada = wsf(F, WS_ADA);
        for (int it = gw; it < 2 * 48 * 32; it += NGW) {
            const int l = it / 1536, rem = it % 1536, cc = rem >> 5, kc = rem & 31;
            const float* W = l ? F.in[I_CD_WADA] : F.in[I_AB_WADA]; const float* bb = l ? F.in[I_CD_BADA] : F.in[I_AB_BADA];
            const int col = cc * 64 + F.lane;
            float s[9];
#pragma unroll
            for (int r = 0; r < 9; ++r) s[r] = 0.f;
            const float* wp = W + (size_t)(kc * 32) * 3072 + col;
#pragma unroll 1
            for (int kh = 0; kh < 32; kh += 8) {
                float w[8];
#pragma unroll
                for (int k = 0; k < 8; ++k) w[k] = wp[(size_t)k * 3072];
                wp += 8 * 3072;
#pragma unroll
                for (int k4 = 0; k4 < 8; k4 += 4) {
#pragma unroll
                    for (int r = 0; r < 9; ++r) { const f32x4 sv = *(const LAS f32x4*)(sl + r * 1024 + kc * 32 + kh + k4); s[r] += sv.x * w[k4] + sv.y * w[k4 + 1] + sv.z * w[k4 + 2] + sv.w * w[k4 + 3]; }
                }
            }
            const float bv = (kc == 0) ? bb[col] : 0.f;
#pragma unroll
            for (int r = 0; r < 9; ++r) atomicAdd(&ada[(l * 9 + r) * 3072 + col], s[r] + bv);
        }
        __syncthreads();
    }
    {
        float* rope = wsf(F, WS_ROPE);
        for (int i = F.bid * NTHR + F.tid; i < SEQ * 32; i += F.G * NTHR) {
            const int t = i >> 5, p = i & 31; const int fi = p & 15;
            const float inv = (float)pow(10000.0, -(double)fi / 16.0);
            const float pos = (float)((p < 16) ? (t / GRIDW) : (t % GRIDW));
            const float ang = pos * inv;
            rope[2 * i] = (float)cos((double)ang); rope[2 * i + 1] = (float)sin((double)ang);
        }
    }
    {
        LAS float* t128 = (LAS float*)F.lds;
        if (F.tid < 128) { t128[F.tid] = (float)cospi((double)F.tid / 64.0); t128[128 + F.tid] = (float)sinpi((double)F.tid / 64.0); }
        __syncthreads();
        float* mcs = wsf(F, WS_MCS); const float* wf = F.in[I_CD_WF];
        for (int i = F.bid * NTHR + F.tid; i < 2 * 4 * 128 * 128; i += F.G * NTHR) {
            const int e = i & 127, c = (i >> 7) & 127, g = (i >> 14) & 3, cs = i >> 16;
            float s = 0.f;
            for (int cp = 0; cp < 128; ++cp) s += t128[cs * 128 + ((c * cp) & 127)] * wf[(g * 128 + cp) * 128 + e];
            mcs[i] = s * (1.f / 512.f);
        }
        __syncthreads();
    }
    {
        LAS float* t2k = (LAS float*)F.lds;
        for (int i = F.tid; i < 2048; i += NTHR) { t2k[i] = (float)cospi((double)i / 1024.0); t2k[2048 + i] = (float)sinpi((double)i / 1024.0); }
        __syncthreads();
        bf16* A = wsb(F, WS_DFT);
        for (int i = F.bid * NTHR + F.tid; i < 2048 * 512; i += F.G * NTHR) {
            const int lp = i >> 9, k0 = (i & 511) * 8; float v[8];
#pragma unroll
            for (int j = 0; j < 8; ++j) { const int k = k0 + j; const int idx = (lp * (k & 2047)) & 2047; v[j] = (k < 2048) ? t2k[idx] : -t2k[2048 + idx]; }
            v4u o; o.x = pk2(v[0], v[1]); o.y = pk2(v[2], v[3]); o.z = pk2(v[4], v[5]); o.w = pk2(v[6], v[7]);
            *(v4u*)(A + (size_t)lp * 4096 + k0) = o;
        }
        __syncthreads();
    }
}

DEVI void modnorm_row(const float* xrow, bf16* orow, const float* g, const float* shift, const float* scale, int lane) {
    f32x4 v[4]; float ss = 0.f;
#pragma unroll
    for (int j = 0; j < 4; ++j) { v[j] = *(const f32x4*)(xrow + 4 * lane + 256 * j); ss += (v[j].x * v[j].x + v[j].y * v[j].y) + (v[j].z * v[j].z + v[j].w * v[j].w); }
    const float rinv = 1.0f / sqrtf(wave_sum(ss) * (1.f / DM) + EPS);
#pragma unroll
    for (int j = 0; j < 4; ++j) {
        const int c = 4 * lane + 256 * j;
        const f32x4 gg = *(const f32x4*)(g + c), sh = *(const f32x4*)(shift + c), sc = *(const f32x4*)(scale + c);
        const float o0 = v[j].x * rinv * gg.x * (1.f + sc.x) + sh.x, o1 = v[j].y * rinv * gg.y * (1.f + sc.y) + sh.y;
        const float o2 = v[j].z * rinv * gg.z * (1.f + sc.z) + sh.z, o3 = v[j].w * rinv * gg.w * (1.f + sc.w) + sh.w;
        *(unsigned long long*)(orow + c) = (unsigned long long)pk2(o0, o1) | ((unsigned long long)pk2(o2, o3) << 32);
    }
}
DEVI void phase_modnorm(Frame& F, int layer) {
    const int gw = F.bid * NWAVES + F.wave, NGW = F.G * NWAVES;
    const float* ada = wsf(F, WS_ADA) + layer * 9 * 3072;
    const float* g = layer ? F.in[I_CD_NORMG] : F.in[I_AB_NORMG];
    bf16* H = wsb(F, WS_H);
    for (int m = gw; m < MT; m += NGW) {
        const float* xr; int r;
        if (m < MX) { r = m >> 11; xr = (layer ? (const float*)F.out : F.in[I_X]) + (size_t)m * DM; }
        else { r = 8; xr = (layer ? (const float*)wsf(F, WS_X1C) : F.in[I_CTX]) + (size_t)(m - MX) * DM; }
        modnorm_row(xr, H + (size_t)m * DM, g, ada + r * 3072, ada + r * 3072 + 1024, F.lane);
    }
}
DEVI void phase_fold(Frame& F) {
    const float* mcs = wsf(F, WS_MCS); const float* W = F.in[I_CD_WIN]; bf16* WT = wsb(F, WS_WIN1);
    LAS float* Ms = (LAS float*)F.lds;
    LAS float* Ws = Ms + 128 * 128;
    for (int it = F.bid; it < 8 * 32; it += F.G) {
        const int kc = it & 31, g = (it >> 5) & 3, cs = it >> 7, k0 = kc * 32;
        __syncthreads();
        const float* mp = mcs + (size_t)(cs * 4 + g) * 128 * 128;
        for (int i = F.tid; i < 128 * 128 / 4; i += NTHR) *(LAS f32x4*)(Ms + 4 * i) = *(const f32x4*)(mp + 4 * i);
        for (int i = F.tid; i < 32 * 128; i += NTHR) { const int k = i >> 7, c = i & 127; Ws[c * 32 + k] = W[(size_t)(k0 + k) * CD_IN + g * 128 + c]; }
        __syncthreads();
        const int e = F.tid & 127, kq = F.tid >> 7;
        float acc[8];
#pragma unroll
        for (int j = 0; j < 8; ++j) acc[j] = 0.f;
#pragma unroll 4
        for (int c = 0; c < 128; ++c) { const float mv = Ms[c * 128 + e]; const f32x4 w0 = *(const LAS f32x4*)(Ws + c * 32 + kq * 8), w1 = *(const LAS f32x4*)(Ws + c * 32 + kq * 8 + 4);
            acc[0] += mv * w0.x; acc[1] += mv * w0.y; acc[2] += mv * w0.z; acc[3] += mv * w0.w; acc[4] += mv * w1.x; acc[5] += mv * w1.y; acc[6] += mv * w1.z; acc[7] += mv * w1.w; }
        v4u o; o.x = pk2(acc[0], acc[1]); o.y = pk2(acc[2], acc[3]); o.z = pk2(acc[4], acc[5]); o.w = pk2(acc[6], acc[7]);
        *(v4u*)(WT + (size_t)(cs * 512 + g * 128 + e) * DM + k0 + kq * 8) = o;
    }
    __syncthreads();
}

namespace pg8 {
#define PG8_LAS __attribute__((address_space(3)))
typedef unsigned short bf16_t;
typedef short bf16x8 __attribute__((ext_vector_type(8)));
typedef unsigned u32x4 __attribute__((ext_vector_type(4)));
constexpr int BM = 256, BK = 64, HALF = 128, HTB = HALF * BK * 2, STAGE_BYTES = 8 * HTB, NXCD = 8, WGM = 8;
__host__ __device__ __forceinline__ int lds_byte(int r, int c) { const int st = (r >> 4) * 2 + (c >> 5), rr = r & 15, cc = c & 31, ob = rr * 64 + cc * 2; return st * 1024 + (ob ^ (((ob >> 9) & 1) << 5)); }
__host__ __device__ __forceinline__ void stage_rc(int b, int& R, int& C) { const int st = b / 1024, sb = b % 1024, swz = sb ^ (((sb >> 9) & 1) << 5); R = (st >> 1) * 16 + swz / 64; C = (st & 1) * 32 + (swz % 64) / 2; }
__host__ __device__ __forceinline__ int perm32(int rho) { const int n = rho >> 4, i = rho & 15; return 8 * (i >> 2) + 4 * n + (i & 3); }

struct Unit { int pm, pn, kind; const char* A; const char* B; };

struct Seg { const bf16_t* A; const bf16_t* Bt; int nM, nN, kind; };
struct SegOrder {
    Seg s0, s1, s2; int n0, n1, n2, G, c; size_t tstep;
    __device__ __forceinline__ void init(const Seg& a, const Seg& b, const Seg& d, int K, int G_, int c_) { s0 = a; s1 = b; s2 = d; n0 = a.nM * a.nN; n1 = b.nM * b.nN; n2 = d.nM * d.nN; G = G_; c = c_; tstep = (size_t)BM * K * 2; }
    __device__ __forceinline__ void map(const Seg& s, int nwg, int wgid, Unit& u) const {
        { const int q = nwg / NXCD, xcd = wgid % NXCD, off = wgid / NXCD; wgid = xcd * q + off; }
        const int nig = WGM * s.nN, gid = wgid / nig, fm = gid * WGM, gsz = (s.nM - fm) < WGM ? (s.nM - fm) : WGM;
        u.pm = fm + ((wgid % nig) % gsz); u.pn = (wgid % nig) / gsz; u.kind = s.kind;
        u.A = (const char*)s.A + (size_t)u.pm * tstep; u.B = (const char*)s.Bt + (size_t)u.pn * tstep;
    }
    __device__ __forceinline__ bool next(int i, Unit& u) const {
        int L = i * G + c;
        if (L < n0) { map(s0, n0, L, u); return true; } L -= n0;
        if (L < n1) { map(s1, n1, L, u); return true; } L -= n1;
        if (L < n2) { map(s2, n2, L, u); return true; }
        return false;
    }
};

__device__ __forceinline__ unsigned cvt_pk_bf16(float lo, float hi) { unsigned r; asm volatile("v_cvt_pk_bf16_f32 %0, %1, %2" : "=v"(r) : "v"(lo), "v"(hi)); return r; }

template <class Epi, class Sched, bool ALIGN_EPI = true>
__device__ __forceinline__ void gemm_phase(PG8_LAS unsigned char* lds, const int K, const Sched& S, const Epi& E) {
    const int tid = threadIdx.x, wid = __builtin_amdgcn_readfirstlane(tid >> 6), lane = tid & 63, wr = wid >> 2, wc = wid & 3, fr = lane & 15, fq = lane >> 4;
    const int nt = K / BK;
    unsigned voffA[2], voffB[2];
#pragma unroll
    for (int i = 0; i < 2; ++i) { int R, C; stage_rc(tid * 16 + i * 8192, R, C); const int Rb = Epi::PERM ? ((R & ~31) + perm32(R & 31)) : R;
        voffA[i] = (unsigned)(R * K + C) * 2u; voffB[i] = (unsigned)(Rb * K + C) * 2u; }
    const size_t kstep = (size_t)(BK * 2);
    const size_t hstep = (size_t)HALF * K * 2;
    const unsigned ldsw = (unsigned)wid * 1024u;
    const int aoff = lds_byte(wr * 64 + fr, fq * 8), boff = lds_byte(wc * 32 + fr, fq * 8);
#define PG8_SA(b, h) (((b) * 2 + (h)) * HTB)
#define PG8_SB(b, h) ((4 + (b) * 2 + (h)) * HTB)
#define PG8_STAGE(bufoff, gbase, voff) do { _Pragma("unroll") for (int _i = 0; _i < 2; ++_i) \
        __builtin_amdgcn_global_load_lds((const unsigned*)((const char*)(gbase) + (voff)[_i]), (PG8_LAS unsigned*)(lds + (bufoff) + ldsw + _i * 8192), 16, 0, 0); } while (0)
#define PG8_LDA(dst, b, h) do { _Pragma("unroll") for (int m = 0; m < 4; ++m) _Pragma("unroll") for (int k = 0; k < 2; ++k) dst[m][k] = *(const PG8_LAS bf16x8*)(lds + PG8_SA(b, h) + aoff + m * 2048 + k * 1024); } while (0)
#define PG8_LDB(dst, b, h) do { _Pragma("unroll") for (int n = 0; n < 2; ++n) _Pragma("unroll") for (int k = 0; k < 2; ++k) dst[n][k] = *(const PG8_LAS bf16x8*)(lds + PG8_SB(b, h) + boff + n * 2048 + k * 1024); } while (0)
#define PG8_MMA(ai, bj, At, Bt) do { __builtin_amdgcn_s_setprio(1); _Pragma("unroll") for (int m = 0; m < 4; ++m) _Pragma("unroll") for (int n = 0; n < 2; ++n) _Pragma("unroll") for (int k = 0; k < 2; ++k) \
        acc[ai][bj][m][n] = __builtin_amdgcn_mfma_f32_16x16x32_bf16(Bt[n][k], At[m][k], acc[ai][bj][m][n], 0, 0, 0); __builtin_amdgcn_s_setprio(0); } while (0)
#define PG8_WAIT_V(n) asm volatile("s_waitcnt vmcnt(" #n ")" ::: "memory")
#define PG8_WAIT_L(n) asm volatile("s_waitcnt lgkmcnt(" #n ")" ::: "memory")
#define PG8_BAR __builtin_amdgcn_s_barrier()
#define PG8_SCHED __builtin_amdgcn_sched_barrier(0)
    Unit cur, nxt; int ui = 0;
    if (!S.next(0, cur)) return;
    f32x4 acc[2][2][4][2];
#pragma unroll
    for (int a = 0; a < 2; ++a)
#pragma unroll
        for (int b = 0; b < 2; ++b)
#pragma unroll
            for (int m = 0; m < 4; ++m)
#pragma unroll
                for (int n = 0; n < 2; ++n) acc[a][b][m][n] = (f32x4){0.f, 0.f, 0.f, 0.f};
    bf16x8 At[4][2], B0[2][2], B1[2][2];
    const char* cA = cur.A; const char* cB = cur.B;
    PG8_STAGE(PG8_SB(0, 0), cB, voffB); PG8_STAGE(PG8_SB(0, 1), cB + hstep, voffB); PG8_STAGE(PG8_SA(0, 0), cA, voffA); PG8_STAGE(PG8_SA(0, 1), cA + hstep, voffA);
    if (wr == 1) PG8_BAR;
    PG8_WAIT_V(2); PG8_BAR;
    PG8_STAGE(PG8_SB(1, 0), cB + kstep, voffB); PG8_STAGE(PG8_SA(1, 0), cA + kstep, voffA); PG8_STAGE(PG8_SB(1, 1), cB + hstep + kstep, voffB);
    PG8_WAIT_V(6); PG8_BAR;
    for (;;) {
        const bool has_next = S.next(ui + 1, nxt);
        const char* nA = has_next ? nxt.A : cA; const char* nB = has_next ? nxt.B : cB;
        for (int t = 0; t < nt; t += 2) {
            const bool last = (t == nt - 2);
            const char* a1 = cA + (size_t)(t + 1) * kstep;
            const char* a2 = last ? nA : cA + (size_t)(t + 2) * kstep; const char* b2 = last ? nB : cB + (size_t)(t + 2) * kstep;
            const char* a3 = a2 + kstep; const char* b3 = b2 + kstep;
            PG8_LDB(B0, 0, 0); PG8_LDB(B1, 0, 1); PG8_SCHED; PG8_LDA(At, 0, 0); PG8_STAGE(PG8_SA(1, 1), a1 + hstep, voffA);
            PG8_WAIT_V(8); PG8_WAIT_L(0); PG8_BAR; PG8_MMA(0, 0, At, B0); PG8_MMA(0, 1, At, B1); PG8_BAR; PG8_SCHED;
            PG8_LDA(At, 0, 1); PG8_STAGE(PG8_SB(0, 0), b2, voffB); PG8_STAGE(PG8_SB(0, 1), b2 + hstep, voffB); PG8_STAGE(PG8_SA(0, 0), a2, voffA);
            PG8_WAIT_V(8); PG8_WAIT_L(0); PG8_BAR; PG8_MMA(1, 0, At, B0); PG8_MMA(1, 1, At, B1); PG8_BAR; PG8_SCHED;
            PG8_LDB(B0, 1, 0); PG8_LDB(B1, 1, 1); PG8_SCHED; PG8_LDA(At, 1, 0); PG8_STAGE(PG8_SA(0, 1), a2 + hstep, voffA);
            PG8_WAIT_V(8); PG8_WAIT_L(0); PG8_BAR; PG8_MMA(0, 0, At, B0); PG8_MMA(0, 1, At, B1); PG8_BAR; PG8_SCHED;
            PG8_LDA(At, 1, 1); PG8_STAGE(PG8_SB(1, 0), b3, voffB); PG8_STAGE(PG8_SB(1, 1), b3 + hstep, voffB); PG8_STAGE(PG8_SA(1, 0), a3, voffA);
            PG8_WAIT_V(8); PG8_WAIT_L(0); PG8_BAR; PG8_MMA(1, 0, At, B0); PG8_MMA(1, 1, At, B1); PG8_BAR; PG8_SCHED;
        }
        if constexpr (ALIGN_EPI) { if (wr == 0) PG8_BAR; }
        E(acc, cur, wr, wc, fr, fq);
        if (!has_next) break;
#pragma unroll
        for (int a = 0; a < 2; ++a)
#pragma unroll
            for (int b = 0; b < 2; ++b)
#pragma unroll
                for (int m = 0; m < 4; ++m)
#pragma unroll
                    for (int n = 0; n < 2; ++n) acc[a][b][m][n] = (f32x4){0.f, 0.f, 0.f, 0.f};
        cur = nxt; cA = nA; cB = nB; ++ui;
        if constexpr (ALIGN_EPI) { if (wr == 1) PG8_BAR; }
    }
    PG8_WAIT_V(0);
    if constexpr (!ALIGN_EPI) { if (wr == 0) PG8_BAR; }
    PG8_BAR;
#undef PG8_SA
#undef PG8_SB
#undef PG8_STAGE
#undef PG8_LDA
#undef PG8_LDB
#undef PG8_MMA
#undef PG8_WAIT_V
#undef PG8_WAIT_L
#undef PG8_BAR
#undef PG8_SCHED
}
}

typedef float f32x4acc[2][2][4][2];
DEVI float fsilu(float v) { return v * __builtin_amdgcn_rcpf(1.f + __builtin_amdgcn_exp2f(-LOG2E * v)); }
DEVI float fsigm(float v) { return __builtin_amdgcn_rcpf(1.f + __builtin_amdgcn_exp2f(-LOG2E * v)); }
DEVI v4u pack8(const f32x4& a, const f32x4& b) { v4u w; w.x = pg8::cvt_pk_bf16(a[0], a[1]); w.y = pg8::cvt_pk_bf16(a[2], a[3]); w.z = pg8::cvt_pk_bf16(b[0], b[1]); w.w = pg8::cvt_pk_bf16(b[2], b[3]); return w; }

struct EpiIn0 {
    static constexpr bool PERM = true;
    bf16 *GLU, *Q0, *K0, *V0, *SZ; const float *qng, *kng, *rope;
    DEVI void operator()(const f32x4 (&acc)[2][2][4][2], const pg8::Unit& u, int wr, int wc, int fr, int fq) const {
        const int pn = u.pn, pm = u.pm; const bool isx = pm < 64;
        const int cw = 32 * wc + 8 * fq;
        float g8[2][8];
        if (pn >= 4 && pn < 7) { const float* gn = (pn < 6) ? qng : kng;
#pragma unroll
            for (int bj = 0; bj < 2; ++bj) { const f32x4 a = *(const f32x4*)(gn + 32 * bj + 8 * fq), b = *(const f32x4*)(gn + 32 * bj + 8 * fq + 4);
                g8[bj][0] = a[0]; g8[bj][1] = a[1]; g8[bj][2] = a[2]; g8[bj][3] = a[3]; g8[bj][4] = b[0]; g8[bj][5] = b[1]; g8[bj][6] = b[2]; g8[bj][7] = b[3]; } }
#pragma unroll
        for (int ai = 0; ai < 2; ++ai)
#pragma unroll
            for (int m = 0; m < 4; ++m) {
                const int lr = 128 * ai + 64 * wr + 16 * m + fr;
                const int row = 256 * pm + lr;
                if (pn < 4) {
                    f32x4 o0, o1;
#pragma unroll
                    for (int e = 0; e < 4; ++e) { o0[e] = acc[ai][0][m][0][e] * fsigm(acc[ai][1][m][0][e]); o1[e] = acc[ai][0][m][1][e] * fsigm(acc[ai][1][m][1][e]); }
                    *(v4u*)(GLU + (size_t)row * 512 + 128 * pn + cw) = pack8(o0, o1);
                } else if (pn < 7) {
                    const bool isv = (pn == 6) && (wc >= 2);
                    int b, key, l;
                    if (isx) { b = pm >> 3; l = (pm & 7) * 256 + lr; key = CTXL + l; } else { b = pm - 64; l = 0; key = lr; }
                    if (isv) {
#pragma unroll
                        for (int bj = 0; bj < 2; ++bj) *(v4u*)(V0 + ((size_t)b * NKEY0 + key) * 128 + (wc - 2) * 64 + 32 * bj + 8 * fq) = pack8(acc[ai][bj][m][0], acc[ai][bj][m][1]);
                    } else {
                        float ss = 0.f;
#pragma unroll
                        for (int bj = 0; bj < 2; ++bj)
#pragma unroll
                            for (int n = 0; n < 2; ++n) { const f32x4 x = acc[ai][bj][m][n]; ss += (x[0] * x[0] + x[1] * x[1]) + (x[2] * x[2] + x[3] * x[3]); }
                        ss += __shfl_xor(ss, 16); ss += __shfl_xor(ss, 32);
                        const float rinv = 1.0f / sqrtf(ss * (1.f / 64.f) + EPS);
                        const float osc = (pn < 6) ? C2 : 1.f;
#pragma unroll
                        for (int bj = 0; bj < 2; ++bj) {
                            f32x4 v[2];
#pragma unroll
                            for (int n = 0; n < 2; ++n)
#pragma unroll
                                for (int e = 0; e < 4; ++e) v[n][e] = acc[ai][bj][m][n][e] * rinv * g8[bj][4 * n + e];
                            if (isx) {
#pragma unroll
                                for (int n = 0; n < 2; ++n) { const f32x4 cs = *(const f32x4*)(rope + ((size_t)l * 32 + 16 * bj + 4 * fq + 2 * n) * 2);
                                    const float a0 = v[n][0], b0 = v[n][1], a1 = v[n][2], b1 = v[n][3];
                                    v[n][0] = a0 * cs[0] - b0 * cs[1]; v[n][1] = a0 * cs[1] + b0 * cs[0]; v[n][2] = a1 * cs[2] - b1 * cs[3]; v[n][3] = a1 * cs[3] + b1 * cs[2]; } }
                            v[0] = v[0] * osc; v[1] = v[1] * osc;
                            if (pn < 6) *(v4u*)(Q0 + (size_t)row * 512 + (4 * (pn - 4) + wc) * 64 + 32 * bj + 8 * fq) = pack8(v[0], v[1]);
                            else *(v4u*)(K0 + ((size_t)b * NKEY0 + key) * 128 + wc * 64 + 32 * bj + 8 * fq) = pack8(v[0], v[1]);
                        }
                    }
                } else {
#pragma unroll
                    for (int bj = 0; bj < 2; ++bj) { f32x4 o0, o1;
#pragma unroll
                        for (int e = 0; e < 4; ++e) { o0[e] = fsilu(acc[ai][bj][m][0][e]); o1[e] = fsilu(acc[ai][bj][m][1][e]); }
                        *(v4u*)(SZ + (size_t)row * 1024 + 256 * (pn - 7) + 128 * bj + cw) = pack8(o0, o1); }
                }
            }
    }
};
struct EpiOut {
    static constexpr bool PERM = false;
    const float *xin_x, *xin_c, *ada; float *o_x, *o_c;
    DEVI void operator()(const f32x4 (&acc)[2][2][4][2], const pg8::Unit& u, int wr, int wc, int fr, int fq) const {
        const int pm = u.pm; const bool isx = pm < 64; const int r = isx ? (pm >> 3) : 8;
        const float* xin = isx ? xin_x + (size_t)pm * 256 * DM : xin_c + (size_t)(pm - 64) * 256 * DM; float* op = isx ? o_x + (size_t)pm * 256 * DM : o_c + (size_t)(pm - 64) * 256 * DM;
        const int col0 = 256 * u.pn + 32 * wc + 4 * fq;
        f32x4 gv[2][2];
#pragma unroll
        for (int bj = 0; bj < 2; ++bj)
#pragma unroll
            for (int n = 0; n < 2; ++n) gv[bj][n] = *(const f32x4*)(ada + r * 3072 + 2048 + col0 + 128 * bj + 16 * n);
#pragma unroll
        for (int ai = 0; ai < 2; ++ai)
#pragma unroll
            for (int m = 0; m < 4; ++m) { const size_t off = (size_t)(128 * ai + 64 * wr + 16 * m + fr) * DM + col0;
#pragma unroll
                for (int bj = 0; bj < 2; ++bj)
#pragma unroll
                    for (int n = 0; n < 2; ++n) { const f32x4 xv = *(const f32x4*)(xin + off + 128 * bj + 16 * n);
                        *(f32x4*)(op + off + 128 * bj + 16 * n) = xv + gv[bj][n] * acc[ai][bj][m][n]; } }
    }
};
struct EpiIn1 {
    static constexpr bool PERM = true;
    bf16 *PT, *Q1, *K1, *V1, *SZ1;
    DEVI void operator()(const f32x4 (&acc)[2][2][4][2], const pg8::Unit& u, int wr, int wc, int fr, int fq) const {
        const int pn = u.pn, pm = u.pm, kind = u.kind; const int cw = 32 * wc + 8 * fq;
#pragma unroll
        for (int ai = 0; ai < 2; ++ai)
#pragma unroll
            for (int m = 0; m < 4; ++m) {
                const int lr = 128 * ai + 64 * wr + 16 * m + fr;
#pragma unroll
                for (int bj = 0; bj < 2; ++bj) {
                    const f32x4 a0 = acc[ai][bj][m][0], a1 = acc[ai][bj][m][1];
                    if (kind == 2) {
                        const int jj = 256 * pm + lr, cs = jj >> 9, jc = jj & 511; const int tok = 256 * pn + 128 * bj + cw, b = tok >> 11, l = tok & 2047;
                        *(v4u*)(PT + ((size_t)(b * 512 + jc) * 2 + cs) * 2048 + l) = pack8(a0, a1);
                    } else if (kind == 1) {
                        const size_t row = (size_t)MX + 256 * pm + lr; bf16* dst = (pn < 2) ? K1 : V1;
                        *(v4u*)(dst + row * 512 + 256 * (pn & 1) + 128 * bj + cw) = pack8(a0, a1);
                    } else {
                        const size_t row = (size_t)256 * pm + lr;
                        if (pn < 2) *(v4u*)(Q1 + row * 512 + 256 * pn + 128 * bj + cw) = pack8(a0 * C2, a1 * C2);
                        else if (pn < 4) *(v4u*)(K1 + row * 512 + 256 * (pn - 2) + 128 * bj + cw) = pack8(a0, a1);
                        else if (pn < 6) *(v4u*)(V1 + row * 512 + 256 * (pn - 4) + 128 * bj + cw) = pack8(a0, a1);
                        else { f32x4 o0, o1;
#pragma unroll
                            for (int e = 0; e < 4; ++e) { o0[e] = fsilu(a0[e]); o1[e] = fsilu(a1[e]); }
                            *(v4u*)(SZ1 + row * 1024 + 256 * (pn - 6) + 128 * bj + cw) = pack8(o0, o1); }
                    }
                }
            }
    }
};
struct EpiDft {
    static constexpr bool PERM = true;
    bf16* Y1; const bf16* SZ1;
    DEVI void operator()(const f32x4 (&acc)[2][2][4][2], const pg8::Unit& u, int wr, int wc, int fr, int fq) const {
#pragma unroll
        for (int ai = 0; ai < 2; ++ai)
#pragma unroll
            for (int m = 0; m < 4; ++m) { const int lp = 256 * u.pm + 128 * ai + 64 * wr + 16 * m + fr;
#pragma unroll
                for (int bj = 0; bj < 2; ++bj) { const int n = 256 * u.pn + 128 * bj + 32 * wc + 8 * fq, b = n >> 9, j = n & 511;
                    const size_t off = (size_t)(b * 2048 + lp) * 1024 + j; const v4u z = *(const v4u*)(SZ1 + off);
                    f32x4 o0 = acc[ai][bj][m][0], o1 = acc[ai][bj][m][1];
                    o0[0] *= bflo(z.x); o0[1] *= bfhi(z.x); o0[2] *= bflo(z.y); o0[3] *= bfhi(z.y); o1[0] *= bflo(z.z); o1[1] *= bfhi(z.z); o1[2] *= bflo(z.w); o1[3] *= bfhi(z.w);
                    *(v4u*)(Y1 + off) = pack8(o0, o1); } }
    }
};

namespace attn_body {
using bf16=__hip_bfloat16;
using bf16x8=__attribute__((ext_vector_type(8)))short;
using s16x4=__attribute__((ext_vector_type(4)))short;
using f32x16=__attribute__((ext_vector_type(16)))float;
using u32x4=__attribute__((ext_vector_type(4)))unsigned;
constexpr int D=64,NW=8,QBLK=32,QB=QBLK*NW,KVBLK=64;
constexpr int QP=512,YP=1024;
__device__ __forceinline__ int crow(int r,int hi){return (r&3)+8*(r>>2)+4*hi;}
#define SBAR() __builtin_amdgcn_sched_barrier(0)
constexpr int NSLOT=3, SLOTB=8192;
constexpr int LDS_K=0, LDS_V=NSLOT*SLOTB, LDS_WS=2*NSLOT*SLOTB, LDS_OST=LDS_WS+NW*64*4, LDS_BYTES=LDS_OST+NW*4096;
__device__ __forceinline__ void glds16(const void*gsrc,unsigned lds_dst){unsigned keep;
  asm volatile("s_mov_b32 %0, m0\n\ts_mov_b32 m0, %2\n\ts_nop 0\n\tglobal_load_lds_dwordx4 %1, off\n\ts_mov_b32 m0, %0":"=&s"(keep):"v"(gsrc),"s"(lds_dst):"memory");}
__device__ __forceinline__ float max3f(float a,float b,float c){float r;asm("v_max3_f32 %0, %1, %2, %3":"=v"(r):"v"(a),"v"(b),"v"(c));return r;}
__device__ __forceinline__ float max2f(float a,float b){float r;asm("v_max_f32_e32 %0, %1, %2":"=v"(r):"v"(a),"v"(b));return r;}
__device__ __forceinline__ float fadd_s(float a,float b){float r;asm("v_add_f32_e32 %0, %1, %2":"=v"(r):"v"(a),"v"(b));return r;}
__device__ __forceinline__ float fsub_s(float a,float b){float r;asm("v_sub_f32_e32 %0, %1, %2":"=v"(r):"v"(a),"v"(b));return r;}
typedef float f32x2_t __attribute__((ext_vector_type(2))); typedef __bf16 bf16x2_t __attribute__((ext_vector_type(2)));
__device__ __forceinline__ unsigned cvtpk_s(float lo,float hi){f32x2_t v={lo,hi};bf16x2_t b=__builtin_convertvector(v,bf16x2_t);return __builtin_bit_cast(unsigned,b);}
#define WAIT_BAR(N) asm volatile("s_waitcnt vmcnt(" #N ") lgkmcnt(0)\n\ts_barrier":::"memory")
__device__ __forceinline__ void qkt(f32x16&p0,f32x16&p1,const char*Kslot,const bf16x8*qr,const f32x16&negm,int r32,int hi){
  const char*kb=Kslot+hi*1024+r32*16;
  #pragma unroll
  for(int d0=0;d0<4;++d0){
    const bf16x8 b0=*reinterpret_cast<const bf16x8*>(kb+d0*2048);
    const bf16x8 b1=*reinterpret_cast<const bf16x8*>(kb+d0*2048+512);
    if(d0==0){p0=__builtin_amdgcn_mfma_f32_32x32x16_bf16(b0,qr[0],negm,0,0,0);p1=__builtin_amdgcn_mfma_f32_32x32x16_bf16(b1,qr[0],negm,0,0,0);}
    else{p0=__builtin_amdgcn_mfma_f32_32x32x16_bf16(b0,qr[d0],p0,0,0,0);p1=__builtin_amdgcn_mfma_f32_32x32x16_bf16(b1,qr[d0],p1,0,0,0);}}
}
typedef __attribute__((address_space(3))) const char* lds_cptr;
typedef short v4i16_t __attribute__((ext_vector_type(4)));
__device__ __forceinline__ void kload8(bf16x8*kf,lds_cptr kp){
  kf[0]=*(const __attribute__((address_space(3))) bf16x8*)(kp);      kf[1]=*(const __attribute__((address_space(3))) bf16x8*)(kp+512);
  kf[2]=*(const __attribute__((address_space(3))) bf16x8*)(kp+2048); kf[3]=*(const __attribute__((address_space(3))) bf16x8*)(kp+2560);
  kf[4]=*(const __attribute__((address_space(3))) bf16x8*)(kp+4096); kf[5]=*(const __attribute__((address_space(3))) bf16x8*)(kp+4608);
  kf[6]=*(const __attribute__((address_space(3))) bf16x8*)(kp+6144); kf[7]=*(const __attribute__((address_space(3))) bf16x8*)(kp+6656);
}
__device__ __forceinline__ void kload2(bf16x8*kf,lds_cptr kp,int j){ kf[2*j]=*(const __attribute__((address_space(3))) bf16x8*)(kp+j*2048); kf[2*j+1]=*(const __attribute__((address_space(3))) bf16x8*)(kp+j*2048+512); }
__device__ __forceinline__ s16x4 vtr(lds_cptr p){ return __builtin_bit_cast(s16x4,__builtin_amdgcn_ds_read_tr16_b64_v4i16((__attribute__((address_space(3))) v4i16_t*)p)); }
__device__ __forceinline__ float rowmax(const f32x16&p0,const f32x16&p1){
  float a=max3f(p0[0],p0[1],p1[0]),b=max3f(p0[2],p0[3],p1[1]);a=max3f(a,p1[2],p1[3]);
  #pragma unroll
  for(int r=4;r<16;r+=4){a=max3f(a,p0[r],p0[r+1]);b=max3f(b,p0[r+2],p0[r+3]);a=max3f(a,p1[r],p1[r+1]);b=max3f(b,p1[r+2],p1[r+3]);}
  const float m=max2f(a,b);
  auto rr=__builtin_amdgcn_permlane32_swap(__float_as_uint(m),__float_as_uint(m),false,false);
  return max2f(__uint_as_float(rr[0]),__uint_as_float(rr[1]));
}
__device__ __forceinline__ void pv(f32x16*o,int vb,bf16x8 pa0,bf16x8 pa1,bf16x8 pa2,bf16x8 pa3){
  #pragma unroll
  for(int d0=0;d0<2;++d0){s16x4 lo[4],hi[4];
    #pragma unroll
    for(int ks=0;ks<4;++ks){
      asm volatile("ds_read_b64_tr_b16 %0,%1 offset:%c2":"=&v"(lo[ks]):"v"(vb),"i"(d0*4096+ks*1024):"memory");
      asm volatile("ds_read_b64_tr_b16 %0,%1 offset:%c2":"=&v"(hi[ks]):"v"(vb),"i"(d0*4096+ks*1024+512):"memory");}
    asm volatile("s_waitcnt lgkmcnt(0)":::"memory");SBAR();
    #define PK(k) (bf16x8){lo[k][0],lo[k][1],lo[k][2],lo[k][3],hi[k][0],hi[k][1],hi[k][2],hi[k][3]}
    o[d0]=__builtin_amdgcn_mfma_f32_32x32x16_bf16(pa0,PK(0),o[d0],0,0,0);
    o[d0]=__builtin_amdgcn_mfma_f32_32x32x16_bf16(pa1,PK(1),o[d0],0,0,0);
    o[d0]=__builtin_amdgcn_mfma_f32_32x32x16_bf16(pa2,PK(2),o[d0],0,0,0);
    o[d0]=__builtin_amdgcn_mfma_f32_32x32x16_bf16(pa3,PK(3),o[d0],0,0,0);
    #undef PK
  }
}
template<int THRL,bool NAT,int KVP> __device__ __forceinline__ void attn_unit(const bf16*Qu,const bf16*__restrict__ Kh,const bf16*__restrict__ Vh,const int NT,bf16*Yu,const bf16*Zu,char*shm,
    const long ctxoff=0,const long winoff=0,const int kr0=0,const int rq0=0,const float*btab=nullptr){
  const int tid=threadIdx.x,lane=tid&63,r32=lane&31,hi=lane>>5; const int wid=__builtin_amdgcn_readfirstlane(tid>>6);
  const bf16*Qw=Qu+(long)(wid*QBLK)*QP;
  const unsigned lds0=(unsigned)(uintptr_t)shm;
  float*wsf=(float*)(shm+LDS_WS)+wid*64;
  const bf16*ksrc=Kh+(long)lane*KVP+wid*8;
  const bf16*vsrc=Vh+(long)(16*(wid&3)+(lane>>2))*KVP+(wid>>2)*32+(lane&3)*8;
  const unsigned kdst=lds0+LDS_K+wid*1024, vdst=lds0+LDS_V+wid*1024;
  #define TOFF(t) (NAT ? (((t)<4) ? (ctxoff+(long)(t)*KVBLK)*KVP : (winoff+(long)((t)-4)*KVBLK)*KVP) : (long)(t)*KVBLK*KVP)
  #define DMA_K(t,slot) glds16(ksrc+TOFF(t),(unsigned)__builtin_amdgcn_readfirstlane(kdst+(slot)))
  #define DMA_V(t,slot) glds16(vsrc+TOFF(t),(unsigned)__builtin_amdgcn_readfirstlane(vdst+(slot)))
  const int nq_r=rq0+(wid>>1), nq_c=32*(wid&1)+r32;
  const int nq_rs=min(max(nq_r-4,0),24), nq_cs=min(max(nq_c-8,0),48);
  const int nq_vb=4*hi-nq_cs, nq_lb=48+15+4*hi-nq_c;
  #define BIASMASK(C0,C1,t) do{ if(NAT && (t)>=4){ const int kr_=kr0+(t)-4; const bool rowok_=(unsigned)(kr_-nq_rs)<8u; const int dr_=min(max(kr_-nq_r+7,0),14); \
      const float*tb_=btab+dr_*31+nq_lb; \
      _Pragma("unroll") for(int rb=0;rb<16;rb+=4){ float b0_[4],b1_[4]; \
        _Pragma("unroll") for(int r=0;r<4;++r){ const int kc_=((rb+r)&3)+8*((rb+r)>>2); b0_[r]=tb_[kc_]; b1_[r]=tb_[kc_+32]; } \
        _Pragma("unroll") for(int r=0;r<4;++r){ const int kc_=((rb+r)&3)+8*((rb+r)>>2); \
          const bool v0_=rowok_&&((unsigned)(kc_+nq_vb)<16u), v1_=rowok_&&((unsigned)(kc_+32+nq_vb)<16u); \
          C0[rb+r]=v0_?C0[rb+r]+b0_[r]:-1e30f; C1[rb+r]=v1_?C1[rb+r]+b1_[r]:-1e30f; } \
        SBAR(); } } }while(0)
  const int vb0=(int)(lds0+LDS_V)+((lane>>4)&1)*32+(lane&3)*8+(4*hi+((lane&15)>>2))*64;
  const char*Kbase=shm+LDS_K; bf16x8 kf[8];
  const lds_cptr shm3=(lds_cptr)shm; const lds_cptr kp0=shm3+LDS_K+hi*1024+r32*16; const lds_cptr vp0=shm3+LDS_V+((lane>>4)&1)*32+(lane&3)*8+(4*hi+((lane&15)>>2))*64;
  DMA_K(0,0);DMA_V(0,0);DMA_K(1,SLOTB);
  bf16x8 qr[4];
  #pragma unroll
  for(int d0=0;d0<4;++d0)qr[d0]=*reinterpret_cast<const bf16x8*>(&Qw[(long)r32*QP+d0*16+hi*8]);
  float mhat=0.f,l_reg=0.f;f32x16 o[2];o[0]=f32x16{};o[1]=f32x16{};float zin_;asm volatile("v_mov_b32 %0, 0":"=v"(zin_));f32x16 negm;
  _Pragma("unroll") for(int r=0;r<16;++r)negm[r]=zin_; asm volatile("":"+v"(negm));
  bool resc=false;
  #define START(P0,P1) do{ const float rm=rowmax(P0,P1); resc=false; \
    { const float dl=rm; mhat=fadd_s(mhat,dl); \
      _Pragma("unroll") for(int r=0;r<16;++r){P0[r]=fsub_s(P0[r],dl);P1[r]=fsub_s(P1[r],dl);} \
      _Pragma("unroll") for(int r=0;r<16;++r)negm[r]=-mhat; asm volatile("":"+v"(negm)); } \
    _Pragma("unroll") for(int r=0;r<16;++r)P0[r]=__builtin_amdgcn_exp2f(P0[r]); }while(0)
  #define RESC() do{ if(resc){ asm volatile("s_waitcnt lgkmcnt(0)":::"memory"); \
      _Pragma("unroll") for(int d_=0;d_<2;++d_) _Pragma("unroll") for(int r=0;r<16;++r)o[d_][r]*=wsf[crow(r,hi)]; } }while(0)
  f32x16 pA0,pA1,pB0,pB1;
  int sl_prev=0,sl_cur=0,sl_next=SLOTB;
  #define ROT() do{sl_prev=sl_cur;sl_cur=sl_next;sl_next=(sl_next==(NSLOT-1)*SLOTB)?0:sl_next+SLOTB;}while(0)
  DMA_K(2,2*SLOTB);
  WAIT_BAR(3);
  qkt(pA0,pA1,Kbase,qr,negm,r32,hi);asm volatile("s_nop 15\n\ts_nop 7":"+v"(pA0),"+v"(pA1));
  START(pA0,pA1);
  _Pragma("unroll") for(int r=0;r<16;++r)pA1[r]=__builtin_amdgcn_exp2f(pA1[r]);
  WAIT_BAR(0);
  DMA_K(3,0);DMA_V(1,SLOTB);
  ROT();
  kload8(kf,kp0+sl_cur);
  WAIT_BAR(2);
  s16x4 vlo[8],vhi[8]; u32x4 pw0,pw1,pw2,pw3;
  #define PKW(P,B) cvtpk_s(P[B],P[B+1])
  #define PAF(k) __builtin_bit_cast(bf16x8,pw##k)
  #define VFR(i) (bf16x8){vlo[i][0],vlo[i][1],vlo[i][2],vlo[i][3],vhi[i][0],vhi[i][1],vhi[i][2],vhi[i][3]}
  #define PIN(x) asm volatile("":"+v"(x))
  #define MX3(a,b,c) __builtin_fmaxf(__builtin_fmaxf((a),(b)),(c))
  #define GAPA(MF,A0,A1,A2,A3,W0,W1,PW) do{ MF; sacc+=A0; sacc+=A1; sacc+=A2; sacc+=A3; PIN(sacc); W0; W1; PIN(PW); SBAR(); }while(0)
  #define EX(v) __builtin_amdgcn_exp2f(v)
  #define GAPB(MF,X,B) do{ MF; X[B]=EX(X[B]); X[B+1]=EX(X[B+1]); X[B+2]=EX(X[B+2]); X[B+3]=EX(X[B+3]); PIN(X); SBAR(); }while(0)
  #define VRD(i) do{ vlo[i]=vtr(vp_+(((i)>>2)*4096+((i)&3)*1024)); vhi[i]=vtr(vp_+(((i)>>2)*4096+((i)&3)*1024+512)); }while(0)
  #define KRD(G,j) do{ if(G){ kload2(kf,kp0+sl_next,j); SBAR(); } }while(0)
  #define STEP(C0,C1,P0,P1,t,GK,GV,GL) do{ SBAR(); \
    const lds_cptr vp_=vp0+sl_prev; \
    VRD(0); SBAR(); float sacc=(P0[0]+P0[1]); \
    GAPA(C0=__builtin_amdgcn_mfma_f32_32x32x16_bf16(kf[0],qr[0],negm,0,0,0), P0[2],P0[3],P0[4],P0[5],     pw0[0]=PKW(P0,0), pw0[1]=PKW(P0,2), pw0); \
    VRD(4); SBAR(); GAPA(C1=__builtin_amdgcn_mfma_f32_32x32x16_bf16(kf[1],qr[0],negm,0,0,0), P0[6],P0[7],P0[8],P0[9],     pw0[2]=PKW(P0,4), pw0[3]=PKW(P0,6), pw0); \
    VRD(1); SBAR(); GAPA(C0=__builtin_amdgcn_mfma_f32_32x32x16_bf16(kf[2],qr[1],C0,0,0,0),   P0[10],P0[11],P0[12],P0[13], pw1[0]=PKW(P0,8), pw1[1]=PKW(P0,10), pw1); \
    VRD(5); SBAR(); GAPA(C1=__builtin_amdgcn_mfma_f32_32x32x16_bf16(kf[3],qr[1],C1,0,0,0),   P0[14],P0[15],P1[0],P1[1],   pw1[2]=PKW(P0,12),pw1[3]=PKW(P0,14), pw1); \
    VRD(2); SBAR(); GAPA(C0=__builtin_amdgcn_mfma_f32_32x32x16_bf16(kf[4],qr[2],C0,0,0,0),   P1[2],P1[3],P1[4],P1[5],     pw2[0]=PKW(P1,0), pw2[1]=PKW(P1,2), pw2); \
    VRD(6); SBAR(); GAPA(C1=__builtin_amdgcn_mfma_f32_32x32x16_bf16(kf[5],qr[2],C1,0,0,0),   P1[6],P1[7],P1[8],P1[9],     pw2[2]=PKW(P1,4), pw2[3]=PKW(P1,6), pw2); \
    VRD(3); SBAR(); GAPA(C0=__builtin_amdgcn_mfma_f32_32x32x16_bf16(kf[6],qr[3],C0,0,0,0),   P1[10],P1[11],P1[12],P1[13], pw3[0]=PKW(P1,8), pw3[1]=PKW(P1,10), pw3); \
    VRD(7); SBAR(); GAPA(C1=__builtin_amdgcn_mfma_f32_32x32x16_bf16(kf[7],qr[3],C1,0,0,0),   P1[14],P1[15],0.f,0.f,       pw3[2]=PKW(P1,12),pw3[3]=PKW(P1,14), pw3); \
    l_reg+=sacc; \
    if(GK){DMA_K((t)+3,sl_cur);} if(GV){DMA_V((t)+1,sl_next);} \
    BIASMASK(C0,C1,t); \
    { float a=MX3(C0[0],C0[1],C1[0]),b=MX3(C0[2],C0[3],C1[1]); a=MX3(a,C1[2],C1[3]); \
      _Pragma("unroll") for(int r=4;r<16;r+=4){a=MX3(a,C0[r],C0[r+1]);b=MX3(b,C0[r+2],C0[r+3]);a=MX3(a,C1[r],C1[r+1]);b=MX3(b,C1[r+2],C1[r+3]);} \
      float rm=__builtin_fmaxf(a,b); { auto rr=__builtin_amdgcn_permlane32_swap(__float_as_uint(rm),__float_as_uint(rm),false,false); rm=__builtin_fmaxf(__uint_as_float(rr[0]),__uint_as_float(rr[1])); } \
      resc=false; \
      if(__builtin_expect(__any(rm>(float)THRL),0)){ const float dl=__builtin_fmaxf(rm,0.f); mhat+=dl; \
        _Pragma("unroll") for(int r=0;r<16;++r){C0[r]-=dl;C1[r]-=dl;} \
        _Pragma("unroll") for(int r=0;r<16;++r)negm[r]=-mhat; asm volatile("":"+v"(negm)); \
        const float f=__builtin_amdgcn_exp2f(-dl); l_reg*=f; if(hi==0)wsf[r32]=f; resc=true; } } \
    SBAR(); \
    GAPB(o[0]=__builtin_amdgcn_mfma_f32_32x32x16_bf16(PAF(0),VFR(0),o[0],0,0,0), C0,0); \
    GAPB(o[1]=__builtin_amdgcn_mfma_f32_32x32x16_bf16(PAF(0),VFR(4),o[1],0,0,0), C0,4); \
    KRD(GL,0); GAPB(o[0]=__builtin_amdgcn_mfma_f32_32x32x16_bf16(PAF(1),VFR(1),o[0],0,0,0), C0,8); \
    KRD(GL,1); GAPB(o[1]=__builtin_amdgcn_mfma_f32_32x32x16_bf16(PAF(1),VFR(5),o[1],0,0,0), C0,12); \
    KRD(GL,2); GAPB(o[0]=__builtin_amdgcn_mfma_f32_32x32x16_bf16(PAF(2),VFR(2),o[0],0,0,0), C1,0); \
    KRD(GL,3); GAPB(o[1]=__builtin_amdgcn_mfma_f32_32x32x16_bf16(PAF(2),VFR(6),o[1],0,0,0), C1,4); \
    GAPB(o[0]=__builtin_amdgcn_mfma_f32_32x32x16_bf16(PAF(3),VFR(3),o[0],0,0,0), C1,8); \
    GAPB(o[1]=__builtin_amdgcn_mfma_f32_32x32x16_bf16(PAF(3),VFR(7),o[1],0,0,0), C1,12); \
    }while(0)
  int t=1;
  for(;t+5<NT;t+=2){
    STEP(pB0,pB1,pA0,pA1,t,true,true,true);     WAIT_BAR(2); RESC(); ROT();
    STEP(pA0,pA1,pB0,pB1,t+1,true,true,true);   WAIT_BAR(2); RESC(); ROT();
  }
  #define ENDW(tt) do{ if((tt)+3<NT){WAIT_BAR(2);} else if((tt)+2<NT){WAIT_BAR(1);} else {WAIT_BAR(0);} }while(0)
  for(;t+1<NT;t+=2){
    STEP(pB0,pB1,pA0,pA1,t,(t+3<NT),(t+1<NT),(t+1<NT));       ENDW(t);   RESC(); ROT();
    STEP(pA0,pA1,pB0,pB1,t+1,(t+4<NT),(t+2<NT),(t+2<NT));     ENDW(t+1); RESC(); ROT();
  }
  STEP(pB0,pB1,pA0,pA1,NT-1,false,false,false); RESC();
  { float sacc=pB0[0]+pB0[1]; _Pragma("unroll") for(int r=2;r<16;++r)sacc+=pB0[r]; _Pragma("unroll") for(int r=0;r<16;++r)sacc+=pB1[r]; l_reg+=sacc;
    pw0=(u32x4){PKW(pB0,0),PKW(pB0,2),PKW(pB0,4),PKW(pB0,6)};pw1=(u32x4){PKW(pB0,8),PKW(pB0,10),PKW(pB0,12),PKW(pB0,14)};pw2=(u32x4){PKW(pB1,0),PKW(pB1,2),PKW(pB1,4),PKW(pB1,6)};pw3=(u32x4){PKW(pB1,8),PKW(pB1,10),PKW(pB1,12),PKW(pB1,14)};
    SBAR(); pv(o,vb0+sl_cur,PAF(0),PAF(1),PAF(2),PAF(3)); }
  #undef PKW
  #undef PAF
  #undef VFR
  #undef PIN
  #undef MX3
  #undef GAPA
  #undef GAPB
  #undef EX
  #undef VRD
  #undef KRD
  #undef STEP
  #undef ENDW
  {auto rr=__builtin_amdgcn_permlane32_swap(__float_as_uint(l_reg),__float_as_uint(l_reg),false,false);l_reg=__uint_as_float(rr[0])+__uint_as_float(rr[1]);}
  if(hi==0)wsf[32+r32]=l_reg;asm volatile("s_waitcnt lgkmcnt(0)":::"memory");
  float rli[16];
  #pragma unroll
  for(int r=0;r<16;++r)rli[r]=__builtin_amdgcn_rcpf(wsf[32+crow(r,hi)]);
  bf16*Yw=Yu+(long)(wid*QBLK)*YP; const bf16*Zw=Zu+(long)(wid*QBLK)*YP;
  { bf16*stg=(bf16*)(shm+LDS_OST)+wid*2048;
    #pragma unroll
    for(int r=0;r<16;++r){const int orow=crow(r,hi);
      #pragma unroll
      for(int d0=0;d0<2;++d0)stg[orow*64+d0*32+r32]=__float2bfloat16(o[d0][r]*rli[r]);}
    asm volatile("s_waitcnt lgkmcnt(0)":::"memory");
    #pragma unroll
    for(int i=0;i<4;++i){const int row=i*8+(lane>>3),ch=lane&7; const u32x4 v=*(const u32x4*)(stg+row*64+ch*8); const u32x4 z=*(const u32x4*)(Zw+(long)row*YP+ch*8); u32x4 w;
      w.x=cvtpk_s(__uint_as_float(v.x<<16)*__uint_as_float(z.x<<16),__uint_as_float(v.x&0xffff0000u)*__uint_as_float(z.x&0xffff0000u));
      w.y=cvtpk_s(__uint_as_float(v.y<<16)*__uint_as_float(z.y<<16),__uint_as_float(v.y&0xffff0000u)*__uint_as_float(z.y&0xffff0000u));
      w.z=cvtpk_s(__uint_as_float(v.z<<16)*__uint_as_float(z.z<<16),__uint_as_float(v.z&0xffff0000u)*__uint_as_float(z.z&0xffff0000u));
      w.w=cvtpk_s(__uint_as_float(v.w<<16)*__uint_as_float(z.w<<16),__uint_as_float(v.w&0xffff0000u)*__uint_as_float(z.w&0xffff0000u));
      *(u32x4*)(Yw+(long)row*YP+ch*8)=w;} }
  asm volatile("s_waitcnt lgkmcnt(0)\n\ts_barrier":::"memory");
  #undef DMA_K
  #undef DMA_V
  #undef TOFF
  #undef BIASMASK
  #undef START
  #undef RESC
  #undef ROT
}
#undef SBAR
#undef WAIT_BAR
}

DEVI void phase_attn0(Frame& F, char* lds_generic) {
    using abf = attn_body::bf16;
    const abf* Q0 = (const abf*)wsb(F, WS_Q0); const abf* K0 = (const abf*)wsb(F, WS_K0); const abf* V0 = (const abf*)wsb(F, WS_V0);
    const abf* SZ = (const abf*)wsb(F, WS_SZ0); abf* Y = (abf*)wsb(F, WS_Y0);
    const int vcu = (F.bid & 7) * (F.G >> 3) + (F.bid >> 3);
    for (int id = vcu; id < 512 + 64; id += F.G) {
        int b, head, NT; size_t row0;
        if (id < 512) { const int qb = id & 7, g = (id >> 3) & 3, kvh = (id >> 5) & 1; b = id >> 6; head = kvh * 4 + g; row0 = (size_t)b * SEQ + qb * 256; NT = NKEY0 / 64; }
        else { const int j = id - 512; b = j >> 3; head = j & 7; row0 = (size_t)MX + b * CTXL; NT = CTXL / 64; }
        const size_t kvoff = (size_t)b * NKEY0 * 128 + (head >> 2) * 64;
        attn_body::attn_unit<8, false, 128>(Q0 + row0 * 512 + head * 64, K0 + kvoff, V0 + kvoff, NT, Y + row0 * 1024 + 512 + head * 64, SZ + row0 * 1024 + 512 + head * 64, lds_generic);
    }
}

DEVI void phase_conv(Frame& F) {
    LAS float* wl = (LAS float*)F.lds;
    const bf16* GLU = wsb(F, WS_GLU); const bf16* SZ = wsb(F, WS_SZ0); bf16* Y = wsb(F, WS_Y0);
    __syncthreads();
    for (int i = F.tid; i < 31 * 512; i += NTHR) wl[i] = F.in[I_AB_CONVW][i];
    __syncthreads();
    const int c8 = F.lane * 8;
    float cb[8], lg[8], lb[8];
#pragma unroll
    for (int j = 0; j < 8; ++j) { cb[j] = F.in[I_AB_CONVB][c8 + j]; lg[j] = F.in[I_AB_LNG][c8 + j]; lb[j] = F.in[I_AB_LNB][c8 + j]; }
    const int gw = F.bid * NWAVES + F.wave, NGW = F.G * NWAVES;
    for (int row = gw; row < MT; row += NGW) {
        int base, len, pos;
        if (row < MX) { base = row & ~2047; len = SEQ; pos = row & 2047; } else { const int rc = row - MX; base = MX + (rc & ~255); len = CTXL; pos = rc & 255; }
        float u[8];
#pragma unroll
        for (int j = 0; j < 8; ++j) u[j] = cb[j];
        const int t0 = max(0, 15 - pos), t1 = min(31, len + 15 - pos);
        for (int t = t0; t < t1; ++t) {
            const v4u gv = *(const v4u*)(GLU + (size_t)(base + pos + t - 15) * 512 + c8);
            const f32x4 w0 = *(const LAS f32x4*)(wl + t * 512 + c8), w1 = *(const LAS f32x4*)(wl + t * 512 + c8 + 4);
            u[0] += bflo(gv.x) * w0.x; u[1] += bfhi(gv.x) * w0.y; u[2] += bflo(gv.y) * w0.z; u[3] += bfhi(gv.y) * w0.w;
            u[4] += bflo(gv.z) * w1.x; u[5] += bfhi(gv.z) * w1.y; u[6] += bflo(gv.w) * w1.z; u[7] += bfhi(gv.w) * w1.w;
        }
        float sm = 0.f;
#pragma unroll
        for (int j = 0; j < 8; ++j) sm += u[j];
        const float mean = wave_sum(sm) * (1.f / 512.f);
        float sq = 0.f;
#pragma unroll
        for (int j = 0; j < 8; ++j) { u[j] -= mean; sq += u[j] * u[j]; }
        const float rstd = 1.0f / sqrtf(wave_sum(sq) * (1.f / 512.f) + EPS);
        const v4u zv = *(const v4u*)(SZ + (size_t)row * 1024 + c8);
        float y[8];
#pragma unroll
        for (int j = 0; j < 8; ++j) y[j] = fsilu(u[j] * rstd * lg[j] + lb[j]);
        v4u o; o.x = pk2(y[0] * bflo(zv.x), y[1] * bfhi(zv.x)); o.y = pk2(y[2] * bflo(zv.y), y[3] * bfhi(zv.y)); o.z = pk2(y[4] * bflo(zv.z), y[5] * bfhi(zv.z)); o.w = pk2(y[6] * bflo(zv.w), y[7] * bfhi(zv.w));
        *(v4u*)(Y + (size_t)row * 1024 + c8) = o;
    }
    __syncthreads();
}

constexpr int NA_BTAB_OFF = 90112;
DEVI void na_unit(Frame& F, char* lds_generic, int id) {
    using abf = attn_body::bf16;
    const abf* Q1 = (const abf*)wsb(F, WS_Q1); const abf* K1 = (const abf*)wsb(F, WS_K1); const abf* V1 = (const abf*)wsb(F, WS_V1);
    const abf* SZ1 = (const abf*)wsb(F, WS_SZ1); abf* Y1 = (abf*)wsb(F, WS_Y1);
    const int rg = id & 7, h = (id >> 3) & 7, b = id >> 6;
    const int r0 = 4 * rg, kr0 = min(max(r0 - 4, 0), 24), nwin = (rg == 0 || rg == 7) ? 8 : 12;
    LAS float* bt = (LAS float*)(F.lds + NA_BTAB_OFF);
    const float* rpb = F.in[I_CD_RPB] + h * 15 * 31;
    for (int i = F.tid; i < 15 * 31; i += NTHR) bt[48 + i] = rpb[i] * LOG2E;
    const size_t row0 = (size_t)b * SEQ + r0 * 64;
    attn_body::attn_unit<8, true, 512>(Q1 + row0 * 512 + h * 64, K1 + h * 64, V1 + h * 64, 4 + nwin, Y1 + row0 * 1024 + 512 + h * 64, SZ1 + row0 * 1024 + 512 + h * 64, lds_generic,
                                       (long)MX + b * CTXL, (long)b * SEQ + kr0 * 64, kr0, r0, (const float*)(lds_generic + NA_BTAB_OFF));
}
DEVI void phase_final(Frame& F) {
    const int gw = F.bid * NWAVES + F.wave, NGW = F.G * NWAVES; const float* g = F.in[I_FNG];
    for (int m = gw; m < MX; m += NGW) {
        float* xr = F.out + (size_t)m * DM; f32x4 v[4]; float ss = 0.f;
#pragma unroll
        for (int j = 0; j < 4; ++j) { v[j] = *(const f32x4*)(xr + 4 * F.lane + 256 * j); ss += (v[j].x * v[j].x + v[j].y * v[j].y) + (v[j].z * v[j].z + v[j].w * v[j].w); }
        const float rinv = 1.0f / sqrtf(wave_sum(ss) * (1.f / DM) + EPS);
#pragma unroll
        for (int j = 0; j < 4; ++j) { const f32x4 gg = *(const f32x4*)(g + 4 * F.lane + 256 * j); f32x4 o; o.x = v[j].x * rinv * gg.x; o.y = v[j].y * rinv * gg.y; o.z = v[j].z * rinv * gg.z; o.w = v[j].w * rinv * gg.w;
            *(f32x4*)(xr + 4 * F.lane + 256 * j) = o; }
    }
}

__global__ void __launch_bounds__(NTHR, 2) mk_fwd(Args args) {
    extern __shared__ __attribute__((aligned(16))) unsigned char lds[];
    Frame F;
    F.lds = (LAS unsigned char*)lds;
    F.tid = threadIdx.x; F.lane = F.tid & 63; F.wave = __builtin_amdgcn_readfirstlane(F.tid >> 6);
    F.G = gridDim.x; F.bid = blockIdx.x;
#pragma unroll
    for (int i = 0; i < 23; ++i) F.in[i] = args.in[i];
    F.out = args.out; F.ws = args.ws;
    volatile LAS unsigned* MISC = (volatile LAS unsigned*)(F.lds + MISC_OFF);
    if (F.tid < 32) MISC[F.tid] = 0u;
    __syncthreads();
    unsigned* ctl = (unsigned*)(F.ws + WS_CTL);
    XcdBarrier bar; bar.bar = ctl + CW_BAR; bar.x = 0; bar.st = nullptr;
    if (MK_N_LAUNCHES == 1) bar = xcd_barrier_post(ctl + CW_BAR, MISC + 8);
    const int lo = args.ph_lo, hi = args.ph_hi;
#define IN(k) (lo <= (k) && (k) < hi)
#define SEAM(k) do { if (IN(k) && IN((k) + 1)) xcd_barrier(bar); } while (0)

    if (IN(0)) { p0_prologue(F); } SEAM(0);
    if (IN(1)) { phase_modnorm(F, 0); phase_fold(F); } SEAM(1);
    if (IN(2)) {
        EpiIn0 E{wsb(F, WS_GLU), wsb(F, WS_Q0), wsb(F, WS_K0), wsb(F, WS_V0), wsb(F, WS_SZ0), F.in[I_AB_QNG], F.in[I_AB_KNG], wsf(F, WS_ROPE)};
        pg8::SegOrder S; S.init(pg8::Seg{wsb(F, WS_H), wsb(F, WS_WIN0), 72, 11, 0}, pg8::Seg{nullptr, nullptr, 0, 0, 0}, pg8::Seg{nullptr, nullptr, 0, 0, 0}, DM, F.G, F.bid);
        pg8::gemm_phase<EpiIn0, pg8::SegOrder>(F.lds, DM, S, E);
    } SEAM(2);
    if (IN(3)) { phase_attn0(F, (char*)lds); phase_conv(F); } SEAM(3);
    if (IN(4)) {
        EpiOut E{F.in[I_X], F.in[I_CTX], wsf(F, WS_ADA), F.out, wsf(F, WS_X1C)};
        pg8::SegOrder S; S.init(pg8::Seg{wsb(F, WS_Y0), wsb(F, WS_WOUT0), 72, 4, 0}, pg8::Seg{nullptr, nullptr, 0, 0, 0}, pg8::Seg{nullptr, nullptr, 0, 0, 0}, DM, F.G, F.bid);
        pg8::gemm_phase<EpiOut, pg8::SegOrder>(F.lds, DM, S, E);
    } SEAM(4);
    if (IN(5)) { phase_modnorm(F, 1); } SEAM(5);
    if (IN(6)) {
        EpiIn1 E{wsb(F, WS_PT), wsb(F, WS_Q1), wsb(F, WS_K1), wsb(F, WS_V1), wsb(F, WS_SZ1)};
        pg8::SegOrder S; S.init(pg8::Seg{wsb(F, WS_H), wsb(F, WS_WIN1) + (size_t)1024 * DM, 64, 10, 0},
                                pg8::Seg{wsb(F, WS_WIN1), wsb(F, WS_H), 4, 64, 2},
                                pg8::Seg{wsb(F, WS_H) + (size_t)MX * DM, wsb(F, WS_WIN1) + (size_t)1536 * DM, 8, 4, 1}, DM, F.G, F.bid);
        pg8::gemm_phase<EpiIn1, pg8::SegOrder>(F.lds, DM, S, E);
    } SEAM(6);
    if (IN(7)) {
        EpiDft E{wsb(F, WS_Y1), wsb(F, WS_SZ1)};
        pg8::SegOrder S; S.init(pg8::Seg{wsb(F, WS_DFT), wsb(F, WS_PT), 8, 16, 0}, pg8::Seg{nullptr, nullptr, 0, 0, 0}, pg8::Seg{nullptr, nullptr, 0, 0, 0}, 4096, F.G, F.bid);
        pg8::gemm_phase<EpiDft, pg8::SegOrder>(F.lds, 4096, S, E);
        {
            const int nmine = (F.bid < 128) ? 1 : 3, first = (F.bid < 128) ? F.bid : 128 + (F.bid - 128) * 3;
            for (int i = 0; i < nmine; ++i) na_unit(F, (char*)lds, first + i);
        }
    } SEAM(7);
    if (IN(8)) {
        EpiOut E{F.out, nullptr, wsf(F, WS_ADA) + 9 * 3072, F.out, nullptr};
        pg8::SegOrder S; S.init(pg8::Seg{wsb(F, WS_Y1), wsb(F, WS_WOUT1), 64, 4, 0}, pg8::Seg{nullptr, nullptr, 0, 0, 0}, pg8::Seg{nullptr, nullptr, 0, 0, 0}, DM, F.G, F.bid);
        pg8::gemm_phase<EpiOut, pg8::SegOrder>(F.lds, DM, S, E);
    } SEAM(8);
    if (IN(9)) { phase_final(F); }
#undef IN
#undef SEAM
}

extern "C" void kernel_launch(void* const* d_in, const int* in_sizes, int n_in, void* d_out, int out_size, void* d_ws, size_t ws_size, hipStream_t stream) {
    static int grid = 0;
    if (grid == 0) {
        if (n_in != 23 || out_size != MX * DM || ws_size < WS_END) { fprintf(stderr, "kernel_launch: unexpected shapes (n_in %d out %d ws %zu)\n", n_in, out_size, ws_size); grid = -1; return; }
        int dev = 0, cus = 0, per_cu = 0;
        if (hipGetDevice(&dev) != hipSuccess || hipDeviceGetAttribute(&cus, hipDeviceAttributeMultiprocessorCount, dev) != hipSuccess) { grid = -1; return; }
        if (hipFuncSetAttribute((const void*)mk_fwd, hipFuncAttributeMaxDynamicSharedMemorySize, LDS_BYTES) != hipSuccess) { fprintf(stderr, "kernel_launch: hipFuncSetAttribute failed\n"); grid = -1; return; }
        if (hipOccupancyMaxActiveBlocksPerMultiprocessor(&per_cu, (const void*)mk_fwd, NTHR, LDS_BYTES) != hipSuccess || per_cu < 1) { fprintf(stderr, "kernel_launch: occupancy query says %d\n", per_cu); per_cu = 1; }
        (void)hipGetLastError();
        grid = cus;
    }
    if (grid < 0) return;
    if (hipMemsetAsync((char*)d_ws + WS_CTL, 0, CTL_ZERO_BYTES, stream) != hipSuccess) { fprintf(stderr, "kernel_launch: memset failed\n"); return; }
    Args a{};
    for (int i = 0; i < 23; ++i) a.in[i] = (const float*)d_in[i];
    a.out = (float*)d_out; a.ws = (unsigned char*)d_ws;
    for (int li = 0; li < MK_N_LAUNCHES; ++li) {
        if (MK_N_LAUNCHES == 1) { a.ph_lo = 0; a.ph_hi = NPHASES; } else { a.ph_lo = li; a.ph_hi = li + 1; }
        a.li = li;
        hipLaunchKernelGGL(mk_fwd, dim3(grid), dim3(NTHR), LDS_BYTES, stream, a);
        const hipError_t le = hipPeekAtLastError();
        if (le != hipSuccess) { fprintf(stderr, "kernel_launch: launch %d failed: %s\n", li, hipGetErrorName(le)); break; }
    }
}
```

```cpp
#include <hip/hip_runtime.h>
#include <cstdio>
#include <cstdint>
#include <hip/hip_bf16.h>

#ifndef PROBE_PHASE
#define PROBE_PHASE -1
#define PROBE_A 0
#define PROBE_B 1
#endif
#ifndef MK_N_LAUNCHES
#define MK_N_LAUNCHES 1
#endif

#define GAS __attribute__((address_space(1)))
#define LAS __attribute__((address_space(3)))
typedef unsigned short bf16;
typedef unsigned v4u __attribute__((ext_vector_type(4)));
typedef float f32x4 __attribute__((ext_vector_type(4)));
typedef GAS unsigned gu32;
#define RLX_AGENT __ATOMIC_RELAXED, __HIP_MEMORY_SCOPE_AGENT
#define LDS_WAIT() asm volatile("s_waitcnt lgkmcnt(0)" ::: "memory")
#define DEVI __device__ __forceinline__

constexpr int NB = 8, SEQ = 2048, DM = 1024, CTXL = 256, GRIDW = 64;
constexpr int MX = NB * SEQ, MC = NB * CTXL, MT = MX + MC;
constexpr int AB_IN = 2816, CD_IN = 3072, N1 = 3584;
constexpr int NKEY0 = CTXL + SEQ;
constexpr float EPS = 1e-6f;
constexpr float LOG2E = 1.4426950408889634f, C2 = 0.125f * LOG2E;
constexpr int NWAVES = 8, NTHR = 512;
constexpr int NPHASES = 10;

constexpr size_t MiB = 1u << 20;
constexpr size_t WS_CTL = 0, CTL_ZERO_BYTES = 1 * MiB;
constexpr size_t WS_ADA = 256 * 1024;
constexpr size_t WS_SSQ = 512 * 1024;
constexpr size_t WS_SSQ2 = 640 * 1024;
constexpr size_t WS_PCNT = 768 * 1024;
constexpr size_t WS_SW = 2 * MiB;
constexpr size_t WS_ROPE = 1 * MiB;
constexpr size_t WS_MCS = 1 * MiB + 512 * 1024;
constexpr size_t WS_WIN0 = 3 * MiB, WS_WOUT0 = 9 * MiB, WS_WIN1 = 11 * MiB, WS_WOUT1 = 18 * MiB;
constexpr size_t WS_DFT = 20 * MiB;
constexpr size_t WS_H = 36 * MiB;
constexpr size_t WS_R = 72 * MiB;
constexpr size_t WS_X1H = 224 * MiB;
constexpr size_t WS_GLU = WS_R, WS_Q0 = WS_R + 18 * MiB, WS_K0 = WS_R + 36 * MiB, WS_V0 = WS_K0 + 4608 * 1024, WS_SZ0 = WS_R + 45 * MiB;
constexpr size_t WS_Y0 = WS_R + 116 * MiB;
constexpr size_t WS_PT = WS_R, WS_Q1 = WS_R + 32 * MiB, WS_K1 = WS_R + 48 * MiB, WS_V1 = WS_R + 66 * MiB, WS_SZ1 = WS_R + 84 * MiB, WS_Y1 = WS_R + 116 * MiB;
constexpr size_t WS_END = WS_R + 152 * MiB;
static_assert(WS_END <= WS_X1H && WS_X1H + (size_t)MX * DM * 2 <= 256 * MiB, "d_ws map");
constexpr int CW_BAR = 4096;

constexpr int LDS_BYTES = 147456;
constexpr int MISC_OFF = 145408;

DEVI unsigned f2bf(float f) { unsigned u = __builtin_bit_cast(unsigned, f); return (u + 0x7fffu + ((u >> 16) & 1u)) >> 16; }
DEVI unsigned pk2(float lo, float hi) { return f2bf(lo) | (f2bf(hi) << 16); }
DEVI float bf2f(unsigned b) { return __builtin_bit_cast(float, (b & 0xffffu) << 16); }
DEVI float bflo(unsigned w) { return __builtin_bit_cast(float, w << 16); }
DEVI float bfhi(unsigned w) { return __builtin_bit_cast(float, w & 0xffff0000u); }
DEVI float siluf(float v) { return v / (1.f + expf(-v)); }
DEVI float sigmf(float v) { return 1.f / (1.f + expf(-v)); }
DEVI float wave_sum_dpp(float v) {
#define WS_DPP(ctrl, rmask) v += __builtin_bit_cast(float, __builtin_amdgcn_update_dpp(0, __builtin_bit_cast(int, v), ctrl, rmask, 0xf, true))
    WS_DPP(0xB1, 0xf);
    WS_DPP(0x4E, 0xf);
    WS_DPP(0x141, 0xf);
    WS_DPP(0x140, 0xf);
    WS_DPP(0x142, 0xa);
    WS_DPP(0x143, 0xc);
#undef WS_DPP
    return __builtin_bit_cast(float, __builtin_amdgcn_readlane(__builtin_bit_cast(int, v), 63));
}
DEVI float sum_fq(float v) {
    { auto r = __builtin_amdgcn_permlane16_swap(__float_as_uint(v), __float_as_uint(v), false, false); v = __uint_as_float(r[0]) + __uint_as_float(r[1]); }
    { auto r = __builtin_amdgcn_permlane32_swap(__float_as_uint(v), __float_as_uint(v), false, false); v = __uint_as_float(r[0]) + __uint_as_float(r[1]); }
    return v;
}
DEVI float wave_sum(float v) {
#pragma unroll
    for (int o = 1; o < 64; o <<= 1) v += __shfl_xor(v, o);
    return v;
}

#define XB_TMO      128
#define XB_XCNT(j)  (256  + 64 * (j))
#define XB_XSUB(j)  (1280 + 64 * (j))
#define XB_XGEN(j)  (2304 + 64 * (j))
#define XB_TOP      3328
#define XB_TOPGEN   3392
#define XCD_BAR_WORDS 3456
#define XB_SPIN_CAP (1u << 22)
DEVI unsigned xb_ld(unsigned* p)              { return __hip_atomic_load(p, __ATOMIC_RELAXED, __HIP_MEMORY_SCOPE_AGENT); }
DEVI unsigned xb_add(unsigned* p, unsigned v) { return __hip_atomic_fetch_add(p, v, __ATOMIC_RELAXED, __HIP_MEMORY_SCOPE_AGENT); }
DEVI unsigned xb_xcc_id() { return (unsigned)__builtin_amdgcn_s_getreg((3 << 11) | 20) & 0xFu; }
#define XB_SPIN(cond, bar) do { unsigned _sp = 0; while (cond) { __builtin_amdgcn_s_sleep(1); \
    if ((++_sp & 255u) == 0u) { if (xb_ld(&(bar)[XB_TMO])) break; if (_sp > XB_SPIN_CAP) { atomicAdd(&(bar)[XB_TMO], 1u); break; } } } } while (0)
struct XcdBarrier { unsigned* bar; unsigned x; volatile LAS unsigned* st; };
DEVI XcdBarrier xcd_barrier_post(unsigned* bar, volatile LAS unsigned* st) {
    XcdBarrier b; b.bar = bar; b.x = xb_xcc_id(); b.st = st;
    if (threadIdx.x == 0) (void)xb_add(&bar[XB_XCNT(b.x)], 1u);
    return b;
}
DEVI void xcd_barrier_complete(unsigned* bar, unsigned x, unsigned& nloc, unsigned& nx) {
    const unsigned G = gridDim.x * gridDim.y * gridDim.z;
    unsigned sum, cnt, mine, sp = 0u;
    for (;;) {
        sum = 0u; cnt = 0u; mine = 0u;
#pragma unroll
        for (unsigned j = 0; j < 16; ++j) { const unsigned c = xb_ld(&bar[XB_XCNT(j)]); sum += c; cnt += (c > 0u) ? 1u : 0u; mine = (j == x) ? c : mine; }
        if (sum == G) break;
        __builtin_amdgcn_s_sleep(1);
        if ((++sp & 255u) == 0u) { if (xb_ld(&bar[XB_TMO])) break; if (sp > XB_SPIN_CAP) { atomicAdd(&bar[XB_TMO], 1u); break; } }
    }
    nloc = mine > 0u ? mine : 1u; nx = cnt > 0u ? cnt : 1u;
}
DEVI void xcd_barrier(const XcdBarrier& b) {
    asm volatile("s_waitcnt vmcnt(0)" ::: "memory");
    __syncthreads();
    if (threadIdx.x == 0) {
        unsigned* bar = b.bar;
        __builtin_amdgcn_s_waitcnt(0);
        unsigned nloc = b.st[0], nx = b.st[1];
        if (nloc == 0u) { xcd_barrier_complete(bar, b.x, nloc, nx); b.st[0] = nloc; b.st[1] = nx; }
        const unsigned old = xb_add(&bar[XB_XSUB(b.x)], 1u);
        const unsigned gen = old / nloc;
        if (old + 1u == (gen + 1u) * nloc) {
            __builtin_amdgcn_fence(__ATOMIC_RELEASE, "agent");
            asm volatile("s_waitcnt vmcnt(0)" ::: "memory");
            const unsigned og = xb_add(&bar[XB_TOP], 1u);
            const unsigned tg = og / nx;
            if (og + 1u == (tg + 1u) * nx) xb_add(&bar[XB_TOPGEN], 1u);
            else XB_SPIN(xb_ld(&bar[XB_TOPGEN]) == tg, bar);
            xb_add(&bar[XB_XGEN(b.x)], 1u);
            __builtin_amdgcn_fence(__ATOMIC_ACQUIRE, "agent");
            asm volatile("s_waitcnt vmcnt(0)" ::: "memory");
        } else {
            XB_SPIN(xb_ld(&bar[XB_XGEN(b.x)]) == gen, bar);
            __builtin_amdgcn_fence(__ATOMIC_ACQUIRE, "agent");
            asm volatile("s_waitcnt vmcnt(0)" ::: "memory");
        }
    }
    __syncthreads();
}

struct Args { const float* in[23]; float* out; unsigned char* ws; int ph_lo, ph_hi, li, pad; };
enum { I_X = 0, I_C, I_CTX, I_CCTX, I_AB_WADA, I_AB_BADA, I_AB_NORMG, I_AB_WIN, I_AB_CONVW, I_AB_CONVB, I_AB_LNG, I_AB_LNB, I_AB_QNG, I_AB_KNG, I_AB_WOUT,
       I_CD_WADA, I_CD_BADA, I_CD_NORMG, I_CD_WIN, I_CD_WF, I_CD_RPB, I_CD_WOUT, I_FNG };

struct Frame {
    LAS unsigned char* lds;
    int tid, lane, wave, G, bid;
    const float* in[23]; float* out; unsigned char* ws;
};
DEVI bf16* wsb(const Frame& F, size_t off) { return (bf16*)(F.ws + off); }
DEVI float* wsf(const Frame& F, size_t off) { return (float*)(F.ws + off); }

DEVI float block_sum(float v, LAS float* red, int lane, int wave) {
    v = wave_sum(v);
    __syncthreads();
    if (lane == 0) red[wave] = v;
    __syncthreads();
    float s = 0.f;
#pragma unroll
    for (int i = 0; i < NWAVES; ++i) s += red[i];
    return s;
}

DEVI void transpose_load(float (&tv)[32], const float* W, int ldw, int c0, int ncols, int item, int lane) {
    const int nblk = ncols / 32, kb = item / nblk, nb = item % nblk, k0 = 64 * kb, n0 = 32 * nb;
#pragma unroll
    for (int i = 0; i < 32; ++i) { const int kk = 2 * i + (lane >> 5); tv[i] = __builtin_nontemporal_load(W + (size_t)(k0 + kk) * ldw + c0 + n0 + (lane & 31)); }
}
template <class Map>
DEVI void transpose_store(const float (&tv)[32], int ncols, int K, bf16* WT, Map map32, LAS float* scr, int item, int lane) {
    const int nblk = ncols / 32, kb = item / nblk, nb = item % nblk, k0 = 64 * kb;
#pragma unroll
    for (int i = 0; i < 32; ++i) { const int kk = 2 * i + (lane >> 5); scr[kk * 33 + (lane & 31)] = tv[i]; }
    LDS_WAIT(); asm volatile("" ::: "memory");
    const int c = lane & 7;
    const int drow0 = map32(nb) * 32;
#pragma unroll
    for (int j = 0; j < 4; ++j) { const int n = (lane >> 3) + 8 * j; const LAS float* s = scr + (8 * c) * 33 + n;
        v4u o; o.x = pk2(s[0 * 33], s[1 * 33]); o.y = pk2(s[2 * 33], s[3 * 33]); o.z = pk2(s[4 * 33], s[5 * 33]); o.w = pk2(s[6 * 33], s[7 * 33]);
        *(v4u*)(WT + (size_t)(drow0 + n) * K + k0 + 8 * c) = o; }
    LDS_WAIT(); asm volatile("" ::: "memory");
}
template <class Map>
DEVI void transpose_item(const float* W, int ldw, int c0, int ncols, int K, bf16* WT, Map map32, LAS float* scr, int item, int lane) {
    float tv[32];
    transpose_load(tv, W, ldw, c0, ncols, item, lane);
    transpose_store(tv, ncols, K, WT, map32, scr, item, lane);
}
struct MapId { int off; DEVI int operator()(int nb) const { return nb + off; } };
struct MapIn0 { DEVI int operator()(int sb) const {
    if (sb < 16) return 8 * (sb >> 2) + (sb & 3);
    if (sb < 32) { const int cb = sb - 16; return 8 * (cb >> 2) + 4 + (cb & 3); }
    if (sb < 48) { const int qb = sb - 32, head = qb >> 1, bj = qb & 1; return 8 * (4 + (head >> 2)) + 4 * bj + (head & 3); }
    if (sb < 52) { const int kb = sb - 48; return 48 + 4 * (kb & 1) + (kb >> 1); }
    if (sb < 56) { const int vb = sb - 52; return 48 + 4 * (vb & 1) + 2 + (vb >> 1); }
    return sb; } };

DEVI void ada_item_load(const Frame& F, int it, float (&w)[64]) {
    const int l = it / 768, rem = it % 768, cc = rem >> 4, kc = rem & 15;
    const float* W = l ? F.in[I_CD_WADA] : F.in[I_AB_WADA];
    const float* rowp = W + (size_t)(kc * 64) * 3072 + cc * 64;
#pragma unroll
    for (int k = 0; k < 64; ++k) w[k] = __builtin_nontemporal_load(rowp + (size_t)k * 3072 + F.lane);
}
DEVI void ada_item_finish(const Frame& F, int it, const float (&w)[64], const LAS float* sl) {
    const int l = it / 768, rem = it % 768, cc = rem >> 4, kc = rem & 15;
    const float* bb = l ? F.in[I_CD_BADA] : F.in[I_AB_BADA];
    const int col = cc * 64 + F.lane;
    const float bv = (kc == 0) ? bb[col] : 0.f;
    float s[9];
#pragma unroll
    for (int r = 0; r < 9; ++r) s[r] = 0.f;
#pragma unroll
    for (int k4 = 0; k4 < 64; k4 += 4) {
#pragma unroll
        for (int r = 0; r < 9; ++r) { const f32x4 sv = *(const LAS f32x4*)(sl + r * 1024 + kc * 64 + k4); s[r] += sv.x * w[k4] + sv.y * w[k4 + 1] + sv.z * w[k4 + 2] + sv.w * w[k4 + 3]; }
    }
    float* ada = wsf(F, WS_ADA);
#pragma unroll
    for (int r = 0; r < 9; ++r) atomicAdd(&ada[(l * 9 + r) * 3072 + col], s[r] + bv);
}
constexpr int XPF = 5;
DEVI const float* modnorm_rowptr(const Frame& F, int m) { return (m < MX) ? F.in[I_X] + (size_t)m * DM : F.in[I_CTX] + (size_t)(m - MX) * DM; }
DEVI void p0_prologue(Frame& F, f32x4 (&xpf)[XPF][4]) {
    LAS float* sl = (LAS float*)F.lds;
    LAS float* scr = (LAS float*)(F.lds + 40960 + F.wave * 8448);
    const int gw = F.bid * NWAVES + F.wave, NGW = F.G * NWAVES;
    constexpr int N_ADA = 2 * 48 * 16, N_TR = 16 * (AB_IN / 32);
    float cv[18];
#pragma unroll
    for (int j = 0; j < 16; ++j) cv[j] = F.in[I_C][F.tid + 512 * j];
    cv[16] = F.in[I_CCTX][F.tid]; cv[17] = F.in[I_CCTX][F.tid + 512];
    const int it_a = min(gw, N_ADA - 1), it_t = min(gw, N_TR - 1), it_m = min(F.bid, 255);
    float w[64]; ada_item_load(F, it_a, w);
    float tv[32]; transpose_load(tv, F.in[I_AB_WIN], AB_IN, 0, AB_IN, it_t, F.lane);
    const float* wf = F.in[I_CD_WF];
    f32x4 wfv[8];
#pragma unroll
    for (int j = 0; j < 8; ++j) wfv[j] = *(const f32x4*)(wf + (size_t)((it_m >> 5) & 3) * 128 * 128 + 4 * (F.tid + 512 * j));
#pragma unroll
    for (int j = 0; j < 18; ++j) sl[F.tid + 512 * j] = siluf(cv[j]);
    __syncthreads();
    if (gw < N_ADA) ada_item_finish(F, gw, w, sl);
    for (int it = gw + NGW; it < N_ADA; it += NGW) { float w2[64]; ada_item_load(F, it, w2); ada_item_finish(F, it, w2, sl); }
#pragma unroll
    for (int k = 0; k < XPF; ++k) { const float* xr = modnorm_rowptr(F, min(gw * 9 + k, MT - 1));
#pragma unroll
        for (int j = 0; j < 4; ++j) xpf[k][j] = __builtin_nontemporal_load((const f32x4*)(xr + 4 * F.lane + 256 * j)); }
    if (gw < N_TR) transpose_store(tv, AB_IN, DM, wsb(F, WS_WIN0), MapIn0{}, scr, gw, F.lane);
    for (int it = gw + NGW; it < N_TR; it += NGW) transpose_item(F.in[I_AB_WIN], AB_IN, 0, AB_IN, DM, wsb(F, WS_WIN0), MapIn0{}, scr, it, F.lane);
    {
        float* rope = wsf(F, WS_ROPE);
        for (int i = gw * 64 + F.lane; i < SEQ * 32; i += NGW * 64) {
            const int t = i >> 5, p = i & 31; const int fi = p & 15;
            const float inv = exp2f(-(float)fi * (13.287712379549449f / 16.0f));
            const float pos = (float)((p < 16) ? (t / GRIDW) : (t % GRIDW));
            const float ang = pos * inv; float sn, cs; sincosf(ang, &sn, &cs);
            rope[2 * i] = cs; rope[2 * i + 1] = sn;
        }
    }
    __syncthreads();
    {
        LAS float* t128 = (LAS float*)F.lds;
        LAS float* wl = t128 + 256;
        if (F.tid < 128) { t128[F.tid] = cospif((float)F.tid * (1.f / 64.f)); t128[128 + F.tid] = sinpif((float)F.tid * (1.f / 64.f)); }
        float* mcs = wsf(F, WS_MCS);
        bool first = true;
        for (int it = F.bid; it < 2 * 4 * 32; it += F.G) {
            const int c4 = it & 31, g = (it >> 5) & 3, cs = it >> 7;
            if (first) {
#pragma unroll
                for (int j = 0; j < 8; ++j) *(LAS f32x4*)(wl + 4 * (F.tid + 512 * j)) = wfv[j];
            } else {
                __syncthreads();
                for (int i = F.tid; i < 128 * 128 / 4; i += NTHR) *(LAS f32x4*)(wl + 4 * i) = *(const f32x4*)(wf + (size_t)g * 128 * 128 + 4 * i);
            }
            first = false;
            __syncthreads();
            const int e = F.tid & 127, c = c4 * 4 + (F.tid >> 7);
            float sacc = 0.f;
#pragma unroll 8
            for (int cp = 0; cp < 128; ++cp) sacc += t128[cs * 128 + ((c * cp) & 127)] * wl[cp * 128 + e];
            mcs[((size_t)(cs * 4 + g) * 128 + c) * 128 + e] = sacc * (1.f / 512.f);
        }
        __syncthreads();
    }
}
DEVI void p2_filler(Frame& F, int ib, int nib) {
    LAS float* scr = (LAS float*)(F.lds + F.wave * 16384);
    const int gw = ib * NWAVES + F.wave, NGW = nib * NWAVES;
    constexpr int I1 = 16 * 32, I2 = 16 * ((CD_IN - 512) / 32);
    for (int it = gw; it < I1 + I2; it += NGW) {
        if (it < I1) transpose_item(F.in[I_AB_WOUT], DM, 0, DM, DM, wsb(F, WS_WOUT0), MapId{0}, scr, it, F.lane);
        else transpose_item(F.in[I_CD_WIN], CD_IN, 512, CD_IN - 512, DM, wsb(F, WS_WIN1), MapId{32}, scr, it - I1, F.lane);
    }
    __syncthreads();
}
DEVI void p6_filler(Frame& F, int ib, int nib) {
    LAS float* scr = (LAS float*)(F.lds + F.wave * 16384);
    const int gw = ib * NWAVES + F.wave, NGW = nib * NWAVES;
    for (int it = gw; it < 16 * 32; it += NGW) transpose_item(F.in[I_CD_WOUT], DM, 0, DM, DM, wsb(F, WS_WOUT1), MapId{0}, scr, it, F.lane);
    __syncthreads();
    {
        LAS float* t2k = (LAS float*)F.lds;
        for (int i = F.tid; i < 2048; i += NTHR) { t2k[i] = cospif((float)i * (1.f / 1024.f)); t2k[2048 + i] = sinpif((float)i * (1.f / 1024.f)); }
        __syncthreads();
        bf16* A = wsb(F, WS_DFT);
        for (int i = ib * NTHR + F.tid; i < 2048 * 256; i += nib * NTHR) {
            const int row = i >> 8, k0 = (i & 255) * 8; const int pm = row >> 8, rr = row & 255, lp = 128 * pm + (rr & 127), tsel = (rr >> 7) * 2048; float v[8];
#pragma unroll
            for (int j = 0; j < 8; ++j) v[j] = t2k[tsel + ((lp * (k0 + j)) & 2047)];
            v4u o; o.x = pk2(v[0], v[1]); o.y = pk2(v[2], v[3]); o.z = pk2(v[4], v[5]); o.w = pk2(v[6], v[7]);
            *(v4u*)(A + (size_t)row * 2048 + k0) = o;
        }
        __syncthreads();
    }
}

DEVI void modnorm_row(const float* xrow, bf16* orow, const float* g, const float* shift, const float* scale, int lane) {
    f32x4 v[4]; float ss = 0.f;
#pragma unroll
    for (int j = 0; j < 4; ++j) { v[j] = *(const f32x4*)(xrow + 4 * lane + 256 * j); ss += (v[j].x * v[j].x + v[j].y * v[j].y) + (v[j].z * v[j].z + v[j].w * v[j].w); }
    const float rinv = 1.0f / sqrtf(wave_sum(ss) * (1.f / DM) + EPS);
#pragma unroll
    for (int j = 0; j < 4; ++j) {
        const int c = 4 * lane + 256 * j;
        const f32x4 gg = *(const f32x4*)(g + c), sh = *(const f32x4*)(shift + c), sc = *(const f32x4*)(scale + c);
        const float o0 = v[j].x * rinv * gg.x * (1.f + sc.x) + sh.x, o1 = v[j].y * rinv * gg.y * (1.f + sc.y) + sh.y;
        const float o2 = v[j].z * rinv * gg.z * (1.f + sc.z) + sh.z, o3 = v[j].w * rinv * gg.w * (1.f + sc.w) + sh.w;
        *(unsigned long long*)(orow + c) = (unsigned long long)pk2(o0, o1) | ((unsigned long long)pk2(o2, o3) << 32);
    }
}
DEVI void phase_modnorm(Frame& F, int layer, const f32x4 (&xpf)[XPF][4]) {
    const int gw = F.bid * NWAVES + F.wave;
    const float* ada = wsf(F, WS_ADA) + layer * 9 * 3072;
    const float* g = layer ? F.in[I_CD_NORMG] : F.in[I_AB_NORMG];
    bf16* H = wsb(F, WS_H);
    constexpr int RPW = MT / (256 * NWAVES);
    const int m0 = gw * RPW;
    f32x4 gm[4], sh[4];
    int rcur = (m0 < MX) ? (m0 >> 11) : 8;
    { const float* shift = ada + rcur * 3072; const float* scale = shift + 1024;
#pragma unroll
      for (int j = 0; j < 4; ++j) { const int c = 4 * F.lane + 256 * j; gm[j] = *(const f32x4*)(g + c) * (*(const f32x4*)(scale + c) + 1.0f); sh[j] = *(const f32x4*)(shift + c); } }
    f32x4 rest[RPW - XPF][4];
#pragma unroll
    for (int k = XPF; k < RPW; ++k) { const float* xr = modnorm_rowptr(F, m0 + k);
#pragma unroll
        for (int j = 0; j < 4; ++j) rest[k - XPF][j] = __builtin_nontemporal_load((const f32x4*)(xr + 4 * F.lane + 256 * j)); }
#pragma unroll
    for (int k = 0; k < RPW; ++k) {
        const int m = m0 + k;
        f32x4 v[4];
#pragma unroll
        for (int j = 0; j < 4; ++j) v[j] = (k < XPF) ? xpf[k < XPF ? k : 0][j] : rest[k < XPF ? 0 : k - XPF][j];
        const int r = (m < MX) ? (m >> 11) : 8;
        if (r != rcur) { rcur = r; const float* shift = ada + r * 3072; const float* scale = shift + 1024;
#pragma unroll
            for (int j = 0; j < 4; ++j) { const int c = 4 * F.lane + 256 * j; gm[j] = *(const f32x4*)(g + c) * (*(const f32x4*)(scale + c) + 1.0f); sh[j] = *(const f32x4*)(shift + c); } }
        float ss = 0.f;
#pragma unroll
        for (int j = 0; j < 4; ++j) ss += (v[j].x * v[j].x + v[j].y * v[j].y) + (v[j].z * v[j].z + v[j].w * v[j].w);
        const float rinv = __builtin_amdgcn_rsqf(wave_sum_dpp(ss) * (1.f / DM) + EPS);
        bf16* orow = H + (size_t)m * DM;
#pragma unroll
        for (int j = 0; j < 4; ++j) {
            const int c = 4 * F.lane + 256 * j;
            const f32x4 o = v[j] * rinv * gm[j] + sh[j];
            __builtin_nontemporal_store((unsigned long long)pk2(o[0], o[1]) | ((unsigned long long)pk2(o[2], o[3]) << 32), (unsigned long long*)(orow + c));
        }
    }
}
DEVI void phase_fold(Frame& F, int ib, int nib) {
    const float* mcs = wsf(F, WS_MCS); const float* W = F.in[I_CD_WIN]; bf16* WT = wsb(F, WS_WIN1);
    LAS float* Ms = (LAS float*)F.lds;
    LAS float* Ws = Ms + 128 * 128;
    for (int it = ib; it < 8 * 32; it += nib) {
        const int kc = it & 31, g = (it >> 5) & 3, cs = it >> 7, k0 = kc * 32;
        __syncthreads();
        const float* mp = mcs + (size_t)(cs * 4 + g) * 128 * 128;
        for (int i = F.tid; i < 128 * 128 / 4; i += NTHR) *(LAS f32x4*)(Ms + 4 * i) = *(const f32x4*)(mp + 4 * i);
        for (int i = F.tid; i < 32 * 128; i += NTHR) { const int k = i >> 7, c = i & 127; Ws[c * 32 + k] = W[(size_t)(k0 + k) * CD_IN + g * 128 + c]; }
        __syncthreads();
        const int e = F.tid & 127, kq = F.tid >> 7;
        float acc[8];
#pragma unroll
        for (int j = 0; j < 8; ++j) acc[j] = 0.f;
#pragma unroll 4
        for (int c = 0; c < 128; ++c) { const float mv = Ms[c * 128 + e]; const f32x4 w0 = *(const LAS f32x4*)(Ws + c * 32 + kq * 8), w1 = *(const LAS f32x4*)(Ws + c * 32 + kq * 8 + 4);
            acc[0] += mv * w0.x; acc[1] += mv * w0.y; acc[2] += mv * w0.z; acc[3] += mv * w0.w; acc[4] += mv * w1.x; acc[5] += mv * w1.y; acc[6] += mv * w1.z; acc[7] += mv * w1.w; }
        v4u o; o.x = pk2(acc[0], acc[1]); o.y = pk2(acc[2], acc[3]); o.z = pk2(acc[4], acc[5]); o.w = pk2(acc[6], acc[7]);
        *(v4u*)(WT + (size_t)(cs * 512 + g * 128 + e) * DM + k0 + kq * 8) = o;
    }
    __syncthreads();
}

DEVI void p2_fill_fold(Frame& F) {
    LAS float* scr = (LAS float*)(F.lds + F.wave * 16384);
    const int gw = F.bid * NWAVES + F.wave, NGW = F.G * NWAVES;
    constexpr int I1 = 16 * 32, I2 = 16 * ((CD_IN - 512) / 32), NI = I1 + I2;
    const float* mcs = wsf(F, WS_MCS); const float* W = F.in[I_CD_WIN]; bf16* WT = wsb(F, WS_WIN1);
    const int it_t = min(gw, NI - 1), it_f = min(F.bid, 255);
    float tv[32];
    if (it_t < I1) transpose_load(tv, F.in[I_AB_WOUT], DM, 0, DM, it_t, F.lane); else transpose_load(tv, F.in[I_CD_WIN], CD_IN, 512, CD_IN - 512, it_t - I1, F.lane);
    const int kc = it_f & 31, g = (it_f >> 5) & 3, cs = it_f >> 7, k0 = kc * 32;
    f32x4 mv8[8]; float wv8[8];
    { const float* mp = mcs + (size_t)(cs * 4 + g) * 128 * 128;
#pragma unroll
      for (int j = 0; j < 8; ++j) mv8[j] = *(const f32x4*)(mp + 4 * (F.tid + 512 * j));
#pragma unroll
      for (int j = 0; j < 8; ++j) { const int i = F.tid + 512 * j, k = i >> 7, c = i & 127; wv8[j] = W[(size_t)(k0 + k) * CD_IN + g * 128 + c]; } }
    if (gw < NI) { if (gw < I1) transpose_store(tv, DM, DM, wsb(F, WS_WOUT0), MapId{0}, scr, gw, F.lane); else transpose_store(tv, CD_IN - 512, DM, wsb(F, WS_WIN1), MapId{32}, scr, gw - I1, F.lane); }
    for (int it = gw + NGW; it < NI; it += NGW) {
        if (it < I1) transpose_item(F.in[I_AB_WOUT], DM, 0, DM, DM, wsb(F, WS_WOUT0), MapId{0}, scr, it, F.lane);
        else transpose_item(F.in[I_CD_WIN], CD_IN, 512, CD_IN - 512, DM, wsb(F, WS_WIN1), MapId{32}, scr, it - I1, F.lane);
    }
    __syncthreads();
    LAS float* Ms = (LAS float*)F.lds;
    LAS float* Ws = Ms + 128 * 128;
    bool first = true;
    for (int it = F.bid; it < 8 * 32; it += F.G) {
        const int kc2 = it & 31, g2 = (it >> 5) & 3, cs2 = it >> 7, k02 = kc2 * 32;
        if (first) {
#pragma unroll
            for (int j = 0; j < 8; ++j) *(LAS f32x4*)(Ms + 4 * (F.tid + 512 * j)) = mv8[j];
#pragma unroll
            for (int j = 0; j < 8; ++j) { const int i = F.tid + 512 * j, k = i >> 7, c = i & 127; Ws[c * 32 + k] = wv8[j]; }
        } else {
            __syncthreads();
            const float* mp = mcs + (size_t)(cs2 * 4 + g2) * 128 * 128;
            for (int i = F.tid; i < 128 * 128 / 4; i += NTHR) *(LAS f32x4*)(Ms + 4 * i) = *(const f32x4*)(mp + 4 * i);
            for (int i = F.tid; i < 32 * 128; i += NTHR) { const int k = i >> 7, c = i & 127; Ws[c * 32 + k] = W[(size_t)(k02 + k) * CD_IN + g2 * 128 + c]; }
        }
        first = false;
        __syncthreads();
        const int e = F.tid & 127, kq = F.tid >> 7;
        float acc[8];
#pragma unroll
        for (int j = 0; j < 8; ++j) acc[j] = 0.f;
#pragma unroll 4
        for (int c = 0; c < 128; ++c) { const float mv = Ms[c * 128 + e]; const f32x4 w0 = *(const LAS f32x4*)(Ws + c * 32 + kq * 8), w1 = *(const LAS f32x4*)(Ws + c * 32 + kq * 8 + 4);
            acc[0] += mv * w0.x; acc[1] += mv * w0.y; acc[2] += mv * w0.z; acc[3] += mv * w0.w; acc[4] += mv * w1.x; acc[5] += mv * w1.y; acc[6] += mv * w1.z; acc[7] += mv * w1.w; }
        v4u o; o.x = pk2(acc[0], acc[1]); o.y = pk2(acc[2], acc[3]); o.z = pk2(acc[4], acc[5]); o.w = pk2(acc[6], acc[7]);
        *(v4u*)(WT + (size_t)(cs2 * 512 + g2 * 128 + e) * DM + k02 + kq * 8) = o;
    }
    __syncthreads();
}

namespace pg8 {
#define PG8_LAS __attribute__((address_space(3)))
typedef unsigned short bf16_t;
typedef short bf16x8 __attribute__((ext_vector_type(8)));
typedef unsigned u32x4 __attribute__((ext_vector_type(4)));
constexpr int BM = 256, BK = 64, HALF = 128, HTB = HALF * BK * 2, STAGE_BYTES = 8 * HTB, NXCD = 8, WGM = 8;
__host__ __device__ __forceinline__ int lds_byte(int r, int c) { const int st = (r >> 4) * 2 + (c >> 5), rr = r & 15, cc = c & 31, ob = rr * 64 + cc * 2; return st * 1024 + (ob ^ (((ob >> 9) & 1) << 5)); }
__host__ __device__ __forceinline__ void stage_rc(int b, int& R, int& C) { const int st = b / 1024, sb = b % 1024, swz = sb ^ (((sb >> 9) & 1) << 5); R = (st >> 1) * 16 + swz / 64; C = (st & 1) * 32 + (swz % 64) / 2; }
__host__ __device__ __forceinline__ int perm32(int rho) { const int n = rho >> 4, i = rho & 15; return 8 * (i >> 2) + 4 * n + (i & 3); }

struct Unit { int pm, pn, kind; const char* A; const char* B; };

struct Seg { const bf16_t* A; const bf16_t* Bt; int nM, nN, kind; };
struct SegOrder {
    Seg s0, s1, s2; int n0, n1, n2, G, c; size_t tstep;
    __device__ __forceinline__ void init(const Seg& a, const Seg& b, const Seg& d, int K, int G_, int c_) { s0 = a; s1 = b; s2 = d; n0 = a.nM * a.nN; n1 = b.nM * b.nN; n2 = d.nM * d.nN; G = G_; c = c_; tstep = (size_t)BM * K * 2; }
    __device__ __forceinline__ void map(const Seg& s, int nwg, int wgid, Unit& u) const {
        { const int q = nwg / NXCD, xcd = wgid % NXCD, off = wgid / NXCD; wgid = xcd * q + off; }
        const int nig = WGM * s.nN, gid = wgid / nig, fm = gid * WGM, gsz = (s.nM - fm) < WGM ? (s.nM - fm) : WGM;
        u.pm = fm + ((wgid % nig) % gsz); u.pn = (wgid % nig) / gsz; u.kind = s.kind;
        u.A = (const char*)s.A + (size_t)u.pm * tstep; u.B = (const char*)s.Bt + (size_t)u.pn * tstep;
    }
    __device__ __forceinline__ bool next(int i, Unit& u) const {
        int L = i * G + c;
        if (L < n0) { map(s0, n0, L, u); return true; } L -= n0;
        if (L < n1) { map(s1, n1, L, u); return true; } L -= n1;
        if (L < n2) { map(s2, n2, L, u); return true; }
        return false;
    }
};

__device__ __forceinline__ unsigned cvt_pk_bf16(float lo, float hi) { unsigned r; asm volatile("v_cvt_pk_bf16_f32 %0, %1, %2" : "=v"(r) : "v"(lo), "v"(hi)); return r; }

template <class Epi, class Sched, bool ALIGN_EPI = true, bool DIAG = false>
__device__ __forceinline__ void gemm_phase(PG8_LAS unsigned char* lds, const int K, const Sched& S, const Epi& E) {
    const int tid = threadIdx.x, wid = __builtin_amdgcn_readfirstlane(tid >> 6), lane = tid & 63, wr = wid >> 2, wc = wid & 3, fr = lane & 15, fq = lane >> 4;
    const int nt = K / BK;
    unsigned voffA[2], voffB[2];
#pragma unroll
    for (int i = 0; i < 2; ++i) { int R, C; stage_rc(tid * 16 + i * 8192, R, C); const int Rb = Epi::PERM ? ((R & ~31) + perm32(R & 31)) : R;
        voffA[i] = (unsigned)(R * K + C) * 2u; voffB[i] = (unsigned)(Rb * K + C) * 2u; }
    const size_t kstep = (size_t)(BK * 2);
    const size_t hstep = (size_t)HALF * K * 2;
    const unsigned ldsw = (unsigned)wid * 1024u;
    const int aoff = lds_byte(wr * 64 + fr, fq * 8), boff = lds_byte(wc * 32 + fr, fq * 8);
#define PG8_SA(b, h) (((b) * 2 + (h)) * HTB)
#define PG8_SB(b, h) ((4 + (b) * 2 + (h)) * HTB)
#define PG8_STAGE(bufoff, gbase, voff) do { _Pragma("unroll") for (int _i = 0; _i < 2; ++_i) \
        __builtin_amdgcn_global_load_lds((const unsigned*)((const char*)(gbase) + (voff)[_i]), (PG8_LAS unsigned*)(lds + (bufoff) + ldsw + _i * 8192), 16, 0, 0); } while (0)
#define PG8_LDA(dst, b, h) do { _Pragma("unroll") for (int m = 0; m < 4; ++m) _Pragma("unroll") for (int k = 0; k < 2; ++k) dst[m][k] = *(const PG8_LAS bf16x8*)(lds + PG8_SA(b, h) + aoff + m * 2048 + k * 1024); } while (0)
#define PG8_LDB(dst, b, h) do { _Pragma("unroll") for (int n = 0; n < 2; ++n) _Pragma("unroll") for (int k = 0; k < 2; ++k) dst[n][k] = *(const PG8_LAS bf16x8*)(lds + PG8_SB(b, h) + boff + n * 2048 + k * 1024); } while (0)
#define PG8_MMA(ai, bj, At, Bt) do { __builtin_amdgcn_s_setprio(1); _Pragma("unroll") for (int m = 0; m < 4; ++m) _Pragma("unroll") for (int n = 0; n < 2; ++n) _Pragma("unroll") for (int k = 0; k < 2; ++k) \
        acc[ai][bj][m][n] = __builtin_amdgcn_mfma_f32_16x16x32_bf16(Bt[n][k], At[m][k], acc[ai][bj][m][n], 0, 0, 0); __builtin_amdgcn_s_setprio(0); } while (0)
#define PG8_WAIT_V(n) asm volatile("s_waitcnt vmcnt(" #n ")" ::: "memory")
#define PG8_WAIT_L(n) asm volatile("s_waitcnt lgkmcnt(" #n ")" ::: "memory")
#define PG8_BAR __builtin_amdgcn_s_barrier()
#define PG8_SCHED __builtin_amdgcn_sched_barrier(0)
    Unit cur, nxt; int ui = 0;
    if (!S.next(0, cur)) return;
    f32x4 acc[2][2][4][2];
#pragma unroll
    for (int a = 0; a < 2; ++a)
#pragma unroll
        for (int b = 0; b < 2; ++b)
#pragma unroll
            for (int m = 0; m < 4; ++m)
#pragma unroll
                for (int n = 0; n < 2; ++n) acc[a][b][m][n] = (f32x4){0.f, 0.f, 0.f, 0.f};
    bf16x8 At[4][2], B0[2][2], B1[2][2];
    const char* cA = cur.A; const char* cB = cur.B;
    PG8_STAGE(PG8_SB(0, 0), cB, voffB); PG8_STAGE(PG8_SB(0, 1), cB + hstep, voffB); PG8_STAGE(PG8_SA(0, 0), cA, voffA); PG8_STAGE(PG8_SA(0, 1), cA + hstep, voffA);
    if (wr == 1) PG8_BAR;
    PG8_WAIT_V(2); PG8_BAR;
    PG8_STAGE(PG8_SB(1, 0), cB + kstep, voffB); PG8_STAGE(PG8_SA(1, 0), cA + kstep, voffA); PG8_STAGE(PG8_SB(1, 1), cB + hstep + kstep, voffB);
    PG8_WAIT_V(6); PG8_BAR;
    for (;;) {
        const bool has_next = S.next(ui + 1, nxt);
        const char* nA = has_next ? nxt.A : cA; const char* nB = has_next ? nxt.B : cB;
        for (int t = 0; t < nt; t += 2) {
            const bool last = (t == nt - 2);
            const char* a1 = cA + (size_t)(t + 1) * kstep;
            const char* a2 = last ? nA : cA + (size_t)(t + 2) * kstep; const char* b2 = last ? nB : cB + (size_t)(t + 2) * kstep;
            const char* a3 = a2 + kstep; const char* b3 = b2 + kstep;
            PG8_LDB(B0, 0, 0); PG8_LDB(B1, 0, 1); PG8_SCHED; PG8_LDA(At, 0, 0); PG8_STAGE(PG8_SA(1, 1), a1 + hstep, voffA);
            PG8_WAIT_V(8); PG8_WAIT_L(0); PG8_BAR; PG8_MMA(0, 0, At, B0); if constexpr (!DIAG) PG8_MMA(0, 1, At, B1); PG8_BAR; PG8_SCHED;
            PG8_LDA(At, 0, 1); PG8_STAGE(PG8_SB(0, 0), b2, voffB); PG8_STAGE(PG8_SB(0, 1), b2 + hstep, voffB); PG8_STAGE(PG8_SA(0, 0), a2, voffA);
            PG8_WAIT_V(8); PG8_WAIT_L(0); PG8_BAR; if constexpr (!DIAG) PG8_MMA(1, 0, At, B0); PG8_MMA(1, 1, At, B1); PG8_BAR; PG8_SCHED;
            PG8_LDB(B0, 1, 0); PG8_LDB(B1, 1, 1); PG8_SCHED; PG8_LDA(At, 1, 0); PG8_STAGE(PG8_SA(0, 1), a2 + hstep, voffA);
            PG8_WAIT_V(8); PG8_WAIT_L(0); PG8_BAR; PG8_MMA(0, 0, At, B0); if constexpr (!DIAG) PG8_MMA(0, 1, At, B1); PG8_BAR; PG8_SCHED;
            PG8_LDA(At, 1, 1); PG8_STAGE(PG8_SB(1, 0), b3, voffB); PG8_STAGE(PG8_SB(1, 1), b3 + hstep, voffB); PG8_STAGE(PG8_SA(1, 0), a3, voffA);
            PG8_WAIT_V(8); PG8_WAIT_L(0); PG8_BAR; if constexpr (!DIAG) PG8_MMA(1, 0, At, B0); PG8_MMA(1, 1, At, B1); PG8_BAR; PG8_SCHED;
        }
        if constexpr (ALIGN_EPI) { if (wr == 0) PG8_BAR; }
        if constexpr (Epi::FUSED) E.fused(acc, cur, wr, wc, fr, fq, wid, lane); else E(acc, cur, wr, wc, fr, fq);
        if (!has_next) break;
#pragma unroll
        for (int a = 0; a < 2; ++a)
#pragma unroll
            for (int b = 0; b < 2; ++b)
#pragma unroll
                for (int m = 0; m < 4; ++m)
#pragma unroll
                    for (int n = 0; n < 2; ++n) acc[a][b][m][n] = (f32x4){0.f, 0.f, 0.f, 0.f};
        cur = nxt; cA = nA; cB = nB; ++ui;
        if constexpr (ALIGN_EPI) { if (wr == 1) PG8_BAR; }
    }
    PG8_WAIT_V(0);
    if constexpr (!ALIGN_EPI) { if (wr == 0) PG8_BAR; }
    PG8_BAR;
#undef PG8_SA
#undef PG8_SB
#undef PG8_STAGE
#undef PG8_LDA
#undef PG8_LDB
#undef PG8_MMA
#undef PG8_WAIT_V
#undef PG8_WAIT_L
#undef PG8_BAR
#undef PG8_SCHED
}
}

typedef float f32x4acc[2][2][4][2];
DEVI float fsilu(float v) { return v * __builtin_amdgcn_rcpf(1.f + __builtin_amdgcn_exp2f(-LOG2E * v)); }
DEVI float fsigm(float v) { return __builtin_amdgcn_rcpf(1.f + __builtin_amdgcn_exp2f(-LOG2E * v)); }
typedef float f32x2p __attribute__((ext_vector_type(2)));
DEVI f32x4 fsigm4(const f32x4& v) {
    const f32x2p nl = {-LOG2E, -LOG2E}, one = {1.f, 1.f};
    const f32x2p t0 = (f32x2p){v[0], v[1]} * nl, t1 = (f32x2p){v[2], v[3]} * nl;
    const f32x2p d0 = (f32x2p){__builtin_amdgcn_exp2f(t0.x), __builtin_amdgcn_exp2f(t0.y)} + one, d1 = (f32x2p){__builtin_amdgcn_exp2f(t1.x), __builtin_amdgcn_exp2f(t1.y)} + one;
    return (f32x4){__builtin_amdgcn_rcpf(d0.x), __builtin_amdgcn_rcpf(d0.y), __builtin_amdgcn_rcpf(d1.x), __builtin_amdgcn_rcpf(d1.y)};
}
DEVI f32x4 fsilu4(const f32x4& v) { return v * fsigm4(v); }
DEVI v4u pack8(const f32x4& a, const f32x4& b) { v4u w; w.x = pg8::cvt_pk_bf16(a[0], a[1]); w.y = pg8::cvt_pk_bf16(a[2], a[3]); w.z = pg8::cvt_pk_bf16(b[0], b[1]); w.w = pg8::cvt_pk_bf16(b[2], b[3]); return w; }

struct EpiIn0 {
    static constexpr bool PERM = true; static constexpr bool FUSED = false;
    bf16 *GLU, *Q0, *K0, *V0, *SZ; const float *qng, *kng, *rope;
    DEVI void operator()(const f32x4 (&acc)[2][2][4][2], const pg8::Unit& u, int wr, int wc, int fr, int fq) const {
        asm volatile("" : "+v"(fr), "+v"(fq));
        const int pn = u.pn + (u.kind ? 7 : 0), pm = u.pm + (u.kind == 2 ? 64 : 0); const bool isx = pm < 64;
        const int cw = 32 * wc + 8 * fq;
        float g8[2][8];
        if (pn >= 4 && pn < 7) { const float* gn = (pn < 6) ? qng : kng;
#pragma unroll
            for (int bj = 0; bj < 2; ++bj) { const f32x4 a = *(const f32x4*)(gn + 32 * bj + 8 * fq), b = *(const f32x4*)(gn + 32 * bj + 8 * fq + 4);
                g8[bj][0] = a[0]; g8[bj][1] = a[1]; g8[bj][2] = a[2]; g8[bj][3] = a[3]; g8[bj][4] = b[0]; g8[bj][5] = b[1]; g8[bj][6] = b[2]; g8[bj][7] = b[3]; } }
        const bool dorope = pn >= 4 && pn < 7 && isx && !((pn == 6) && (wc >= 2));
        f32x4 rpR[2][2], rpC[2];
        if (dorope) {
#pragma unroll
            for (int ai = 0; ai < 2; ++ai)
#pragma unroll
                for (int n = 0; n < 2; ++n) rpR[ai][n] = *(const f32x4*)(rope + ((size_t)((pm & 7) * 256 + 128 * ai + 64 * wr) * 32 + 4 * fq + 2 * n) * 2);
        }
#pragma unroll
        for (int m = 0; m < 4; ++m) {
            if (dorope) {
#pragma unroll
                for (int n = 0; n < 2; ++n) rpC[n] = *(const f32x4*)(rope + ((size_t)(16 * m + fr) * 32 + 16 + 4 * fq + 2 * n) * 2);
            }
#pragma unroll
            for (int ai = 0; ai < 2; ++ai) {
                const int lr = 128 * ai + 64 * wr + 16 * m + fr;
                const int row = 256 * pm + lr;
                if (pn < 4) {
                    f32x4 o0, o1;
#pragma unroll
                    for (int e = 0; e < 1; ++e) { o0 = acc[ai][0][m][0] * fsigm4(acc[ai][1][m][0]); o1 = acc[ai][0][m][1] * fsigm4(acc[ai][1][m][1]); }
                    *(v4u*)(GLU + (size_t)row * 512 + 128 * pn + cw) = pack8(o0, o1);
                } else if (pn < 7) {
                    const bool isv = (pn == 6) && (wc >= 2);
                    int b, key, l;
                    if (isx) { b = pm >> 3; l = (pm & 7) * 256 + lr; key = CTXL + l; } else { b = pm - 64; l = 0; key = lr; }
                    if (isv) {
#pragma unroll
                        for (int bj = 0; bj < 2; ++bj) *(v4u*)(V0 + ((size_t)b * NKEY0 + key) * 128 + (wc - 2) * 64 + 32 * bj + 8 * fq) = pack8(acc[ai][bj][m][0], acc[ai][bj][m][1]);
                    } else {
                        float ss = 0.f;
#pragma unroll
                        for (int bj = 0; bj < 2; ++bj)
#pragma unroll
                            for (int n = 0; n < 2; ++n) { const f32x4 x = acc[ai][bj][m][n]; ss += (x[0] * x[0] + x[1] * x[1]) + (x[2] * x[2] + x[3] * x[3]); }
                        ss = sum_fq(ss);
                        const float rinv = __builtin_amdgcn_rsqf(ss * (1.f / 64.f) + EPS);
                        const float osc = (pn < 6) ? C2 : 1.f;
#pragma unroll
                        for (int bj = 0; bj < 2; ++bj) {
                            f32x4 v[2];
#pragma unroll
                            for (int n = 0; n < 2; ++n)
#pragma unroll
                                for (int e = 0; e < 4; ++e) v[n][e] = acc[ai][bj][m][n][e] * rinv * g8[bj][4 * n + e];
                            if (isx) {
#pragma unroll
                                for (int n = 0; n < 2; ++n) { const f32x4 cs = bj ? rpC[n] : rpR[ai][n];
                                    const float a0 = v[n][0], b0 = v[n][1], a1 = v[n][2], b1 = v[n][3];
                                    v[n][0] = a0 * cs[0] - b0 * cs[1]; v[n][1] = a0 * cs[1] + b0 * cs[0]; v[n][2] = a1 * cs[2] - b1 * cs[3]; v[n][3] = a1 * cs[3] + b1 * cs[2]; } }
                            v[0] = v[0] * osc; v[1] = v[1] * osc;
                            if (pn < 6) *(v4u*)(Q0 + (size_t)row * 512 + (4 * (pn - 4) + wc) * 64 + 32 * bj + 8 * fq) = pack8(v[0], v[1]);
                            else *(v4u*)(K0 + ((size_t)b * NKEY0 + key) * 128 + wc * 64 + 32 * bj + 8 * fq) = pack8(v[0], v[1]);
                        }
                    }
                } else {
#pragma unroll
                    for (int bj = 0; bj < 2; ++bj) { f32x4 o0, o1;
#pragma unroll
                        for (int e = 0; e < 1; ++e) { o0 = fsilu4(acc[ai][bj][m][0]); o1 = fsilu4(acc[ai][bj][m][1]); }
                        *(v4u*)(SZ + (size_t)row * 1024 + 256 * (pn - 7) + 128 * bj + cw) = pack8(o0, o1); }
                }
            }
        }
    }
};
template <bool CTX>
DEVI void outproj0_epi(const f32x4 (&acc)[2][2][4][2], int pm, int pn, int wr, int wc, int fr, int fq, const float* xin, const float* ada0, const float* ada1, const float* ng1, _Float16* o_x, bf16* H, float* ssq) {
    const int r = CTX ? 8 : (pm >> 3); const size_t rowbase = (size_t)(CTX ? MX : 0) + 256 * pm;
    f32x4 gate[2][2], gp[2][2];
#pragma unroll
    for (int bj = 0; bj < 2; ++bj)
#pragma unroll
        for (int n = 0; n < 2; ++n) { const int col = 256 * pn + 128 * bj + 32 * wc + 8 * fq + 4 * n;
            gate[bj][n] = *(const f32x4*)(ada0 + r * 3072 + 2048 + col);
            gp[bj][n] = *(const f32x4*)(ng1 + col) * (*(const f32x4*)(ada1 + r * 3072 + 1024 + col) + 1.0f); }
#pragma unroll
    for (int ai = 0; ai < 2; ++ai)
#pragma unroll
        for (int mp = 0; mp < 4; mp += 2) {
            f32x4 xr[2][2][2];
#pragma unroll
            for (int mm = 0; mm < 2; ++mm) { const size_t xoff = (size_t)(256 * pm + 128 * ai + 64 * wr + 16 * (mp + mm) + fr) * DM;
#pragma unroll
                for (int bj = 0; bj < 2; ++bj)
#pragma unroll
                    for (int n = 0; n < 2; ++n) xr[mm][bj][n] = __builtin_nontemporal_load((const f32x4*)(xin + xoff + 256 * pn + 128 * bj + 32 * wc + 8 * fq + 4 * n)); }
            asm volatile("" ::: "memory");
#pragma unroll
            for (int mm = 0; mm < 2; ++mm) { const int m = mp + mm;
                const int lr = 128 * ai + 64 * wr + 16 * m + fr; const size_t row = rowbase + lr; const size_t xoff = (size_t)(256 * pm + lr) * DM;
                float ss = 0.f;
#pragma unroll
                for (int bj = 0; bj < 2; ++bj) { const int col8 = 256 * pn + 128 * bj + 32 * wc + 8 * fq; f32x4 xg[2];
#pragma unroll
                    for (int n = 0; n < 2; ++n) { const f32x4 x1 = xr[mm][bj][n] + gate[bj][n] * acc[ai][bj][m][n];
                        if (!CTX) { typedef _Float16 h4 __attribute__((ext_vector_type(4))); __builtin_nontemporal_store(__builtin_convertvector(x1, h4), (h4*)(o_x + xoff + col8 + 4 * n)); }
                        ss += (x1[0] * x1[0] + x1[1] * x1[1]) + (x1[2] * x1[2] + x1[3] * x1[3]); xg[n] = x1 * gp[bj][n]; }
                    *(v4u*)(H + row * DM + col8) = pack8(xg[0], xg[1]); }
                ss = sum_fq(ss);
                if (fq == 0) atomicAdd(ssq + row, ss);
            }
        }
}
struct EpiOutX {
    static constexpr bool PERM = true; static constexpr bool FUSED = false;
    const float *xin, *ada0, *ada1, *ng1; _Float16* o_x; bf16* H; float* ssq;
    DEVI void operator()(const f32x4 (&acc)[2][2][4][2], const pg8::Unit& u, int wr, int wc, int fr, int fq) const { outproj0_epi<false>(acc, u.pm, u.pn, wr, wc, fr, fq, xin, ada0, ada1, ng1, o_x, H, ssq); }
};
struct EpiOutF {
    static constexpr bool PERM = false; static constexpr bool FUSED = true;
    const float *ada, *gfin; const _Float16* x1h; float* o_x; float* ssq2; unsigned* cnt;
    DEVI void fused(f32x4 (&acc)[2][2][4][2], const pg8::Unit& u, int wr, int wc, int fr, int fq, int wid, int lane) const {
        typedef _Float16 h4 __attribute__((ext_vector_type(4))); typedef unsigned u32x2 __attribute__((ext_vector_type(2)));
        const int pm = __builtin_amdgcn_readfirstlane(u.pm), pn = __builtin_amdgcn_readfirstlane(u.pn); const int r = pm >> 3;
        const __amdgpu_buffer_rsrc_t rs_x = __builtin_amdgcn_make_buffer_rsrc((void*)x1h, 0, MX * DM * 2, 0x00020000);
        const __amdgpu_buffer_rsrc_t rs_o = __builtin_amdgcn_make_buffer_rsrc((void*)o_x, 0, MX * DM * 4, 0x00020000);
        const int e0 = (256 * pm + 64 * wr + fr) * DM + 256 * pn + 32 * wc + 4 * fq;
        f32x4 gv[2][2];
#pragma unroll
        for (int bj = 0; bj < 2; ++bj)
#pragma unroll
            for (int n = 0; n < 2; ++n) gv[bj][n] = *(const f32x4*)(ada + r * 3072 + 2048 + 256 * pn + 32 * wc + 4 * fq + 128 * bj + 16 * n);
#pragma unroll
        for (int ai = 0; ai < 2; ++ai) {
            u32x2 xh[4][2][2];
#pragma unroll
            for (int m = 0; m < 4; ++m)
#pragma unroll
                for (int bj = 0; bj < 2; ++bj)
#pragma unroll
                    for (int n = 0; n < 2; ++n) xh[m][bj][n] = __builtin_amdgcn_raw_buffer_load_b64(rs_x, (e0 + (128 * ai + 16 * m) * DM + 128 * bj + 16 * n) * 2, 0, 2  );
#pragma unroll
            for (int m = 0; m < 4; ++m) { const int lr = 128 * ai + 64 * wr + 16 * m + fr; float ss = 0.f;
#pragma unroll
                for (int bj = 0; bj < 2; ++bj)
#pragma unroll
                    for (int n = 0; n < 2; ++n) { const f32x4 x2 = __builtin_convertvector(__builtin_bit_cast(h4, xh[m][bj][n]), f32x4) + gv[bj][n] * acc[ai][bj][m][n]; acc[ai][bj][m][n] = x2;
                        ss += (x2[0] * x2[0] + x2[1] * x2[1]) + (x2[2] * x2[2] + x2[3] * x2[3]); }
                ss = sum_fq(ss);
                if (fq == 0) atomicAdd(ssq2 + 256 * pm + lr, ss); }
        }
        asm volatile("s_waitcnt vmcnt(0)" ::: "memory");
        __builtin_amdgcn_s_barrier(); asm volatile("" ::: "memory");
        if (wid == 0) {
            if (lane == 0) __hip_atomic_fetch_add(cnt + 64 * pm, 1u, __ATOMIC_RELAXED, __HIP_MEMORY_SCOPE_AGENT);
            unsigned sp = 0;
            while ((unsigned)__builtin_amdgcn_readfirstlane(__hip_atomic_load(cnt + 64 * pm, __ATOMIC_RELAXED, __HIP_MEMORY_SCOPE_AGENT)) < 4u) { __builtin_amdgcn_s_sleep(2); if (++sp > (1u << 22)) break; }
        }
        asm volatile("s_waitcnt vmcnt(0) lgkmcnt(0)" ::: "memory");
        __builtin_amdgcn_s_barrier(); asm volatile("" ::: "memory");
        f32x4 gf[2][2];
#pragma unroll
        for (int bj = 0; bj < 2; ++bj)
#pragma unroll
            for (int n = 0; n < 2; ++n) gf[bj][n] = *(const f32x4*)(gfin + 256 * pn + 32 * wc + 4 * fq + 128 * bj + 16 * n);
        float qs[2][4];
#pragma unroll
        for (int ai = 0; ai < 2; ++ai)
#pragma unroll
            for (int m = 0; m < 4; ++m) qs[ai][m] = __hip_atomic_load(ssq2 + 256 * pm + 128 * ai + 64 * wr + 16 * m + fr, __ATOMIC_RELAXED, __HIP_MEMORY_SCOPE_AGENT);
#pragma unroll
        for (int ai = 0; ai < 2; ++ai)
#pragma unroll
            for (int m = 0; m < 4; ++m) {
                const float ri = __builtin_amdgcn_rsqf(qs[ai][m] * (1.f / DM) + EPS);
#pragma unroll
                for (int bj = 0; bj < 2; ++bj)
#pragma unroll
                    for (int n = 0; n < 2; ++n) { const f32x4 o = acc[ai][bj][m][n] * ri * gf[bj][n];
                        __builtin_amdgcn_raw_buffer_store_b128(__builtin_bit_cast(v4u, o), rs_o, (e0 + (128 * ai + 16 * m) * DM + 128 * bj + 16 * n) * 4, 0, 2  ); } }
    }
    DEVI void operator()(const f32x4 (&)[2][2][4][2], const pg8::Unit&, int, int, int, int) const {}
};
struct EpiIn1 {
    static constexpr bool PERM = true; static constexpr bool FUSED = false;
    bf16 *PT, *Q1, *K1, *V1, *SZ1; const float *ssq, *sw;
    const float *ctx, *ada0, *ada1, *ng1; bf16* H; float* ssqw; int pt_pn0; unsigned* gate;
    DEVI void operator()(const f32x4 (&acc)[2][2][4][2], const pg8::Unit& u, int wr, int wc, int fr, int fq) const {
        asm volatile("" : "+v"(fr), "+v"(fq));
        const int pm = u.pm, kind = u.kind; const int cw = 32 * wc + 8 * fq;
        if (kind == 3) { outproj0_epi<true>(acc, pm, u.pn, wr, wc, fr, fq, ctx, ada0, ada1, ng1, nullptr, H, ssqw);
            asm volatile("s_waitcnt vmcnt(0)" ::: "memory"); __builtin_amdgcn_s_barrier(); asm volatile("" ::: "memory");
            if (wr == 0 && wc == 0) { __builtin_amdgcn_fence(__ATOMIC_RELEASE, "agent"); asm volatile("s_waitcnt vmcnt(0)" ::: "memory");
                if (fr == 0 && fq == 0) __hip_atomic_fetch_add(gate, 8u, __ATOMIC_RELAXED, __HIP_MEMORY_SCOPE_AGENT); }
            return; }
        if (kind == 2) {
            const int pn = u.pn + pt_pn0, b = pn >> 3;
            f32x4 ri[2][2];
#pragma unroll
            for (int bj = 0; bj < 2; ++bj)
#pragma unroll
                for (int n = 0; n < 2; ++n) { const f32x4 q = *(const f32x4*)(ssq + 256 * pn + 128 * bj + cw + 4 * n);
#pragma unroll
                    for (int e = 0; e < 4; ++e) ri[bj][n][e] = __builtin_amdgcn_rsqf(q[e] * (1.f / DM) + EPS); }
            float svs[2][4];
#pragma unroll
            for (int ai = 0; ai < 2; ++ai)
#pragma unroll
                for (int m = 0; m < 4; ++m) svs[ai][m] = sw[b * N1 + 256 * pm + 128 * ai + 64 * wr + 16 * m + fr];
            const __amdgpu_buffer_rsrc_t rs_p = __builtin_amdgcn_make_buffer_rsrc((void*)PT, 0, 4096 * 4096 * 2, 0x00020000);
#pragma unroll
            for (int ai = 0; ai < 2; ++ai)
#pragma unroll
                for (int m = 0; m < 4; ++m) { const int jj = 256 * pm + 128 * ai + 64 * wr + 16 * m + fr, cs = jj >> 9, jc = jj & 511; const float sv = svs[ai][m];
#pragma unroll
                    for (int bj = 0; bj < 2; ++bj) { const int tok = 256 * pn + 128 * bj + cw, l = tok & 2047; const int ng = b * 512 + jc;
                        __builtin_amdgcn_raw_buffer_store_b128(pack8(acc[ai][bj][m][0] * ri[bj][0] + sv, acc[ai][bj][m][1] * ri[bj][1] + sv), rs_p, ((((ng >> 7) * 2 + cs) * 128 + (ng & 127)) * 2048 + l) * 2, 0, 0); } }
            return;
        }
        const int pn = u.pn; const int r = (kind == 1) ? 8 : (pm >> 3); const int wcol0 = (kind == 1) ? 1536 : 1024;
        f32x4 sv[2][2];
#pragma unroll
        for (int bj = 0; bj < 2; ++bj)
#pragma unroll
            for (int n = 0; n < 2; ++n) sv[bj][n] = *(const f32x4*)(sw + r * N1 + wcol0 + 256 * pn + 128 * bj + cw + 4 * n);
        const int rowb = ((kind == 1) ? MX : 0) + 256 * pm + 64 * wr + fr;
        float qsv[2][4];
#pragma unroll
        for (int ai = 0; ai < 2; ++ai)
#pragma unroll
            for (int m = 0; m < 4; ++m) qsv[ai][m] = ssq[rowb + 128 * ai + 16 * m];
        bf16* dst; int pitch, colb; float osc = 1.f; bool act = false;
        if (kind == 1) { dst = (pn < 2) ? K1 : V1; pitch = 512; colb = 256 * (pn & 1); }
        else if (pn < 2) { dst = Q1; pitch = 512; colb = 256 * pn; osc = C2; }
        else if (pn < 4) { dst = K1; pitch = 512; colb = 256 * (pn - 2); }
        else if (pn < 6) { dst = V1; pitch = 512; colb = 256 * (pn - 4); }
        else { dst = SZ1; pitch = 1024; colb = 256 * (pn - 6); act = true; }
        const __amdgpu_buffer_rsrc_t rs_d = __builtin_amdgcn_make_buffer_rsrc((void*)dst, 0, MT * 1024 * 2, 0x00020000);
        const int ob = (rowb * pitch + colb + cw) * 2;
#pragma unroll
        for (int ai = 0; ai < 2; ++ai)
#pragma unroll
            for (int m = 0; m < 4; ++m) {
                const float ri = __builtin_amdgcn_rsqf(qsv[ai][m] * (1.f / DM) + EPS);
#pragma unroll
                for (int bj = 0; bj < 2; ++bj) {
                    f32x4 a0 = acc[ai][bj][m][0] * ri + sv[bj][0], a1 = acc[ai][bj][m][1] * ri + sv[bj][1];
                    if (act) {
#pragma unroll
                        for (int e = 0; e < 1; ++e) { a0 = fsilu4(a0); a1 = fsilu4(a1); } }
                    else { a0 = a0 * osc; a1 = a1 * osc; }
                    __builtin_amdgcn_raw_buffer_store_b128(pack8(a0, a1), rs_d, ob + ((128 * ai + 16 * m) * pitch + 128 * bj) * 2, 0, 0);
                }
            }
    }
};
struct EpiDft {
    static constexpr bool PERM = true; static constexpr bool FUSED = false;
    bf16* Y1; const bf16* SZ1;
    DEVI void operator()(const f32x4 (&acc)[2][2][4][2], const pg8::Unit& u, int wr, int wc, int fr, int fq) const {
        const int n = 128 * u.pn + 32 * wc + 8 * fq, b = n >> 9, j = n & 511;
        v4u zs[4][2];
#pragma unroll
        for (int m = 0; m < 4; ++m) { const int lp = 128 * u.pm + 64 * wr + 16 * m + fr;
            zs[m][0] = __builtin_nontemporal_load((const v4u*)(SZ1 + (size_t)(b * 2048 + lp) * 1024 + j));
            zs[m][1] = __builtin_nontemporal_load((const v4u*)(SZ1 + (size_t)(b * 2048 + ((2048 - lp) & 2047)) * 1024 + j)); }
#pragma unroll
        for (int m = 0; m < 4; ++m) { const int lp = 128 * u.pm + 64 * wr + 16 * m + fr;
            const f32x4 a0 = acc[0][0][m][0], a1 = acc[0][0][m][1], b0 = acc[1][1][m][0], b1 = acc[1][1][m][1];
            { const size_t off = (size_t)(b * 2048 + lp) * 1024 + j; const v4u z = zs[m][0];
              f32x4 o0 = a0 - b0, o1 = a1 - b1;
              o0[0] *= bflo(z.x); o0[1] *= bfhi(z.x); o0[2] *= bflo(z.y); o0[3] *= bfhi(z.y); o1[0] *= bflo(z.z); o1[1] *= bfhi(z.z); o1[2] *= bflo(z.w); o1[3] *= bfhi(z.w);
              *(v4u*)(Y1 + off) = pack8(o0, o1); }
            if (lp >= 1) { const size_t off = (size_t)(b * 2048 + 2048 - lp) * 1024 + j; const v4u z = zs[m][1];
              f32x4 o0 = a0 + b0, o1 = a1 + b1;
              o0[0] *= bflo(z.x); o0[1] *= bfhi(z.x); o0[2] *= bflo(z.y); o0[3] *= bfhi(z.y); o1[0] *= bflo(z.z); o1[1] *= bfhi(z.z); o1[2] *= bflo(z.w); o1[3] *= bfhi(z.w);
              *(v4u*)(Y1 + off) = pack8(o0, o1); }
        }
    }
};
DEVI void phase_nyquist(Frame& F) {
    const bf16* PT = wsb(F, WS_PT); const bf16* SZ1 = wsb(F, WS_SZ1); bf16* Y1 = wsb(F, WS_Y1);
    const int gw = F.bid * NWAVES + F.wave, NGW = F.G * NWAVES;
    for (int n0 = gw; n0 < 4096; n0 += 2 * NGW) {
        const int n1 = n0 + NGW; const bool has1 = n1 < 4096; const int n1c = has1 ? n1 : n0;
        const bf16* row0 = PT + ((size_t)((n0 >> 7) * 2) * 128 + (n0 & 127)) * 2048 + F.lane * 32;
        const bf16* row1 = PT + ((size_t)((n1c >> 7) * 2) * 128 + (n1c & 127)) * 2048 + F.lane * 32;
        const size_t off0 = (size_t)((n0 >> 9) * 2048 + 1024) * 1024 + (n0 & 511), off1 = (size_t)((n1c >> 9) * 2048 + 1024) * 1024 + (n1c & 511);
        v4u w0[4], w1[4];
#pragma unroll
        for (int q = 0; q < 4; ++q) { w0[q] = *(const v4u*)(row0 + 8 * q); w1[q] = *(const v4u*)(row1 + 8 * q); }
        const float z0 = bf2f(SZ1[off0]), z1 = bf2f(SZ1[off1]);
        float a0 = 0.f, a1 = 0.f;
#pragma unroll
        for (int q = 0; q < 4; ++q) {
            a0 += (bflo(w0[q].x) - bfhi(w0[q].x)) + (bflo(w0[q].y) - bfhi(w0[q].y)) + (bflo(w0[q].z) - bfhi(w0[q].z)) + (bflo(w0[q].w) - bfhi(w0[q].w));
            a1 += (bflo(w1[q].x) - bfhi(w1[q].x)) + (bflo(w1[q].y) - bfhi(w1[q].y)) + (bflo(w1[q].z) - bfhi(w1[q].z)) + (bflo(w1[q].w) - bfhi(w1[q].w)); }
        a0 = wave_sum_dpp(a0); a1 = wave_sum_dpp(a1);
        if (F.lane == 0) { Y1[off0] = (bf16)f2bf(a0 * z0); if (has1) Y1[off1] = (bf16)f2bf(a1 * z1); }
    }
}

namespace attn_body {
using bf16=__hip_bfloat16;
using bf16x8=__attribute__((ext_vector_type(8)))short;
using s16x4=__attribute__((ext_vector_type(4)))short;
using f32x16=__attribute__((ext_vector_type(16)))float;
using u32x4=__attribute__((ext_vector_type(4)))unsigned;
constexpr int D=64,NW=8,QBLK=32,QB=QBLK*NW,KVBLK=64;
constexpr int QP=512,YP=1024;
__device__ __forceinline__ int crow(int r,int hi){return (r&3)+8*(r>>2)+4*hi;}
#define SBAR() __builtin_amdgcn_sched_barrier(0)
constexpr int NSLOT=3, SLOTB=8192;
constexpr int LDS_K=0, LDS_V=NSLOT*SLOTB, LDS_WS=2*NSLOT*SLOTB, LDS_OST=LDS_WS+NW*64*4, LDS_BYTES=LDS_OST+NW*4096;
__device__ __forceinline__ void glds16(const void*gsrc,unsigned lds_dst){unsigned keep;
  asm volatile("s_mov_b32 %0, m0\n\ts_mov_b32 m0, %2\n\ts_nop 0\n\tglobal_load_lds_dwordx4 %1, off\n\ts_mov_b32 m0, %0":"=&s"(keep):"v"(gsrc),"s"(lds_dst):"memory");}
__device__ __forceinline__ float max3f(float a,float b,float c){float r;asm("v_max3_f32 %0, %1, %2, %3":"=v"(r):"v"(a),"v"(b),"v"(c));return r;}
__device__ __forceinline__ float max2f(float a,float b){float r;asm("v_max_f32_e32 %0, %1, %2":"=v"(r):"v"(a),"v"(b));return r;}
__device__ __forceinline__ float fadd_s(float a,float b){float r;asm("v_add_f32_e32 %0, %1, %2":"=v"(r):"v"(a),"v"(b));return r;}
__device__ __forceinline__ float fsub_s(float a,float b){float r;asm("v_sub_f32_e32 %0, %1, %2":"=v"(r):"v"(a),"v"(b));return r;}
typedef float f32x2_t __attribute__((ext_vector_type(2))); typedef __bf16 bf16x2_t __attribute__((ext_vector_type(2)));
__device__ __forceinline__ unsigned cvtpk_s(float lo,float hi){f32x2_t v={lo,hi};bf16x2_t b=__builtin_convertvector(v,bf16x2_t);return __builtin_bit_cast(unsigned,b);}
#define WAIT_BAR(N) asm volatile("s_waitcnt vmcnt(" #N ") lgkmcnt(0)\n\ts_barrier":::"memory")
__device__ __forceinline__ void qkt(f32x16&p0,f32x16&p1,const char*Kslot,const bf16x8*qr,const f32x16&negm,int r32,int hi){
  const char*kb=Kslot+hi*1024+r32*16;
  #pragma unroll
  for(int d0=0;d0<4;++d0){
    const bf16x8 b0=*reinterpret_cast<const bf16x8*>(kb+d0*2048);
    const bf16x8 b1=*reinterpret_cast<const bf16x8*>(kb+d0*2048+512);
    if(d0==0){p0=__builtin_amdgcn_mfma_f32_32x32x16_bf16(b0,qr[0],negm,0,0,0);p1=__builtin_amdgcn_mfma_f32_32x32x16_bf16(b1,qr[0],negm,0,0,0);}
    else{p0=__builtin_amdgcn_mfma_f32_32x32x16_bf16(b0,qr[d0],p0,0,0,0);p1=__builtin_amdgcn_mfma_f32_32x32x16_bf16(b1,qr[d0],p1,0,0,0);}}
}
typedef __attribute__((address_space(3))) const char* lds_cptr;
typedef short v4i16_t __attribute__((ext_vector_type(4)));
__device__ __forceinline__ void kload8(bf16x8*kf,lds_cptr kp){
  kf[0]=*(const __attribute__((address_space(3))) bf16x8*)(kp);      kf[1]=*(const __attribute__((address_space(3))) bf16x8*)(kp+512);
  kf[2]=*(const __attribute__((address_space(3))) bf16x8*)(kp+2048); kf[3]=*(const __attribute__((address_space(3))) bf16x8*)(kp+2560);
  kf[4]=*(const __attribute__((address_space(3))) bf16x8*)(kp+4096); kf[5]=*(const __attribute__((address_space(3))) bf16x8*)(kp+4608);
  kf[6]=*(const __attribute__((address_space(3))) bf16x8*)(kp+6144); kf[7]=*(const __attribute__((address_space(3))) bf16x8*)(kp+6656);
}
__device__ __forceinline__ void kload2(bf16x8*kf,lds_cptr kp,int j){ kf[2*j]=*(const __attribute__((address_space(3))) bf16x8*)(kp+j*2048); kf[2*j+1]=*(const __attribute__((address_space(3))) bf16x8*)(kp+j*2048+512); }
__device__ __forceinline__ s16x4 vtr(lds_cptr p){ return __builtin_bit_cast(s16x4,__builtin_amdgcn_ds_read_tr16_b64_v4i16((__attribute__((address_space(3))) v4i16_t*)p)); }
__device__ __forceinline__ float rowmax(const f32x16&p0,const f32x16&p1){
  float a=max3f(p0[0],p0[1],p1[0]),b=max3f(p0[2],p0[3],p1[1]);a=max3f(a,p1[2],p1[3]);
  #pragma unroll
  for(int r=4;r<16;r+=4){a=max3f(a,p0[r],p0[r+1]);b=max3f(b,p0[r+2],p0[r+3]);a=max3f(a,p1[r],p1[r+1]);b=max3f(b,p1[r+2],p1[r+3]);}
  const float m=max2f(a,b);
  auto rr=__builtin_amdgcn_permlane32_swap(__float_as_uint(m),__float_as_uint(m),false,false);
  return max2f(__uint_as_float(rr[0]),__uint_as_float(rr[1]));
}
__device__ __forceinline__ void pv(f32x16*o,int vb,bf16x8 pa0,bf16x8 pa1,bf16x8 pa2,bf16x8 pa3){
  #pragma unroll
  for(int d0=0;d0<2;++d0){s16x4 lo[4],hi[4];
    #pragma unroll
    for(int ks=0;ks<4;++ks){
      asm volatile("ds_read_b64_tr_b16 %0,%1 offset:%c2":"=&v"(lo[ks]):"v"(vb),"i"(d0*4096+ks*1024):"memory");
      asm volatile("ds_read_b64_tr_b16 %0,%1 offset:%c2":"=&v"(hi[ks]):"v"(vb),"i"(d0*4096+ks*1024+512):"memory");}
    asm volatile("s_waitcnt lgkmcnt(0)":::"memory");SBAR();
    #define PK(k) (bf16x8){lo[k][0],lo[k][1],lo[k][2],lo[k][3],hi[k][0],hi[k][1],hi[k][2],hi[k][3]}
    o[d0]=__builtin_amdgcn_mfma_f32_32x32x16_bf16(pa0,PK(0),o[d0],0,0,0);
    o[d0]=__builtin_amdgcn_mfma_f32_32x32x16_bf16(pa1,PK(1),o[d0],0,0,0);
    o[d0]=__builtin_amdgcn_mfma_f32_32x32x16_bf16(pa2,PK(2),o[d0],0,0,0);
    o[d0]=__builtin_amdgcn_mfma_f32_32x32x16_bf16(pa3,PK(3),o[d0],0,0,0);
    #undef PK
  }
}
template<int THRL,bool NAT,int KVP> __device__ __forceinline__ void attn_unit(const bf16*Qu,const bf16*__restrict__ Kh,const bf16*__restrict__ Vh,const int NT,bf16*Yu,const bf16*Zu,char*shm,
    const long ctxoff=0,const long winoff=0,const int kr0=0,const int rq0=0,const float*btab=nullptr){
  const int tid=threadIdx.x,lane=tid&63,r32=lane&31,hi=lane>>5; const int wid=__builtin_amdgcn_readfirstlane(tid>>6);
  const bf16*Qw=Qu+(long)(wid*QBLK)*QP;
  const unsigned lds0=(unsigned)(uintptr_t)shm;
  float*wsf=(float*)(shm+LDS_WS)+wid*64;
  const bf16*ksrc=Kh+(long)lane*KVP+wid*8;
  const bf16*vsrc=Vh+(long)(16*(wid&3)+(lane>>2))*KVP+(wid>>2)*32+(lane&3)*8;
  const unsigned kdst=lds0+LDS_K+wid*1024, vdst=lds0+LDS_V+wid*1024;
  #define TOFF(t) (NAT ? (((t)<4) ? (ctxoff+(long)(t)*KVBLK)*KVP : (winoff+(long)((t)-4)*KVBLK)*KVP) : (long)(t)*KVBLK*KVP)
  #define DMA_K(t,slot) glds16(ksrc+TOFF(t),(unsigned)__builtin_amdgcn_readfirstlane(kdst+(slot)))
  #define DMA_V(t,slot) glds16(vsrc+TOFF(t),(unsigned)__builtin_amdgcn_readfirstlane(vdst+(slot)))
  const int nq_r=rq0+(wid>>1), nq_c=32*(wid&1)+r32;
  const int nq_rs=min(max(nq_r-4,0),24), nq_cs=min(max(nq_c-8,0),48);
  const int nq_vb=4*hi-nq_cs, nq_lb=48+15+4*hi-nq_c;
  #define BIASMASK(C0,C1,t) do{ if(NAT && (t)>=4){ const int kr_=kr0+(t)-4; const bool rowok_=(unsigned)(kr_-nq_rs)<8u; const int dr_=min(max(kr_-nq_r+7,0),14); \
      const float*tb_=btab+dr_*31+nq_lb; \
      _Pragma("unroll") for(int rb=0;rb<16;rb+=4){ float b0_[4],b1_[4]; \
        _Pragma("unroll") for(int r=0;r<4;++r){ const int kc_=((rb+r)&3)+8*((rb+r)>>2); b0_[r]=tb_[kc_]; b1_[r]=tb_[kc_+32]; } \
        _Pragma("unroll") for(int r=0;r<4;++r){ const int kc_=((rb+r)&3)+8*((rb+r)>>2); \
          const bool v0_=rowok_&&((unsigned)(kc_+nq_vb)<16u), v1_=rowok_&&((unsigned)(kc_+32+nq_vb)<16u); \
          C0[rb+r]=v0_?C0[rb+r]+b0_[r]:-1e30f; C1[rb+r]=v1_?C1[rb+r]+b1_[r]:-1e30f; } \
        SBAR(); } } }while(0)
  const int vb0=(int)(lds0+LDS_V)+((lane>>4)&1)*32+(lane&3)*8+(4*hi+((lane&15)>>2))*64;
  const char*Kbase=shm+LDS_K; bf16x8 kf[8];
  const lds_cptr shm3=(lds_cptr)shm; const lds_cptr kp0=shm3+LDS_K+hi*1024+r32*16; const lds_cptr vp0=shm3+LDS_V+((lane>>4)&1)*32+(lane&3)*8+(4*hi+((lane&15)>>2))*64;
  DMA_K(0,0);DMA_V(0,0);DMA_K(1,SLOTB);
  bf16x8 qr[4];
  #pragma unroll
  for(int d0=0;d0<4;++d0)qr[d0]=*reinterpret_cast<const bf16x8*>(&Qw[(long)r32*QP+d0*16+hi*8]);
  float mhat=0.f,l_reg=0.f;f32x16 o[2];o[0]=f32x16{};o[1]=f32x16{};float zin_;asm volatile("v_mov_b32 %0, 0":"=v"(zin_));f32x16 negm;
  _Pragma("unroll") for(int r=0;r<16;++r)negm[r]=zin_; asm volatile("":"+v"(negm));
  bool resc=false;
  #define START(P0,P1) do{ const float rm=rowmax(P0,P1); resc=false; \
    { const float dl=rm; mhat=fadd_s(mhat,dl); \
      _Pragma("unroll") for(int r=0;r<16;++r){P0[r]=fsub_s(P0[r],dl);P1[r]=fsub_s(P1[r],dl);} \
      _Pragma("unroll") for(int r=0;r<16;++r)negm[r]=-mhat; asm volatile("":"+v"(negm)); } \
    _Pragma("unroll") for(int r=0;r<16;++r)P0[r]=__builtin_amdgcn_exp2f(P0[r]); }while(0)
  #define RESC() do{ if(resc){ asm volatile("s_waitcnt lgkmcnt(0)":::"memory"); \
      _Pragma("unroll") for(int d_=0;d_<2;++d_) _Pragma("unroll") for(int r=0;r<16;++r)o[d_][r]*=wsf[crow(r,hi)]; } }while(0)
  f32x16 pA0,pA1,pB0,pB1;
  int sl_prev=0,sl_cur=0,sl_next=SLOTB;
  #define ROT() do{sl_prev=sl_cur;sl_cur=sl_next;sl_next=(sl_next==(NSLOT-1)*SLOTB)?0:sl_next+SLOTB;}while(0)
  DMA_K(2,2*SLOTB);
  WAIT_BAR(3);
  qkt(pA0,pA1,Kbase,qr,negm,r32,hi);asm volatile("s_nop 15\n\ts_nop 7":"+v"(pA0),"+v"(pA1));
  START(pA0,pA1);
  _Pragma("unroll") for(int r=0;r<16;++r)pA1[r]=__builtin_amdgcn_exp2f(pA1[r]);
  WAIT_BAR(0);
  DMA_K(3,0);DMA_V(1,SLOTB);
  ROT();
  kload8(kf,kp0+sl_cur);
  WAIT_BAR(2);
  s16x4 vlo[8],vhi[8]; u32x4 pw0,pw1,pw2,pw3;
  #define PKW(P,B) cvtpk_s(P[B],P[B+1])
  #define PAF(k) __builtin_bit_cast(bf16x8,pw##k)
  #define VFR(i) (bf16x8){vlo[i][0],vlo[i][1],vlo[i][2],vlo[i][3],vhi[i][0],vhi[i][1],vhi[i][2],vhi[i][3]}
  #define PIN(x) asm volatile("":"+v"(x))
  #define MX3(a,b,c) __builtin_fmaxf(__builtin_fmaxf((a),(b)),(c))
  #define GAPA(MF,A0,A1,A2,A3,W0,W1,PW) do{ MF; sacc+=A0; sacc+=A1; sacc+=A2; sacc+=A3; PIN(sacc); W0; W1; PIN(PW); SBAR(); }while(0)
  #define EX(v) __builtin_amdgcn_exp2f(v)
  #define GAPB(MF,X,B) do{ MF; X[B]=EX(X[B]); X[B+1]=EX(X[B+1]); X[B+2]=EX(X[B+2]); X[B+3]=EX(X[B+3]); PIN(X); SBAR(); }while(0)
  #define VRD(i) do{ vlo[i]=vtr(vp_+(((i)>>2)*4096+((i)&3)*1024)); vhi[i]=vtr(vp_+(((i)>>2)*4096+((i)&3)*1024+512)); }while(0)
  #define KRD(G,j) do{ if(G){ kload2(kf,kp0+sl_next,j); SBAR(); } }while(0)
  bf16*Yw=Yu+(long)(wid*QBLK)*YP; const bf16*Zw=Zu+(long)(wid*QBLK)*YP;
  u32x4 zq[4];
  #define STEP(C0,C1,P0,P1,t,GK,GV,GL,ZL) do{ SBAR(); \
    const lds_cptr vp_=vp0+sl_prev; \
    VRD(0); SBAR(); float sacc=(P0[0]+P0[1]); \
    GAPA(C0=__builtin_amdgcn_mfma_f32_32x32x16_bf16(kf[0],qr[0],negm,0,0,0), P0[2],P0[3],P0[4],P0[5],     pw0[0]=PKW(P0,0), pw0[1]=PKW(P0,2), pw0); \
    VRD(4); SBAR(); GAPA(C1=__builtin_amdgcn_mfma_f32_32x32x16_bf16(kf[1],qr[0],negm,0,0,0), P0[6],P0[7],P0[8],P0[9],     pw0[2]=PKW(P0,4), pw0[3]=PKW(P0,6), pw0); \
    VRD(1); SBAR(); GAPA(C0=__builtin_amdgcn_mfma_f32_32x32x16_bf16(kf[2],qr[1],C0,0,0,0),   P0[10],P0[11],P0[12],P0[13], pw1[0]=PKW(P0,8), pw1[1]=PKW(P0,10), pw1); \
    VRD(5); SBAR(); GAPA(C1=__builtin_amdgcn_mfma_f32_32x32x16_bf16(kf[3],qr[1],C1,0,0,0),   P0[14],P0[15],P1[0],P1[1],   pw1[2]=PKW(P0,12),pw1[3]=PKW(P0,14), pw1); \
    VRD(2); SBAR(); GAPA(C0=__builtin_amdgcn_mfma_f32_32x32x16_bf16(kf[4],qr[2],C0,0,0,0),   P1[2],P1[3],P1[4],P1[5],     pw2[0]=PKW(P1,0), pw2[1]=PKW(P1,2), pw2); \
    VRD(6); SBAR(); GAPA(C1=__builtin_amdgcn_mfma_f32_32x32x16_bf16(kf[5],qr[2],C1,0,0,0),   P1[6],P1[7],P1[8],P1[9],     pw2[2]=PKW(P1,4), pw2[3]=PKW(P1,6), pw2); \
    VRD(3); SBAR(); GAPA(C0=__builtin_amdgcn_mfma_f32_32x32x16_bf16(kf[6],qr[3],C0,0,0,0),   P1[10],P1[11],P1[12],P1[13], pw3[0]=PKW(P1,8), pw3[1]=PKW(P1,10), pw3); \
    VRD(7); SBAR(); GAPA(C1=__builtin_amdgcn_mfma_f32_32x32x16_bf16(kf[7],qr[3],C1,0,0,0),   P1[14],P1[15],0.f,0.f,       pw3[2]=PKW(P1,12),pw3[3]=PKW(P1,14), pw3); \
    l_reg+=sacc; \
    if(GK){DMA_K((t)+3,sl_cur);} if(GV){DMA_V((t)+1,sl_next);} \
    if(ZL){ _Pragma("unroll") for(int i=0;i<4;++i)zq[i]=__builtin_nontemporal_load((const u32x4*)(Zw+(long)(i*8+(lane>>3))*YP+(lane&7)*8)); } \
    BIASMASK(C0,C1,t); \
    { float a=MX3(C0[0],C0[1],C1[0]),b=MX3(C0[2],C0[3],C1[1]); a=MX3(a,C1[2],C1[3]); \
      _Pragma("unroll") for(int r=4;r<16;r+=4){a=MX3(a,C0[r],C0[r+1]);b=MX3(b,C0[r+2],C0[r+3]);a=MX3(a,C1[r],C1[r+1]);b=MX3(b,C1[r+2],C1[r+3]);} \
      float rm=__builtin_fmaxf(a,b); { auto rr=__builtin_amdgcn_permlane32_swap(__float_as_uint(rm),__float_as_uint(rm),false,false); rm=__builtin_fmaxf(__uint_as_float(rr[0]),__uint_as_float(rr[1])); } \
      resc=false; \
      if(__builtin_expect(__any(rm>(float)THRL),0)){ const float dl=__builtin_fmaxf(rm,0.f); mhat+=dl; \
        _Pragma("unroll") for(int r=0;r<16;++r){C0[r]-=dl;C1[r]-=dl;} \
        _Pragma("unroll") for(int r=0;r<16;++r)negm[r]=-mhat; asm volatile("":"+v"(negm)); \
        const float f=__builtin_amdgcn_exp2f(-dl); l_reg*=f; if(hi==0)wsf[r32]=f; resc=true; } } \
    SBAR(); \
    GAPB(o[0]=__builtin_amdgcn_mfma_f32_32x32x16_bf16(PAF(0),VFR(0),o[0],0,0,0), C0,0); \
    GAPB(o[1]=__builtin_amdgcn_mfma_f32_32x32x16_bf16(PAF(0),VFR(4),o[1],0,0,0), C0,4); \
    KRD(GL,0); GAPB(o[0]=__builtin_amdgcn_mfma_f32_32x32x16_bf16(PAF(1),VFR(1),o[0],0,0,0), C0,8); \
    KRD(GL,1); GAPB(o[1]=__builtin_amdgcn_mfma_f32_32x32x16_bf16(PAF(1),VFR(5),o[1],0,0,0), C0,12); \
    KRD(GL,2); GAPB(o[0]=__builtin_amdgcn_mfma_f32_32x32x16_bf16(PAF(2),VFR(2),o[0],0,0,0), C1,0); \
    KRD(GL,3); GAPB(o[1]=__builtin_amdgcn_mfma_f32_32x32x16_bf16(PAF(2),VFR(6),o[1],0,0,0), C1,4); \
    GAPB(o[0]=__builtin_amdgcn_mfma_f32_32x32x16_bf16(PAF(3),VFR(3),o[0],0,0,0), C1,8); \
    GAPB(o[1]=__builtin_amdgcn_mfma_f32_32x32x16_bf16(PAF(3),VFR(7),o[1],0,0,0), C1,12); \
    }while(0)
  int t=1;
  for(;t+5<NT;t+=2){
    STEP(pB0,pB1,pA0,pA1,t,true,true,true,false);     WAIT_BAR(2); RESC(); ROT();
    STEP(pA0,pA1,pB0,pB1,t+1,true,true,true,false);   WAIT_BAR(2); RESC(); ROT();
  }
  #define ENDW(tt) do{ if((tt)+3<NT){WAIT_BAR(2);} else if((tt)+2<NT){WAIT_BAR(1);} else {WAIT_BAR(0);} }while(0)
  for(;t+1<NT;t+=2){
    STEP(pB0,pB1,pA0,pA1,t,(t+3<NT),(t+1<NT),(t+1<NT),false);       ENDW(t);   RESC(); ROT();
    STEP(pA0,pA1,pB0,pB1,t+1,(t+4<NT),(t+2<NT),(t+2<NT),false);     ENDW(t+1); RESC(); ROT();
  }
  STEP(pB0,pB1,pA0,pA1,NT-1,false,false,false,true); RESC();
  { float sacc=pB0[0]+pB0[1]; _Pragma("unroll") for(int r=2;r<16;++r)sacc+=pB0[r]; _Pragma("unroll") for(int r=0;r<16;++r)sacc+=pB1[r]; l_reg+=sacc;
    pw0=(u32x4){PKW(pB0,0),PKW(pB0,2),PKW(pB0,4),PKW(pB0,6)};pw1=(u32x4){PKW(pB0,8),PKW(pB0,10),PKW(pB0,12),PKW(pB0,14)};pw2=(u32x4){PKW(pB1,0),PKW(pB1,2),PKW(pB1,4),PKW(pB1,6)};pw3=(u32x4){PKW(pB1,8),PKW(pB1,10),PKW(pB1,12),PKW(pB1,14)};
    SBAR(); pv(o,vb0+sl_cur,PAF(0),PAF(1),PAF(2),PAF(3)); }
  #undef PKW
  #undef PAF
  #undef VFR
  #undef PIN
  #undef MX3
  #undef GAPA
  #undef GAPB
  #undef EX
  #undef VRD
  #undef KRD
  #undef STEP
  #undef ENDW
  {auto rr=__builtin_amdgcn_permlane32_swap(__float_as_uint(l_reg),__float_as_uint(l_reg),false,false);l_reg=__uint_as_float(rr[0])+__uint_as_float(rr[1]);}
  if(hi==0)wsf[32+r32]=l_reg;asm volatile("s_waitcnt lgkmcnt(0)":::"memory");
  float rli[16];
  #pragma unroll
  for(int r=0;r<16;++r)rli[r]=__builtin_amdgcn_rcpf(wsf[32+crow(r,hi)]);
  { bf16*stg=(bf16*)(shm+LDS_OST)+wid*2048;
    #pragma unroll
    for(int r=0;r<16;++r){const int orow=crow(r,hi);
      #pragma unroll
      for(int d0=0;d0<2;++d0)stg[orow*64+d0*32+r32]=__float2bfloat16(o[d0][r]*rli[r]);}
    asm volatile("s_waitcnt lgkmcnt(0)":::"memory");
    #pragma unroll
    for(int i=0;i<4;++i){const int row=i*8+(lane>>3),ch=lane&7; const u32x4 v=*(const u32x4*)(stg+row*64+ch*8); const u32x4 z=zq[i]; u32x4 w;
      w.x=cvtpk_s(__uint_as_float(v.x<<16)*__uint_as_float(z.x<<16),__uint_as_float(v.x&0xffff0000u)*__uint_as_float(z.x&0xffff0000u));
      w.y=cvtpk_s(__uint_as_float(v.y<<16)*__uint_as_float(z.y<<16),__uint_as_float(v.y&0xffff0000u)*__uint_as_float(z.y&0xffff0000u));
      w.z=cvtpk_s(__uint_as_float(v.z<<16)*__uint_as_float(z.z<<16),__uint_as_float(v.z&0xffff0000u)*__uint_as_float(z.z&0xffff0000u));
      w.w=cvtpk_s(__uint_as_float(v.w<<16)*__uint_as_float(z.w<<16),__uint_as_float(v.w&0xffff0000u)*__uint_as_float(z.w&0xffff0000u));
      *(u32x4*)(Yw+(long)row*YP+ch*8)=w;} }
  asm volatile("s_waitcnt lgkmcnt(0)\n\ts_barrier":::"memory");
  #undef DMA_K
  #undef DMA_V
  #undef TOFF
  #undef BIASMASK
  #undef START
  #undef RESC
  #undef ROT
}
constexpr int NA_SLOTB=16384, NA_LDS_K=0, NA_LDS_V=3*NA_SLOTB, NA_LDS_WS=6*NA_SLOTB, NA_LDS_OST=NA_LDS_WS+NW*64*4, NA_LDS_BYTES=NA_LDS_OST+NW*4096;
template<int THRL> __device__ __forceinline__ void na_attn_unit(const bf16*Qu,const bf16*__restrict__ Kh,const bf16*__restrict__ Vh,const int NT,bf16*Yu,const bf16*Zu,char*shm,
    const long ctxoff,const long winoff,const int kr0,const int rq0,const float*btab){
  constexpr int KVP=512;
  const int tid=threadIdx.x,lane=tid&63,r32=lane&31,hi=lane>>5; const int wid=__builtin_amdgcn_readfirstlane(tid>>6);
  const int wi=wid>>2, wj=wid&3;
  const int c0=(wj==0)?0:(wj==1)?8:(wj==2)?24:32;
  const int qtok=(2*wi+(r32>>4))*64+16*wj+(r32&15);
  const unsigned lds0=(unsigned)(uintptr_t)shm;
  float*wsf=(float*)(shm+NA_LDS_WS)+wid*64;
  const bf16*ksrc=Kh+(long)lane*KVP+wid*8;
  const bf16*vsrc=Vh+(long)(16*(wid&3)+(lane>>2))*KVP+(wid>>2)*32+(lane&3)*8;
  const unsigned kdst=lds0+NA_LDS_K+wid*1024, vdst=lds0+NA_LDS_V+wid*1024;
  #define DMA_K(t,slot) do{ if((t)<4){ glds16(ksrc+(ctxoff+(long)(t)*KVBLK)*KVP,(unsigned)__builtin_amdgcn_readfirstlane(kdst+(slot))); } \
      else { glds16(ksrc+(winoff+(long)(2*((t)-4))*KVBLK)*KVP,(unsigned)__builtin_amdgcn_readfirstlane(kdst+(slot))); glds16(ksrc+(winoff+(long)(2*((t)-4)+1)*KVBLK)*KVP,(unsigned)__builtin_amdgcn_readfirstlane(kdst+(slot)+8192)); } }while(0)
  #define DMA_V(t,slot) do{ if((t)<4){ glds16(vsrc+(ctxoff+(long)(t)*KVBLK)*KVP,(unsigned)__builtin_amdgcn_readfirstlane(vdst+(slot))); } \
      else { glds16(vsrc+(winoff+(long)(2*((t)-4))*KVBLK)*KVP,(unsigned)__builtin_amdgcn_readfirstlane(vdst+(slot))); glds16(vsrc+(winoff+(long)(2*((t)-4)+1)*KVBLK)*KVP,(unsigned)__builtin_amdgcn_readfirstlane(vdst+(slot)+8192)); } }while(0)
  const int nq_r=rq0+2*wi+(r32>>4), nq_c=16*wj+(r32&15);
  const int nq_rs=min(max(nq_r-4,0),24), nq_cs=min(max(nq_c-8,0),48);
  const int nq_vb=c0+4*hi-nq_cs, nq_lb=48+15+c0+4*hi-nq_c;
  const char*Kbase=shm+NA_LDS_K; bf16x8 kf[8];
  const lds_cptr shm3=(lds_cptr)shm; const lds_cptr kp0=shm3+NA_LDS_K+hi*1024+r32*16; const lds_cptr vp0=shm3+NA_LDS_V+((lane>>4)&1)*32+(lane&3)*8+(4*hi+((lane&15)>>2))*64;
  const lds_cptr kpw=kp0+c0*16, vpw=vp0+c0*64;
  const int vbw=(int)(lds0+NA_LDS_V)+((lane>>4)&1)*32+(lane&3)*8+(4*hi+((lane&15)>>2))*64+c0*64;
  DMA_K(0,0);DMA_V(0,0);DMA_K(1,NA_SLOTB);
  bf16x8 qr[4];
  #pragma unroll
  for(int d0=0;d0<4;++d0)qr[d0]=*reinterpret_cast<const bf16x8*>(&Qu[(long)qtok*QP+d0*16+hi*8]);
  float mhat=0.f,l_reg=0.f;f32x16 o[2];o[0]=f32x16{};o[1]=f32x16{};float zin_;asm volatile("v_mov_b32 %0, 0":"=v"(zin_));f32x16 negm;
  _Pragma("unroll") for(int r=0;r<16;++r)negm[r]=zin_; asm volatile("":"+v"(negm));
  bool resc=false;
  #define RESC() do{ if(resc){ asm volatile("s_waitcnt lgkmcnt(0)":::"memory"); \
      _Pragma("unroll") for(int d_=0;d_<2;++d_) _Pragma("unroll") for(int r=0;r<16;++r)o[d_][r]*=wsf[crow(r,hi)]; } }while(0)
  f32x16 pA0,pA1,pB0,pB1;
  int sl_prev=0,sl_cur=0,sl_next=NA_SLOTB;
  #define ROT() do{sl_prev=sl_cur;sl_cur=sl_next;sl_next=(sl_next==2*NA_SLOTB)?0:sl_next+NA_SLOTB;}while(0)
  DMA_K(2,2*NA_SLOTB);
  WAIT_BAR(3);
  qkt(pA0,pA1,Kbase,qr,negm,r32,hi);asm volatile("s_nop 15\n\ts_nop 7":"+v"(pA0),"+v"(pA1));
  { const float rm=rowmax(pA0,pA1); mhat=fadd_s(mhat,rm);
    _Pragma("unroll") for(int r=0;r<16;++r){pA0[r]=fsub_s(pA0[r],rm);pA1[r]=fsub_s(pA1[r],rm);}
    _Pragma("unroll") for(int r=0;r<16;++r)negm[r]=-mhat; asm volatile("":"+v"(negm));
    _Pragma("unroll") for(int r=0;r<16;++r)pA0[r]=__builtin_amdgcn_exp2f(pA0[r]);
    _Pragma("unroll") for(int r=0;r<16;++r)pA1[r]=__builtin_amdgcn_exp2f(pA1[r]); }
  WAIT_BAR(0);
  DMA_K(3,0);DMA_V(1,NA_SLOTB);
  ROT();
  kload8(kf,kp0+sl_cur);
  WAIT_BAR(2);
  s16x4 vlo[8],vhi[8]; u32x4 pw0,pw1,pw2,pw3;
  #define PKW(P,B) cvtpk_s(P[B],P[B+1])
  #define PAF(k) __builtin_bit_cast(bf16x8,pw##k)
  #define VFR(i) (bf16x8){vlo[i][0],vlo[i][1],vlo[i][2],vlo[i][3],vhi[i][0],vhi[i][1],vhi[i][2],vhi[i][3]}
  #define PIN(x) asm volatile("":"+v"(x))
  #define MX3(a,b,c) __builtin_fmaxf(__builtin_fmaxf((a),(b)),(c))
  #define MFMA(a,b,c) __builtin_amdgcn_mfma_f32_32x32x16_bf16(a,b,c,0,0,0)
  #define GAPA(MF,A0,A1,A2,A3,W0,W1,PW) do{ MF; sacc+=A0; sacc+=A1; sacc+=A2; sacc+=A3; PIN(sacc); W0; W1; PIN(PW); SBAR(); }while(0)
  #define EX(v) __builtin_amdgcn_exp2f(v)
  #define GAPB(MF,X,B) do{ MF; X[B]=EX(X[B]); X[B+1]=EX(X[B+1]); X[B+2]=EX(X[B+2]); X[B+3]=EX(X[B+3]); PIN(X); SBAR(); }while(0)
  #define VRD(i,PW) do{ if(PW){ vlo[i]=vtr(vpw+sl_prev+((((i)&2)?8192:0)+((i)>>2)*4096+((i)&1)*1024)); vhi[i]=vtr(vpw+sl_prev+((((i)&2)?8192:0)+((i)>>2)*4096+((i)&1)*1024+512)); } \
      else { vlo[i]=vtr(vp0+sl_prev+(((i)>>2)*4096+((i)&3)*1024)); vhi[i]=vtr(vp0+sl_prev+(((i)>>2)*4096+((i)&3)*1024+512)); } }while(0)
  #define KRD(G,j,NW_) do{ if(G){ if(NW_){ kf[2*(j)]=*(const __attribute__((address_space(3))) bf16x8*)(kpw+sl_next+(j)*2048); kf[2*(j)+1]=*(const __attribute__((address_space(3))) bf16x8*)(kpw+sl_next+8192+(j)*2048); } \
      else { kload2(kf,kp0+sl_next,j); } SBAR(); } }while(0)
  #define COLV(r) ((unsigned)(((r)&3)+8*((r)>>2)+nq_vb)<16u)
  #define DECIDE2(C0,C1,WIN_) do{ float a=MX3(C0[0],C0[1],C1[0]),b=MX3(C0[2],C0[3],C1[1]); a=MX3(a,C1[2],C1[3]); \
      _Pragma("unroll") for(int r=4;r<16;r+=4){a=MX3(a,C0[r],C0[r+1]);b=MX3(b,C0[r+2],C0[r+3]);a=MX3(a,C1[r],C1[r+1]);b=MX3(b,C1[r+2],C1[r+3]);} \
      float rm=__builtin_fmaxf(a,b); { auto rr=__builtin_amdgcn_permlane32_swap(__float_as_uint(rm),__float_as_uint(rm),false,false); rm=__builtin_fmaxf(__uint_as_float(rr[0]),__uint_as_float(rr[1])); } \
      resc=false; \
      if(__builtin_expect(__any(rm>(float)THRL),0)){ const float dl=__builtin_fmaxf(rm,0.f); mhat+=dl; \
        _Pragma("unroll") for(int r=0;r<16;++r){C0[r]-=dl;C1[r]-=dl;} \
        _Pragma("unroll") for(int r=0;r<16;++r)negm[r]=((WIN_)&&!COLV(r))?-1e30f:-mhat; asm volatile("":"+v"(negm)); \
        const float f=__builtin_amdgcn_exp2f(-dl); l_reg*=f; if(hi==0)wsf[r32]=f; resc=true; } }while(0)
  #define NBIAS1(C,kr_) do{ const bool rowok_=(unsigned)((kr_)-nq_rs)<8u; const int dr_=min(max((kr_)-nq_r+7,0),14); \
      const float*tb_=btab+(rowok_?dr_*31+nq_lb:513); float b_[16]; \
      _Pragma("unroll") for(int r=0;r<16;++r){ const int kc_=(r&3)+8*(r>>2); b_[r]=tb_[kc_]; } \
      _Pragma("unroll") for(int r=0;r<16;++r){ C[r]+=b_[r]; } \
      SBAR(); }while(0)
  u32x4 zq[4];
  #define NSTEP(C0,C1,P0,P1,t,GK,GV,GL,WIN_,PW,NW_,ZL) do{ SBAR(); \
    VRD(0,PW); SBAR(); float sacc=(P0[0]+P0[1]); \
    GAPA(C0=MFMA(kf[0],qr[0],negm), P0[2],P0[3],P0[4],P0[5],     pw0[0]=PKW(P0,0), pw0[1]=PKW(P0,2), pw0); \
    VRD(4,PW); SBAR(); GAPA(C1=MFMA(kf[1],qr[0],negm), P0[6],P0[7],P0[8],P0[9],     pw0[2]=PKW(P0,4), pw0[3]=PKW(P0,6), pw0); \
    VRD(1,PW); SBAR(); GAPA(C0=MFMA(kf[2],qr[1],C0),   P0[10],P0[11],P0[12],P0[13], pw1[0]=PKW(P0,8), pw1[1]=PKW(P0,10), pw1); \
    VRD(5,PW); SBAR(); GAPA(C1=MFMA(kf[3],qr[1],C1),   P0[14],P0[15],P1[0],P1[1],   pw1[2]=PKW(P0,12),pw1[3]=PKW(P0,14), pw1); \
    VRD(2,PW); SBAR(); GAPA(C0=MFMA(kf[4],qr[2],C0),   P1[2],P1[3],P1[4],P1[5],     pw2[0]=PKW(P1,0), pw2[1]=PKW(P1,2), pw2); \
    VRD(6,PW); SBAR(); GAPA(C1=MFMA(kf[5],qr[2],C1),   P1[6],P1[7],P1[8],P1[9],     pw2[2]=PKW(P1,4), pw2[3]=PKW(P1,6), pw2); \
    VRD(3,PW); SBAR(); GAPA(C0=MFMA(kf[6],qr[3],C0),   P1[10],P1[11],P1[12],P1[13], pw3[0]=PKW(P1,8), pw3[1]=PKW(P1,10), pw3); \
    VRD(7,PW); SBAR(); GAPA(C1=MFMA(kf[7],qr[3],C1),   P1[14],P1[15],0.f,0.f,       pw3[2]=PKW(P1,12),pw3[3]=PKW(P1,14), pw3); \
    l_reg+=sacc; \
    if(GK){DMA_K((t)+3,sl_cur);} if(GV){DMA_V((t)+1,sl_next);} \
    if(ZL){ _Pragma("unroll") for(int i=0;i<4;++i){const int row=i*8+(lane>>3); const long tok=(2*wi+(row>>4))*64+16*wj+(row&15); zq[i]=__builtin_nontemporal_load((const u32x4*)(Zu+tok*YP+(lane&7)*8));} } \
    if(WIN_){ const int krA_=kr0+2*((t)-4); NBIAS1(C0,krA_); NBIAS1(C1,krA_+1); } \
    DECIDE2(C0,C1,WIN_); \
    SBAR(); \
    GAPB(o[0]=MFMA(PAF(0),VFR(0),o[0]), C0,0); \
    GAPB(o[1]=MFMA(PAF(0),VFR(4),o[1]), C0,4); \
    KRD(GL,0,NW_); GAPB(o[0]=MFMA(PAF(1),VFR(1),o[0]), C0,8); \
    KRD(GL,1,NW_); GAPB(o[1]=MFMA(PAF(1),VFR(5),o[1]), C0,12); \
    KRD(GL,2,NW_); GAPB(o[0]=MFMA(PAF(2),VFR(2),o[0]), C1,0); \
    KRD(GL,3,NW_); GAPB(o[1]=MFMA(PAF(2),VFR(6),o[1]), C1,4); \
    GAPB(o[0]=MFMA(PAF(3),VFR(3),o[0]), C1,8); \
    GAPB(o[1]=MFMA(PAF(3),VFR(7),o[1]), C1,12); \
    }while(0)
  #define ENDW(tt) do{ if((tt)+3<NT){WAIT_BAR(4);} else if((tt)+2<NT){WAIT_BAR(2);} else {WAIT_BAR(0);} }while(0)
  NSTEP(pB0,pB1,pA0,pA1,1,true,true,true,false,false,false,false); WAIT_BAR(3); RESC(); ROT();
  NSTEP(pA0,pA1,pB0,pB1,2,true,true,true,false,false,false,false); WAIT_BAR(3); RESC(); ROT();
  NSTEP(pB0,pB1,pA0,pA1,3,true,true,true,false,false,true,false);  WAIT_BAR(4); RESC(); ROT();
  _Pragma("unroll") for(int r=0;r<16;++r)negm[r]=COLV(r)?negm[r]:-1e30f; asm volatile("":"+v"(negm));
  NSTEP(pA0,pA1,pB0,pB1,4,(7<NT),true,true,true,false,true,false); ENDW(4);     RESC(); ROT();
  int t=5;
  for(;t+2<NT;t+=2){
    NSTEP(pB0,pB1,pA0,pA1,t,(t+3<NT),(t+1<NT),(t+1<NT),true,true,true,false);     ENDW(t);   RESC(); ROT();
    NSTEP(pA0,pA1,pB0,pB1,t+1,(t+4<NT),(t+2<NT),(t+2<NT),true,true,true,false);   ENDW(t+1); RESC(); ROT();
  }
  NSTEP(pB0,pB1,pA0,pA1,NT-1,false,false,false,true,true,true,true); RESC();
  { float sacc=pB0[0]+pB0[1]; _Pragma("unroll") for(int r=2;r<16;++r)sacc+=pB0[r]; _Pragma("unroll") for(int r=0;r<16;++r)sacc+=pB1[r]; l_reg+=sacc;
    pw0=(u32x4){PKW(pB0,0),PKW(pB0,2),PKW(pB0,4),PKW(pB0,6)};pw1=(u32x4){PKW(pB0,8),PKW(pB0,10),PKW(pB0,12),PKW(pB0,14)};pw2=(u32x4){PKW(pB1,0),PKW(pB1,2),PKW(pB1,4),PKW(pB1,6)};pw3=(u32x4){PKW(pB1,8),PKW(pB1,10),PKW(pB1,12),PKW(pB1,14)};
    SBAR();
    const int vb=vbw+sl_cur;
    #pragma unroll
    for(int d0=0;d0<2;++d0){s16x4 lo[4],hh[4];
      #pragma unroll
      for(int ks=0;ks<4;++ks){
        asm volatile("ds_read_b64_tr_b16 %0,%1 offset:%c2":"=&v"(lo[ks]):"v"(vb),"i"(((ks&2)?8192:0)+d0*4096+(ks&1)*1024):"memory");
        asm volatile("ds_read_b64_tr_b16 %0,%1 offset:%c2":"=&v"(hh[ks]):"v"(vb),"i"(((ks&2)?8192:0)+d0*4096+(ks&1)*1024+512):"memory");}
      asm volatile("s_waitcnt lgkmcnt(0)":::"memory");SBAR();
      #define PK(k) (bf16x8){lo[k][0],lo[k][1],lo[k][2],lo[k][3],hh[k][0],hh[k][1],hh[k][2],hh[k][3]}
      o[d0]=MFMA(PAF(0),PK(0),o[d0]);
      o[d0]=MFMA(PAF(1),PK(1),o[d0]);
      o[d0]=MFMA(PAF(2),PK(2),o[d0]);
      o[d0]=MFMA(PAF(3),PK(3),o[d0]);
      #undef PK
    } }
  #undef PKW
  #undef PAF
  #undef VFR
  #undef PIN
  #undef MX3
  #undef MFMA
  #undef GAPA
  #undef GAPB
  #undef EX
  #undef VRD
  #undef KRD
  #undef DECIDE2
  #undef COLV
  #undef NBIAS1
  #undef NSTEP
  #undef ENDW
  {auto rr=__builtin_amdgcn_permlane32_swap(__float_as_uint(l_reg),__float_as_uint(l_reg),false,false);l_reg=__uint_as_float(rr[0])+__uint_as_float(rr[1]);}
  if(hi==0)wsf[32+r32]=l_reg;asm volatile("s_waitcnt lgkmcnt(0)":::"memory");
  float rli[16];
  #pragma unroll
  for(int r=0;r<16;++r)rli[r]=__builtin_amdgcn_rcpf(wsf[32+crow(r,hi)]);
  { bf16*stg=(bf16*)(shm+NA_LDS_OST)+wid*2048;
    #pragma unroll
    for(int r=0;r<16;++r){const int orow=crow(r,hi);
      #pragma unroll
      for(int d0=0;d0<2;++d0)stg[orow*64+d0*32+r32]=__float2bfloat16(o[d0][r]*rli[r]);}
    asm volatile("s_waitcnt lgkmcnt(0)":::"memory");
    #pragma unroll
    for(int i=0;i<4;++i){const int row=i*8+(lane>>3),ch=lane&7; const long tok=(2*wi+(row>>4))*64+16*wj+(row&15);
      const u32x4 v=*(const u32x4*)(stg+row*64+ch*8); const u32x4 z=zq[i]; u32x4 w;
      w.x=cvtpk_s(__uint_as_float(v.x<<16)*__uint_as_float(z.x<<16),__uint_as_float(v.x&0xffff0000u)*__uint_as_float(z.x&0xffff0000u));
      w.y=cvtpk_s(__uint_as_float(v.y<<16)*__uint_as_float(z.y<<16),__uint_as_float(v.y&0xffff0000u)*__uint_as_float(z.y&0xffff0000u));
      w.z=cvtpk_s(__uint_as_float(v.z<<16)*__uint_as_float(z.z<<16),__uint_as_float(v.z&0xffff0000u)*__uint_as_float(z.z&0xffff0000u));
      w.w=cvtpk_s(__uint_as_float(v.w<<16)*__uint_as_float(z.w<<16),__uint_as_float(v.w&0xffff0000u)*__uint_as_float(z.w&0xffff0000u));
      *(u32x4*)(Yu+tok*YP+ch*8)=w;} }
  asm volatile("s_waitcnt lgkmcnt(0)\n\ts_barrier":::"memory");
  #undef DMA_K
  #undef DMA_V
  #undef RESC
  #undef ROT
}
#undef SBAR
#undef WAIT_BAR
}

DEVI int p3_rank(const Frame& F) { const int vcu = (F.bid & 7) * (F.G >> 3) + (F.bid >> 3); return ((vcu & 31) < 4) ? -1 : vcu - 4 * ((vcu >> 5) + 1); }
DEVI void p3_wait_deferred(Frame& F) {
    if (F.wave == 0) { unsigned* gate = (unsigned*)(F.ws + WS_PCNT) + 64 * 67; unsigned sp = 0;
        while ((unsigned)__builtin_amdgcn_readfirstlane(__hip_atomic_load(gate, __ATOMIC_RELAXED, __HIP_MEMORY_SCOPE_AGENT)) < 32u) { __builtin_amdgcn_s_sleep(8); if (++sp > (1u << 20)) break; }
        __builtin_amdgcn_fence(__ATOMIC_ACQUIRE, "agent"); }
    asm volatile("s_waitcnt vmcnt(0)" ::: "memory");
    __syncthreads();
}
DEVI void phase_attn0(Frame& F, char* lds_generic) {
    using abf = attn_body::bf16;
    const abf* Q0 = (const abf*)wsb(F, WS_Q0); const abf* K0 = (const abf*)wsb(F, WS_K0); const abf* V0 = (const abf*)wsb(F, WS_V0);
    const abf* SZ = (const abf*)wsb(F, WS_SZ0); abf* Y = (abf*)wsb(F, WS_Y0);
    const int vcu = (F.bid & 7) * (F.G >> 3) + (F.bid >> 3);
    const int rk = p3_rank(F);
    for (int k = 0; k < 3; ++k) {
        int id;
        if (k < 2) id = vcu + k * F.G; else { if (rk < 160) break; id = 512 + (rk - 160); p3_wait_deferred(F); }
        int b, head, NT; size_t row0;
        if (id < 512) { const int qb = id & 7, g = (id >> 3) & 3, kvh = (id >> 5) & 1; b = id >> 6; head = kvh * 4 + g; row0 = (size_t)b * SEQ + qb * 256; NT = NKEY0 / 64; }
        else { const int j = id - 512; b = j >> 3; head = j & 7; row0 = (size_t)MX + b * CTXL; NT = CTXL / 64; }
        const size_t kvoff = (size_t)b * NKEY0 * 128 + (head >> 2) * 64;
        attn_body::attn_unit<8, false, 128>(Q0 + row0 * 512 + head * 64, K0 + kvoff, V0 + kvoff, NT, Y + row0 * 1024 + 512 + head * 64, SZ + row0 * 1024 + 512 + head * 64, lds_generic);
    }
}

DEVI void phase_conv(Frame& F) {
    LAS float* red = (LAS float*)F.lds;
    const bf16* GLU = wsb(F, WS_GLU); const bf16* SZ = wsb(F, WS_SZ0); bf16* Y = wsb(F, WS_Y0);
    const int half = F.wave >> 2, wq = F.wave & 3, c2 = wq * 128 + F.lane * 2;
    typedef float f32x2v __attribute__((ext_vector_type(2)));
    f32x2v wt[31];
#pragma unroll
    for (int t = 0; t < 31; ++t) wt[t] = *(const f32x2v*)(F.in[I_AB_CONVW] + t * 512 + c2);
    const float2 cb = *(const float2*)(F.in[I_AB_CONVB] + c2), lg = *(const float2*)(F.in[I_AB_LNG] + c2), lb = *(const float2*)(F.in[I_AB_LNB] + c2);
    constexpr int NCH = MT / 16;
    const int rk = p3_rank(F);
    bool waited = rk >= 160;
    for (int it = rk; rk >= 0 && it * 2 < NCH; it += 224) {
        if (it * 32 >= MX && !waited) { p3_wait_deferred(F); waited = true; }
        const int ch = it * 2 + half;
        const int row0 = ch * 16;
        int base, len, pos0;
        if (row0 < MX) { base = row0 & ~2047; len = SEQ; pos0 = row0 & 2047; } else { const int rc = row0 - MX; base = MX + (rc & ~255); len = CTXL; pos0 = rc & 255; }
        unsigned gin[46];
#pragma unroll
        for (int pi = 0; pi < 46; ++pi) { const int p = pos0 - 15 + pi, pc = min(max(p, 0), len - 1); gin[pi] = *(const unsigned*)(GLU + (size_t)(base + pc) * 512 + c2); }
#pragma unroll
        for (int pi = 0; pi < 46; ++pi) { const int p = pos0 - 15 + pi; gin[pi] = (p >= 0 && p < len) ? gin[pi] : 0u; }
        unsigned zin[16];
#pragma unroll
        for (int li = 0; li < 16; ++li) zin[li] = __builtin_nontemporal_load((const unsigned*)(SZ + (size_t)(row0 + li) * 1024 + c2));
        f32x2v av[16];
#pragma unroll
        for (int li = 0; li < 16; ++li) av[li] = (f32x2v){cb.x, cb.y};
#pragma unroll
        for (int pi = 0; pi < 46; ++pi) { const f32x2v g = (f32x2v){bflo(gin[pi]), bfhi(gin[pi])};
#pragma unroll
            for (int li = 0; li < 16; ++li) { const int t = pi - li; if (t >= 0 && t <= 30) av[li] = __builtin_elementwise_fma(g, wt[t], av[li]); } }
        float a0[16], a1[16];
#pragma unroll
        for (int li = 0; li < 16; ++li) { a0[li] = av[li].x; a1[li] = av[li].y; }
        float st[32];
#pragma unroll
        for (int li = 0; li < 16; ++li) { st[li] = a0[li] + a1[li]; st[16 + li] = a0[li] * a0[li] + a1[li] * a1[li]; }
#define WS_STEP(ctrl, rmask) _Pragma("unroll") for (int j = 0; j < 32; ++j) st[j] += __builtin_bit_cast(float, __builtin_amdgcn_update_dpp(0, __builtin_bit_cast(int, st[j]), ctrl, rmask, 0xf, true))
        WS_STEP(0xB1, 0xf); WS_STEP(0x4E, 0xf); WS_STEP(0x141, 0xf); WS_STEP(0x140, 0xf); WS_STEP(0x142, 0xa); WS_STEP(0x143, 0xc);
#undef WS_STEP
#pragma unroll
        for (int j = 0; j < 32; ++j) st[j] = __builtin_bit_cast(float, __builtin_amdgcn_readlane(__builtin_bit_cast(int, st[j]), 63));
        __syncthreads();
        if (F.lane < 32) { float v = st[0];
#pragma unroll
            for (int j = 1; j < 32; ++j) v = (F.lane == j) ? st[j] : v;
            red[(half * 4 + wq) * 32 + F.lane] = v; }
        __syncthreads();
#pragma unroll
        for (int li = 0; li < 16; ++li) {
            const LAS float* rp = red + half * 128;
            const float sm = (rp[li] + rp[32 + li]) + (rp[64 + li] + rp[96 + li]), sq = (rp[16 + li] + rp[48 + li]) + (rp[80 + li] + rp[112 + li]);
            const float mean = sm * (1.f / 512.f), var = fmaxf(sq * (1.f / 512.f) - mean * mean, 0.f), rstd = __builtin_amdgcn_rsqf(var + EPS);
            const float y0 = fsilu((a0[li] - mean) * rstd * lg.x + lb.x) * bflo(zin[li]), y1 = fsilu((a1[li] - mean) * rstd * lg.y + lb.y) * bfhi(zin[li]);
            *(unsigned*)(Y + (size_t)(row0 + li) * 1024 + c2) = pk2(y0, y1);
        }
    }
    __syncthreads();
}

constexpr int NA_BTAB_OFF = 133120;
DEVI void na_fill_table(Frame& F, int h) {
    LAS float* bt = (LAS float*)(F.lds + NA_BTAB_OFF);
    const float* rpb = F.in[I_CD_RPB] + h * 15 * 31;
    for (int i = F.tid; i < 544; i += NTHR) bt[i] = (i < 48) ? 0.f : (i < 48 + 465) ? rpb[i - 48] * LOG2E : -1e30f;
}
DEVI void na_unit(Frame& F, char* lds_generic, int id, int& cur_h) {
    using abf = attn_body::bf16;
    const abf* Q1 = (const abf*)wsb(F, WS_Q1); const abf* K1 = (const abf*)wsb(F, WS_K1); const abf* V1 = (const abf*)wsb(F, WS_V1);
    const abf* SZ1 = (const abf*)wsb(F, WS_SZ1); abf* Y1 = (abf*)wsb(F, WS_Y1);
    const int rg = id & 7, h = (id >> 3) & 7, b = id >> 6;
    const int r0 = 4 * rg, kr0 = min(max(r0 - 4, 0), 24), nwin = (rg == 0 || rg == 7) ? 8 : 12;
    if (h != cur_h) { na_fill_table(F, h); cur_h = h; }
    const size_t row0 = (size_t)b * SEQ + r0 * 64;
    attn_body::na_attn_unit<8>(Q1 + row0 * 512 + h * 64, K1 + h * 64, V1 + h * 64, 4 + nwin / 2, Y1 + row0 * 1024 + 512 + h * 64, SZ1 + row0 * 1024 + 512 + h * 64, lds_generic,
                                       (long)MX + b * CTXL, (long)b * SEQ + kr0 * 64, kr0, r0, (const float*)(lds_generic + NA_BTAB_OFF));
}
DEVI void phase_shiftw(Frame& F) {
    LAS float* sh = (LAS float*)F.lds;
    __syncthreads();
    const float* ada1 = wsf(F, WS_ADA) + 9 * 3072;
    for (int i = F.tid; i < 9 * 1024; i += NTHR) sh[i] = ada1[(i >> 10) * 3072 + (i & 1023)];
    __syncthreads();
    const bf16* WT = wsb(F, WS_WIN1); float* sw = wsf(F, WS_SW);
    const int rk = p3_rank(F); const bool light = rk >= 128 && rk < 160;
    const int gw = light ? 1792 + (rk - 128) * NWAVES + F.wave : ((rk < 0) ? F.bid : (rk < 128 ? 32 + rk : rk)) * NWAVES + F.wave;
    const int NGW = 256, nend = light ? N1 : gw + 1;
    for (int n = gw; n < nend; n += NGW) {
        const v4u w0 = *(const v4u*)(WT + (size_t)n * DM + F.lane * 16), w1 = *(const v4u*)(WT + (size_t)n * DM + F.lane * 16 + 8);
        float wv[16] = {bflo(w0.x), bfhi(w0.x), bflo(w0.y), bfhi(w0.y), bflo(w0.z), bfhi(w0.z), bflo(w0.w), bfhi(w0.w), bflo(w1.x), bfhi(w1.x), bflo(w1.y), bfhi(w1.y), bflo(w1.z), bfhi(w1.z), bflo(w1.w), bfhi(w1.w)};
        float a[9];
#pragma unroll
        for (int r = 0; r < 9; ++r) { a[r] = 0.f;
#pragma unroll
            for (int q = 0; q < 4; ++q) { const f32x4 sv = *(const LAS f32x4*)(sh + r * 1024 + F.lane * 16 + 4 * q); a[r] += sv.x * wv[4 * q] + sv.y * wv[4 * q + 1] + sv.z * wv[4 * q + 2] + sv.w * wv[4 * q + 3]; } }
#define WS_STEP(ctrl, rmask) _Pragma("unroll") for (int r = 0; r < 9; ++r) a[r] += __builtin_bit_cast(float, __builtin_amdgcn_update_dpp(0, __builtin_bit_cast(int, a[r]), ctrl, rmask, 0xf, true))
        WS_STEP(0xB1, 0xf); WS_STEP(0x4E, 0xf); WS_STEP(0x141, 0xf); WS_STEP(0x140, 0xf); WS_STEP(0x142, 0xa); WS_STEP(0x143, 0xc);
#undef WS_STEP
        if (F.lane == 63) {
#pragma unroll
            for (int r = 0; r < 9; ++r) sw[r * N1 + n] = a[r]; }
    }
    __syncthreads();
}
__global__ void __launch_bounds__(NTHR, 2) mk_fwd(Args args) {
    extern __shared__ __attribute__((aligned(16))) unsigned char lds[];
    Frame F;
    F.lds = (LAS unsigned char*)lds;
    F.tid = threadIdx.x; F.lane = F.tid & 63; F.wave = __builtin_amdgcn_readfirstlane(F.tid >> 6);
    F.G = gridDim.x; F.bid = blockIdx.x;
#pragma unroll
    for (int i = 0; i < 23; ++i) F.in[i] = args.in[i];
    F.out = args.out; F.ws = args.ws;
    volatile LAS unsigned* MISC = (volatile LAS unsigned*)(F.lds + MISC_OFF);
    if (F.tid < 32) MISC[F.tid] = 0u;
    __syncthreads();
    unsigned* ctl = (unsigned*)(F.ws + WS_CTL);
    XcdBarrier bar; bar.bar = ctl + CW_BAR; bar.x = 0; bar.st = nullptr;
    if (MK_N_LAUNCHES == 1) bar = xcd_barrier_post(ctl + CW_BAR, MISC + 8);
    const int lo = args.ph_lo, hi = args.ph_hi;
#define IN(k) (lo <= (k) && (k) < hi)
    volatile LAS unsigned long long* TS = (volatile LAS unsigned long long*)(F.lds + 146432);
#define STAMP(k) do { if (PROBE_PHASE >= 0 && F.bid == 0 && F.tid == 0) TS[k] = __builtin_amdgcn_s_memrealtime(); } while (0)
#define SEAM(k) do { if (IN(k) && IN((k) + 1)) xcd_barrier(bar); STAMP((k) + 1); } while (0)
    STAMP(0);

    {
        f32x4 xpf[XPF][4];
        if (IN(0)) { p0_prologue(F, xpf); } SEAM(0);
        if (IN(1)) { phase_modnorm(F, 0, xpf); } SEAM(1);
    }
    if (IN(2)) {
        EpiIn0 E{wsb(F, WS_GLU), wsb(F, WS_Q0), wsb(F, WS_K0), wsb(F, WS_V0), wsb(F, WS_SZ0), F.in[I_AB_QNG], F.in[I_AB_KNG], wsf(F, WS_ROPE)};
        pg8::SegOrder S; S.init(pg8::Seg{wsb(F, WS_H), wsb(F, WS_WIN0), 72, 7, 0}, pg8::Seg{wsb(F, WS_H), wsb(F, WS_WIN0) + (size_t)7 * 256 * DM, 64, 4, 1}, pg8::Seg{nullptr, nullptr, 0, 0, 0}, DM, F.G, F.bid);
        pg8::gemm_phase<EpiIn0, pg8::SegOrder>(F.lds, DM, S, E);
        p2_fill_fold(F);
    } SEAM(2);
    if (IN(3)) {
        if (F.bid < 32) {
            EpiIn0 E{wsb(F, WS_GLU), wsb(F, WS_Q0), wsb(F, WS_K0), wsb(F, WS_V0), wsb(F, WS_SZ0), F.in[I_AB_QNG], F.in[I_AB_KNG], wsf(F, WS_ROPE)};
            pg8::SegOrder S; S.init(pg8::Seg{wsb(F, WS_H) + (size_t)64 * 256 * DM, wsb(F, WS_WIN0) + (size_t)7 * 256 * DM, 8, 4, 2}, pg8::Seg{nullptr, nullptr, 0, 0, 0}, pg8::Seg{nullptr, nullptr, 0, 0, 0}, DM, F.G, F.bid);
            pg8::gemm_phase<EpiIn0, pg8::SegOrder>(F.lds, DM, S, E);
            if (F.tid == 0) { __builtin_amdgcn_fence(__ATOMIC_RELEASE, "agent"); asm volatile("s_waitcnt vmcnt(0)" ::: "memory");
                __hip_atomic_fetch_add((unsigned*)(F.ws + WS_PCNT) + 64 * 67, 1u, __ATOMIC_RELAXED, __HIP_MEMORY_SCOPE_AGENT); }
        }
        phase_attn0(F, (char*)lds); STAMP(11); phase_conv(F); phase_shiftw(F); } SEAM(3);
    if (IN(4)) {
        EpiOutX E{F.in[I_X], wsf(F, WS_ADA), wsf(F, WS_ADA) + 9 * 3072, F.in[I_CD_NORMG], (_Float16*)(F.ws + WS_X1H), wsb(F, WS_H), wsf(F, WS_SSQ)};
        pg8::SegOrder S; S.init(pg8::Seg{wsb(F, WS_Y0), wsb(F, WS_WOUT0), 64, 4, 0}, pg8::Seg{nullptr, nullptr, 0, 0, 0}, pg8::Seg{nullptr, nullptr, 0, 0, 0}, DM, F.G, F.bid);
        pg8::gemm_phase<EpiOutX, pg8::SegOrder>(F.lds, DM, S, E);
    } SEAM(4);
    if (IN(5)) {
        EpiIn1 E{wsb(F, WS_PT), wsb(F, WS_Q1), wsb(F, WS_K1), wsb(F, WS_V1), wsb(F, WS_SZ1), wsf(F, WS_SSQ), wsf(F, WS_SW),
                 F.in[I_CTX], wsf(F, WS_ADA), wsf(F, WS_ADA) + 9 * 3072, F.in[I_CD_NORMG], wsb(F, WS_H), wsf(F, WS_SSQ), 0, (unsigned*)(F.ws + WS_PCNT) + 64 * 64};
        pg8::SegOrder S; S.init(pg8::Seg{wsb(F, WS_Y0) + (size_t)MX * DM, wsb(F, WS_WOUT0), 8, 4, 3},
                                pg8::Seg{wsb(F, WS_H), wsb(F, WS_WIN1) + (size_t)1024 * DM, 64, 10, 0},
                                pg8::Seg{wsb(F, WS_WIN1), wsb(F, WS_H), 4, 24, 2}, DM, F.G, F.bid);
        pg8::gemm_phase<EpiIn1, pg8::SegOrder>(F.lds, DM, S, E);
    }
    if (IN(5) && IN(6)) {
        const int c6 = (F.bid + 224) & 255;
        if (c6 >= 160 && c6 < 192) {
            if (F.wave == 0) { unsigned* gate = (unsigned*)(F.ws + WS_PCNT) + 64 * 64; unsigned sp = 0;
                while ((unsigned)__builtin_amdgcn_readfirstlane(__hip_atomic_load(gate, __ATOMIC_RELAXED, __HIP_MEMORY_SCOPE_AGENT)) < 256u) { __builtin_amdgcn_s_sleep(2); if (++sp > (1u << 22)) break; }
                __builtin_amdgcn_fence(__ATOMIC_ACQUIRE, "agent"); }
            asm volatile("s_waitcnt vmcnt(0)" ::: "memory");
            __syncthreads();
        }
    } STAMP(6);
    if (IN(6)) {
        EpiIn1 E{wsb(F, WS_PT), wsb(F, WS_Q1), wsb(F, WS_K1), wsb(F, WS_V1), wsb(F, WS_SZ1), wsf(F, WS_SSQ), wsf(F, WS_SW),
                 F.in[I_CTX], wsf(F, WS_ADA), wsf(F, WS_ADA) + 9 * 3072, F.in[I_CD_NORMG], wsb(F, WS_H), wsf(F, WS_SSQ), 24, (unsigned*)(F.ws + WS_PCNT) + 64 * 64};
        pg8::SegOrder S; S.init(pg8::Seg{wsb(F, WS_WIN1), wsb(F, WS_H) + (size_t)24 * 256 * DM, 4, 40, 2},
                                pg8::Seg{wsb(F, WS_H) + (size_t)MX * DM, wsb(F, WS_WIN1) + (size_t)1536 * DM, 8, 4, 1}, pg8::Seg{nullptr, nullptr, 0, 0, 0}, DM, F.G, (F.bid + 224) & 255);
        pg8::gemm_phase<EpiIn1, pg8::SegOrder>(F.lds, DM, S, E);
        if (((F.bid + 224) & 255) >= 192) p6_filler(F, ((F.bid + 224) & 255) - 192, F.G - 192);
    } SEAM(6);
    if (IN(7)) {
        EpiDft E{wsb(F, WS_Y1), wsb(F, WS_SZ1)};
        pg8::SegOrder S; S.init(pg8::Seg{wsb(F, WS_DFT), wsb(F, WS_PT), 8, 32, 0}, pg8::Seg{nullptr, nullptr, 0, 0, 0}, pg8::Seg{nullptr, nullptr, 0, 0, 0}, 2048, F.G, F.bid);
        pg8::gemm_phase<EpiDft, pg8::SegOrder, true, true>(F.lds, 2048, S, E); STAMP(12);
        phase_nyquist(F);
        {
            const int vcu = (F.bid & 7) * (F.G >> 3) + (F.bid >> 3);
            int cur_h = -1;
            for (int id = vcu; id < 512; id += F.G) na_unit(F, (char*)lds, id, cur_h);
        }
    } SEAM(7);
    if (IN(8)) {
        EpiOutF E{wsf(F, WS_ADA) + 9 * 3072, F.in[I_FNG], (const _Float16*)(F.ws + WS_X1H), F.out, wsf(F, WS_SSQ2), (unsigned*)(F.ws + WS_PCNT)};
        pg8::SegOrder S; S.init(pg8::Seg{wsb(F, WS_Y1), wsb(F, WS_WOUT1), 64, 4, 0}, pg8::Seg{nullptr, nullptr, 0, 0, 0}, pg8::Seg{nullptr, nullptr, 0, 0, 0}, DM, F.G, F.bid);
        if (F.G == 256) pg8::gemm_phase<EpiOutF, pg8::SegOrder>(F.lds, DM, S, E);
    }
    if (PROBE_PHASE >= 0) { STAMP(10); __syncthreads(); if (F.bid == 0 && F.tid == 0) F.out[0] += (float)(TS[PROBE_B] - TS[PROBE_A]) * 0.01f; }
#undef IN
#undef SEAM
}

extern "C" void kernel_launch(void* const* d_in, const int* in_sizes, int n_in, void* d_out, int out_size, void* d_ws, size_t ws_size, hipStream_t stream) {
    static int grid = 0;
    if (grid == 0) {
        if (n_in != 23 || out_size != MX * DM || ws_size < WS_X1H + (size_t)MX * DM * 2) { fprintf(stderr, "kernel_launch: unexpected shapes (n_in %d out %d ws %zu)\n", n_in, out_size, ws_size); grid = -1; return; }
        int dev = 0, cus = 0, per_cu = 0;
        if (hipGetDevice(&dev) != hipSuccess || hipDeviceGetAttribute(&cus, hipDeviceAttributeMultiprocessorCount, dev) != hipSuccess) { grid = -1; return; }
        if (hipFuncSetAttribute((const void*)mk_fwd, hipFuncAttributeMaxDynamicSharedMemorySize, LDS_BYTES) != hipSuccess) { fprintf(stderr, "kernel_launch: hipFuncSetAttribute failed\n"); grid = -1; return; }
        if (hipOccupancyMaxActiveBlocksPerMultiprocessor(&per_cu, (const void*)mk_fwd, NTHR, LDS_BYTES) != hipSuccess || per_cu < 1) { fprintf(stderr, "kernel_launch: occupancy query says %d\n", per_cu); per_cu = 1; }
        (void)hipGetLastError();
        grid = cus;
    }
    if (grid < 0) return;
    if (hipMemsetAsync((char*)d_ws + WS_CTL, 0, CTL_ZERO_BYTES, stream) != hipSuccess) { fprintf(stderr, "kernel_launch: memset failed\n"); return; }
    Args a{};
    for (int i = 0; i < 23; ++i) a.in[i] = (const float*)d_in[i];
    a.out = (float*)d_out; a.ws = (unsigned char*)d_ws;
    for (int li = 0; li < MK_N_LAUNCHES; ++li) {
        if (MK_N_LAUNCHES == 1) { a.ph_lo = 0; a.ph_hi = NPHASES; } else { a.ph_lo = li; a.ph_hi = li + 1; }
        a.li = li;
        hipLaunchKernelGGL(mk_fwd, dim3(grid), dim3(NTHR), LDS_BYTES, stream, a);
        const hipError_t le = hipPeekAtLastError();
        if (le != hipSuccess) { fprintf(stderr, "kernel_launch: launch %d failed: %s\n", li, hipGetErrorName(le)); break; }
    }
}
```

```cpp
#include <hip/hip_runtime.h>
#include <cstdio>
#include <cstdint>
#include <hip/hip_bf16.h>

#ifndef PROBE_PHASE
#define PROBE_PHASE -1
#define PROBE_A 0
#define PROBE_B 1
#endif
#ifndef MK_N_LAUNCHES
#define MK_N_LAUNCHES 1
#endif

#define GAS __attribute__((address_space(1)))
#define LAS __attribute__((address_space(3)))
typedef unsigned short bf16;
typedef unsigned v4u __attribute__((ext_vector_type(4)));
typedef float f32x4 __attribute__((ext_vector_type(4)));
typedef GAS unsigned gu32;
#define RLX_AGENT __ATOMIC_RELAXED, __HIP_MEMORY_SCOPE_AGENT
#define LDS_WAIT() asm volatile("s_waitcnt lgkmcnt(0)" ::: "memory")
#define DEVI __device__ __forceinline__

constexpr int NB = 8, SEQ = 2048, DM = 1024, CTXL = 256, GRIDW = 64;
constexpr int MX = NB * SEQ, MC = NB * CTXL, MT = MX + MC;
constexpr int AB_IN = 2816, CD_IN = 3072, N1 = 3584;
constexpr int NKEY0 = CTXL + SEQ;
constexpr float EPS = 1e-6f;
constexpr float LOG2E = 1.4426950408889634f, C2 = 0.125f * LOG2E;
constexpr int NWAVES = 8, NTHR = 512;
constexpr int NPHASES = 10;

constexpr size_t MiB = 1u << 20;
constexpr size_t WS_CTL = 0, CTL_ZERO_BYTES = 1 * MiB;
constexpr size_t WS_ADA = 256 * 1024;
constexpr size_t WS_SSQ = 512 * 1024;
constexpr size_t WS_SSQ2 = 640 * 1024;
constexpr size_t WS_PCNT = 768 * 1024;
constexpr size_t WS_SW = 2 * MiB;
constexpr size_t WS_ROPE = 1 * MiB;
constexpr size_t WS_MCS = 1 * MiB + 512 * 1024;
constexpr size_t WS_WIN0 = 3 * MiB, WS_WOUT0 = 9 * MiB, WS_WIN1 = 11 * MiB, WS_WOUT1 = 18 * MiB;
constexpr size_t WS_DFT = 20 * MiB;
constexpr size_t WS_H = 36 * MiB;
constexpr size_t WS_R = 72 * MiB;
constexpr size_t WS_X1H = 224 * MiB;
constexpr size_t WS_GLU = WS_R, WS_Q0 = WS_R + 18 * MiB, WS_K0 = WS_R + 36 * MiB, WS_V0 = WS_K0 + 4608 * 1024, WS_SZ0 = WS_R + 45 * MiB;
constexpr size_t WS_Y0 = WS_R + 116 * MiB;
constexpr size_t WS_PT = WS_R, WS_Q1 = WS_R + 32 * MiB, WS_K1 = WS_R + 48 * MiB, WS_V1 = WS_R + 66 * MiB, WS_SZ1 = WS_R + 84 * MiB, WS_Y1 = WS_R + 116 * MiB;
constexpr size_t WS_END = WS_R + 152 * MiB;
static_assert(WS_END <= WS_X1H && WS_X1H + (size_t)MX * DM * 2 <= 256 * MiB, "d_ws map");
constexpr int CW_BAR = 4096;

constexpr int LDS_BYTES = 147456;
constexpr int MISC_OFF = 145408;

DEVI unsigned f2bf(float f) { unsigned u = __builtin_bit_cast(unsigned, f); return (u + 0x7fffu + ((u >> 16) & 1u)) >> 16; }
DEVI unsigned pk2(float lo, float hi) { return f2bf(lo) | (f2bf(hi) << 16); }
DEVI float bf2f(unsigned b) { return __builtin_bit_cast(float, (b & 0xffffu) << 16); }
DEVI float bflo(unsigned w) { return __builtin_bit_cast(float, w << 16); }
DEVI float bfhi(unsigned w) { return __builtin_bit_cast(float, w & 0xffff0000u); }
DEVI float siluf(float v) { return v / (1.f + expf(-v)); }
DEVI float sigmf(float v) { return 1.f / (1.f + expf(-v)); }
DEVI float wave_sum_dpp(float v) {
#define WS_DPP(ctrl, rmask) v += __builtin_bit_cast(float, __builtin_amdgcn_update_dpp(0, __builtin_bit_cast(int, v), ctrl, rmask, 0xf, true))
    WS_DPP(0xB1, 0xf);
    WS_DPP(0x4E, 0xf);
    WS_DPP(0x141, 0xf);
    WS_DPP(0x140, 0xf);
    WS_DPP(0x142, 0xa);
    WS_DPP(0x143, 0xc);
#undef WS_DPP
    return __builtin_bit_cast(float, __builtin_amdgcn_readlane(__builtin_bit_cast(int, v), 63));
}
DEVI float sum_fq(float v) {
    { auto r = __builtin_amdgcn_permlane16_swap(__float_as_uint(v), __float_as_uint(v), false, false); v = __uint_as_float(r[0]) + __uint_as_float(r[1]); }
    { auto r = __builtin_amdgcn_permlane32_swap(__float_as_uint(v), __float_as_uint(v), false, false); v = __uint_as_float(r[0]) + __uint_as_float(r[1]); }
    return v;
}
DEVI float wave_sum(float v) {
#pragma unroll
    for (int o = 1; o < 64; o <<= 1) v += __shfl_xor(v, o);
    return v;
}

#define XB_TMO      128
#define XB_XCNT(j)  (256  + 64 * (j))
#define XB_XSUB(j)  (1280 + 64 * (j))
#define XB_XGEN(j)  (2304 + 64 * (j))
#define XB_TOP      3328
#define XB_TOPGEN   3392
#define XCD_BAR_WORDS 3456
#define XB_SPIN_CAP (1u << 22)
DEVI unsigned xb_ld(unsigned* p)              { return __hip_atomic_load(p, __ATOMIC_RELAXED, __HIP_MEMORY_SCOPE_AGENT); }
DEVI unsigned xb_add(unsigned* p, unsigned v) { return __hip_atomic_fetch_add(p, v, __ATOMIC_RELAXED, __HIP_MEMORY_SCOPE_AGENT); }
DEVI unsigned xb_xcc_id() { return (unsigned)__builtin_amdgcn_s_getreg((3 << 11) | 20) & 0xFu; }
#define XB_SPIN(cond, bar) do { unsigned _sp = 0; while (cond) { __builtin_amdgcn_s_sleep(1); \
    if ((++_sp & 255u) == 0u) { if (xb_ld(&(bar)[XB_TMO])) break; if (_sp > XB_SPIN_CAP) { atomicAdd(&(bar)[XB_TMO], 1u); break; } } } } while (0)
struct XcdBarrier { unsigned* bar; unsigned x; volatile LAS unsigned* st; };
DEVI XcdBarrier xcd_barrier_post(unsigned* bar, volatile LAS unsigned* st) {
    XcdBarrier b; b.bar = bar; b.x = xb_xcc_id(); b.st = st;
    if (threadIdx.x == 0) (void)xb_add(&bar[XB_XCNT(b.x)], 1u);
    return b;
}
DEVI void xcd_barrier_complete(unsigned* bar, unsigned x, unsigned& nloc, unsigned& nx) {
    const unsigned G = gridDim.x * gridDim.y * gridDim.z;
    unsigned sum, cnt, mine, sp = 0u;
    for (;;) {
        sum = 0u; cnt = 0u; mine = 0u;
#pragma unroll
        for (unsigned j = 0; j < 16; ++j) { const unsigned c = xb_ld(&bar[XB_XCNT(j)]); sum += c; cnt += (c > 0u) ? 1u : 0u; mine = (j == x) ? c : mine; }
        if (sum == G) break;
        __builtin_amdgcn_s_sleep(1);
        if ((++sp & 255u) == 0u) { if (xb_ld(&bar[XB_TMO])) break; if (sp > XB_SPIN_CAP) { atomicAdd(&bar[XB_TMO], 1u); break; } }
    }
    nloc = mine > 0u ? mine : 1u; nx = cnt > 0u ? cnt : 1u;
}
DEVI void xcd_barrier(const XcdBarrier& b) {
    asm volatile("s_waitcnt vmcnt(0)" ::: "memory");
    __syncthreads();
    if (threadIdx.x == 0) {
        unsigned* bar = b.bar;
        __builtin_amdgcn_s_waitcnt(0);
        unsigned nloc = b.st[0], nx = b.st[1];
        if (nloc == 0u) { xcd_barrier_complete(bar, b.x, nloc, nx); b.st[0] = nloc; b.st[1] = nx; }
        const unsigned old = xb_add(&bar[XB_XSUB(b.x)], 1u);
        const unsigned gen = old / nloc;
        if (old + 1u == (gen + 1u) * nloc) {
            __builtin_amdgcn_fence(__ATOMIC_RELEASE, "agent");
            asm volatile("s_waitcnt vmcnt(0)" ::: "memory");
            const unsigned og = xb_add(&bar[XB_TOP], 1u);
            const unsigned tg = og / nx;
            if (og + 1u == (tg + 1u) * nx) xb_add(&bar[XB_TOPGEN], 1u);
            else XB_SPIN(xb_ld(&bar[XB_TOPGEN]) == tg, bar);
            __builtin_amdgcn_fence(__ATOMIC_ACQUIRE, "agent");
            xb_add(&bar[XB_XGEN(b.x)], 1u);
            asm volatile("s_waitcnt vmcnt(0)" ::: "memory");
        } else {
            XB_SPIN(xb_ld(&bar[XB_TOPGEN]) == gen, bar);
            __builtin_amdgcn_fence(__ATOMIC_ACQUIRE, "agent");
            asm volatile("s_waitcnt vmcnt(0)" ::: "memory");
        }
    }
    __syncthreads();
}

struct Args { const float* in[23]; float* out; unsigned char* ws; int ph_lo, ph_hi, li, pad; };
enum { I_X = 0, I_C, I_CTX, I_CCTX, I_AB_WADA, I_AB_BADA, I_AB_NORMG, I_AB_WIN, I_AB_CONVW, I_AB_CONVB, I_AB_LNG, I_AB_LNB, I_AB_QNG, I_AB_KNG, I_AB_WOUT,
       I_CD_WADA, I_CD_BADA, I_CD_NORMG, I_CD_WIN, I_CD_WF, I_CD_RPB, I_CD_WOUT, I_FNG };

struct Frame {
    LAS unsigned char* lds;
    int tid, lane, wave, G, bid;
    const float* in[23]; float* out; unsigned char* ws;
};
DEVI bf16* wsb(const Frame& F, size_t off) { return (bf16*)(F.ws + off); }
DEVI float* wsf(const Frame& F, size_t off) { return (float*)(F.ws + off); }

DEVI float block_sum(float v, LAS float* red, int lane, int wave) {
    v = wave_sum(v);
    __syncthreads();
    if (lane == 0) red[wave] = v;
    __syncthreads();
    float s = 0.f;
#pragma unroll
    for (int i = 0; i < NWAVES; ++i) s += red[i];
    return s;
}

DEVI void transpose_load(float (&tv)[32], const float* W, int ldw, int c0, int ncols, int item, int lane) {
    const int nblk = ncols / 32, kb = item / nblk, nb = item % nblk, k0 = 64 * kb, n0 = 32 * nb;
#pragma unroll
    for (int i = 0; i < 32; ++i) { const int kk = 2 * i + (lane >> 5); tv[i] = __builtin_nontemporal_load(W + (size_t)(k0 + kk) * ldw + c0 + n0 + (lane & 31)); }
}
template <class Map>
DEVI void transpose_store(const float (&tv)[32], int ncols, int K, bf16* WT, Map map32, LAS float* scr, int item, int lane) {
    const int nblk = ncols / 32, kb = item / nblk, nb = item % nblk, k0 = 64 * kb;
#pragma unroll
    for (int i = 0; i < 32; ++i) { const int kk = 2 * i + (lane >> 5); scr[kk * 33 + (lane & 31)] = tv[i]; }
    LDS_WAIT(); asm volatile("" ::: "memory");
    const int c = lane & 7;
    const int drow0 = map32(nb) * 32;
#pragma unroll
    for (int j = 0; j < 4; ++j) { const int n = (lane >> 3) + 8 * j; const LAS float* s = scr + (8 * c) * 33 + n;
        v4u o; o.x = pk2(s[0 * 33], s[1 * 33]); o.y = pk2(s[2 * 33], s[3 * 33]); o.z = pk2(s[4 * 33], s[5 * 33]); o.w = pk2(s[6 * 33], s[7 * 33]);
        *(v4u*)(WT + (size_t)(drow0 + n) * K + k0 + 8 * c) = o; }
    LDS_WAIT(); asm volatile("" ::: "memory");
}
template <class Map>
DEVI void transpose_item(const float* W, int ldw, int c0, int ncols, int K, bf16* WT, Map map32, LAS float* scr, int item, int lane) {
    float tv[32];
    transpose_load(tv, W, ldw, c0, ncols, item, lane);
    transpose_store(tv, ncols, K, WT, map32, scr, item, lane);
}
struct MapId { int off; DEVI int operator()(int nb) const { return nb + off; } };
struct MapIn0 { DEVI int operator()(int sb) const {
    if (sb < 16) return 8 * (sb >> 2) + (sb & 3);
    if (sb < 32) { const int cb = sb - 16; return 8 * (cb >> 2) + 4 + (cb & 3); }
    if (sb < 48) { const int qb = sb - 32, head = qb >> 1, bj = qb & 1; return 8 * (4 + (head >> 2)) + 4 * bj + (head & 3); }
    if (sb < 52) { const int kb = sb - 48; return 48 + 4 * (kb & 1) + (kb >> 1); }
    if (sb < 56) { const int vb = sb - 52; return 48 + 4 * (vb & 1) + 2 + (vb >> 1); }
    return sb; } };

DEVI void ada_item_load(const Frame& F, int it, float (&w)[64]) {
    const int l = it / 768, rem = it % 768, cc = rem >> 4, kc = rem & 15;
    const float* W = l ? F.in[I_CD_WADA] : F.in[I_AB_WADA];
    const float* rowp = W + (size_t)(kc * 64) * 3072 + cc * 64;
#pragma unroll
    for (int k = 0; k < 64; ++k) w[k] = __builtin_nontemporal_load(rowp + (size_t)k * 3072 + F.lane);
}
DEVI void ada_item_finish(const Frame& F, int it, const float (&w)[64], const LAS float* sl) {
    const int l = it / 768, rem = it % 768, cc = rem >> 4, kc = rem & 15;
    const float* bb = l ? F.in[I_CD_BADA] : F.in[I_AB_BADA];
    const int col = cc * 64 + F.lane;
    const float bv = (kc == 0) ? bb[col] : 0.f;
    float s[9];
#pragma unroll
    for (int r = 0; r < 9; ++r) s[r] = 0.f;
#pragma unroll
    for (int k4 = 0; k4 < 64; k4 += 4) {
#pragma unroll
        for (int r = 0; r < 9; ++r) { const f32x4 sv = *(const LAS f32x4*)(sl + r * 1024 + kc * 64 + k4); s[r] += sv.x * w[k4] + sv.y * w[k4 + 1] + sv.z * w[k4 + 2] + sv.w * w[k4 + 3]; }
    }
    float* ada = wsf(F, WS_ADA);
#pragma unroll
    for (int r = 0; r < 9; ++r) atomicAdd(&ada[(l * 9 + r) * 3072 + col], s[r] + bv);
}
constexpr int XPF = 5;
DEVI const float* modnorm_rowptr(const Frame& F, int m) { return (m < MX) ? F.in[I_X] + (size_t)m * DM : F.in[I_CTX] + (size_t)(m - MX) * DM; }
DEVI void p0_prologue(Frame& F, f32x4 (&xpf)[XPF][4]) {
    LAS float* sl = (LAS float*)F.lds;
    LAS float* scr = (LAS float*)(F.lds + 40960 + F.wave * 8448);
    const int gw = F.bid * NWAVES + F.wave, NGW = F.G * NWAVES;
    constexpr int N_ADA = 2 * 48 * 16, N_TR = 16 * (AB_IN / 32);
    float cv[18];
#pragma unroll
    for (int j = 0; j < 16; ++j) cv[j] = F.in[I_C][F.tid + 512 * j];
    cv[16] = F.in[I_CCTX][F.tid]; cv[17] = F.in[I_CCTX][F.tid + 512];
    const int it_a = min(gw, N_ADA - 1), it_t = min(gw, N_TR - 1), it_m = min(F.bid, 255);
    float w[64]; ada_item_load(F, it_a, w);
    float tv[32]; transpose_load(tv, F.in[I_AB_WIN], AB_IN, 0, AB_IN, it_t, F.lane);
    const float* wf = F.in[I_CD_WF];
    f32x4 wfv[8];
#pragma unroll
    for (int j = 0; j < 8; ++j) wfv[j] = *(const f32x4*)(wf + (size_t)((it_m >> 5) & 3) * 128 * 128 + 4 * (F.tid + 512 * j));
#pragma unroll
    for (int j = 0; j < 18; ++j) sl[F.tid + 512 * j] = siluf(cv[j]);
    __syncthreads();
    if (gw < N_ADA) ada_item_finish(F, gw, w, sl);
    for (int it = gw + NGW; it < N_ADA; it += NGW) { float w2[64]; ada_item_load(F, it, w2); ada_item_finish(F, it, w2, sl); }
#pragma unroll
    for (int k = 0; k < XPF; ++k) { const float* xr = modnorm_rowptr(F, min(gw * 9 + k, MT - 1));
#pragma unroll
        for (int j = 0; j < 4; ++j) xpf[k][j] = __builtin_nontemporal_load((const f32x4*)(xr + 4 * F.lane + 256 * j)); }
    if (gw < N_TR) transpose_store(tv, AB_IN, DM, wsb(F, WS_WIN0), MapIn0{}, scr, gw, F.lane);
    for (int it = gw + NGW; it < N_TR; it += NGW) transpose_item(F.in[I_AB_WIN], AB_IN, 0, AB_IN, DM, wsb(F, WS_WIN0), MapIn0{}, scr, it, F.lane);
    {
        float* rope = wsf(F, WS_ROPE);
        for (int i = gw * 64 + F.lane; i < SEQ * 32; i += NGW * 64) {
            const int t = i >> 5, p = i & 31; const int fi = p & 15;
            const float inv = exp2f(-(float)fi * (13.287712379549449f / 16.0f));
            const float pos = (float)((p < 16) ? (t / GRIDW) : (t % GRIDW));
            const float ang = pos * inv; float sn, cs; sincosf(ang, &sn, &cs);
            rope[2 * i] = cs; rope[2 * i + 1] = sn;
        }
    }
    __syncthreads();
    {
        LAS float* t128 = (LAS float*)F.lds;
        LAS float* wl = t128 + 256;
        if (F.tid < 128) { t128[F.tid] = cospif((float)F.tid * (1.f / 64.f)); t128[128 + F.tid] = sinpif((float)F.tid * (1.f / 64.f)); }
        float* mcs = wsf(F, WS_MCS);
        bool first = true;
        for (int it = F.bid; it < 2 * 4 * 32; it += F.G) {
            const int c4 = it & 31, g = (it >> 5) & 3, cs = it >> 7;
            if (first) {
#pragma unroll
                for (int j = 0; j < 8; ++j) *(LAS f32x4*)(wl + 4 * (F.tid + 512 * j)) = wfv[j];
            } else {
                __syncthreads();
                for (int i = F.tid; i < 128 * 128 / 4; i += NTHR) *(LAS f32x4*)(wl + 4 * i) = *(const f32x4*)(wf + (size_t)g * 128 * 128 + 4 * i);
            }
            first = false;
            __syncthreads();
            const int e = F.tid & 127, c = c4 * 4 + (F.tid >> 7);
            float sacc = 0.f;
#pragma unroll 8
            for (int cp = 0; cp < 128; ++cp) sacc += t128[cs * 128 + ((c * cp) & 127)] * wl[cp * 128 + e];
            mcs[((size_t)(cs * 4 + g) * 128 + c) * 128 + e] = sacc * (1.f / 512.f);
        }
        __syncthreads();
    }
}
DEVI void p2_filler(Frame& F, int ib, int nib) {
    LAS float* scr = (LAS float*)(F.lds + F.wave * 16384);
    const int gw = ib * NWAVES + F.wave, NGW = nib * NWAVES;
    constexpr int I1 = 16 * 32, I2 = 16 * ((CD_IN - 512) / 32);
    for (int it = gw; it < I1 + I2; it += NGW) {
        if (it < I1) transpose_item(F.in[I_AB_WOUT], DM, 0, DM, DM, wsb(F, WS_WOUT0), MapId{0}, scr, it, F.lane);
        else transpose_item(F.in[I_CD_WIN], CD_IN, 512, CD_IN - 512, DM, wsb(F, WS_WIN1), MapId{32}, scr, it - I1, F.lane);
    }
    __syncthreads();
}
DEVI void p6_filler(Frame& F, int ib, int nib) {
    LAS float* scr = (LAS float*)(F.lds + F.wave * 16384);
    const int gw = ib * NWAVES + F.wave, NGW = nib * NWAVES;
    for (int it = gw; it < 16 * 32; it += NGW) transpose_item(F.in[I_CD_WOUT], DM, 0, DM, DM, wsb(F, WS_WOUT1), MapId{0}, scr, it, F.lane);
    __syncthreads();
    {
        LAS float* t2k = (LAS float*)F.lds;
        for (int i = F.tid; i < 2048; i += NTHR) { t2k[i] = cospif((float)i * (1.f / 1024.f)); t2k[2048 + i] = sinpif((float)i * (1.f / 1024.f)); }
        __syncthreads();
        bf16* A = wsb(F, WS_DFT);
        for (int i = ib * NTHR + F.tid; i < 2048 * 256; i += nib * NTHR) {
            const int row = i >> 8, k0 = (i & 255) * 8; const int pm = row >> 8, rr = row & 255, lp = 128 * pm + (rr & 127), tsel = (rr >> 7) * 2048; float v[8];
#pragma unroll
            for (int j = 0; j < 8; ++j) v[j] = t2k[tsel + ((lp * (k0 + j)) & 2047)];
            v4u o; o.x = pk2(v[0], v[1]); o.y = pk2(v[2], v[3]); o.z = pk2(v[4], v[5]); o.w = pk2(v[6], v[7]);
            *(v4u*)(A + (size_t)row * 2048 + k0) = o;
        }
        __syncthreads();
    }
}

DEVI void modnorm_row(const float* xrow, bf16* orow, const float* g, const float* shift, const float* scale, int lane) {
    f32x4 v[4]; float ss = 0.f;
#pragma unroll
    for (int j = 0; j < 4; ++j) { v[j] = *(const f32x4*)(xrow + 4 * lane + 256 * j); ss += (v[j].x * v[j].x + v[j].y * v[j].y) + (v[j].z * v[j].z + v[j].w * v[j].w); }
    const float rinv = 1.0f / sqrtf(wave_sum(ss) * (1.f / DM) + EPS);
#pragma unroll
    for (int j = 0; j < 4; ++j) {
        const int c = 4 * lane + 256 * j;
        const f32x4 gg = *(const f32x4*)(g + c), sh = *(const f32x4*)(shift + c), sc = *(const f32x4*)(scale + c);
        const float o0 = v[j].x * rinv * gg.x * (1.f + sc.x) + sh.x, o1 = v[j].y * rinv * gg.y * (1.f + sc.y) + sh.y;
        const float o2 = v[j].z * rinv * gg.z * (1.f + sc.z) + sh.z, o3 = v[j].w * rinv * gg.w * (1.f + sc.w) + sh.w;
        *(unsigned long long*)(orow + c) = (unsigned long long)pk2(o0, o1) | ((unsigned long long)pk2(o2, o3) << 32);
    }
}
DEVI void phase_modnorm(Frame& F, int layer, const f32x4 (&xpf)[XPF][4]) {
    const int gw = F.bid * NWAVES + F.wave;
    const float* ada = wsf(F, WS_ADA) + layer * 9 * 3072;
    const float* g = layer ? F.in[I_CD_NORMG] : F.in[I_AB_NORMG];
    bf16* H = wsb(F, WS_H);
    constexpr int RPW = MT / (256 * NWAVES);
    const int m0 = gw * RPW;
    f32x4 gm[4], sh[4];
    int rcur = (m0 < MX) ? (m0 >> 11) : 8;
    { const float* shift = ada + rcur * 3072; const float* scale = shift + 1024;
#pragma unroll
      for (int j = 0; j < 4; ++j) { const int c = 4 * F.lane + 256 * j; gm[j] = *(const f32x4*)(g + c) * (*(const f32x4*)(scale + c) + 1.0f); sh[j] = *(const f32x4*)(shift + c); } }
    f32x4 rest[RPW - XPF][4];
#pragma unroll
    for (int k = XPF; k < RPW; ++k) { const float* xr = modnorm_rowptr(F, m0 + k);
#pragma unroll
        for (int j = 0; j < 4; ++j) rest[k - XPF][j] = __builtin_nontemporal_load((const f32x4*)(xr + 4 * F.lane + 256 * j)); }
#pragma unroll
    for (int k = 0; k < RPW; ++k) {
        const int m = m0 + k;
        f32x4 v[4];
#pragma unroll
        for (int j = 0; j < 4; ++j) v[j] = (k < XPF) ? xpf[k < XPF ? k : 0][j] : rest[k < XPF ? 0 : k - XPF][j];
        const int r = (m < MX) ? (m >> 11) : 8;
        if (r != rcur) { rcur = r; const float* shift = ada + r * 3072; const float* scale = shift + 1024;
#pragma unroll
            for (int j = 0; j < 4; ++j) { const int c = 4 * F.lane + 256 * j; gm[j] = *(const f32x4*)(g + c) * (*(const f32x4*)(scale + c) + 1.0f); sh[j] = *(const f32x4*)(shift + c); } }
        float ss = 0.f;
#pragma unroll
        for (int j = 0; j < 4; ++j) ss += (v[j].x * v[j].x + v[j].y * v[j].y) + (v[j].z * v[j].z + v[j].w * v[j].w);
        const float rinv = __builtin_amdgcn_rsqf(wave_sum_dpp(ss) * (1.f / DM) + EPS);
        bf16* orow = H + (size_t)m * DM;
#pragma unroll
        for (int j = 0; j < 4; ++j) {
            const int c = 4 * F.lane + 256 * j;
            const f32x4 o = v[j] * rinv * gm[j] + sh[j];
            __builtin_nontemporal_store((unsigned long long)pk2(o[0], o[1]) | ((unsigned long long)pk2(o[2], o[3]) << 32), (unsigned long long*)(orow + c));
        }
    }
}
DEVI void phase_fold(Frame& F, int ib, int nib) {
    const float* mcs = wsf(F, WS_MCS); const float* W = F.in[I_CD_WIN]; bf16* WT = wsb(F, WS_WIN1);
    LAS float* Ms = (LAS float*)F.lds;
    LAS float* Ws = Ms + 128 * 128;
    for (int it = ib; it < 8 * 32; it += nib) {
        const int kc = it & 31, g = (it >> 5) & 3, cs = it >> 7, k0 = kc * 32;
        __syncthreads();
        const float* mp = mcs + (size_t)(cs * 4 + g) * 128 * 128;
        for (int i = F.tid; i < 128 * 128 / 4; i += NTHR) *(LAS f32x4*)(Ms + 4 * i) = *(const f32x4*)(mp + 4 * i);
        for (int i = F.tid; i < 32 * 128; i += NTHR) { const int k = i >> 7, c = i & 127; Ws[c * 32 + k] = W[(size_t)(k0 + k) * CD_IN + g * 128 + c]; }
        __syncthreads();
        const int e = F.tid & 127, kq = F.tid >> 7;
        float acc[8];
#pragma unroll
        for (int j = 0; j < 8; ++j) acc[j] = 0.f;
#pragma unroll 4
        for (int c = 0; c < 128; ++c) { const float mv = Ms[c * 128 + e]; const f32x4 w0 = *(const LAS f32x4*)(Ws + c * 32 + kq * 8), w1 = *(const LAS f32x4*)(Ws + c * 32 + kq * 8 + 4);
            acc[0] += mv * w0.x; acc[1] += mv * w0.y; acc[2] += mv * w0.z; acc[3] += mv * w0.w; acc[4] += mv * w1.x; acc[5] += mv * w1.y; acc[6] += mv * w1.z; acc[7] += mv * w1.w; }
        v4u o; o.x = pk2(acc[0], acc[1]); o.y = pk2(acc[2], acc[3]); o.z = pk2(acc[4], acc[5]); o.w = pk2(acc[6], acc[7]);
        *(v4u*)(WT + (size_t)(cs * 512 + g * 128 + e) * DM + k0 + kq * 8) = o;
    }
    __syncthreads();
}

DEVI void p2_fill_fold(Frame& F) {
    LAS float* scr = (LAS float*)(F.lds + F.wave * 16384);
    const int gw = F.bid * NWAVES + F.wave, NGW = F.G * NWAVES;
    constexpr int I1 = 16 * 32, I2 = 16 * ((CD_IN - 512) / 32), NI = I1 + I2;
    const float* mcs = wsf(F, WS_MCS); const float* W = F.in[I_CD_WIN]; bf16* WT = wsb(F, WS_WIN1);
    const int it_t = min(gw, NI - 1), it_f = min(F.bid, 255);
    float tv[32];
    if (it_t < I1) transpose_load(tv, F.in[I_AB_WOUT], DM, 0, DM, it_t, F.lane); else transpose_load(tv, F.in[I_CD_WIN], CD_IN, 512, CD_IN - 512, it_t - I1, F.lane);
    const int kc = it_f & 31, g = (it_f >> 5) & 3, cs = it_f >> 7, k0 = kc * 32;
    f32x4 mv8[8]; float wv8[8];
    { const float* mp = mcs + (size_t)(cs * 4 + g) * 128 * 128;
#pragma unroll
      for (int j = 0; j < 8; ++j) mv8[j] = *(const f32x4*)(mp + 4 * (F.tid + 512 * j));
#pragma unroll
      for (int j = 0; j < 8; ++j) { const int i = F.tid + 512 * j, k = i >> 7, c = i & 127; wv8[j] = W[(size_t)(k0 + k) * CD_IN + g * 128 + c]; } }
    if (gw < NI) { if (gw < I1) transpose_store(tv, DM, DM, wsb(F, WS_WOUT0), MapId{0}, scr, gw, F.lane); else transpose_store(tv, CD_IN - 512, DM, wsb(F, WS_WIN1), MapId{32}, scr, gw - I1, F.lane); }
    for (int it = gw + NGW; it < NI; it += NGW) {
        if (it < I1) transpose_item(F.in[I_AB_WOUT], DM, 0, DM, DM, wsb(F, WS_WOUT0), MapId{0}, scr, it, F.lane);
        else transpose_item(F.in[I_CD_WIN], CD_IN, 512, CD_IN - 512, DM, wsb(F, WS_WIN1), MapId{32}, scr, it - I1, F.lane);
    }
    __syncthreads();
    LAS float* Ms = (LAS float*)F.lds;
    LAS float* Ws = Ms + 128 * 128;
    bool first = true;
    for (int it = F.bid; it < 8 * 32; it += F.G) {
        const int kc2 = it & 31, g2 = (it >> 5) & 3, cs2 = it >> 7, k02 = kc2 * 32;
        if (first) {
#pragma unroll
            for (int j = 0; j < 8; ++j) *(LAS f32x4*)(Ms + 4 * (F.tid + 512 * j)) = mv8[j];
#pragma unroll
            for (int j = 0; j < 8; ++j) { const int i = F.tid + 512 * j, k = i >> 7, c = i & 127; Ws[c * 32 + k] = wv8[j]; }
        } else {
            __syncthreads();
            const float* mp = mcs + (size_t)(cs2 * 4 + g2) * 128 * 128;
            for (int i = F.tid; i < 128 * 128 / 4; i += NTHR) *(LAS f32x4*)(Ms + 4 * i) = *(const f32x4*)(mp + 4 * i);
            for (int i = F.tid; i < 32 * 128; i += NTHR) { const int k = i >> 7, c = i & 127; Ws[c * 32 + k] = W[(size_t)(k02 + k) * CD_IN + g2 * 128 + c]; }
        }
        first = false;
        __syncthreads();
        const int e = F.tid & 127, kq = F.tid >> 7;
        float acc[8];
#pragma unroll
        for (int j = 0; j < 8; ++j) acc[j] = 0.f;
#pragma unroll 4
        for (int c = 0; c < 128; ++c) { const float mv = Ms[c * 128 + e]; const f32x4 w0 = *(const LAS f32x4*)(Ws + c * 32 + kq * 8), w1 = *(const LAS f32x4*)(Ws + c * 32 + kq * 8 + 4);
            acc[0] += mv * w0.x; acc[1] += mv * w0.y; acc[2] += mv * w0.z; acc[3] += mv * w0.w; acc[4] += mv * w1.x; acc[5] += mv * w1.y; acc[6] += mv * w1.z; acc[7] += mv * w1.w; }
        v4u o; o.x = pk2(acc[0], acc[1]); o.y = pk2(acc[2], acc[3]); o.z = pk2(acc[4], acc[5]); o.w = pk2(acc[6], acc[7]);
        *(v4u*)(WT + (size_t)(cs2 * 512 + g2 * 128 + e) * DM + k02 + kq * 8) = o;
    }
    __syncthreads();
}

namespace pg8 {
#define PG8_LAS __attribute__((address_space(3)))
typedef unsigned short bf16_t;
typedef short bf16x8 __attribute__((ext_vector_type(8)));
typedef unsigned u32x4 __attribute__((ext_vector_type(4)));
constexpr int BM = 256, BK = 64, HALF = 128, HTB = HALF * BK * 2, STAGE_BYTES = 8 * HTB, NXCD = 8, WGM = 8;
__host__ __device__ __forceinline__ int lds_byte(int r, int c) { const int st = (r >> 4) * 2 + (c >> 5), rr = r & 15, cc = c & 31, ob = rr * 64 + cc * 2; return st * 1024 + (ob ^ (((ob >> 9) & 1) << 5)); }
__host__ __device__ __forceinline__ void stage_rc(int b, int& R, int& C) { const int st = b / 1024, sb = b % 1024, swz = sb ^ (((sb >> 9) & 1) << 5); R = (st >> 1) * 16 + swz / 64; C = (st & 1) * 32 + (swz % 64) / 2; }
__host__ __device__ __forceinline__ int perm32(int rho) { const int n = rho >> 4, i = rho & 15; return 8 * (i >> 2) + 4 * n + (i & 3); }

struct Unit { int pm, pn, kind; const char* A; const char* B; };

struct Seg { const bf16_t* A; const bf16_t* Bt; int nM, nN, kind; };
struct SegOrder {
    Seg s0, s1, s2; int n0, n1, n2, G, c; size_t tstep;
    __device__ __forceinline__ void init(const Seg& a, const Seg& b, const Seg& d, int K, int G_, int c_) { s0 = a; s1 = b; s2 = d; n0 = a.nM * a.nN; n1 = b.nM * b.nN; n2 = d.nM * d.nN; G = G_; c = c_; tstep = (size_t)BM * K * 2; }
    __device__ __forceinline__ void map(const Seg& s, int nwg, int wgid, Unit& u) const {
        { const int q = nwg / NXCD, xcd = wgid % NXCD, off = wgid / NXCD; wgid = xcd * q + off; }
        const int nig = WGM * s.nN, gid = wgid / nig, fm = gid * WGM, gsz = (s.nM - fm) < WGM ? (s.nM - fm) : WGM;
        u.pm = fm + ((wgid % nig) % gsz); u.pn = (wgid % nig) / gsz; u.kind = s.kind;
        u.A = (const char*)s.A + (size_t)u.pm * tstep; u.B = (const char*)s.Bt + (size_t)u.pn * tstep;
    }
    __device__ __forceinline__ bool next(int i, Unit& u) const {
        int L = i * G + c;
        if (L < n0) { map(s0, n0, L, u); return true; } L -= n0;
        if (L < n1) { map(s1, n1, L, u); return true; } L -= n1;
        if (L < n2) { map(s2, n2, L, u); return true; }
        return false;
    }
};

__device__ __forceinline__ unsigned cvt_pk_bf16(float lo, float hi) { unsigned r; asm volatile("v_cvt_pk_bf16_f32 %0, %1, %2" : "=v"(r) : "v"(lo), "v"(hi)); return r; }

template <class Epi, class Sched, bool ALIGN_EPI = true, bool DIAG = false>
__device__ __forceinline__ void gemm_phase(PG8_LAS unsigned char* lds, const int K, const Sched& S, const Epi& E) {
    const int tid = threadIdx.x, wid = __builtin_amdgcn_readfirstlane(tid >> 6), lane = tid & 63, wr = wid >> 2, wc = wid & 3, fr = lane & 15, fq = lane >> 4;
    const int nt = K / BK;
    unsigned voffA[2], voffB[2];
#pragma unroll
    for (int i = 0; i < 2; ++i) { int R, C; stage_rc(tid * 16 + i * 8192, R, C); const int Rb = Epi::PERM ? ((R & ~31) + perm32(R & 31)) : R;
        voffA[i] = (unsigned)(R * K + C) * 2u; voffB[i] = (unsigned)(Rb * K + C) * 2u; }
    const size_t kstep = (size_t)(BK * 2);
    const size_t hstep = (size_t)HALF * K * 2;
    const unsigned ldsw = (unsigned)wid * 1024u;
    const int aoff = lds_byte(wr * 64 + fr, fq * 8), boff = lds_byte(wc * 32 + fr, fq * 8);
#define PG8_SA(b, h) (((b) * 2 + (h)) * HTB)
#define PG8_SB(b, h) ((4 + (b) * 2 + (h)) * HTB)
#define PG8_STAGE(bufoff, gbase, voff) do { _Pragma("unroll") for (int _i = 0; _i < 2; ++_i) \
        __builtin_amdgcn_global_load_lds((const unsigned*)((const char*)(gbase) + (voff)[_i]), (PG8_LAS unsigned*)(lds + (bufoff) + ldsw + _i * 8192), 16, 0, 0); } while (0)
#define PG8_LDA(dst, b, h) do { _Pragma("unroll") for (int m = 0; m < 4; ++m) _Pragma("unroll") for (int k = 0; k < 2; ++k) dst[m][k] = *(const PG8_LAS bf16x8*)(lds + PG8_SA(b, h) + aoff + m * 2048 + k * 1024); } while (0)
#define PG8_LDB(dst, b, h) do { _Pragma("unroll") for (int n = 0; n < 2; ++n) _Pragma("unroll") for (int k = 0; k < 2; ++k) dst[n][k] = *(const PG8_LAS bf16x8*)(lds + PG8_SB(b, h) + boff + n * 2048 + k * 1024); } while (0)
#define PG8_MMA(ai, bj, At, Bt) do { __builtin_amdgcn_s_setprio(1); _Pragma("unroll") for (int m = 0; m < 4; ++m) _Pragma("unroll") for (int n = 0; n < 2; ++n) _Pragma("unroll") for (int k = 0; k < 2; ++k) \
        acc[ai][bj][m][n] = __builtin_amdgcn_mfma_f32_16x16x32_bf16(Bt[n][k], At[m][k], acc[ai][bj][m][n], 0, 0, 0); __builtin_amdgcn_s_setprio(0); } while (0)
#define PG8_WAIT_V(n) asm volatile("s_waitcnt vmcnt(" #n ")" ::: "memory")
#define PG8_WAIT_L(n) asm volatile("s_waitcnt lgkmcnt(" #n ")" ::: "memory")
#define PG8_BAR __builtin_amdgcn_s_barrier()
#define PG8_SCHED __builtin_amdgcn_sched_barrier(0)
    Unit cur, nxt; int ui = 0;
    if (!S.next(0, cur)) return;
    f32x4 acc[2][2][4][2];
#pragma unroll
    for (int a = 0; a < 2; ++a)
#pragma unroll
        for (int b = 0; b < 2; ++b)
#pragma unroll
            for (int m = 0; m < 4; ++m)
#pragma unroll
                for (int n = 0; n < 2; ++n) acc[a][b][m][n] = (f32x4){0.f, 0.f, 0.f, 0.f};
    bf16x8 At[4][2], B0[2][2], B1[2][2];
    const char* cA = cur.A; const char* cB = cur.B;
    PG8_STAGE(PG8_SB(0, 0), cB, voffB); PG8_STAGE(PG8_SB(0, 1), cB + hstep, voffB); PG8_STAGE(PG8_SA(0, 0), cA, voffA); PG8_STAGE(PG8_SA(0, 1), cA + hstep, voffA);
    if (wr == 1) PG8_BAR;
    PG8_WAIT_V(2); PG8_BAR;
    PG8_STAGE(PG8_SB(1, 0), cB + kstep, voffB); PG8_STAGE(PG8_SA(1, 0), cA + kstep, voffA); PG8_STAGE(PG8_SB(1, 1), cB + hstep + kstep, voffB);
    PG8_WAIT_V(6); PG8_BAR;
    for (;;) {
        const bool has_next = S.next(ui + 1, nxt);
        const char* nA = has_next ? nxt.A : cA; const char* nB = has_next ? nxt.B : cB;
        for (int t = 0; t < nt; t += 2) {
            const bool last = (t == nt - 2);
            const char* a1 = cA + (size_t)(t + 1) * kstep;
            const char* a2 = last ? nA : cA + (size_t)(t + 2) * kstep; const char* b2 = last ? nB : cB + (size_t)(t + 2) * kstep;
            const char* a3 = a2 + kstep; const char* b3 = b2 + kstep;
            PG8_LDB(B0, 0, 0); PG8_LDB(B1, 0, 1); PG8_SCHED; PG8_LDA(At, 0, 0); PG8_STAGE(PG8_SA(1, 1), a1 + hstep, voffA);
            PG8_WAIT_V(8); PG8_WAIT_L(0); PG8_BAR; PG8_MMA(0, 0, At, B0); if constexpr (!DIAG) PG8_MMA(0, 1, At, B1); PG8_BAR; PG8_SCHED;
            PG8_LDA(At, 0, 1); PG8_STAGE(PG8_SB(0, 0), b2, voffB); PG8_STAGE(PG8_SB(0, 1), b2 + hstep, voffB); PG8_STAGE(PG8_SA(0, 0), a2, voffA);
            PG8_WAIT_V(8); PG8_WAIT_L(0); PG8_BAR; if constexpr (!DIAG) PG8_MMA(1, 0, At, B0); PG8_MMA(1, 1, At, B1); PG8_BAR; PG8_SCHED;
            PG8_LDB(B0, 1, 0); PG8_LDB(B1, 1, 1); PG8_SCHED; PG8_LDA(At, 1, 0); PG8_STAGE(PG8_SA(0, 1), a2 + hstep, voffA);
            PG8_WAIT_V(8); PG8_WAIT_L(0); PG8_BAR; PG8_MMA(0, 0, At, B0); if constexpr (!DIAG) PG8_MMA(0, 1, At, B1); PG8_BAR; PG8_SCHED;
            PG8_LDA(At, 1, 1); PG8_STAGE(PG8_SB(1, 0), b3, voffB); PG8_STAGE(PG8_SB(1, 1), b3 + hstep, voffB); PG8_STAGE(PG8_SA(1, 0), a3, voffA);
            PG8_WAIT_V(8); PG8_WAIT_L(0); PG8_BAR; if constexpr (!DIAG) PG8_MMA(1, 0, At, B0); PG8_MMA(1, 1, At, B1); PG8_BAR; PG8_SCHED;
        }
        if constexpr (ALIGN_EPI) { if (wr == 0) PG8_BAR; }
        if constexpr (Epi::FUSED) E.fused(acc, cur, wr, wc, fr, fq, wid, lane); else E(acc, cur, wr, wc, fr, fq);
        if (!has_next) break;
#pragma unroll
        for (int a = 0; a < 2; ++a)
#pragma unroll
            for (int b = 0; b < 2; ++b)
#pragma unroll
                for (int m = 0; m < 4; ++m)
#pragma unroll
                    for (int n = 0; n < 2; ++n) acc[a][b][m][n] = (f32x4){0.f, 0.f, 0.f, 0.f};
        cur = nxt; cA = nA; cB = nB; ++ui;
        if constexpr (ALIGN_EPI) { if (wr == 1) PG8_BAR; }
    }
    PG8_WAIT_V(0);
    if constexpr (!ALIGN_EPI) { if (wr == 0) PG8_BAR; }
    PG8_BAR;
#undef PG8_SA
#undef PG8_SB
#undef PG8_STAGE
#undef PG8_LDA
#undef PG8_LDB
#undef PG8_MMA
#undef PG8_WAIT_V
#undef PG8_WAIT_L
#undef PG8_BAR
#undef PG8_SCHED
}
}

typedef float f32x4acc[2][2][4][2];
DEVI float fsilu(float v) { return v * __builtin_amdgcn_rcpf(1.f + __builtin_amdgcn_exp2f(-LOG2E * v)); }
DEVI float fsigm(float v) { return __builtin_amdgcn_rcpf(1.f + __builtin_amdgcn_exp2f(-LOG2E * v)); }
typedef float f32x2p __attribute__((ext_vector_type(2)));
DEVI f32x4 fsigm4(const f32x4& v) {
    const f32x2p nl = {-LOG2E, -LOG2E}, one = {1.f, 1.f};
    const f32x2p t0 = (f32x2p){v[0], v[1]} * nl, t1 = (f32x2p){v[2], v[3]} * nl;
    const f32x2p d0 = (f32x2p){__builtin_amdgcn_exp2f(t0.x), __builtin_amdgcn_exp2f(t0.y)} + one, d1 = (f32x2p){__builtin_amdgcn_exp2f(t1.x), __builtin_amdgcn_exp2f(t1.y)} + one;
    return (f32x4){__builtin_amdgcn_rcpf(d0.x), __builtin_amdgcn_rcpf(d0.y), __builtin_amdgcn_rcpf(d1.x), __builtin_amdgcn_rcpf(d1.y)};
}
DEVI f32x4 fsilu4(const f32x4& v) { return v * fsigm4(v); }
DEVI v4u pack8(const f32x4& a, const f32x4& b) { v4u w; w.x = pg8::cvt_pk_bf16(a[0], a[1]); w.y = pg8::cvt_pk_bf16(a[2], a[3]); w.z = pg8::cvt_pk_bf16(b[0], b[1]); w.w = pg8::cvt_pk_bf16(b[2], b[3]); return w; }

struct EpiIn0 {
    static constexpr bool PERM = true; static constexpr bool FUSED = false;
    bf16 *GLU, *Q0, *K0, *V0, *SZ; const float *qng, *kng, *rope;
    DEVI void operator()(const f32x4 (&acc)[2][2][4][2], const pg8::Unit& u, int wr, int wc, int fr, int fq) const {
        asm volatile("" : "+v"(fr), "+v"(fq));
        const int pn = u.pn + (u.kind ? 7 : 0), pm = u.pm + (u.kind == 2 ? 64 : 0); const bool isx = pm < 64;
        const int cw = 32 * wc + 8 * fq;
        float g8[2][8];
        if (pn >= 4 && pn < 7) { const float* gn = (pn < 6) ? qng : kng;
#pragma unroll
            for (int bj = 0; bj < 2; ++bj) { const f32x4 a = *(const f32x4*)(gn + 32 * bj + 8 * fq), b = *(const f32x4*)(gn + 32 * bj + 8 * fq + 4);
                g8[bj][0] = a[0]; g8[bj][1] = a[1]; g8[bj][2] = a[2]; g8[bj][3] = a[3]; g8[bj][4] = b[0]; g8[bj][5] = b[1]; g8[bj][6] = b[2]; g8[bj][7] = b[3]; } }
        const bool dorope = pn >= 4 && pn < 7 && isx && !((pn == 6) && (wc >= 2));
        f32x4 rpR[2][2], rpC[2];
        if (dorope) {
#pragma unroll
            for (int ai = 0; ai < 2; ++ai)
#pragma unroll
                for (int n = 0; n < 2; ++n) rpR[ai][n] = *(const f32x4*)(rope + ((size_t)((pm & 7) * 256 + 128 * ai + 64 * wr) * 32 + 4 * fq + 2 * n) * 2);
        }
#pragma unroll
        for (int m = 0; m < 4; ++m) {
            if (dorope) {
#pragma unroll
                for (int n = 0; n < 2; ++n) rpC[n] = *(const f32x4*)(rope + ((size_t)(16 * m + fr) * 32 + 16 + 4 * fq + 2 * n) * 2);
            }
#pragma unroll
            for (int ai = 0; ai < 2; ++ai) {
                const int lr = 128 * ai + 64 * wr + 16 * m + fr;
                const int row = 256 * pm + lr;
                if (pn < 4) {
                    f32x4 o0, o1;
#pragma unroll
                    for (int e = 0; e < 1; ++e) { o0 = acc[ai][0][m][0] * fsigm4(acc[ai][1][m][0]); o1 = acc[ai][0][m][1] * fsigm4(acc[ai][1][m][1]); }
                    *(v4u*)(GLU + (size_t)row * 512 + 128 * pn + cw) = pack8(o0, o1);
                } else if (pn < 7) {
                    const bool isv = (pn == 6) && (wc >= 2);
                    int b, key, l;
                    if (isx) { b = pm >> 3; l = (pm & 7) * 256 + lr; key = CTXL + l; } else { b = pm - 64; l = 0; key = lr; }
                    if (isv) {
#pragma unroll
                        for (int bj = 0; bj < 2; ++bj) *(v4u*)(V0 + ((size_t)b * NKEY0 + key) * 128 + (wc - 2) * 64 + 32 * bj + 8 * fq) = pack8(acc[ai][bj][m][0], acc[ai][bj][m][1]);
                    } else {
                        float ss = 0.f;
#pragma unroll
                        for (int bj = 0; bj < 2; ++bj)
#pragma unroll
                            for (int n = 0; n < 2; ++n) { const f32x4 x = acc[ai][bj][m][n]; ss += (x[0] * x[0] + x[1] * x[1]) + (x[2] * x[2] + x[3] * x[3]); }
                        ss = sum_fq(ss);
                        const float rinv = __builtin_amdgcn_rsqf(ss * (1.f / 64.f) + EPS);
                        const float osc = (pn < 6) ? C2 : 1.f;
#pragma unroll
                        for (int bj = 0; bj < 2; ++bj) {
                            f32x4 v[2];
#pragma unroll
                            for (int n = 0; n < 2; ++n)
#pragma unroll
                                for (int e = 0; e < 4; ++e) v[n][e] = acc[ai][bj][m][n][e] * rinv * g8[bj][4 * n + e];
                            if (isx) {
#pragma unroll
                                for (int n = 0; n < 2; ++n) { const f32x4 cs = bj ? rpC[n] : rpR[ai][n];
                                    const float a0 = v[n][0], b0 = v[n][1], a1 = v[n][2], b1 = v[n][3];
                                    v[n][0] = a0 * cs[0] - b0 * cs[1]; v[n][1] = a0 * cs[1] + b0 * cs[0]; v[n][2] = a1 * cs[2] - b1 * cs[3]; v[n][3] = a1 * cs[3] + b1 * cs[2]; } }
                            v[0] = v[0] * osc; v[1] = v[1] * osc;
                            if (pn < 6) *(v4u*)(Q0 + (size_t)row * 512 + (4 * (pn - 4) + wc) * 64 + 32 * bj + 8 * fq) = pack8(v[0], v[1]);
                            else *(v4u*)(K0 + ((size_t)b * NKEY0 + key) * 128 + wc * 64 + 32 * bj + 8 * fq) = pack8(v[0], v[1]);
                        }
                    }
                } else {
#pragma unroll
                    for (int bj = 0; bj < 2; ++bj) { f32x4 o0, o1;
#pragma unroll
                        for (int e = 0; e < 1; ++e) { o0 = fsilu4(acc[ai][bj][m][0]); o1 = fsilu4(acc[ai][bj][m][1]); }
                        *(v4u*)(SZ + (size_t)row * 1024 + 256 * (pn - 7) + 128 * bj + cw) = pack8(o0, o1); }
                }
            }
        }
    }
};
template <bool CTX>
DEVI void outproj0_epi(const f32x4 (&acc)[2][2][4][2], int pm, int pn, int wr, int wc, int fr, int fq, const float* xin, const float* ada0, const float* ada1, const float* ng1, _Float16* o_x, bf16* H, float* ssq) {
    const int r = CTX ? 8 : (pm >> 3); const size_t rowbase = (size_t)(CTX ? MX : 0) + 256 * pm;
    f32x4 gate[2][2], gp[2][2];
#pragma unroll
    for (int bj = 0; bj < 2; ++bj)
#pragma unroll
        for (int n = 0; n < 2; ++n) { const int col = 256 * pn + 128 * bj + 32 * wc + 8 * fq + 4 * n;
            gate[bj][n] = *(const f32x4*)(ada0 + r * 3072 + 2048 + col);
            gp[bj][n] = *(const f32x4*)(ng1 + col) * (*(const f32x4*)(ada1 + r * 3072 + 1024 + col) + 1.0f); }
#pragma unroll
    for (int ai = 0; ai < 2; ++ai)
#pragma unroll
        for (int mp = 0; mp < 4; mp += 2) {
            f32x4 xr[2][2][2];
#pragma unroll
            for (int mm = 0; mm < 2; ++mm) { const size_t xoff = (size_t)(256 * pm + 128 * ai + 64 * wr + 16 * (mp + mm) + fr) * DM;
#pragma unroll
                for (int bj = 0; bj < 2; ++bj)
#pragma unroll
                    for (int n = 0; n < 2; ++n) xr[mm][bj][n] = __builtin_nontemporal_load((const f32x4*)(xin + xoff + 256 * pn + 128 * bj + 32 * wc + 8 * fq + 4 * n)); }
            asm volatile("" ::: "memory");
#pragma unroll
            for (int mm = 0; mm < 2; ++mm) { const int m = mp + mm;
                const int lr = 128 * ai + 64 * wr + 16 * m + fr; const size_t row = rowbase + lr; const size_t xoff = (size_t)(256 * pm + lr) * DM;
                float ss = 0.f;
#pragma unroll
                for (int bj = 0; bj < 2; ++bj) { const int col8 = 256 * pn + 128 * bj + 32 * wc + 8 * fq; f32x4 xg[2];
#pragma unroll
                    for (int n = 0; n < 2; ++n) { const f32x4 x1 = xr[mm][bj][n] + gate[bj][n] * acc[ai][bj][m][n];
                        if (!CTX) { typedef _Float16 h4 __attribute__((ext_vector_type(4))); __builtin_nontemporal_store(__builtin_convertvector(x1, h4), (h4*)(o_x + xoff + col8 + 4 * n)); }
                        ss += (x1[0] * x1[0] + x1[1] * x1[1]) + (x1[2] * x1[2] + x1[3] * x1[3]); xg[n] = x1 * gp[bj][n]; }
                    *(v4u*)(H + row * DM + col8) = pack8(xg[0], xg[1]); }
                ss = sum_fq(ss);
                if (fq == 0) atomicAdd(ssq + row, ss);
            }
        }
}
struct EpiOutX {
    static constexpr bool PERM = true; static constexpr bool FUSED = false;
    const float *xin, *ada0, *ada1, *ng1; _Float16* o_x; bf16* H; float* ssq;
    DEVI void operator()(const f32x4 (&acc)[2][2][4][2], const pg8::Unit& u, int wr, int wc, int fr, int fq) const { outproj0_epi<false>(acc, u.pm, u.pn, wr, wc, fr, fq, xin, ada0, ada1, ng1, o_x, H, ssq); }
};
struct EpiOutF {
    static constexpr bool PERM = false; static constexpr bool FUSED = true;
    const float *ada, *gfin; const _Float16* x1h; float* o_x; float* ssq2; unsigned* cnt;
    DEVI void fused(f32x4 (&acc)[2][2][4][2], const pg8::Unit& u, int wr, int wc, int fr, int fq, int wid, int lane) const {
        typedef _Float16 h4 __attribute__((ext_vector_type(4))); typedef unsigned u32x2 __attribute__((ext_vector_type(2)));
        const int pm = __builtin_amdgcn_readfirstlane(u.pm), pn = __builtin_amdgcn_readfirstlane(u.pn); const int r = pm >> 3;
        const __amdgpu_buffer_rsrc_t rs_x = __builtin_amdgcn_make_buffer_rsrc((void*)x1h, 0, MX * DM * 2, 0x00020000);
        const __amdgpu_buffer_rsrc_t rs_o = __builtin_amdgcn_make_buffer_rsrc((void*)o_x, 0, MX * DM * 4, 0x00020000);
        const int e0 = (256 * pm + 64 * wr + fr) * DM + 256 * pn + 32 * wc + 4 * fq;
        f32x4 gv[2][2];
#pragma unroll
        for (int bj = 0; bj < 2; ++bj)
#pragma unroll
            for (int n = 0; n < 2; ++n) gv[bj][n] = *(const f32x4*)(ada + r * 3072 + 2048 + 256 * pn + 32 * wc + 4 * fq + 128 * bj + 16 * n);
#pragma unroll
        for (int ai = 0; ai < 2; ++ai) {
            u32x2 xh[4][2][2];
#pragma unroll
            for (int m = 0; m < 4; ++m)
#pragma unroll
                for (int bj = 0; bj < 2; ++bj)
#pragma unroll
                    for (int n = 0; n < 2; ++n) xh[m][bj][n] = __builtin_amdgcn_raw_buffer_load_b64(rs_x, (e0 + (128 * ai + 16 * m) * DM + 128 * bj + 16 * n) * 2, 0, 2  );
#pragma unroll
            for (int m = 0; m < 4; ++m) { const int lr = 128 * ai + 64 * wr + 16 * m + fr; float ss = 0.f;
#pragma unroll
                for (int bj = 0; bj < 2; ++bj)
#pragma unroll
                    for (int n = 0; n < 2; ++n) { const f32x4 x2 = __builtin_convertvector(__builtin_bit_cast(h4, xh[m][bj][n]), f32x4) + gv[bj][n] * acc[ai][bj][m][n]; acc[ai][bj][m][n] = x2;
                        ss += (x2[0] * x2[0] + x2[1] * x2[1]) + (x2[2] * x2[2] + x2[3] * x2[3]); }
                ss = sum_fq(ss);
                if (fq == 0) atomicAdd(ssq2 + 256 * pm + lr, ss); }
        }
        asm volatile("s_waitcnt vmcnt(0)" ::: "memory");
        __builtin_amdgcn_s_barrier(); asm volatile("" ::: "memory");
        if (wid == 0) {
            if (lane == 0) __hip_atomic_fetch_add(cnt + 64 * pm, 1u, __ATOMIC_RELAXED, __HIP_MEMORY_SCOPE_AGENT);
            unsigned sp = 0;
            while ((unsigned)__builtin_amdgcn_readfirstlane(__hip_atomic_load(cnt + 64 * pm, __ATOMIC_RELAXED, __HIP_MEMORY_SCOPE_AGENT)) < 4u) { __builtin_amdgcn_s_sleep(2); if (++sp > (1u << 22)) break; }
        }
        asm volatile("s_waitcnt vmcnt(0) lgkmcnt(0)" ::: "memory");
        __builtin_amdgcn_s_barrier(); asm volatile("" ::: "memory");
        f32x4 gf[2][2];
#pragma unroll
        for (int bj = 0; bj < 2; ++bj)
#pragma unroll
            for (int n = 0; n < 2; ++n) gf[bj][n] = *(const f32x4*)(gfin + 256 * pn + 32 * wc + 4 * fq + 128 * bj + 16 * n);
        float qs[2][4];
#pragma unroll
        for (int ai = 0; ai < 2; ++ai)
#pragma unroll
            for (int m = 0; m < 4; ++m) qs[ai][m] = __hip_atomic_load(ssq2 + 256 * pm + 128 * ai + 64 * wr + 16 * m + fr, __ATOMIC_RELAXED, __HIP_MEMORY_SCOPE_AGENT);
#pragma unroll
        for (int ai = 0; ai < 2; ++ai)
#pragma unroll
            for (int m = 0; m < 4; ++m) {
                const float ri = __builtin_amdgcn_rsqf(qs[ai][m] * (1.f / DM) + EPS);
#pragma unroll
                for (int bj = 0; bj < 2; ++bj)
#pragma unroll
                    for (int n = 0; n < 2; ++n) { const f32x4 o = acc[ai][bj][m][n] * ri * gf[bj][n];
                        __builtin_amdgcn_raw_buffer_store_b128(__builtin_bit_cast(v4u, o), rs_o, (e0 + (128 * ai + 16 * m) * DM + 128 * bj + 16 * n) * 4, 0, 2  ); } }
    }
    DEVI void operator()(const f32x4 (&)[2][2][4][2], const pg8::Unit&, int, int, int, int) const {}
};
struct EpiIn1 {
    static constexpr bool PERM = true; static constexpr bool FUSED = false;
    bf16 *PT, *Q1, *K1, *V1, *SZ1; const float *ssq, *sw;
    const float *ctx, *ada0, *ada1, *ng1; bf16* H; float* ssqw; int pt_pn0; unsigned* gate;
    DEVI void operator()(const f32x4 (&acc)[2][2][4][2], const pg8::Unit& u, int wr, int wc, int fr, int fq) const {
        asm volatile("" : "+v"(fr), "+v"(fq));
        const int pm = u.pm, kind = u.kind; const int cw = 32 * wc + 8 * fq;
        if (kind == 3) { outproj0_epi<true>(acc, pm, u.pn, wr, wc, fr, fq, ctx, ada0, ada1, ng1, nullptr, H, ssqw);
            asm volatile("s_waitcnt vmcnt(0)" ::: "memory"); __builtin_amdgcn_s_barrier(); asm volatile("" ::: "memory");
            if (wr == 0 && wc == 0) { __builtin_amdgcn_fence(__ATOMIC_RELEASE, "agent"); asm volatile("s_waitcnt vmcnt(0)" ::: "memory");
                if (fr == 0 && fq == 0) __hip_atomic_fetch_add(gate, 8u, __ATOMIC_RELAXED, __HIP_MEMORY_SCOPE_AGENT); }
            return; }
        if (kind == 2) {
            const int pn = u.pn + pt_pn0, b = pn >> 3;
            f32x4 ri[2][2];
#pragma unroll
            for (int bj = 0; bj < 2; ++bj)
#pragma unroll
                for (int n = 0; n < 2; ++n) { const f32x4 q = *(const f32x4*)(ssq + 256 * pn + 128 * bj + cw + 4 * n);
#pragma unroll
                    for (int e = 0; e < 4; ++e) ri[bj][n][e] = __builtin_amdgcn_rsqf(q[e] * (1.f / DM) + EPS); }
            float svs[2][4];
#pragma unroll
            for (int ai = 0; ai < 2; ++ai)
#pragma unroll
                for (int m = 0; m < 4; ++m) svs[ai][m] = sw[b * N1 + 256 * pm + 128 * ai + 64 * wr + 16 * m + fr];
            const __amdgpu_buffer_rsrc_t rs_p = __builtin_amdgcn_make_buffer_rsrc((void*)PT, 0, 4096 * 4096 * 2, 0x00020000);
#pragma unroll
            for (int ai = 0; ai < 2; ++ai)
#pragma unroll
                for (int m = 0; m < 4; ++m) { const int jj = 256 * pm + 128 * ai + 64 * wr + 16 * m + fr, cs = jj >> 9, jc = jj & 511; const float sv = svs[ai][m];
#pragma unroll
                    for (int bj = 0; bj < 2; ++bj) { const int tok = 256 * pn + 128 * bj + cw, l = tok & 2047; const int ng = b * 512 + jc;
                        __builtin_amdgcn_raw_buffer_store_b128(pack8(acc[ai][bj][m][0] * ri[bj][0] + sv, acc[ai][bj][m][1] * ri[bj][1] + sv), rs_p, ((((ng >> 7) * 2 + cs) * 128 + (ng & 127)) * 2048 + l) * 2, 0, 0); } }
            return;
        }
        const int pn = u.pn; const int r = (kind == 1) ? 8 : (pm >> 3); const int wcol0 = (kind == 1) ? 1536 : 1024;
        f32x4 sv[2][2];
#pragma unroll
        for (int bj = 0; bj < 2; ++bj)
#pragma unroll
            for (int n = 0; n < 2; ++n) sv[bj][n] = *(const f32x4*)(sw + r * N1 + wcol0 + 256 * pn + 128 * bj + cw + 4 * n);
        const int rowb = ((kind == 1) ? MX : 0) + 256 * pm + 64 * wr + fr;
        float qsv[2][4];
#pragma unroll
        for (int ai = 0; ai < 2; ++ai)
#pragma unroll
            for (int m = 0; m < 4; ++m) qsv[ai][m] = ssq[rowb + 128 * ai + 16 * m];
        bf16* dst; int pitch, colb; float osc = 1.f; bool act = false;
        if (kind == 1) { dst = (pn < 2) ? K1 : V1; pitch = 512; colb = 256 * (pn & 1); }
        else if (pn < 2) { dst = Q1; pitch = 512; colb = 256 * pn; osc = C2; }
        else if (pn < 4) { dst = K1; pitch = 512; colb = 256 * (pn - 2); }
        else if (pn < 6) { dst = V1; pitch = 512; colb = 256 * (pn - 4); }
        else { dst = SZ1; pitch = 1024; colb = 256 * (pn - 6); act = true; }
        const __amdgpu_buffer_rsrc_t rs_d = __builtin_amdgcn_make_buffer_rsrc((void*)dst, 0, MT * 1024 * 2, 0x00020000);
        const int ob = (rowb * pitch + colb + cw) * 2;
#pragma unroll
        for (int ai = 0; ai < 2; ++ai)
#pragma unroll
            for (int m = 0; m < 4; ++m) {
                const float ri = __builtin_amdgcn_rsqf(qsv[ai][m] * (1.f / DM) + EPS);
#pragma unroll
                for (int bj = 0; bj < 2; ++bj) {
                    f32x4 a0 = acc[ai][bj][m][0] * ri + sv[bj][0], a1 = acc[ai][bj][m][1] * ri + sv[bj][1];
                    if (act) {
#pragma unroll
                        for (int e = 0; e < 1; ++e) { a0 = fsilu4(a0); a1 = fsilu4(a1); } }
                    else { a0 = a0 * osc; a1 = a1 * osc; }
                    __builtin_amdgcn_raw_buffer_store_b128(pack8(a0, a1), rs_d, ob + ((128 * ai + 16 * m) * pitch + 128 * bj) * 2, 0, 0);
                }
            }
    }
};
struct EpiDft {
    static constexpr bool PERM = true; static constexpr bool FUSED = false;
    bf16* Y1; const bf16* SZ1;
    DEVI void operator()(const f32x4 (&acc)[2][2][4][2], const pg8::Unit& u, int wr, int wc, int fr, int fq) const {
        const int n = 128 * u.pn + 32 * wc + 8 * fq, b = n >> 9, j = n & 511;
        v4u zs[4][2];
#pragma unroll
        for (int m = 0; m < 4; ++m) { const int lp = 128 * u.pm + 64 * wr + 16 * m + fr;
            zs[m][0] = __builtin_nontemporal_load((const v4u*)(SZ1 + (size_t)(b * 2048 + lp) * 1024 + j));
            zs[m][1] = __builtin_nontemporal_load((const v4u*)(SZ1 + (size_t)(b * 2048 + ((2048 - lp) & 2047)) * 1024 + j)); }
#pragma unroll
        for (int m = 0; m < 4; ++m) { const int lp = 128 * u.pm + 64 * wr + 16 * m + fr;
            const f32x4 a0 = acc[0][0][m][0], a1 = acc[0][0][m][1], b0 = acc[1][1][m][0], b1 = acc[1][1][m][1];
            { const size_t off = (size_t)(b * 2048 + lp) * 1024 + j; const v4u z = zs[m][0];
              f32x4 o0 = a0 - b0, o1 = a1 - b1;
              o0[0] *= bflo(z.x); o0[1] *= bfhi(z.x); o0[2] *= bflo(z.y); o0[3] *= bfhi(z.y); o1[0] *= bflo(z.z); o1[1] *= bfhi(z.z); o1[2] *= bflo(z.w); o1[3] *= bfhi(z.w);
              *(v4u*)(Y1 + off) = pack8(o0, o1); }
            if (lp >= 1) { const size_t off = (size_t)(b * 2048 + 2048 - lp) * 1024 + j; const v4u z = zs[m][1];
              f32x4 o0 = a0 + b0, o1 = a1 + b1;
              o0[0] *= bflo(z.x); o0[1] *= bfhi(z.x); o0[2] *= bflo(z.y); o0[3] *= bfhi(z.y); o1[0] *= bflo(z.z); o1[1] *= bfhi(z.z); o1[2] *= bflo(z.w); o1[3] *= bfhi(z.w);
              *(v4u*)(Y1 + off) = pack8(o0, o1); }
        }
    }
};
DEVI void phase_nyquist(Frame& F) {
    const bf16* PT = wsb(F, WS_PT); const bf16* SZ1 = wsb(F, WS_SZ1); bf16* Y1 = wsb(F, WS_Y1);
    const int gw = F.bid * NWAVES + F.wave, NGW = F.G * NWAVES;
    for (int n0 = gw; n0 < 4096; n0 += 2 * NGW) {
        const int n1 = n0 + NGW; const bool has1 = n1 < 4096; const int n1c = has1 ? n1 : n0;
        const bf16* row0 = PT + ((size_t)((n0 >> 7) * 2) * 128 + (n0 & 127)) * 2048 + F.lane * 32;
        const bf16* row1 = PT + ((size_t)((n1c >> 7) * 2) * 128 + (n1c & 127)) * 2048 + F.lane * 32;
        const size_t off0 = (size_t)((n0 >> 9) * 2048 + 1024) * 1024 + (n0 & 511), off1 = (size_t)((n1c >> 9) * 2048 + 1024) * 1024 + (n1c & 511);
        v4u w0[4], w1[4];
#pragma unroll
        for (int q = 0; q < 4; ++q) { w0[q] = *(const v4u*)(row0 + 8 * q); w1[q] = *(const v4u*)(row1 + 8 * q); }
        const float z0 = bf2f(SZ1[off0]), z1 = bf2f(SZ1[off1]);
        float a0 = 0.f, a1 = 0.f;
#pragma unroll
        for (int q = 0; q < 4; ++q) {
            a0 += (bflo(w0[q].x) - bfhi(w0[q].x)) + (bflo(w0[q].y) - bfhi(w0[q].y)) + (bflo(w0[q].z) - bfhi(w0[q].z)) + (bflo(w0[q].w) - bfhi(w0[q].w));
            a1 += (bflo(w1[q].x) - bfhi(w1[q].x)) + (bflo(w1[q].y) - bfhi(w1[q].y)) + (bflo(w1[q].z) - bfhi(w1[q].z)) + (bflo(w1[q].w) - bfhi(w1[q].w)); }
        a0 = wave_sum_dpp(a0); a1 = wave_sum_dpp(a1);
        if (F.lane == 0) { Y1[off0] = (bf16)f2bf(a0 * z0); if (has1) Y1[off1] = (bf16)f2bf(a1 * z1); }
    }
}

namespace attn_body {
using bf16=__hip_bfloat16;
using bf16x8=__attribute__((ext_vector_type(8)))short;
using s16x4=__attribute__((ext_vector_type(4)))short;
using f32x16=__attribute__((ext_vector_type(16)))float;
using u32x4=__attribute__((ext_vector_type(4)))unsigned;
constexpr int D=64,NW=8,QBLK=32,QB=QBLK*NW,KVBLK=64;
constexpr int QP=512,YP=1024;
__device__ __forceinline__ int crow(int r,int hi){return (r&3)+8*(r>>2)+4*hi;}
#define SBAR() __builtin_amdgcn_sched_barrier(0)
constexpr int NSLOT=3, SLOTB=8192;
constexpr int LDS_K=0, LDS_V=NSLOT*SLOTB, LDS_WS=2*NSLOT*SLOTB, LDS_OST=LDS_WS+NW*64*4, LDS_BYTES=LDS_OST+NW*4096;
__device__ __forceinline__ void glds16(const void*gsrc,unsigned lds_dst){unsigned keep;
  asm volatile("s_mov_b32 %0, m0\n\ts_mov_b32 m0, %2\n\ts_nop 0\n\tglobal_load_lds_dwordx4 %1, off\n\ts_mov_b32 m0, %0":"=&s"(keep):"v"(gsrc),"s"(lds_dst):"memory");}
__device__ __forceinline__ float max3f(float a,float b,float c){float r;asm("v_max3_f32 %0, %1, %2, %3":"=v"(r):"v"(a),"v"(b),"v"(c));return r;}
__device__ __forceinline__ float max2f(float a,float b){float r;asm("v_max_f32_e32 %0, %1, %2":"=v"(r):"v"(a),"v"(b));return r;}
__device__ __forceinline__ float fadd_s(float a,float b){float r;asm("v_add_f32_e32 %0, %1, %2":"=v"(r):"v"(a),"v"(b));return r;}
__device__ __forceinline__ float fsub_s(float a,float b){float r;asm("v_sub_f32_e32 %0, %1, %2":"=v"(r):"v"(a),"v"(b));return r;}
typedef float f32x2_t __attribute__((ext_vector_type(2))); typedef __bf16 bf16x2_t __attribute__((ext_vector_type(2)));
__device__ __forceinline__ unsigned cvtpk_s(float lo,float hi){f32x2_t v={lo,hi};bf16x2_t b=__builtin_convertvector(v,bf16x2_t);return __builtin_bit_cast(unsigned,b);}
#define WAIT_BAR(N) asm volatile("s_waitcnt vmcnt(" #N ") lgkmcnt(0)\n\ts_barrier":::"memory")
__device__ __forceinline__ void qkt(f32x16&p0,f32x16&p1,const char*Kslot,const bf16x8*qr,const f32x16&negm,int r32,int hi){
  const char*kb=Kslot+hi*1024+r32*16;
  #pragma unroll
  for(int d0=0;d0<4;++d0){
    const bf16x8 b0=*reinterpret_cast<const bf16x8*>(kb+d0*2048);
    const bf16x8 b1=*reinterpret_cast<const bf16x8*>(kb+d0*2048+512);
    if(d0==0){p0=__builtin_amdgcn_mfma_f32_32x32x16_bf16(b0,qr[0],negm,0,0,0);p1=__builtin_amdgcn_mfma_f32_32x32x16_bf16(b1,qr[0],negm,0,0,0);}
    else{p0=__builtin_amdgcn_mfma_f32_32x32x16_bf16(b0,qr[d0],p0,0,0,0);p1=__builtin_amdgcn_mfma_f32_32x32x16_bf16(b1,qr[d0],p1,0,0,0);}}
}
typedef __attribute__((address_space(3))) const char* lds_cptr;
typedef short v4i16_t __attribute__((ext_vector_type(4)));
__device__ __forceinline__ void kload8(bf16x8*kf,lds_cptr kp){
  kf[0]=*(const __attribute__((address_space(3))) bf16x8*)(kp);      kf[1]=*(const __attribute__((address_space(3))) bf16x8*)(kp+512);
  kf[2]=*(const __attribute__((address_space(3))) bf16x8*)(kp+2048); kf[3]=*(const __attribute__((address_space(3))) bf16x8*)(kp+2560);
  kf[4]=*(const __attribute__((address_space(3))) bf16x8*)(kp+4096); kf[5]=*(const __attribute__((address_space(3))) bf16x8*)(kp+4608);
  kf[6]=*(const __attribute__((address_space(3))) bf16x8*)(kp+6144); kf[7]=*(const __attribute__((address_space(3))) bf16x8*)(kp+6656);
}
__device__ __forceinline__ void kload2(bf16x8*kf,lds_cptr kp,int j){ kf[2*j]=*(const __attribute__((address_space(3))) bf16x8*)(kp+j*2048); kf[2*j+1]=*(const __attribute__((address_space(3))) bf16x8*)(kp+j*2048+512); }
__device__ __forceinline__ s16x4 vtr(lds_cptr p){ return __builtin_bit_cast(s16x4,__builtin_amdgcn_ds_read_tr16_b64_v4i16((__attribute__((address_space(3))) v4i16_t*)p)); }
__device__ __forceinline__ float rowmax(const f32x16&p0,const f32x16&p1){
  float a=max3f(p0[0],p0[1],p1[0]),b=max3f(p0[2],p0[3],p1[1]);a=max3f(a,p1[2],p1[3]);
  #pragma unroll
  for(int r=4;r<16;r+=4){a=max3f(a,p0[r],p0[r+1]);b=max3f(b,p0[r+2],p0[r+3]);a=max3f(a,p1[r],p1[r+1]);b=max3f(b,p1[r+2],p1[r+3]);}
  const float m=max2f(a,b);
  auto rr=__builtin_amdgcn_permlane32_swap(__float_as_uint(m),__float_as_uint(m),false,false);
  return max2f(__uint_as_float(rr[0]),__uint_as_float(rr[1]));
}
__device__ __forceinline__ void pv(f32x16*o,int vb,bf16x8 pa0,bf16x8 pa1,bf16x8 pa2,bf16x8 pa3){
  #pragma unroll
  for(int d0=0;d0<2;++d0){s16x4 lo[4],hi[4];
    #pragma unroll
    for(int ks=0;ks<4;++ks){
      asm volatile("ds_read_b64_tr_b16 %0,%1 offset:%c2":"=&v"(lo[ks]):"v"(vb),"i"(d0*4096+ks*1024):"memory");
      asm volatile("ds_read_b64_tr_b16 %0,%1 offset:%c2":"=&v"(hi[ks]):"v"(vb),"i"(d0*4096+ks*1024+512):"memory");}
    asm volatile("s_waitcnt lgkmcnt(0)":::"memory");SBAR();
    #define PK(k) (bf16x8){lo[k][0],lo[k][1],lo[k][2],lo[k][3],hi[k][0],hi[k][1],hi[k][2],hi[k][3]}
    o[d0]=__builtin_amdgcn_mfma_f32_32x32x16_bf16(pa0,PK(0),o[d0],0,0,0);
    o[d0]=__builtin_amdgcn_mfma_f32_32x32x16_bf16(pa1,PK(1),o[d0],0,0,0);
    o[d0]=__builtin_amdgcn_mfma_f32_32x32x16_bf16(pa2,PK(2),o[d0],0,0,0);
    o[d0]=__builtin_amdgcn_mfma_f32_32x32x16_bf16(pa3,PK(3),o[d0],0,0,0);
    #undef PK
  }
}
template<int THRL,bool NAT,int KVP> __device__ __forceinline__ void attn_unit(const bf16*Qu,const bf16*__restrict__ Kh,const bf16*__restrict__ Vh,const int NT,bf16*Yu,const bf16*Zu,char*shm,
    const long ctxoff=0,const long winoff=0,const int kr0=0,const int rq0=0,const float*btab=nullptr){
  const int tid=threadIdx.x,lane=tid&63,r32=lane&31,hi=lane>>5; const int wid=__builtin_amdgcn_readfirstlane(tid>>6);
  const bf16*Qw=Qu+(long)(wid*QBLK)*QP;
  const unsigned lds0=(unsigned)(uintptr_t)shm;
  float*wsf=(float*)(shm+LDS_WS)+wid*64;
  const bf16*ksrc=Kh+(long)lane*KVP+wid*8;
  const bf16*vsrc=Vh+(long)(16*(wid&3)+(lane>>2))*KVP+(wid>>2)*32+(lane&3)*8;
  const unsigned kdst=lds0+LDS_K+wid*1024, vdst=lds0+LDS_V+wid*1024;
  #define TOFF(t) (NAT ? (((t)<4) ? (ctxoff+(long)(t)*KVBLK)*KVP : (winoff+(long)((t)-4)*KVBLK)*KVP) : (long)(t)*KVBLK*KVP)
  #define DMA_K(t,slot) glds16(ksrc+TOFF(t),(unsigned)__builtin_amdgcn_readfirstlane(kdst+(slot)))
  #define DMA_V(t,slot) glds16(vsrc+TOFF(t),(unsigned)__builtin_amdgcn_readfirstlane(vdst+(slot)))
  const int nq_r=rq0+(wid>>1), nq_c=32*(wid&1)+r32;
  const int nq_rs=min(max(nq_r-4,0),24), nq_cs=min(max(nq_c-8,0),48);
  const int nq_vb=4*hi-nq_cs, nq_lb=48+15+4*hi-nq_c;
  #define BIASMASK(C0,C1,t) do{ if(NAT && (t)>=4){ const int kr_=kr0+(t)-4; const bool rowok_=(unsigned)(kr_-nq_rs)<8u; const int dr_=min(max(kr_-nq_r+7,0),14); \
      const float*tb_=btab+dr_*31+nq_lb; \
      _Pragma("unroll") for(int rb=0;rb<16;rb+=4){ float b0_[4],b1_[4]; \
        _Pragma("unroll") for(int r=0;r<4;++r){ const int kc_=((rb+r)&3)+8*((rb+r)>>2); b0_[r]=tb_[kc_]; b1_[r]=tb_[kc_+32]; } \
        _Pragma("unroll") for(int r=0;r<4;++r){ const int kc_=((rb+r)&3)+8*((rb+r)>>2); \
          const bool v0_=rowok_&&((unsigned)(kc_+nq_vb)<16u), v1_=rowok_&&((unsigned)(kc_+32+nq_vb)<16u); \
          C0[rb+r]=v0_?C0[rb+r]+b0_[r]:-1e30f; C1[rb+r]=v1_?C1[rb+r]+b1_[r]:-1e30f; } \
        SBAR(); } } }while(0)
  const int vb0=(int)(lds0+LDS_V)+((lane>>4)&1)*32+(lane&3)*8+(4*hi+((lane&15)>>2))*64;
  const char*Kbase=shm+LDS_K; bf16x8 kf[8];
  const lds_cptr shm3=(lds_cptr)shm; const lds_cptr kp0=shm3+LDS_K+hi*1024+r32*16; const lds_cptr vp0=shm3+LDS_V+((lane>>4)&1)*32+(lane&3)*8+(4*hi+((lane&15)>>2))*64;
  DMA_K(0,0);DMA_V(0,0);DMA_K(1,SLOTB);
  bf16x8 qr[4];
  #pragma unroll
  for(int d0=0;d0<4;++d0)qr[d0]=*reinterpret_cast<const bf16x8*>(&Qw[(long)r32*QP+d0*16+hi*8]);
  float mhat=0.f,l_reg=0.f;f32x16 o[2];o[0]=f32x16{};o[1]=f32x16{};float zin_;asm volatile("v_mov_b32 %0, 0":"=v"(zin_));f32x16 negm;
  _Pragma("unroll") for(int r=0;r<16;++r)negm[r]=zin_; asm volatile("":"+v"(negm));
  bool resc=false;
  #define START(P0,P1) do{ const float rm=rowmax(P0,P1); resc=false; \
    { const float dl=rm; mhat=fadd_s(mhat,dl); \
      _Pragma("unroll") for(int r=0;r<16;++r){P0[r]=fsub_s(P0[r],dl);P1[r]=fsub_s(P1[r],dl);} \
      _Pragma("unroll") for(int r=0;r<16;++r)negm[r]=-mhat; asm volatile("":"+v"(negm)); } \
    _Pragma("unroll") for(int r=0;r<16;++r)P0[r]=__builtin_amdgcn_exp2f(P0[r]); }while(0)
  #define RESC() do{ if(resc){ asm volatile("s_waitcnt lgkmcnt(0)":::"memory"); \
      _Pragma("unroll") for(int d_=0;d_<2;++d_) _Pragma("unroll") for(int r=0;r<16;++r)o[d_][r]*=wsf[crow(r,hi)]; } }while(0)
  f32x16 pA0,pA1,pB0,pB1;
  int sl_prev=0,sl_cur=0,sl_next=SLOTB;
  #define ROT() do{sl_prev=sl_cur;sl_cur=sl_next;sl_next=(sl_next==(NSLOT-1)*SLOTB)?0:sl_next+SLOTB;}while(0)
  DMA_K(2,2*SLOTB);
  WAIT_BAR(3);
  qkt(pA0,pA1,Kbase,qr,negm,r32,hi);asm volatile("s_nop 15\n\ts_nop 7":"+v"(pA0),"+v"(pA1));
  START(pA0,pA1);
  _Pragma("unroll") for(int r=0;r<16;++r)pA1[r]=__builtin_amdgcn_exp2f(pA1[r]);
  WAIT_BAR(0);
  DMA_K(3,0);DMA_V(1,SLOTB);
  ROT();
  kload8(kf,kp0+sl_cur);
  WAIT_BAR(2);
  s16x4 vlo[8],vhi[8]; u32x4 pw0,pw1,pw2,pw3;
  #define PKW(P,B) cvtpk_s(P[B],P[B+1])
  #define PAF(k) __builtin_bit_cast(bf16x8,pw##k)
  #define VFR(i) (bf16x8){vlo[i][0],vlo[i][1],vlo[i][2],vlo[i][3],vhi[i][0],vhi[i][1],vhi[i][2],vhi[i][3]}
  #define PIN(x) asm volatile("":"+v"(x))
  #define MX3(a,b,c) __builtin_fmaxf(__builtin_fmaxf((a),(b)),(c))
  #define GAPA(MF,A0,A1,A2,A3,W0,W1,PW) do{ MF; sacc+=A0; sacc+=A1; sacc+=A2; sacc+=A3; PIN(sacc); W0; W1; PIN(PW); SBAR(); }while(0)
  #define EX(v) __builtin_amdgcn_exp2f(v)
  #define GAPB(MF,X,B) do{ MF; X[B]=EX(X[B]); X[B+1]=EX(X[B+1]); X[B+2]=EX(X[B+2]); X[B+3]=EX(X[B+3]); PIN(X); SBAR(); }while(0)
  #define VRD(i) do{ vlo[i]=vtr(vp_+(((i)>>2)*4096+((i)&3)*1024)); vhi[i]=vtr(vp_+(((i)>>2)*4096+((i)&3)*1024+512)); }while(0)
  #define KRD(G,j) do{ if(G){ kload2(kf,kp0+sl_next,j); SBAR(); } }while(0)
  bf16*Yw=Yu+(long)(wid*QBLK)*YP; const bf16*Zw=Zu+(long)(wid*QBLK)*YP;
  u32x4 zq[4];
  #define STEP(C0,C1,P0,P1,t,GK,GV,GL,ZL) do{ SBAR(); \
    const lds_cptr vp_=vp0+sl_prev; \
    VRD(0); SBAR(); float sacc=(P0[0]+P0[1]); \
    GAPA(C0=__builtin_amdgcn_mfma_f32_32x32x16_bf16(kf[0],qr[0],negm,0,0,0), P0[2],P0[3],P0[4],P0[5],     pw0[0]=PKW(P0,0), pw0[1]=PKW(P0,2), pw0); \
    VRD(4); SBAR(); GAPA(C1=__builtin_amdgcn_mfma_f32_32x32x16_bf16(kf[1],qr[0],negm,0,0,0), P0[6],P0[7],P0[8],P0[9],     pw0[2]=PKW(P0,4), pw0[3]=PKW(P0,6), pw0); \
    VRD(1); SBAR(); GAPA(C0=__builtin_amdgcn_mfma_f32_32x32x16_bf16(kf[2],qr[1],C0,0,0,0),   P0[10],P0[11],P0[12],P0[13], pw1[0]=PKW(P0,8), pw1[1]=PKW(P0,10), pw1); \
    VRD(5); SBAR(); GAPA(C1=__builtin_amdgcn_mfma_f32_32x32x16_bf16(kf[3],qr[1],C1,0,0,0),   P0[14],P0[15],P1[0],P1[1],   pw1[2]=PKW(P0,12),pw1[3]=PKW(P0,14), pw1); \
    VRD(2); SBAR(); GAPA(C0=__builtin_amdgcn_mfma_f32_32x32x16_bf16(kf[4],qr[2],C0,0,0,0),   P1[2],P1[3],P1[4],P1[5],     pw2[0]=PKW(P1,0), pw2[1]=PKW(P1,2), pw2); \
    VRD(6); SBAR(); GAPA(C1=__builtin_amdgcn_mfma_f32_32x32x16_bf16(kf[5],qr[2],C1,0,0,0),   P1[6],P1[7],P1[8],P1[9],     pw2[2]=PKW(P1,4), pw2[3]=PKW(P1,6), pw2); \
    VRD(3); SBAR(); GAPA(C0=__builtin_amdgcn_mfma_f32_32x32x16_bf16(kf[6],qr[3],C0,0,0,0),   P1[10],P1[11],P1[12],P1[13], pw3[0]=PKW(P1,8), pw3[1]=PKW(P1,10), pw3); \
    VRD(7); SBAR(); GAPA(C1=__builtin_amdgcn_mfma_f32_32x32x16_bf16(kf[7],qr[3],C1,0,0,0),   P1[14],P1[15],0.f,0.f,       pw3[2]=PKW(P1,12),pw3[3]=PKW(P1,14), pw3); \
    l_reg+=sacc; \
    if(GK){DMA_K((t)+3,sl_cur);} if(GV){DMA_V((t)+1,sl_next);} \
    if(ZL){ _Pragma("unroll") for(int i=0;i<4;++i)zq[i]=__builtin_nontemporal_load((const u32x4*)(Zw+(long)(i*8+(lane>>3))*YP+(lane&7)*8)); } \
    BIASMASK(C0,C1,t); \
    { float a=MX3(C0[0],C0[1],C1[0]),b=MX3(C0[2],C0[3],C1[1]); a=MX3(a,C1[2],C1[3]); \
      _Pragma("unroll") for(int r=4;r<16;r+=4){a=MX3(a,C0[r],C0[r+1]);b=MX3(b,C0[r+2],C0[r+3]);a=MX3(a,C1[r],C1[r+1]);b=MX3(b,C1[r+2],C1[r+3]);} \
      float rm=__builtin_fmaxf(a,b); { auto rr=__builtin_amdgcn_permlane32_swap(__float_as_uint(rm),__float_as_uint(rm),false,false); rm=__builtin_fmaxf(__uint_as_float(rr[0]),__uint_as_float(rr[1])); } \
      resc=false; \
      if(__builtin_expect(__any(rm>(float)THRL),0)){ const float dl=__builtin_fmaxf(rm,0.f); mhat+=dl; \
        _Pragma("unroll") for(int r=0;r<16;++r){C0[r]-=dl;C1[r]-=dl;} \
        _Pragma("unroll") for(int r=0;r<16;++r)negm[r]=-mhat; asm volatile("":"+v"(negm)); \
        const float f=__builtin_amdgcn_exp2f(-dl); l_reg*=f; if(hi==0)wsf[r32]=f; resc=true; } } \
    SBAR(); \
    GAPB(o[0]=__builtin_amdgcn_mfma_f32_32x32x16_bf16(PAF(0),VFR(0),o[0],0,0,0), C0,0); \
    GAPB(o[1]=__builtin_amdgcn_mfma_f32_32x32x16_bf16(PAF(0),VFR(4),o[1],0,0,0), C0,4); \
    KRD(GL,0); GAPB(o[0]=__builtin_amdgcn_mfma_f32_32x32x16_bf16(PAF(1),VFR(1),o[0],0,0,0), C0,8); \
    KRD(GL,1); GAPB(o[1]=__builtin_amdgcn_mfma_f32_32x32x16_bf16(PAF(1),VFR(5),o[1],0,0,0), C0,12); \
    KRD(GL,2); GAPB(o[0]=__builtin_amdgcn_mfma_f32_32x32x16_bf16(PAF(2),VFR(2),o[0],0,0,0), C1,0); \
    KRD(GL,3); GAPB(o[1]=__builtin_amdgcn_mfma_f32_32x32x16_bf16(PAF(2),VFR(6),o[1],0,0,0), C1,4); \
    GAPB(o[0]=__builtin_amdgcn_mfma_f32_32x32x16_bf16(PAF(3),VFR(3),o[0],0,0,0), C1,8); \
    GAPB(o[1]=__builtin_amdgcn_mfma_f32_32x32x16_bf16(PAF(3),VFR(7),o[1],0,0,0), C1,12); \
    }while(0)
  int t=1;
  for(;t+5<NT;t+=2){
    STEP(pB0,pB1,pA0,pA1,t,true,true,true,false);     WAIT_BAR(2); RESC(); ROT();
    STEP(pA0,pA1,pB0,pB1,t+1,true,true,true,false);   WAIT_BAR(2); RESC(); ROT();
  }
  #define ENDW(tt) do{ if((tt)+3<NT){WAIT_BAR(2);} else if((tt)+2<NT){WAIT_BAR(1);} else {WAIT_BAR(0);} }while(0)
  for(;t+1<NT;t+=2){
    STEP(pB0,pB1,pA0,pA1,t,(t+3<NT),(t+1<NT),(t+1<NT),false);       ENDW(t);   RESC(); ROT();
    STEP(pA0,pA1,pB0,pB1,t+1,(t+4<NT),(t+2<NT),(t+2<NT),false);     ENDW(t+1); RESC(); ROT();
  }
  STEP(pB0,pB1,pA0,pA1,NT-1,false,false,false,true); RESC();
  { float sacc=pB0[0]+pB0[1]; _Pragma("unroll") for(int r=2;r<16;++r)sacc+=pB0[r]; _Pragma("unroll") for(int r=0;r<16;++r)sacc+=pB1[r]; l_reg+=sacc;
    pw0=(u32x4){PKW(pB0,0),PKW(pB0,2),PKW(pB0,4),PKW(pB0,6)};pw1=(u32x4){PKW(pB0,8),PKW(pB0,10),PKW(pB0,12),PKW(pB0,14)};pw2=(u32x4){PKW(pB1,0),PKW(pB1,2),PKW(pB1,4),PKW(pB1,6)};pw3=(u32x4){PKW(pB1,8),PKW(pB1,10),PKW(pB1,12),PKW(pB1,14)};
    SBAR(); pv(o,vb0+sl_cur,PAF(0),PAF(1),PAF(2),PAF(3)); }
  #undef PKW
  #undef PAF
  #undef VFR
  #undef PIN
  #undef MX3
  #undef GAPA
  #undef GAPB
  #undef EX
  #undef VRD
  #undef KRD
  #undef STEP
  #undef ENDW
  {auto rr=__builtin_amdgcn_permlane32_swap(__float_as_uint(l_reg),__float_as_uint(l_reg),false,false);l_reg=__uint_as_float(rr[0])+__uint_as_float(rr[1]);}
  if(hi==0)wsf[32+r32]=l_reg;asm volatile("s_waitcnt lgkmcnt(0)":::"memory");
  float rli[16];
  #pragma unroll
  for(int r=0;r<16;++r)rli[r]=__builtin_amdgcn_rcpf(wsf[32+crow(r,hi)]);
  { bf16*stg=(bf16*)(shm+LDS_OST)+wid*2048;
    #pragma unroll
    for(int r=0;r<16;++r){const int orow=crow(r,hi);
      #pragma unroll
      for(int d0=0;d0<2;++d0)stg[orow*64+d0*32+r32]=__float2bfloat16(o[d0][r]*rli[r]);}
    asm volatile("s_waitcnt lgkmcnt(0)":::"memory");
    #pragma unroll
    for(int i=0;i<4;++i){const int row=i*8+(lane>>3),ch=lane&7; const u32x4 v=*(const u32x4*)(stg+row*64+ch*8); const u32x4 z=zq[i]; u32x4 w;
      w.x=cvtpk_s(__uint_as_float(v.x<<16)*__uint_as_float(z.x<<16),__uint_as_float(v.x&0xffff0000u)*__uint_as_float(z.x&0xffff0000u));
      w.y=cvtpk_s(__uint_as_float(v.y<<16)*__uint_as_float(z.y<<16),__uint_as_float(v.y&0xffff0000u)*__uint_as_float(z.y&0xffff0000u));
      w.z=cvtpk_s(__uint_as_float(v.z<<16)*__uint_as_float(z.z<<16),__uint_as_float(v.z&0xffff0000u)*__uint_as_float(z.z&0xffff0000u));
      w.w=cvtpk_s(__uint_as_float(v.w<<16)*__uint_as_float(z.w<<16),__uint_as_float(v.w&0xffff0000u)*__uint_as_float(z.w&0xffff0000u));
      *(u32x4*)(Yw+(long)row*YP+ch*8)=w;} }
  asm volatile("s_waitcnt lgkmcnt(0)\n\ts_barrier":::"memory");
  #undef DMA_K
  #undef DMA_V
  #undef TOFF
  #undef BIASMASK
  #undef START
  #undef RESC
  #undef ROT
}
constexpr int NA_SLOTB=16384, NA_LDS_K=0, NA_LDS_V=3*NA_SLOTB, NA_LDS_WS=6*NA_SLOTB, NA_LDS_OST=NA_LDS_WS+NW*64*4, NA_LDS_BYTES=NA_LDS_OST+NW*4096;
template<int THRL> __device__ __forceinline__ void na_attn_unit(const bf16*Qu,const bf16*__restrict__ Kh,const bf16*__restrict__ Vh,const int NT,bf16*Yu,const bf16*Zu,char*shm,
    const long ctxoff,const long winoff,const int kr0,const int rq0,const float*btab){
  constexpr int KVP=512;
  const int tid=threadIdx.x,lane=tid&63,r32=lane&31,hi=lane>>5; const int wid=__builtin_amdgcn_readfirstlane(tid>>6);
  const int wi=wid>>2, wj=wid&3;
  const int c0=(wj==0)?0:(wj==1)?8:(wj==2)?24:32;
  const int qtok=(2*wi+(r32>>4))*64+16*wj+(r32&15);
  const unsigned lds0=(unsigned)(uintptr_t)shm;
  float*wsf=(float*)(shm+NA_LDS_WS)+wid*64;
  const bf16*ksrc=Kh+(long)lane*KVP+wid*8;
  const bf16*vsrc=Vh+(long)(16*(wid&3)+(lane>>2))*KVP+(wid>>2)*32+(lane&3)*8;
  const unsigned kdst=lds0+NA_LDS_K+wid*1024, vdst=lds0+NA_LDS_V+wid*1024;
  #define DMA_K(t,slot) do{ if((t)<4){ glds16(ksrc+(ctxoff+(long)(t)*KVBLK)*KVP,(unsigned)__builtin_amdgcn_readfirstlane(kdst+(slot))); } \
      else { glds16(ksrc+(winoff+(long)(2*((t)-4))*KVBLK)*KVP,(unsigned)__builtin_amdgcn_readfirstlane(kdst+(slot))); glds16(ksrc+(winoff+(long)(2*((t)-4)+1)*KVBLK)*KVP,(unsigned)__builtin_amdgcn_readfirstlane(kdst+(slot)+8192)); } }while(0)
  #define DMA_V(t,slot) do{ if((t)<4){ glds16(vsrc+(ctxoff+(long)(t)*KVBLK)*KVP,(unsigned)__builtin_amdgcn_readfirstlane(vdst+(slot))); } \
      else { glds16(vsrc+(winoff+(long)(2*((t)-4))*KVBLK)*KVP,(unsigned)__builtin_amdgcn_readfirstlane(vdst+(slot))); glds16(vsrc+(winoff+(long)(2*((t)-4)+1)*KVBLK)*KVP,(unsigned)__builtin_amdgcn_readfirstlane(vdst+(slot)+8192)); } }while(0)
  const int nq_r=rq0+2*wi+(r32>>4), nq_c=16*wj+(r32&15);
  const int nq_rs=min(max(nq_r-4,0),24), nq_cs=min(max(nq_c-8,0),48);
  const int nq_vb=c0+4*hi-nq_cs, nq_lb=48+15+c0+4*hi-nq_c;
  const char*Kbase=shm+NA_LDS_K; bf16x8 kf[8];
  const lds_cptr shm3=(lds_cptr)shm; const lds_cptr kp0=shm3+NA_LDS_K+hi*1024+r32*16; const lds_cptr vp0=shm3+NA_LDS_V+((lane>>4)&1)*32+(lane&3)*8+(4*hi+((lane&15)>>2))*64;
  const lds_cptr kpw=kp0+c0*16, vpw=vp0+c0*64;
  const int vbw=(int)(lds0+NA_LDS_V)+((lane>>4)&1)*32+(lane&3)*8+(4*hi+((lane&15)>>2))*64+c0*64;
  DMA_K(0,0);DMA_V(0,0);DMA_K(1,NA_SLOTB);
  bf16x8 qr[4];
  #pragma unroll
  for(int d0=0;d0<4;++d0)qr[d0]=*reinterpret_cast<const bf16x8*>(&Qu[(long)qtok*QP+d0*16+hi*8]);
  float mhat=0.f,l_reg=0.f;f32x16 o[2];o[0]=f32x16{};o[1]=f32x16{};float zin_;asm volatile("v_mov_b32 %0, 0":"=v"(zin_));f32x16 negm;
  _Pragma("unroll") for(int r=0;r<16;++r)negm[r]=zin_; asm volatile("":"+v"(negm));
  bool resc=false;
  #define RESC() do{ if(resc){ asm volatile("s_waitcnt lgkmcnt(0)":::"memory"); \
      _Pragma("unroll") for(int d_=0;d_<2;++d_) _Pragma("unroll") for(int r=0;r<16;++r)o[d_][r]*=wsf[crow(r,hi)]; } }while(0)
  f32x16 pA0,pA1,pB0,pB1;
  int sl_prev=0,sl_cur=0,sl_next=NA_SLOTB;
  #define ROT() do{sl_prev=sl_cur;sl_cur=sl_next;sl_next=(sl_next==2*NA_SLOTB)?0:sl_next+NA_SLOTB;}while(0)
  DMA_K(2,2*NA_SLOTB);
  WAIT_BAR(3);
  qkt(pA0,pA1,Kbase,qr,negm,r32,hi);asm volatile("s_nop 15\n\ts_nop 7":"+v"(pA0),"+v"(pA1));
  { const float rm=rowmax(pA0,pA1); mhat=fadd_s(mhat,rm);
    _Pragma("unroll") for(int r=0;r<16;++r){pA0[r]=fsub_s(pA0[r],rm);pA1[r]=fsub_s(pA1[r],rm);}
    _Pragma("unroll") for(int r=0;r<16;++r)negm[r]=-mhat; asm volatile("":"+v"(negm));
    _Pragma("unroll") for(int r=0;r<16;++r)pA0[r]=__builtin_amdgcn_exp2f(pA0[r]);
    _Pragma("unroll") for(int r=0;r<16;++r)pA1[r]=__builtin_amdgcn_exp2f(pA1[r]); }
  WAIT_BAR(0);
  DMA_K(3,0);DMA_V(1,NA_SLOTB);
  ROT();
  kload8(kf,kp0+sl_cur);
  WAIT_BAR(2);
  s16x4 vlo[8],vhi[8]; u32x4 pw0,pw1,pw2,pw3;
  #define PKW(P,B) cvtpk_s(P[B],P[B+1])
  #define PAF(k) __builtin_bit_cast(bf16x8,pw##k)
  #define VFR(i) (bf16x8){vlo[i][0],vlo[i][1],vlo[i][2],vlo[i][3],vhi[i][0],vhi[i][1],vhi[i][2],vhi[i][3]}
  #define PIN(x) asm volatile("":"+v"(x))
  #define MX3(a,b,c) __builtin_fmaxf(__builtin_fmaxf((a),(b)),(c))
  #define MFMA(a,b,c) __builtin_amdgcn_mfma_f32_32x32x16_bf16(a,b,c,0,0,0)
  #define GAPA(MF,A0,A1,A2,A3,W0,W1,PW) do{ MF; sacc+=A0; sacc+=A1; sacc+=A2; sacc+=A3; PIN(sacc); W0; W1; PIN(PW); SBAR(); }while(0)
  #define EX(v) __builtin_amdgcn_exp2f(v)
  #define GAPB(MF,X,B) do{ MF; X[B]=EX(X[B]); X[B+1]=EX(X[B+1]); X[B+2]=EX(X[B+2]); X[B+3]=EX(X[B+3]); PIN(X); SBAR(); }while(0)
  #define VRD(i,PW) do{ if(PW){ vlo[i]=vtr(vpw+sl_prev+((((i)&2)?8192:0)+((i)>>2)*4096+((i)&1)*1024)); vhi[i]=vtr(vpw+sl_prev+((((i)&2)?8192:0)+((i)>>2)*4096+((i)&1)*1024+512)); } \
      else { vlo[i]=vtr(vp0+sl_prev+(((i)>>2)*4096+((i)&3)*1024)); vhi[i]=vtr(vp0+sl_prev+(((i)>>2)*4096+((i)&3)*1024+512)); } }while(0)
  #define KRD(G,j,NW_) do{ if(G){ if(NW_){ kf[2*(j)]=*(const __attribute__((address_space(3))) bf16x8*)(kpw+sl_next+(j)*2048); kf[2*(j)+1]=*(const __attribute__((address_space(3))) bf16x8*)(kpw+sl_next+8192+(j)*2048); } \
      else { kload2(kf,kp0+sl_next,j); } SBAR(); } }while(0)
  #define COLV(r) ((unsigned)(((r)&3)+8*((r)>>2)+nq_vb)<16u)
  #define DECIDE2(C0,C1,WIN_) do{ float a=MX3(C0[0],C0[1],C1[0]),b=MX3(C0[2],C0[3],C1[1]); a=MX3(a,C1[2],C1[3]); \
      _Pragma("unroll") for(int r=4;r<16;r+=4){a=MX3(a,C0[r],C0[r+1]);b=MX3(b,C0[r+2],C0[r+3]);a=MX3(a,C1[r],C1[r+1]);b=MX3(b,C1[r+2],C1[r+3]);} \
      float rm=__builtin_fmaxf(a,b); { auto rr=__builtin_amdgcn_permlane32_swap(__float_as_uint(rm),__float_as_uint(rm),false,false); rm=__builtin_fmaxf(__uint_as_float(rr[0]),__uint_as_float(rr[1])); } \
      resc=false; \
      if(__builtin_expect(__any(rm>(float)THRL),0)){ const float dl=__builtin_fmaxf(rm,0.f); mhat+=dl; \
        _Pragma("unroll") for(int r=0;r<16;++r){C0[r]-=dl;C1[r]-=dl;} \
        _Pragma("unroll") for(int r=0;r<16;++r)negm[r]=((WIN_)&&!COLV(r))?-1e30f:-mhat; asm volatile("":"+v"(negm)); \
        const float f=__builtin_amdgcn_exp2f(-dl); l_reg*=f; if(hi==0)wsf[r32]=f; resc=true; } }while(0)
  #define NBIAS1(C,kr_) do{ const bool rowok_=(unsigned)((kr_)-nq_rs)<8u; const int dr_=min(max((kr_)-nq_r+7,0),14); \
      const float*tb_=btab+(rowok_?dr_*31+nq_lb:513); float b_[16]; \
      _Pragma("unroll") for(int r=0;r<16;++r){ const int kc_=(r&3)+8*(r>>2); b_[r]=tb_[kc_]; } \
      _Pragma("unroll") for(int r=0;r<16;++r){ C[r]+=b_[r]; } \
      SBAR(); }while(0)
  u32x4 zq[4];
  #define NSTEP(C0,C1,P0,P1,t,GK,GV,GL,WIN_,PW,NW_,ZL) do{ SBAR(); \
    VRD(0,PW); SBAR(); float sacc=(P0[0]+P0[1]); \
    GAPA(C0=MFMA(kf[0],qr[0],negm), P0[2],P0[3],P0[4],P0[5],     pw0[0]=PKW(P0,0), pw0[1]=PKW(P0,2), pw0); \
    VRD(4,PW); SBAR(); GAPA(C1=MFMA(kf[1],qr[0],negm), P0[6],P0[7],P0[8],P0[9],     pw0[2]=PKW(P0,4), pw0[3]=PKW(P0,6), pw0); \
    VRD(1,PW); SBAR(); GAPA(C0=MFMA(kf[2],qr[1],C0),   P0[10],P0[11],P0[12],P0[13], pw1[0]=PKW(P0,8), pw1[1]=PKW(P0,10), pw1); \
    VRD(5,PW); SBAR(); GAPA(C1=MFMA(kf[3],qr[1],C1),   P0[14],P0[15],P1[0],P1[1],   pw1[2]=PKW(P0,12),pw1[3]=PKW(P0,14), pw1); \
    VRD(2,PW); SBAR(); GAPA(C0=MFMA(kf[4],qr[2],C0),   P1[2],P1[3],P1[4],P1[5],     pw2[0]=PKW(P1,0), pw2[1]=PKW(P1,2), pw2); \
    VRD(6,PW); SBAR(); GAPA(C1=MFMA(kf[5],qr[2],C1),   P1[6],P1[7],P1[8],P1[9],     pw2[2]=PKW(P1,4), pw2[3]=PKW(P1,6), pw2); \
    VRD(3,PW); SBAR(); GAPA(C0=MFMA(kf[6],qr[3],C0),   P1[10],P1[11],P1[12],P1[13], pw3[0]=PKW(P1,8), pw3[1]=PKW(P1,10), pw3); \
    VRD(7,PW); SBAR(); GAPA(C1=MFMA(kf[7],qr[3],C1),   P1[14],P1[15],0.f,0.f,       pw3[2]=PKW(P1,12),pw3[3]=PKW(P1,14), pw3); \
    l_reg+=sacc; \
    if(GK){DMA_K((t)+3,sl_cur);} if(GV){DMA_V((t)+1,sl_next);} \
    if(ZL){ _Pragma("unroll") for(int i=0;i<4;++i){const int row=i*8+(lane>>3); const long tok=(2*wi+(row>>4))*64+16*wj+(row&15); zq[i]=__builtin_nontemporal_load((const u32x4*)(Zu+tok*YP+(lane&7)*8));} } \
    if(WIN_){ const int krA_=kr0+2*((t)-4); NBIAS1(C0,krA_); NBIAS1(C1,krA_+1); } \
    DECIDE2(C0,C1,WIN_); \
    SBAR(); \
    GAPB(o[0]=MFMA(PAF(0),VFR(0),o[0]), C0,0); \
    GAPB(o[1]=MFMA(PAF(0),VFR(4),o[1]), C0,4); \
    KRD(GL,0,NW_); GAPB(o[0]=MFMA(PAF(1),VFR(1),o[0]), C0,8); \
    KRD(GL,1,NW_); GAPB(o[1]=MFMA(PAF(1),VFR(5),o[1]), C0,12); \
    KRD(GL,2,NW_); GAPB(o[0]=MFMA(PAF(2),VFR(2),o[0]), C1,0); \
    KRD(GL,3,NW_); GAPB(o[1]=MFMA(PAF(2),VFR(6),o[1]), C1,4); \
    GAPB(o[0]=MFMA(PAF(3),VFR(3),o[0]), C1,8); \
    GAPB(o[1]=MFMA(PAF(3),VFR(7),o[1]), C1,12); \
    }while(0)
  #define ENDW(tt) do{ if((tt)+3<NT){WAIT_BAR(4);} else if((tt)+2<NT){WAIT_BAR(2);} else {WAIT_BAR(0);} }while(0)
  NSTEP(pB0,pB1,pA0,pA1,1,true,true,true,false,false,false,false); WAIT_BAR(3); RESC(); ROT();
  NSTEP(pA0,pA1,pB0,pB1,2,true,true,true,false,false,false,false); WAIT_BAR(3); RESC(); ROT();
  NSTEP(pB0,pB1,pA0,pA1,3,true,true,true,false,false,true,false);  WAIT_BAR(4); RESC(); ROT();
  _Pragma("unroll") for(int r=0;r<16;++r)negm[r]=COLV(r)?negm[r]:-1e30f; asm volatile("":"+v"(negm));
  NSTEP(pA0,pA1,pB0,pB1,4,(7<NT),true,true,true,false,true,false); ENDW(4);     RESC(); ROT();
  int t=5;
  for(;t+2<NT;t+=2){
    NSTEP(pB0,pB1,pA0,pA1,t,(t+3<NT),(t+1<NT),(t+1<NT),true,true,true,false);     ENDW(t);   RESC(); ROT();
    NSTEP(pA0,pA1,pB0,pB1,t+1,(t+4<NT),(t+2<NT),(t+2<NT),true,true,true,false);   ENDW(t+1); RESC(); ROT();
  }
  NSTEP(pB0,pB1,pA0,pA1,NT-1,false,false,false,true,true,true,true); RESC();
  { float sacc=pB0[0]+pB0[1]; _Pragma("unroll") for(int r=2;r<16;++r)sacc+=pB0[r]; _Pragma("unroll") for(int r=0;r<16;++r)sacc+=pB1[r]; l_reg+=sacc;
    pw0=(u32x4){PKW(pB0,0),PKW(pB0,2),PKW(pB0,4),PKW(pB0,6)};pw1=(u32x4){PKW(pB0,8),PKW(pB0,10),PKW(pB0,12),PKW(pB0,14)};pw2=(u32x4){PKW(pB1,0),PKW(pB1,2),PKW(pB1,4),PKW(pB1,6)};pw3=(u32x4){PKW(pB1,8),PKW(pB1,10),PKW(pB1,12),PKW(pB1,14)};
    SBAR();
    const int vb=vbw+sl_cur;
    #pragma unroll
    for(int d0=0;d0<2;++d0){s16x4 lo[4],hh[4];
      #pragma unroll
      for(int ks=0;ks<4;++ks){
        asm volatile("ds_read_b64_tr_b16 %0,%1 offset:%c2":"=&v"(lo[ks]):"v"(vb),"i"(((ks&2)?8192:0)+d0*4096+(ks&1)*1024):"memory");
        asm volatile("ds_read_b64_tr_b16 %0,%1 offset:%c2":"=&v"(hh[ks]):"v"(vb),"i"(((ks&2)?8192:0)+d0*4096+(ks&1)*1024+512):"memory");}
      asm volatile("s_waitcnt lgkmcnt(0)":::"memory");SBAR();
      #define PK(k) (bf16x8){lo[k][0],lo[k][1],lo[k][2],lo[k][3],hh[k][0],hh[k][1],hh[k][2],hh[k][3]}
      o[d0]=MFMA(PAF(0),PK(0),o[d0]);
      o[d0]=MFMA(PAF(1),PK(1),o[d0]);
      o[d0]=MFMA(PAF(2),PK(2),o[d0]);
      o[d0]=MFMA(PAF(3),PK(3),o[d0]);
      #undef PK
    } }
  #undef PKW
  #undef PAF
  #undef VFR
  #undef PIN
  #undef MX3
  #undef MFMA
  #undef GAPA
  #undef GAPB
  #undef EX
  #undef VRD
  #undef KRD
  #undef DECIDE2
  #undef COLV
  #undef NBIAS1
  #undef NSTEP
  #undef ENDW
  {auto rr=__builtin_amdgcn_permlane32_swap(__float_as_uint(l_reg),__float_as_uint(l_reg),false,false);l_reg=__uint_as_float(rr[0])+__uint_as_float(rr[1]);}
  if(hi==0)wsf[32+r32]=l_reg;asm volatile("s_waitcnt lgkmcnt(0)":::"memory");
  float rli[16];
  #pragma unroll
  for(int r=0;r<16;++r)rli[r]=__builtin_amdgcn_rcpf(wsf[32+crow(r,hi)]);
  { bf16*stg=(bf16*)(shm+NA_LDS_OST)+wid*2048;
    #pragma unroll
    for(int r=0;r<16;++r){const int orow=crow(r,hi);
      #pragma unroll
      for(int d0=0;d0<2;++d0)stg[orow*64+d0*32+r32]=__float2bfloat16(o[d0][r]*rli[r]);}
    asm volatile("s_waitcnt lgkmcnt(0)":::"memory");
    #pragma unroll
    for(int i=0;i<4;++i){const int row=i*8+(lane>>3),ch=lane&7; const long tok=(2*wi+(row>>4))*64+16*wj+(row&15);
      const u32x4 v=*(const u32x4*)(stg+row*64+ch*8); const u32x4 z=zq[i]; u32x4 w;
      w.x=cvtpk_s(__uint_as_float(v.x<<16)*__uint_as_float(z.x<<16),__uint_as_float(v.x&0xffff0000u)*__uint_as_float(z.x&0xffff0000u));
      w.y=cvtpk_s(__uint_as_float(v.y<<16)*__uint_as_float(z.y<<16),__uint_as_float(v.y&0xffff0000u)*__uint_as_float(z.y&0xffff0000u));
      w.z=cvtpk_s(__uint_as_float(v.z<<16)*__uint_as_float(z.z<<16),__uint_as_float(v.z&0xffff0000u)*__uint_as_float(z.z&0xffff0000u));
      w.w=cvtpk_s(__uint_as_float(v.w<<16)*__uint_as_float(z.w<<16),__uint_as_float(v.w&0xffff0000u)*__uint_as_float(z.w&0xffff0000u));
      *(u32x4*)(Yu+tok*YP+ch*8)=w;} }
  asm volatile("s_waitcnt lgkmcnt(0)\n\ts_barrier":::"memory");
  #undef DMA_K
  #undef DMA_V
  #undef RESC
  #undef ROT
}
#undef SBAR
#undef WAIT_BAR
}

DEVI int p3_rank(const Frame& F) { const int vcu = (F.bid & 7) * (F.G >> 3) + (F.bid >> 3); return ((vcu & 31) < 4) ? -1 : vcu - 4 * ((vcu >> 5) + 1); }
DEVI void p3_wait_deferred(Frame& F) {
    if (F.wave == 0) { unsigned* gate = (unsigned*)(F.ws + WS_PCNT) + 64 * 67; unsigned sp = 0;
        while ((unsigned)__builtin_amdgcn_readfirstlane(__hip_atomic_load(gate, __ATOMIC_RELAXED, __HIP_MEMORY_SCOPE_AGENT)) < 32u) { __builtin_amdgcn_s_sleep(8); if (++sp > (1u << 20)) break; }
        __builtin_amdgcn_fence(__ATOMIC_ACQUIRE, "agent"); }
    asm volatile("s_waitcnt vmcnt(0)" ::: "memory");
    __syncthreads();
}
DEVI void phase_attn0(Frame& F, char* lds_generic) {
    using abf = attn_body::bf16;
    const abf* Q0 = (const abf*)wsb(F, WS_Q0); const abf* K0 = (const abf*)wsb(F, WS_K0); const abf* V0 = (const abf*)wsb(F, WS_V0);
    const abf* SZ = (const abf*)wsb(F, WS_SZ0); abf* Y = (abf*)wsb(F, WS_Y0);
    const int vcu = (F.bid & 7) * (F.G >> 3) + (F.bid >> 3);
    const int rk = p3_rank(F);
    for (int k = 0; k < 3; ++k) {
        int id;
        if (k < 2) id = vcu + k * F.G; else { if (rk < 160) break; id = 512 + (rk - 160); p3_wait_deferred(F); }
        int b, head, NT; size_t row0;
        if (id < 512) { const int qb = id & 7, g = (id >> 3) & 3, kvh = (id >> 5) & 1; b = id >> 6; head = kvh * 4 + g; row0 = (size_t)b * SEQ + qb * 256; NT = NKEY0 / 64; }
        else { const int j = id - 512; b = j >> 3; head = j & 7; row0 = (size_t)MX + b * CTXL; NT = CTXL / 64; }
        const size_t kvoff = (size_t)b * NKEY0 * 128 + (head >> 2) * 64;
        attn_body::attn_unit<8, false, 128>(Q0 + row0 * 512 + head * 64, K0 + kvoff, V0 + kvoff, NT, Y + row0 * 1024 + 512 + head * 64, SZ + row0 * 1024 + 512 + head * 64, lds_generic);
    }
}

DEVI void phase_conv(Frame& F) {
    LAS float* red = (LAS float*)F.lds;
    const bf16* GLU = wsb(F, WS_GLU); const bf16* SZ = wsb(F, WS_SZ0); bf16* Y = wsb(F, WS_Y0);
    const int half = F.wave >> 2, wq = F.wave & 3, c2 = wq * 128 + F.lane * 2;
    typedef float f32x2v __attribute__((ext_vector_type(2)));
    f32x2v wt[31];
#pragma unroll
    for (int t = 0; t < 31; ++t) wt[t] = *(const f32x2v*)(F.in[I_AB_CONVW] + t * 512 + c2);
    const float2 cb = *(const float2*)(F.in[I_AB_CONVB] + c2), lg = *(const float2*)(F.in[I_AB_LNG] + c2), lb = *(const float2*)(F.in[I_AB_LNB] + c2);
    constexpr int NCH = MT / 16;
    const int rk = p3_rank(F);
    bool waited = rk >= 160;
    for (int it = rk; rk >= 0 && it * 2 < NCH; it += 224) {
        if (it * 32 >= MX && !waited) { p3_wait_deferred(F); waited = true; }
        const int ch = it * 2 + half;
        const int row0 = ch * 16;
        int base, len, pos0;
        if (row0 < MX) { base = row0 & ~2047; len = SEQ; pos0 = row0 & 2047; } else { const int rc = row0 - MX; base = MX + (rc & ~255); len = CTXL; pos0 = rc & 255; }
        unsigned gin[46];
#pragma unroll
        for (int pi = 0; pi < 46; ++pi) { const int p = pos0 - 15 + pi, pc = min(max(p, 0), len - 1); gin[pi] = *(const unsigned*)(GLU + (size_t)(base + pc) * 512 + c2); }
#pragma unroll
        for (int pi = 0; pi < 46; ++pi) { const int p = pos0 - 15 + pi; gin[pi] = (p >= 0 && p < len) ? gin[pi] : 0u; }
        unsigned zin[16];
#pragma unroll
        for (int li = 0; li < 16; ++li) zin[li] = __builtin_nontemporal_load((const unsigned*)(SZ + (size_t)(row0 + li) * 1024 + c2));
        f32x2v av[16];
#pragma unroll
        for (int li = 0; li < 16; ++li) av[li] = (f32x2v){cb.x, cb.y};
#pragma unroll
        for (int pi = 0; pi < 46; ++pi) { const f32x2v g = (f32x2v){bflo(gin[pi]), bfhi(gin[pi])};
#pragma unroll
            for (int li = 0; li < 16; ++li) { const int t = pi - li; if (t >= 0 && t <= 30) av[li] = __builtin_elementwise_fma(g, wt[t], av[li]); } }
        float a0[16], a1[16];
#pragma unroll
        for (int li = 0; li < 16; ++li) { a0[li] = av[li].x; a1[li] = av[li].y; }
        float st[32];
#pragma unroll
        for (int li = 0; li < 16; ++li) { st[li] = a0[li] + a1[li]; st[16 + li] = a0[li] * a0[li] + a1[li] * a1[li]; }
#define WS_STEP(ctrl, rmask) _Pragma("unroll") for (int j = 0; j < 32; ++j) st[j] += __builtin_bit_cast(float, __builtin_amdgcn_update_dpp(0, __builtin_bit_cast(int, st[j]), ctrl, rmask, 0xf, true))
        WS_STEP(0xB1, 0xf); WS_STEP(0x4E, 0xf); WS_STEP(0x141, 0xf); WS_STEP(0x140, 0xf); WS_STEP(0x142, 0xa); WS_STEP(0x143, 0xc);
#undef WS_STEP
#pragma unroll
        for (int j = 0; j < 32; ++j) st[j] = __builtin_bit_cast(float, __builtin_amdgcn_readlane(__builtin_bit_cast(int, st[j]), 63));
        __syncthreads();
        if (F.lane < 32) { float v = st[0];
#pragma unroll
            for (int j = 1; j < 32; ++j) v = (F.lane == j) ? st[j] : v;
            red[(half * 4 + wq) * 32 + F.lane] = v; }
        __syncthreads();
#pragma unroll
        for (int li = 0; li < 16; ++li) {
            const LAS float* rp = red + half * 128;
            const float sm = (rp[li] + rp[32 + li]) + (rp[64 + li] + rp[96 + li]), sq = (rp[16 + li] + rp[48 + li]) + (rp[80 + li] + rp[112 + li]);
            const float mean = sm * (1.f / 512.f), var = fmaxf(sq * (1.f / 512.f) - mean * mean, 0.f), rstd = __builtin_amdgcn_rsqf(var + EPS);
            const float y0 = fsilu((a0[li] - mean) * rstd * lg.x + lb.x) * bflo(zin[li]), y1 = fsilu((a1[li] - mean) * rstd * lg.y + lb.y) * bfhi(zin[li]);
            *(unsigned*)(Y + (size_t)(row0 + li) * 1024 + c2) = pk2(y0, y1);
        }
    }
    __syncthreads();
}

constexpr int NA_BTAB_OFF = 133120;
DEVI void na_fill_table(Frame& F, int h) {
    LAS float* bt = (LAS float*)(F.lds + NA_BTAB_OFF);
    const float* rpb = F.in[I_CD_RPB] + h * 15 * 31;
    for (int i = F.tid; i < 544; i += NTHR) bt[i] = (i < 48) ? 0.f : (i < 48 + 465) ? rpb[i - 48] * LOG2E : -1e30f;
}
DEVI void na_unit(Frame& F, char* lds_generic, int id, int& cur_h) {
    using abf = attn_body::bf16;
    const abf* Q1 = (const abf*)wsb(F, WS_Q1); const abf* K1 = (const abf*)wsb(F, WS_K1); const abf* V1 = (const abf*)wsb(F, WS_V1);
    const abf* SZ1 = (const abf*)wsb(F, WS_SZ1); abf* Y1 = (abf*)wsb(F, WS_Y1);
    const int rg = id & 7, h = (id >> 3) & 7, b = id >> 6;
    const int r0 = 4 * rg, kr0 = min(max(r0 - 4, 0), 24), nwin = (rg == 0 || rg == 7) ? 8 : 12;
    if (h != cur_h) { na_fill_table(F, h); cur_h = h; }
    const size_t row0 = (size_t)b * SEQ + r0 * 64;
    attn_body::na_attn_unit<8>(Q1 + row0 * 512 + h * 64, K1 + h * 64, V1 + h * 64, 4 + nwin / 2, Y1 + row0 * 1024 + 512 + h * 64, SZ1 + row0 * 1024 + 512 + h * 64, lds_generic,
                                       (long)MX + b * CTXL, (long)b * SEQ + kr0 * 64, kr0, r0, (const float*)(lds_generic + NA_BTAB_OFF));
}
DEVI void phase_shiftw(Frame& F) {
    LAS float* sh = (LAS float*)F.lds;
    __syncthreads();
    const float* ada1 = wsf(F, WS_ADA) + 9 * 3072;
    for (int i = F.tid; i < 9 * 1024; i += NTHR) sh[i] = ada1[(i >> 10) * 3072 + (i & 1023)];
    __syncthreads();
    const bf16* WT = wsb(F, WS_WIN1); float* sw = wsf(F, WS_SW);
    const int rk = p3_rank(F); const bool light = rk >= 128 && rk < 160;
    const int gw = light ? 1792 + (rk - 128) * NWAVES + F.wave : ((rk < 0) ? F.bid : (rk < 128 ? 32 + rk : rk)) * NWAVES + F.wave;
    const int NGW = 256, nend = light ? N1 : gw + 1;
    for (int n = gw; n < nend; n += NGW) {
        const v4u w0 = *(const v4u*)(WT + (size_t)n * DM + F.lane * 16), w1 = *(const v4u*)(WT + (size_t)n * DM + F.lane * 16 + 8);
        float wv[16] = {bflo(w0.x), bfhi(w0.x), bflo(w0.y), bfhi(w0.y), bflo(w0.z), bfhi(w0.z), bflo(w0.w), bfhi(w0.w), bflo(w1.x), bfhi(w1.x), bflo(w1.y), bfhi(w1.y), bflo(w1.z), bfhi(w1.z), bflo(w1.w), bfhi(w1.w)};
        float a[9];
#pragma unroll
        for (int r = 0; r < 9; ++r) { a[r] = 0.f;
#pragma unroll
            for (int q = 0; q < 4; ++q) { const f32x4 sv = *(const LAS f32x4*)(sh + r * 1024 + F.lane * 16 + 4 * q); a[r] += sv.x * wv[4 * q] + sv.y * wv[4 * q + 1] + sv.z * wv[4 * q + 2] + sv.w * wv[4 * q + 3]; } }
#define WS_STEP(ctrl, rmask) _Pragma("unroll") for (int r = 0; r < 9; ++r) a[r] += __builtin_bit_cast(float, __builtin_amdgcn_update_dpp(0, __builtin_bit_cast(int, a[r]), ctrl, rmask, 0xf, true))
        WS_STEP(0xB1, 0xf); WS_STEP(0x4E, 0xf); WS_STEP(0x141, 0xf); WS_STEP(0x140, 0xf); WS_STEP(0x142, 0xa); WS_STEP(0x143, 0xc);
#undef WS_STEP
        if (F.lane == 63) {
#pragma unroll
            for (int r = 0; r < 9; ++r) sw[r * N1 + n] = a[r]; }
    }
    __syncthreads();
}
__global__ void __launch_bounds__(NTHR, 2) mk_fwd(Args args) {
    extern __shared__ __attribute__((aligned(16))) unsigned char lds[];
    Frame F;
    F.lds = (LAS unsigned char*)lds;
    F.tid = threadIdx.x; F.lane = F.tid & 63; F.wave = __builtin_amdgcn_readfirstlane(F.tid >> 6);
    F.G = gridDim.x; F.bid = blockIdx.x;
#pragma unroll
    for (int i = 0; i < 23; ++i) F.in[i] = args.in[i];
    F.out = args.out; F.ws = args.ws;
    volatile LAS unsigned* MISC = (volatile LAS unsigned*)(F.lds + MISC_OFF);
    if (F.tid < 32) MISC[F.tid] = 0u;
    __syncthreads();
    unsigned* ctl = (unsigned*)(F.ws + WS_CTL);
    XcdBarrier bar; bar.bar = ctl + CW_BAR; bar.x = 0; bar.st = nullptr;
    if (MK_N_LAUNCHES == 1) bar = xcd_barrier_post(ctl + CW_BAR, MISC + 8);
    const int lo = args.ph_lo, hi = args.ph_hi;
#define IN(k) (lo <= (k) && (k) < hi)
    volatile LAS unsigned long long* TS = (volatile LAS unsigned long long*)(F.lds + 146432);
#define STAMP(k) do { if (PROBE_PHASE >= 0 && F.bid == 0 && F.tid == 0) TS[k] = __builtin_amdgcn_s_memrealtime(); } while (0)
#define SEAM(k) do { if (IN(k) && IN((k) + 1)) xcd_barrier(bar); STAMP((k) + 1); } while (0)
    STAMP(0);

    {
        f32x4 xpf[XPF][4];
        if (IN(0)) { p0_prologue(F, xpf); } SEAM(0);
        if (IN(1)) { phase_modnorm(F, 0, xpf); } SEAM(1);
    }
    if (IN(2)) {
        EpiIn0 E{wsb(F, WS_GLU), wsb(F, WS_Q0), wsb(F, WS_K0), wsb(F, WS_V0), wsb(F, WS_SZ0), F.in[I_AB_QNG], F.in[I_AB_KNG], wsf(F, WS_ROPE)};
        pg8::SegOrder S; S.init(pg8::Seg{wsb(F, WS_H), wsb(F, WS_WIN0), 72, 7, 0}, pg8::Seg{wsb(F, WS_H), wsb(F, WS_WIN0) + (size_t)7 * 256 * DM, 64, 4, 1}, pg8::Seg{nullptr, nullptr, 0, 0, 0}, DM, F.G, F.bid);
        pg8::gemm_phase<EpiIn0, pg8::SegOrder>(F.lds, DM, S, E);
        p2_fill_fold(F);
    } SEAM(2);
    if (IN(3)) {
        if (F.bid < 32) {
            EpiIn0 E{wsb(F, WS_GLU), wsb(F, WS_Q0), wsb(F, WS_K0), wsb(F, WS_V0), wsb(F, WS_SZ0), F.in[I_AB_QNG], F.in[I_AB_KNG], wsf(F, WS_ROPE)};
            pg8::SegOrder S; S.init(pg8::Seg{wsb(F, WS_H) + (size_t)64 * 256 * DM, wsb(F, WS_WIN0) + (size_t)7 * 256 * DM, 8, 4, 2}, pg8::Seg{nullptr, nullptr, 0, 0, 0}, pg8::Seg{nullptr, nullptr, 0, 0, 0}, DM, F.G, F.bid);
            pg8::gemm_phase<EpiIn0, pg8::SegOrder>(F.lds, DM, S, E);
            if (F.tid == 0) { __builtin_amdgcn_fence(__ATOMIC_RELEASE, "agent"); asm volatile("s_waitcnt vmcnt(0)" ::: "memory");
                __hip_atomic_fetch_add((unsigned*)(F.ws + WS_PCNT) + 64 * 67, 1u, __ATOMIC_RELAXED, __HIP_MEMORY_SCOPE_AGENT); }
        }
        phase_attn0(F, (char*)lds); STAMP(11); phase_conv(F); phase_shiftw(F); } SEAM(3);
    if (IN(4)) {
        EpiOutX E{F.in[I_X], wsf(F, WS_ADA), wsf(F, WS_ADA) + 9 * 3072, F.in[I_CD_NORMG], (_Float16*)(F.ws + WS_X1H), wsb(F, WS_H), wsf(F, WS_SSQ)};
        pg8::SegOrder S; S.init(pg8::Seg{wsb(F, WS_Y0), wsb(F, WS_WOUT0), 64, 4, 0}, pg8::Seg{nullptr, nullptr, 0, 0, 0}, pg8::Seg{nullptr, nullptr, 0, 0, 0}, DM, F.G, F.bid);
        pg8::gemm_phase<EpiOutX, pg8::SegOrder>(F.lds, DM, S, E);
    } SEAM(4);
    if (IN(5)) {
        EpiIn1 E{wsb(F, WS_PT), wsb(F, WS_Q1), wsb(F, WS_K1), wsb(F, WS_V1), wsb(F, WS_SZ1), wsf(F, WS_SSQ), wsf(F, WS_SW),
                 F.in[I_CTX], wsf(F, WS_ADA), wsf(F, WS_ADA) + 9 * 3072, F.in[I_CD_NORMG], wsb(F, WS_H), wsf(F, WS_SSQ), 0, (unsigned*)(F.ws + WS_PCNT) + 64 * 64};
        pg8::SegOrder S; S.init(pg8::Seg{wsb(F, WS_Y0) + (size_t)MX * DM, wsb(F, WS_WOUT0), 8, 4, 3},
                                pg8::Seg{wsb(F, WS_H), wsb(F, WS_WIN1) + (size_t)1024 * DM, 64, 10, 0},
                                pg8::Seg{wsb(F, WS_WIN1), wsb(F, WS_H), 4, 24, 2}, DM, F.G, F.bid);
        pg8::gemm_phase<EpiIn1, pg8::SegOrder>(F.lds, DM, S, E);
    }
    if (IN(5) && IN(6)) {
        const int c6 = (F.bid + 224) & 255;
        if (c6 >= 160 && c6 < 192) {
            if (F.wave == 0) { unsigned* gate = (unsigned*)(F.ws + WS_PCNT) + 64 * 64; unsigned sp = 0;
                while ((unsigned)__builtin_amdgcn_readfirstlane(__hip_atomic_load(gate, __ATOMIC_RELAXED, __HIP_MEMORY_SCOPE_AGENT)) < 256u) { __builtin_amdgcn_s_sleep(2); if (++sp > (1u << 22)) break; }
                __builtin_amdgcn_fence(__ATOMIC_ACQUIRE, "agent"); }
            asm volatile("s_waitcnt vmcnt(0)" ::: "memory");
            __syncthreads();
        }
    } STAMP(6);
    if (IN(6)) {
        EpiIn1 E{wsb(F, WS_PT), wsb(F, WS_Q1), wsb(F, WS_K1), wsb(F, WS_V1), wsb(F, WS_SZ1), wsf(F, WS_SSQ), wsf(F, WS_SW),
                 F.in[I_CTX], wsf(F, WS_ADA), wsf(F, WS_ADA) + 9 * 3072, F.in[I_CD_NORMG], wsb(F, WS_H), wsf(F, WS_SSQ), 24, (unsigned*)(F.ws + WS_PCNT) + 64 * 64};
        pg8::SegOrder S; S.init(pg8::Seg{wsb(F, WS_WIN1), wsb(F, WS_H) + (size_t)24 * 256 * DM, 4, 40, 2},
                                pg8::Seg{wsb(F, WS_H) + (size_t)MX * DM, wsb(F, WS_WIN1) + (size_t)1536 * DM, 8, 4, 1}, pg8::Seg{nullptr, nullptr, 0, 0, 0}, DM, F.G, (F.bid + 224) & 255);
        pg8::gemm_phase<EpiIn1, pg8::SegOrder>(F.lds, DM, S, E);
        if (((F.bid + 224) & 255) >= 192) p6_filler(F, ((F.bid + 224) & 255) - 192, F.G - 192);
    } SEAM(6);
    if (IN(7)) {
        EpiDft E{wsb(F, WS_Y1), wsb(F, WS_SZ1)};
        pg8::SegOrder S; S.init(pg8::Seg{wsb(F, WS_DFT), wsb(F, WS_PT), 8, 32, 0}, pg8::Seg{nullptr, nullptr, 0, 0, 0}, pg8::Seg{nullptr, nullptr, 0, 0, 0}, 2048, F.G, F.bid);
        pg8::gemm_phase<EpiDft, pg8::SegOrder, true, true>(F.lds, 2048, S, E); STAMP(12);
        phase_nyquist(F);
        {
            const int vcu = (F.bid & 7) * (F.G >> 3) + (F.bid >> 3);
            int cur_h = -1;
            for (int id = vcu; id < 512; id += F.G) na_unit(F, (char*)lds, id, cur_h);
        }
    } SEAM(7);
    if (IN(8)) {
        EpiOutF E{wsf(F, WS_ADA) + 9 * 3072, F.in[I_FNG], (const _Float16*)(F.ws + WS_X1H), F.out, wsf(F, WS_SSQ2), (unsigned*)(F.ws + WS_PCNT)};
        pg8::SegOrder S; S.init(pg8::Seg{wsb(F, WS_Y1), wsb(F, WS_WOUT1), 64, 4, 0}, pg8::Seg{nullptr, nullptr, 0, 0, 0}, pg8::Seg{nullptr, nullptr, 0, 0, 0}, DM, F.G, F.bid);
        if (F.G == 256) pg8::gemm_phase<EpiOutF, pg8::SegOrder>(F.lds, DM, S, E);
    }
    if (PROBE_PHASE >= 0) { STAMP(10); __syncthreads(); if (F.bid == 0 && F.tid == 0) F.out[0] += (float)(TS[PROBE_B] - TS[PROBE_A]) * 0.01f; }
#undef IN
#undef SEAM
}

extern "C" void kernel_launch(void* const* d_in, const int* in_sizes, int n_in, void* d_out, int out_size, void* d_ws, size_t ws_size, hipStream_t stream) {
    static int grid = 0;
    if (grid == 0) {
        if (n_in != 23 || out_size != MX * DM || ws_size < WS_X1H + (size_t)MX * DM * 2) { fprintf(stderr, "kernel_launch: unexpected shapes (n_in %d out %d ws %zu)\n", n_in, out_size, ws_size); grid = -1; return; }
        int dev = 0, cus = 0, per_cu = 0;
        if (hipGetDevice(&dev) != hipSuccess || hipDeviceGetAttribute(&cus, hipDeviceAttributeMultiprocessorCount, dev) != hipSuccess) { grid = -1; return; }
        if (hipFuncSetAttribute((const void*)mk_fwd, hipFuncAttributeMaxDynamicSharedMemorySize, LDS_BYTES) != hipSuccess) { fprintf(stderr, "kernel_launch: hipFuncSetAttribute failed\n"); grid = -1; return; }
        if (hipOccupancyMaxActiveBlocksPerMultiprocessor(&per_cu, (const void*)mk_fwd, NTHR, LDS_BYTES) != hipSuccess || per_cu < 1) { fprintf(stderr, "kernel_launch: occupancy query says %d\n", per_cu); per_cu = 1; }
        (void)hipGetLastError();
        grid = cus;
    }
    if (grid < 0) return;
    if (hipMemsetAsync((char*)d_ws + WS_CTL, 0, CTL_ZERO_BYTES, stream) != hipSuccess) { fprintf(stderr, "kernel_launch: memset failed\n"); return; }
    Args a{};
    for (int i = 0; i < 23; ++i) a.in[i] = (const float*)d_in[i];
    a.out = (float*)d_out; a.ws = (unsigned char*)d_ws;
    for (int li = 0; li < MK_N_LAUNCHES; ++li) {
        if (MK_N_LAUNCHES == 1) { a.ph_lo = 0; a.ph_hi = NPHASES; } else { a.ph_lo = li; a.ph_hi = li + 1; }
        a.li = li;
        hipLaunchKernelGGL(mk_fwd, dim3(grid), dim3(NTHR), LDS_BYTES, stream, a);
        const hipError_t le = hipPeekAtLastError();
        if (le != hipSuccess) { fprintf(stderr, "kernel_launch: launch %d failed: %s\n", li, hipGetErrorName(le)); break; }
    }
}
```

```cpp
#include <hip/hip_runtime.h>
#include <cstdio>
#include <cstdint>
#include <hip/hip_bf16.h>

#ifndef PROBE_PHASE
#define PROBE_PHASE -1
#define PROBE_A 0
#define PROBE_B 1
#endif
#ifndef MK_N_LAUNCHES
#define MK_N_LAUNCHES 1
#endif

#define GAS __attribute__((address_space(1)))
#define LAS __attribute__((address_space(3)))
typedef unsigned short bf16;
typedef unsigned v4u __attribute__((ext_vector_type(4)));
typedef float f32x4 __attribute__((ext_vector_type(4)));
typedef GAS unsigned gu32;
#define RLX_AGENT __ATOMIC_RELAXED, __HIP_MEMORY_SCOPE_AGENT
#define LDS_WAIT() asm volatile("s_waitcnt lgkmcnt(0)" ::: "memory")
#define DEVI __device__ __forceinline__

constexpr int NB = 8, SEQ = 2048, DM = 1024, CTXL = 256, GRIDW = 64;
constexpr int MX = NB * SEQ, MC = NB * CTXL, MT = MX + MC;
constexpr int AB_IN = 2816, CD_IN = 3072, N1 = 3584;
constexpr int NKEY0 = CTXL + SEQ;
constexpr float EPS = 1e-6f;
constexpr float LOG2E = 1.4426950408889634f, C2 = 0.125f * LOG2E;
constexpr int NWAVES = 8, NTHR = 512;
constexpr int NPHASES = 10;

constexpr size_t MiB = 1u << 20;
constexpr size_t WS_CTL = 0, CTL_ZERO_BYTES = 1 * MiB;
constexpr size_t WS_ADA = 256 * 1024;
constexpr size_t WS_SSQ = 512 * 1024;
constexpr size_t WS_SSQ2 = 640 * 1024;
constexpr size_t WS_PCNT = 768 * 1024;
constexpr size_t WS_SW = 2 * MiB;
constexpr size_t WS_ROPE = 1 * MiB;
constexpr size_t WS_MCS = 1 * MiB + 512 * 1024;
constexpr size_t WS_WIN0 = 3 * MiB, WS_WOUT0 = 9 * MiB, WS_WIN1 = 11 * MiB, WS_WOUT1 = 18 * MiB;
constexpr size_t WS_DFT = 20 * MiB;
constexpr size_t WS_H = 36 * MiB;
constexpr size_t WS_R = 72 * MiB;
constexpr size_t WS_X1H = 224 * MiB;
constexpr size_t WS_GLU = WS_R, WS_Q0 = WS_R + 18 * MiB, WS_K0 = WS_R + 36 * MiB, WS_V0 = WS_K0 + 4608 * 1024, WS_SZ0 = WS_R + 45 * MiB;
constexpr size_t WS_Y0 = WS_R + 116 * MiB;
constexpr size_t WS_PT = WS_R, WS_Q1 = WS_R + 32 * MiB, WS_K1 = WS_R + 48 * MiB, WS_V1 = WS_R + 66 * MiB, WS_SZ1 = WS_R + 84 * MiB, WS_Y1 = WS_R + 116 * MiB;
constexpr size_t WS_END = WS_R + 152 * MiB;
static_assert(WS_END <= WS_X1H && WS_X1H + (size_t)MX * DM * 2 <= 256 * MiB, "d_ws map");
constexpr int CW_BAR = 4096;

constexpr int LDS_BYTES = 147456;
constexpr int MISC_OFF = 145408;

DEVI unsigned f2bf(float f) { unsigned u = __builtin_bit_cast(unsigned, f); return (u + 0x7fffu + ((u >> 16) & 1u)) >> 16; }
DEVI unsigned pk2(float lo, float hi) { return f2bf(lo) | (f2bf(hi) << 16); }
DEVI float bf2f(unsigned b) { return __builtin_bit_cast(float, (b & 0xffffu) << 16); }
DEVI float bflo(unsigned w) { return __builtin_bit_cast(float, w << 16); }
DEVI float bfhi(unsigned w) { return __builtin_bit_cast(float, w & 0xffff0000u); }
DEVI float siluf(float v) { return v / (1.f + expf(-v)); }
DEVI float sigmf(float v) { return 1.f / (1.f + expf(-v)); }
DEVI float wave_sum_dpp(float v) {
#define WS_DPP(ctrl, rmask) v += __builtin_bit_cast(float, __builtin_amdgcn_update_dpp(0, __builtin_bit_cast(int, v), ctrl, rmask, 0xf, true))
    WS_DPP(0xB1, 0xf);
    WS_DPP(0x4E, 0xf);
    WS_DPP(0x141, 0xf);
    WS_DPP(0x140, 0xf);
    WS_DPP(0x142, 0xa);
    WS_DPP(0x143, 0xc);
#undef WS_DPP
    return __builtin_bit_cast(float, __builtin_amdgcn_readlane(__builtin_bit_cast(int, v), 63));
}
DEVI float sum_fq(float v) {
    { auto r = __builtin_amdgcn_permlane16_swap(__float_as_uint(v), __float_as_uint(v), false, false); v = __uint_as_float(r[0]) + __uint_as_float(r[1]); }
    { auto r = __builtin_amdgcn_permlane32_swap(__float_as_uint(v), __float_as_uint(v), false, false); v = __uint_as_float(r[0]) + __uint_as_float(r[1]); }
    return v;
}
DEVI float wave_sum(float v) {
#pragma unroll
    for (int o = 1; o < 64; o <<= 1) v += __shfl_xor(v, o);
    return v;
}

#define XB_TMO      128
#define XB_XCNT(j)  (256  + 64 * (j))
#define XB_XSUB(j)  (1280 + 64 * (j))
#define XB_XGEN(j)  (2304 + 64 * (j))
#define XB_TOP      3328
#define XB_TOPGEN   3392
#define XCD_BAR_WORDS 3456
#define XB_SPIN_CAP (1u << 22)
DEVI unsigned xb_ld(unsigned* p)              { return __hip_atomic_load(p, __ATOMIC_RELAXED, __HIP_MEMORY_SCOPE_AGENT); }
DEVI unsigned xb_add(unsigned* p, unsigned v) { return __hip_atomic_fetch_add(p, v, __ATOMIC_RELAXED, __HIP_MEMORY_SCOPE_AGENT); }
DEVI unsigned xb_xcc_id() { return (unsigned)__builtin_amdgcn_s_getreg((3 << 11) | 20) & 0xFu; }
#define XB_SPIN(cond, bar) do { unsigned _sp = 0; while (cond) { __builtin_amdgcn_s_sleep(1); \
    if ((++_sp & 255u) == 0u) { if (xb_ld(&(bar)[XB_TMO])) break; if (_sp > XB_SPIN_CAP) { atomicAdd(&(bar)[XB_TMO], 1u); break; } } } } while (0)
struct XcdBarrier { unsigned* bar; unsigned x; volatile LAS unsigned* st; };
DEVI XcdBarrier xcd_barrier_post(unsigned* bar, volatile LAS unsigned* st) {
    XcdBarrier b; b.bar = bar; b.x = xb_xcc_id(); b.st = st;
    if (threadIdx.x == 0) (void)xb_add(&bar[XB_XCNT(b.x)], 1u);
    return b;
}
DEVI void xcd_barrier_complete(unsigned* bar, unsigned x, unsigned& nloc, unsigned& nx) {
    const unsigned G = gridDim.x * gridDim.y * gridDim.z;
    unsigned sum, cnt, mine, sp = 0u;
    for (;;) {
        sum = 0u; cnt = 0u; mine = 0u;
#pragma unroll
        for (unsigned j = 0; j < 16; ++j) { const unsigned c = xb_ld(&bar[XB_XCNT(j)]); sum += c; cnt += (c > 0u) ? 1u : 0u; mine = (j == x) ? c : mine; }
        if (sum == G) break;
        __builtin_amdgcn_s_sleep(1);
        if ((++sp & 255u) == 0u) { if (xb_ld(&bar[XB_TMO])) break; if (sp > XB_SPIN_CAP) { atomicAdd(&bar[XB_TMO], 1u); break; } }
    }
    nloc = mine > 0u ? mine : 1u; nx = cnt > 0u ? cnt : 1u;
}
DEVI void xcd_barrier(const XcdBarrier& b) {
    asm volatile("s_waitcnt vmcnt(0)" ::: "memory");
    __syncthreads();
    if (threadIdx.x == 0) {
        unsigned* bar = b.bar;
        __builtin_amdgcn_s_waitcnt(0);
        unsigned nloc = b.st[0], nx = b.st[1];
        if (nloc == 0u) { xcd_barrier_complete(bar, b.x, nloc, nx); b.st[0] = nloc; b.st[1] = nx; }
        const unsigned old = xb_add(&bar[XB_XSUB(b.x)], 1u);
        const unsigned gen = old / nloc;
        if (old + 1u == (gen + 1u) * nloc) {
            __builtin_amdgcn_fence(__ATOMIC_RELEASE, "agent");
            asm volatile("s_waitcnt vmcnt(0)" ::: "memory");
            const unsigned og = xb_add(&bar[XB_TOP], 1u);
            const unsigned tg = og / nx;
            if (og + 1u == (tg + 1u) * nx) xb_add(&bar[XB_TOPGEN], 1u);
            else XB_SPIN(xb_ld(&bar[XB_TOPGEN]) == tg, bar);
            __builtin_amdgcn_fence(__ATOMIC_ACQUIRE, "agent");
            xb_add(&bar[XB_XGEN(b.x)], 1u);
            asm volatile("s_waitcnt vmcnt(0)" ::: "memory");
        } else {
            asm volatile("buffer_inv sc1" ::: "memory");
            XB_SPIN(xb_ld(&bar[XB_XGEN(b.x)]) == gen, bar);
            asm volatile("s_waitcnt vmcnt(0)" ::: "memory");
        }
    }
    __syncthreads();
}

struct Args { const float* in[23]; float* out; unsigned char* ws; int ph_lo, ph_hi, li, pad; };
enum { I_X = 0, I_C, I_CTX, I_CCTX, I_AB_WADA, I_AB_BADA, I_AB_NORMG, I_AB_WIN, I_AB_CONVW, I_AB_CONVB, I_AB_LNG, I_AB_LNB, I_AB_QNG, I_AB_KNG, I_AB_WOUT,
       I_CD_WADA, I_CD_BADA, I_CD_NORMG, I_CD_WIN, I_CD_WF, I_CD_RPB, I_CD_WOUT, I_FNG };

struct Frame {
    LAS unsigned char* lds;
    int tid, lane, wave, G, bid;
    const float* in[23]; float* out; unsigned char* ws;
};
DEVI bf16* wsb(const Frame& F, size_t off) { return (bf16*)(F.ws + off); }
DEVI float* wsf(const Frame& F, size_t off) { return (float*)(F.ws + off); }

DEVI float block_sum(float v, LAS float* red, int lane, int wave) {
    v = wave_sum(v);
    __syncthreads();
    if (lane == 0) red[wave] = v;
    __syncthreads();
    float s = 0.f;
#pragma unroll
    for (int i = 0; i < NWAVES; ++i) s += red[i];
    return s;
}

DEVI void transpose_load(float (&tv)[32], const float* W, int ldw, int c0, int ncols, int item, int lane) {
    const int nblk = ncols / 32, kb = item / nblk, nb = item % nblk, k0 = 64 * kb, n0 = 32 * nb;
#pragma unroll
    for (int i = 0; i < 32; ++i) { const int kk = 2 * i + (lane >> 5); tv[i] = __builtin_nontemporal_load(W + (size_t)(k0 + kk) * ldw + c0 + n0 + (lane & 31)); }
}
template <class Map>
DEVI void transpose_store(const float (&tv)[32], int ncols, int K, bf16* WT, Map map32, LAS float* scr, int item, int lane) {
    const int nblk = ncols / 32, kb = item / nblk, nb = item % nblk, k0 = 64 * kb;
#pragma unroll
    for (int i = 0; i < 32; ++i) { const int kk = 2 * i + (lane >> 5); scr[kk * 33 + (lane & 31)] = tv[i]; }
    LDS_WAIT(); asm volatile("" ::: "memory");
    const int c = lane & 7;
    const int drow0 = map32(nb) * 32;
#pragma unroll
    for (int j = 0; j < 4; ++j) { const int n = (lane >> 3) + 8 * j; const LAS float* s = scr + (8 * c) * 33 + n;
        v4u o; o.x = pk2(s[0 * 33], s[1 * 33]); o.y = pk2(s[2 * 33], s[3 * 33]); o.z = pk2(s[4 * 33], s[5 * 33]); o.w = pk2(s[6 * 33], s[7 * 33]);
        *(v4u*)(WT + (size_t)(drow0 + n) * K + k0 + 8 * c) = o; }
    LDS_WAIT(); asm volatile("" ::: "memory");
}
template <class Map>
DEVI void transpose_item(const float* W, int ldw, int c0, int ncols, int K, bf16* WT, Map map32, LAS float* scr, int item, int lane) {
    float tv[32];
    transpose_load(tv, W, ldw, c0, ncols, item, lane);
    transpose_store(tv, ncols, K, WT, map32, scr, item, lane);
}
struct MapId { int off; DEVI int operator()(int nb) const { return nb + off; } };
struct MapIn0 { DEVI int operator()(int sb) const {
    if (sb < 16) return 8 * (sb >> 2) + (sb & 3);
    if (sb < 32) { const int cb = sb - 16; return 8 * (cb >> 2) + 4 + (cb & 3); }
    if (sb < 48) { const int qb = sb - 32, head = qb >> 1, bj = qb & 1; return 8 * (4 + (head >> 2)) + 4 * bj + (head & 3); }
    if (sb < 52) { const int kb = sb - 48; return 48 + 4 * (kb & 1) + (kb >> 1); }
    if (sb < 56) { const int vb = sb - 52; return 48 + 4 * (vb & 1) + 2 + (vb >> 1); }
    return sb; } };

DEVI void ada_item_load(const Frame& F, int it, float (&w)[64]) {
    const int l = it / 768, rem = it % 768, cc = rem >> 4, kc = rem & 15;
    const float* W = l ? F.in[I_CD_WADA] : F.in[I_AB_WADA];
    const float* rowp = W + (size_t)(kc * 64) * 3072 + cc * 64;
#pragma unroll
    for (int k = 0; k < 64; ++k) w[k] = __builtin_nontemporal_load(rowp + (size_t)k * 3072 + F.lane);
}
DEVI void ada_item_finish(const Frame& F, int it, const float (&w)[64], const LAS float* sl) {
    const int l = it / 768, rem = it % 768, cc = rem >> 4, kc = rem & 15;
    const float* bb = l ? F.in[I_CD_BADA] : F.in[I_AB_BADA];
    const int col = cc * 64 + F.lane;
    const float bv = (kc == 0) ? bb[col] : 0.f;
    float s[9];
#pragma unroll
    for (int r = 0; r < 9; ++r) s[r] = 0.f;
#pragma unroll
    for (int k4 = 0; k4 < 64; k4 += 4) {
#pragma unroll
        for (int r = 0; r < 9; ++r) { const f32x4 sv = *(const LAS f32x4*)(sl + r * 1024 + kc * 64 + k4); s[r] += sv.x * w[k4] + sv.y * w[k4 + 1] + sv.z * w[k4 + 2] + sv.w * w[k4 + 3]; }
    }
    float* ada = wsf(F, WS_ADA);
#pragma unroll
    for (int r = 0; r < 9; ++r) atomicAdd(&ada[(l * 9 + r) * 3072 + col], s[r] + bv);
}
constexpr int XPF = 5;
DEVI const float* modnorm_rowptr(const Frame& F, int m) { return (m < MX) ? F.in[I_X] + (size_t)m * DM : F.in[I_CTX] + (size_t)(m - MX) * DM; }
DEVI void p0_prologue(Frame& F, f32x4 (&xpf)[XPF][4]) {
    LAS float* sl = (LAS float*)F.lds;
    LAS float* scr = (LAS float*)(F.lds + 40960 + F.wave * 8448);
    const int gw = F.bid * NWAVES + F.wave, NGW = F.G * NWAVES;
    constexpr int N_ADA = 2 * 48 * 16, N_TR = 16 * (AB_IN / 32);
    float cv[18];
#pragma unroll
    for (int j = 0; j < 16; ++j) cv[j] = F.in[I_C][F.tid + 512 * j];
    cv[16] = F.in[I_CCTX][F.tid]; cv[17] = F.in[I_CCTX][F.tid + 512];
    const int it_a = min(gw, N_ADA - 1), it_t = min(gw, N_TR - 1), it_m = min(F.bid, 255);
    float w[64]; ada_item_load(F, it_a, w);
    float tv[32]; transpose_load(tv, F.in[I_AB_WIN], AB_IN, 0, AB_IN, it_t, F.lane);
    const float* wf = F.in[I_CD_WF];
    f32x4 wfv[8];
#pragma unroll
    for (int j = 0; j < 8; ++j) wfv[j] = *(const f32x4*)(wf + (size_t)((it_m >> 5) & 3) * 128 * 128 + 4 * (F.tid + 512 * j));
#pragma unroll
    for (int j = 0; j < 18; ++j) sl[F.tid + 512 * j] = siluf(cv[j]);
    __syncthreads();
    if (gw < N_ADA) ada_item_finish(F, gw, w, sl);
    for (int it = gw + NGW; it < N_ADA; it += NGW) { float w2[64]; ada_item_load(F, it, w2); ada_item_finish(F, it, w2, sl); }
#pragma unroll
    for (int k = 0; k < XPF; ++k) { const float* xr = modnorm_rowptr(F, min(gw * 9 + k, MT - 1));
#pragma unroll
        for (int j = 0; j < 4; ++j) xpf[k][j] = __builtin_nontemporal_load((const f32x4*)(xr + 4 * F.lane + 256 * j)); }
    if (gw < N_TR) transpose_store(tv, AB_IN, DM, wsb(F, WS_WIN0), MapIn0{}, scr, gw, F.lane);
    for (int it = gw + NGW; it < N_TR; it += NGW) transpose_item(F.in[I_AB_WIN], AB_IN, 0, AB_IN, DM, wsb(F, WS_WIN0), MapIn0{}, scr, it, F.lane);
    {
        float* rope = wsf(F, WS_ROPE);
        for (int i = gw * 64 + F.lane; i < SEQ * 32; i += NGW * 64) {
            const int t = i >> 5, p = i & 31; const int fi = p & 15;
            const float inv = exp2f(-(float)fi * (13.287712379549449f / 16.0f));
            const float pos = (float)((p < 16) ? (t / GRIDW) : (t % GRIDW));
            const float ang = pos * inv; float sn, cs; sincosf(ang, &sn, &cs);
            rope[2 * i] = cs; rope[2 * i + 1] = sn;
        }
    }
    __syncthreads();
    {
        LAS float* t128 = (LAS float*)F.lds;
        LAS float* wl = t128 + 256;
        if (F.tid < 128) { t128[F.tid] = cospif((float)F.tid * (1.f / 64.f)); t128[128 + F.tid] = sinpif((float)F.tid * (1.f / 64.f)); }
        float* mcs = wsf(F, WS_MCS);
        bool first = true;
        for (int it = F.bid; it < 2 * 4 * 32; it += F.G) {
            const int c4 = it & 31, g = (it >> 5) & 3, cs = it >> 7;
            if (first) {
#pragma unroll
                for (int j = 0; j < 8; ++j) *(LAS f32x4*)(wl + 4 * (F.tid + 512 * j)) = wfv[j];
            } else {
                __syncthreads();
                for (int i = F.tid; i < 128 * 128 / 4; i += NTHR) *(LAS f32x4*)(wl + 4 * i) = *(const f32x4*)(wf + (size_t)g * 128 * 128 + 4 * i);
            }
            first = false;
            __syncthreads();
            const int e = F.tid & 127, c = c4 * 4 + (F.tid >> 7);
            float sacc = 0.f;
#pragma unroll 8
            for (int cp = 0; cp < 128; ++cp) sacc += t128[cs * 128 + ((c * cp) & 127)] * wl[cp * 128 + e];
            mcs[((size_t)(cs * 4 + g) * 128 + c) * 128 + e] = sacc * (1.f / 512.f);
        }
        __syncthreads();
    }
}
DEVI void p2_filler(Frame& F, int ib, int nib) {
    LAS float* scr = (LAS float*)(F.lds + F.wave * 16384);
    const int gw = ib * NWAVES + F.wave, NGW = nib * NWAVES;
    constexpr int I1 = 16 * 32, I2 = 16 * ((CD_IN - 512) / 32);
    for (int it = gw; it < I1 + I2; it += NGW) {
        if (it < I1) transpose_item(F.in[I_AB_WOUT], DM, 0, DM, DM, wsb(F, WS_WOUT0), MapId{0}, scr, it, F.lane);
        else transpose_item(F.in[I_CD_WIN], CD_IN, 512, CD_IN - 512, DM, wsb(F, WS_WIN1), MapId{32}, scr, it - I1, F.lane);
    }
    __syncthreads();
}
DEVI void p6_filler(Frame& F, int ib, int nib) {
    LAS float* scr = (LAS float*)(F.lds + F.wave * 16384);
    const int gw = ib * NWAVES + F.wave, NGW = nib * NWAVES;
    for (int it = gw; it < 16 * 32; it += NGW) transpose_item(F.in[I_CD_WOUT], DM, 0, DM, DM, wsb(F, WS_WOUT1), MapId{0}, scr, it, F.lane);
    __syncthreads();
    {
        LAS float* t2k = (LAS float*)F.lds;
        for (int i = F.tid; i < 2048; i += NTHR) { t2k[i] = cospif((float)i * (1.f / 1024.f)); t2k[2048 + i] = sinpif((float)i * (1.f / 1024.f)); }
        __syncthreads();
        bf16* A = wsb(F, WS_DFT);
        for (int i = ib * NTHR + F.tid; i < 2048 * 256; i += nib * NTHR) {
            const int row = i >> 8, k0 = (i & 255) * 8; const int pm = row >> 8, rr = row & 255, lp = 128 * pm + (rr & 127), tsel = (rr >> 7) * 2048; float v[8];
#pragma unroll
            for (int j = 0; j < 8; ++j) v[j] = t2k[tsel + ((lp * (k0 + j)) & 2047)];
            v4u o; o.x = pk2(v[0], v[1]); o.y = pk2(v[2], v[3]); o.z = pk2(v[4], v[5]); o.w = pk2(v[6], v[7]);
            *(v4u*)(A + (size_t)row * 2048 + k0) = o;
        }
        __syncthreads();
    }
}

DEVI void modnorm_row(const float* xrow, bf16* orow, const float* g, const float* shift, const float* scale, int lane) {
    f32x4 v[4]; float ss = 0.f;
#pragma unroll
    for (int j = 0; j < 4; ++j) { v[j] = *(const f32x4*)(xrow + 4 * lane + 256 * j); ss += (v[j].x * v[j].x + v[j].y * v[j].y) + (v[j].z * v[j].z + v[j].w * v[j].w); }
    const float rinv = 1.0f / sqrtf(wave_sum(ss) * (1.f / DM) + EPS);
#pragma unroll
    for (int j = 0; j < 4; ++j) {
        const int c = 4 * lane + 256 * j;
        const f32x4 gg = *(const f32x4*)(g + c), sh = *(const f32x4*)(shift + c), sc = *(const f32x4*)(scale + c);
        const float o0 = v[j].x * rinv * gg.x * (1.f + sc.x) + sh.x, o1 = v[j].y * rinv * gg.y * (1.f + sc.y) + sh.y;
        const float o2 = v[j].z * rinv * gg.z * (1.f + sc.z) + sh.z, o3 = v[j].w * rinv * gg.w * (1.f + sc.w) + sh.w;
        *(unsigned long long*)(orow + c) = (unsigned long long)pk2(o0, o1) | ((unsigned long long)pk2(o2, o3) << 32);
    }
}
DEVI void phase_modnorm(Frame& F, int layer, const f32x4 (&xpf)[XPF][4]) {
    const int gw = F.bid * NWAVES + F.wave;
    const float* ada = wsf(F, WS_ADA) + layer * 9 * 3072;
    const float* g = layer ? F.in[I_CD_NORMG] : F.in[I_AB_NORMG];
    bf16* H = wsb(F, WS_H);
    constexpr int RPW = MT / (256 * NWAVES);
    const int m0 = gw * RPW;
    f32x4 gm[4], sh[4];
    int rcur = (m0 < MX) ? (m0 >> 11) : 8;
    { const float* shift = ada + rcur * 3072; const float* scale = shift + 1024;
#pragma unroll
      for (int j = 0; j < 4; ++j) { const int c = 4 * F.lane + 256 * j; gm[j] = *(const f32x4*)(g + c) * (*(const f32x4*)(scale + c) + 1.0f); sh[j] = *(const f32x4*)(shift + c); } }
    f32x4 rest[RPW - XPF][4];
#pragma unroll
    for (int k = XPF; k < RPW; ++k) { const float* xr = modnorm_rowptr(F, m0 + k);
#pragma unroll
        for (int j = 0; j < 4; ++j) rest[k - XPF][j] = __builtin_nontemporal_load((const f32x4*)(xr + 4 * F.lane + 256 * j)); }
#pragma unroll
    for (int k = 0; k < RPW; ++k) {
        const int m = m0 + k;
        f32x4 v[4];
#pragma unroll
        for (int j = 0; j < 4; ++j) v[j] = (k < XPF) ? xpf[k < XPF ? k : 0][j] : rest[k < XPF ? 0 : k - XPF][j];
        const int r = (m < MX) ? (m >> 11) : 8;
        if (r != rcur) { rcur = r; const float* shift = ada + r * 3072; const float* scale = shift + 1024;
#pragma unroll
            for (int j = 0; j < 4; ++j) { const int c = 4 * F.lane + 256 * j; gm[j] = *(const f32x4*)(g + c) * (*(const f32x4*)(scale + c) + 1.0f); sh[j] = *(const f32x4*)(shift + c); } }
        float ss = 0.f;
#pragma unroll
        for (int j = 0; j < 4; ++j) ss += (v[j].x * v[j].x + v[j].y * v[j].y) + (v[j].z * v[j].z + v[j].w * v[j].w);
        const float rinv = __builtin_amdgcn_rsqf(wave_sum_dpp(ss) * (1.f / DM) + EPS);
        bf16* orow = H + (size_t)m * DM;
#pragma unroll
        for (int j = 0; j < 4; ++j) {
            const int c = 4 * F.lane + 256 * j;
            const f32x4 o = v[j] * rinv * gm[j] + sh[j];
            __builtin_nontemporal_store((unsigned long long)pk2(o[0], o[1]) | ((unsigned long long)pk2(o[2], o[3]) << 32), (unsigned long long*)(orow + c));
        }
    }
}
DEVI void phase_fold(Frame& F, int ib, int nib) {
    const float* mcs = wsf(F, WS_MCS); const float* W = F.in[I_CD_WIN]; bf16* WT = wsb(F, WS_WIN1);
    LAS float* Ms = (LAS float*)F.lds;
    LAS float* Ws = Ms + 128 * 128;
    for (int it = ib; it < 8 * 32; it += nib) {
        const int kc = it & 31, g = (it >> 5) & 3, cs = it >> 7, k0 = kc * 32;
        __syncthreads();
        const float* mp = mcs + (size_t)(cs * 4 + g) * 128 * 128;
        for (int i = F.tid; i < 128 * 128 / 4; i += NTHR) *(LAS f32x4*)(Ms + 4 * i) = *(const f32x4*)(mp + 4 * i);
        for (int i = F.tid; i < 32 * 128; i += NTHR) { const int k = i >> 7, c = i & 127; Ws[c * 32 + k] = W[(size_t)(k0 + k) * CD_IN + g * 128 + c]; }
        __syncthreads();
        const int e = F.tid & 127, kq = F.tid >> 7;
        float acc[8];
#pragma unroll
        for (int j = 0; j < 8; ++j) acc[j] = 0.f;
#pragma unroll 4
        for (int c = 0; c < 128; ++c) { const float mv = Ms[c * 128 + e]; const f32x4 w0 = *(const LAS f32x4*)(Ws + c * 32 + kq * 8), w1 = *(const LAS f32x4*)(Ws + c * 32 + kq * 8 + 4);
            acc[0] += mv * w0.x; acc[1] += mv * w0.y; acc[2] += mv * w0.z; acc[3] += mv * w0.w; acc[4] += mv * w1.x; acc[5] += mv * w1.y; acc[6] += mv * w1.z; acc[7] += mv * w1.w; }
        v4u o; o.x = pk2(acc[0], acc[1]); o.y = pk2(acc[2], acc[3]); o.z = pk2(acc[4], acc[5]); o.w = pk2(acc[6], acc[7]);
        *(v4u*)(WT + (size_t)(cs * 512 + g * 128 + e) * DM + k0 + kq * 8) = o;
    }
    __syncthreads();
}

DEVI void p2_fill_fold(Frame& F) {
    LAS float* scr = (LAS float*)(F.lds + F.wave * 16384);
    const int gw = F.bid * NWAVES + F.wave, NGW = F.G * NWAVES;
    constexpr int I1 = 16 * 32, I2 = 16 * ((CD_IN - 512) / 32), NI = I1 + I2;
    const float* mcs = wsf(F, WS_MCS); const float* W = F.in[I_CD_WIN]; bf16* WT = wsb(F, WS_WIN1);
    const int it_t = min(gw, NI - 1), it_f = min(F.bid, 255);
    float tv[32];
    if (it_t < I1) transpose_load(tv, F.in[I_AB_WOUT], DM, 0, DM, it_t, F.lane); else transpose_load(tv, F.in[I_CD_WIN], CD_IN, 512, CD_IN - 512, it_t - I1, F.lane);
    const int kc = it_f & 31, g = (it_f >> 5) & 3, cs = it_f >> 7, k0 = kc * 32;
    f32x4 mv8[8]; float wv8[8];
    { const float* mp = mcs + (size_t)(cs * 4 + g) * 128 * 128;
#pragma unroll
      for (int j = 0; j < 8; ++j) mv8[j] = *(const f32x4*)(mp + 4 * (F.tid + 512 * j));
#pragma unroll
      for (int j = 0; j < 8; ++j) { const int i = F.tid + 512 * j, k = i >> 7, c = i & 127; wv8[j] = W[(size_t)(k0 + k) * CD_IN + g * 128 + c]; } }
    if (gw < NI) { if (gw < I1) transpose_store(tv, DM, DM, wsb(F, WS_WOUT0), MapId{0}, scr, gw, F.lane); else transpose_store(tv, CD_IN - 512, DM, wsb(F, WS_WIN1), MapId{32}, scr, gw - I1, F.lane); }
    for (int it = gw + NGW; it < NI; it += NGW) {
        if (it < I1) transpose_item(F.in[I_AB_WOUT], DM, 0, DM, DM, wsb(F, WS_WOUT0), MapId{0}, scr, it, F.lane);
        else transpose_item(F.in[I_CD_WIN], CD_IN, 512, CD_IN - 512, DM, wsb(F, WS_WIN1), MapId{32}, scr, it - I1, F.lane);
    }
    __syncthreads();
    LAS float* Ms = (LAS float*)F.lds;
    LAS float* Ws = Ms + 128 * 128;
    bool first = true;
    for (int it = F.bid; it < 8 * 32; it += F.G) {
        const int kc2 = it & 31, g2 = (it >> 5) & 3, cs2 = it >> 7, k02 = kc2 * 32;
        if (first) {
#pragma unroll
            for (int j = 0; j < 8; ++j) *(LAS f32x4*)(Ms + 4 * (F.tid + 512 * j)) = mv8[j];
#pragma unroll
            for (int j = 0; j < 8; ++j) { const int i = F.tid + 512 * j, k = i >> 7, c = i & 127; Ws[c * 32 + k] = wv8[j]; }
        } else {
            __syncthreads();
            const float* mp = mcs + (size_t)(cs2 * 4 + g2) * 128 * 128;
            for (int i = F.tid; i < 128 * 128 / 4; i += NTHR) *(LAS f32x4*)(Ms + 4 * i) = *(const f32x4*)(mp + 4 * i);
            for (int i = F.tid; i < 32 * 128; i += NTHR) { const int k = i >> 7, c = i & 127; Ws[c * 32 + k] = W[(size_t)(k02 + k) * CD_IN + g2 * 128 + c]; }
        }
        first = false;
        __syncthreads();
        const int e = F.tid & 127, kq = F.tid >> 7;
        float acc[8];
#pragma unroll
        for (int j = 0; j < 8; ++j) acc[j] = 0.f;
#pragma unroll 4
        for (int c = 0; c < 128; ++c) { const float mv = Ms[c * 128 + e]; const f32x4 w0 = *(const LAS f32x4*)(Ws + c * 32 + kq * 8), w1 = *(const LAS f32x4*)(Ws + c * 32 + kq * 8 + 4);
            acc[0] += mv * w0.x; acc[1] += mv * w0.y; acc[2] += mv * w0.z; acc[3] += mv * w0.w; acc[4] += mv * w1.x; acc[5] += mv * w1.y; acc[6] += mv * w1.z; acc[7] += mv * w1.w; }
        v4u o; o.x = pk2(acc[0], acc[1]); o.y = pk2(acc[2], acc[3]); o.z = pk2(acc[4], acc[5]); o.w = pk2(acc[6], acc[7]);
        *(v4u*)(WT + (size_t)(cs2 * 512 + g2 * 128 + e) * DM + k02 + kq * 8) = o;
    }
    __syncthreads();
}

namespace pg8 {
#define PG8_LAS __attribute__((address_space(3)))
typedef unsigned short bf16_t;
typedef short bf16x8 __attribute__((ext_vector_type(8)));
typedef unsigned u32x4 __attribute__((ext_vector_type(4)));
constexpr int BM = 256, BK = 64, HALF = 128, HTB = HALF * BK * 2, STAGE_BYTES = 8 * HTB, NXCD = 8, WGM = 8;
__host__ __device__ __forceinline__ int lds_byte(int r, int c) { const int st = (r >> 4) * 2 + (c >> 5), rr = r & 15, cc = c & 31, ob = rr * 64 + cc * 2; return st * 1024 + (ob ^ (((ob >> 9) & 1) << 5)); }
__host__ __device__ __forceinline__ void stage_rc(int b, int& R, int& C) { const int st = b / 1024, sb = b % 1024, swz = sb ^ (((sb >> 9) & 1) << 5); R = (st >> 1) * 16 + swz / 64; C = (st & 1) * 32 + (swz % 64) / 2; }
__host__ __device__ __forceinline__ int perm32(int rho) { const int n = rho >> 4, i = rho & 15; return 8 * (i >> 2) + 4 * n + (i & 3); }

struct Unit { int pm, pn, kind; const char* A; const char* B; };

struct Seg { const bf16_t* A; const bf16_t* Bt; int nM, nN, kind; };
struct SegOrder {
    Seg s0, s1, s2; int n0, n1, n2, G, c; size_t tstep;
    __device__ __forceinline__ void init(const Seg& a, const Seg& b, const Seg& d, int K, int G_, int c_) { s0 = a; s1 = b; s2 = d; n0 = a.nM * a.nN; n1 = b.nM * b.nN; n2 = d.nM * d.nN; G = G_; c = c_; tstep = (size_t)BM * K * 2; }
    __device__ __forceinline__ void map(const Seg& s, int nwg, int wgid, Unit& u) const {
        { const int q = nwg / NXCD, xcd = wgid % NXCD, off = wgid / NXCD; wgid = xcd * q + off; }
        const int nig = WGM * s.nN, gid = wgid / nig, fm = gid * WGM, gsz = (s.nM - fm) < WGM ? (s.nM - fm) : WGM;
        u.pm = fm + ((wgid % nig) % gsz); u.pn = (wgid % nig) / gsz; u.kind = s.kind;
        u.A = (const char*)s.A + (size_t)u.pm * tstep; u.B = (const char*)s.Bt + (size_t)u.pn * tstep;
    }
    __device__ __forceinline__ bool next(int i, Unit& u) const {
        int L = i * G + c;
        if (L < n0) { map(s0, n0, L, u); return true; } L -= n0;
        if (L < n1) { map(s1, n1, L, u); return true; } L -= n1;
        if (L < n2) { map(s2, n2, L, u); return true; }
        return false;
    }
};

__device__ __forceinline__ unsigned cvt_pk_bf16(float lo, float hi) { unsigned r; asm volatile("v_cvt_pk_bf16_f32 %0, %1, %2" : "=v"(r) : "v"(lo), "v"(hi)); return r; }

template <class Epi, class Sched, bool ALIGN_EPI = true, bool DIAG = false>
__device__ __forceinline__ void gemm_phase(PG8_LAS unsigned char* lds, const int K, const Sched& S, const Epi& E) {
    const int tid = threadIdx.x, wid = __builtin_amdgcn_readfirstlane(tid >> 6), lane = tid & 63, wr = wid >> 2, wc = wid & 3, fr = lane & 15, fq = lane >> 4;
    const int nt = K / BK;
    unsigned voffA[2], voffB[2];
#pragma unroll
    for (int i = 0; i < 2; ++i) { int R, C; stage_rc(tid * 16 + i * 8192, R, C); const int Rb = Epi::PERM ? ((R & ~31) + perm32(R & 31)) : R;
        voffA[i] = (unsigned)(R * K + C) * 2u; voffB[i] = (unsigned)(Rb * K + C) * 2u; }
    const size_t kstep = (size_t)(BK * 2);
    const size_t hstep = (size_t)HALF * K * 2;
    const unsigned ldsw = (unsigned)wid * 1024u;
    const int aoff = lds_byte(wr * 64 + fr, fq * 8), boff = lds_byte(wc * 32 + fr, fq * 8);
#define PG8_SA(b, h) (((b) * 2 + (h)) * HTB)
#define PG8_SB(b, h) ((4 + (b) * 2 + (h)) * HTB)
#define PG8_STAGE(bufoff, gbase, voff) do { _Pragma("unroll") for (int _i = 0; _i < 2; ++_i) \
        __builtin_amdgcn_global_load_lds((const unsigned*)((const char*)(gbase) + (voff)[_i]), (PG8_LAS unsigned*)(lds + (bufoff) + ldsw + _i * 8192), 16, 0, 0); } while (0)
#define PG8_LDA(dst, b, h) do { _Pragma("unroll") for (int m = 0; m < 4; ++m) _Pragma("unroll") for (int k = 0; k < 2; ++k) dst[m][k] = *(const PG8_LAS bf16x8*)(lds + PG8_SA(b, h) + aoff + m * 2048 + k * 1024); } while (0)
#define PG8_LDB(dst, b, h) do { _Pragma("unroll") for (int n = 0; n < 2; ++n) _Pragma("unroll") for (int k = 0; k < 2; ++k) dst[n][k] = *(const PG8_LAS bf16x8*)(lds + PG8_SB(b, h) + boff + n * 2048 + k * 1024); } while (0)
#define PG8_MMA(ai, bj, At, Bt) do { __builtin_amdgcn_s_setprio(1); _Pragma("unroll") for (int m = 0; m < 4; ++m) _Pragma("unroll") for (int n = 0; n < 2; ++n) _Pragma("unroll") for (int k = 0; k < 2; ++k) \
        acc[ai][bj][m][n] = __builtin_amdgcn_mfma_f32_16x16x32_bf16(Bt[n][k], At[m][k], acc[ai][bj][m][n], 0, 0, 0); __builtin_amdgcn_s_setprio(0); } while (0)
#define PG8_WAIT_V(n) asm volatile("s_waitcnt vmcnt(" #n ")" ::: "memory")
#define PG8_WAIT_L(n) asm volatile("s_waitcnt lgkmcnt(" #n ")" ::: "memory")
#define PG8_BAR __builtin_amdgcn_s_barrier()
#define PG8_SCHED __builtin_amdgcn_sched_barrier(0)
    Unit cur, nxt; int ui = 0;
    if (!S.next(0, cur)) return;
    f32x4 acc[2][2][4][2];
#pragma unroll
    for (int a = 0; a < 2; ++a)
#pragma unroll
        for (int b = 0; b < 2; ++b)
#pragma unroll
            for (int m = 0; m < 4; ++m)
#pragma unroll
                for (int n = 0; n < 2; ++n) acc[a][b][m][n] = (f32x4){0.f, 0.f, 0.f, 0.f};
    bf16x8 At[4][2], B0[2][2], B1[2][2];
    const char* cA = cur.A; const char* cB = cur.B;
    PG8_STAGE(PG8_SB(0, 0), cB, voffB); PG8_STAGE(PG8_SB(0, 1), cB + hstep, voffB); PG8_STAGE(PG8_SA(0, 0), cA, voffA); PG8_STAGE(PG8_SA(0, 1), cA + hstep, voffA);
    if (wr == 1) PG8_BAR;
    PG8_WAIT_V(2); PG8_BAR;
    PG8_STAGE(PG8_SB(1, 0), cB + kstep, voffB); PG8_STAGE(PG8_SA(1, 0), cA + kstep, voffA); PG8_STAGE(PG8_SB(1, 1), cB + hstep + kstep, voffB);
    PG8_WAIT_V(6); PG8_BAR;
    for (;;) {
        const bool has_next = S.next(ui + 1, nxt);
        const char* nA = has_next ? nxt.A : cA; const char* nB = has_next ? nxt.B : cB;
        for (int t = 0; t < nt; t += 2) {
            const bool last = (t == nt - 2);
            const char* a1 = cA + (size_t)(t + 1) * kstep;
            const char* a2 = last ? nA : cA + (size_t)(t + 2) * kstep; const char* b2 = last ? nB : cB + (size_t)(t + 2) * kstep;
            const char* a3 = a2 + kstep; const char* b3 = b2 + kstep;
            PG8_LDB(B0, 0, 0); PG8_LDB(B1, 0, 1); PG8_SCHED; PG8_LDA(At, 0, 0); PG8_STAGE(PG8_SA(1, 1), a1 + hstep, voffA);
            PG8_WAIT_V(8); PG8_WAIT_L(0); PG8_BAR; PG8_MMA(0, 0, At, B0); if constexpr (!DIAG) PG8_MMA(0, 1, At, B1); PG8_BAR; PG8_SCHED;
            PG8_LDA(At, 0, 1); PG8_STAGE(PG8_SB(0, 0), b2, voffB); PG8_STAGE(PG8_SB(0, 1), b2 + hstep, voffB); PG8_STAGE(PG8_SA(0, 0), a2, voffA);
            PG8_WAIT_V(8); PG8_WAIT_L(0); PG8_BAR; if constexpr (!DIAG) PG8_MMA(1, 0, At, B0); PG8_MMA(1, 1, At, B1); PG8_BAR; PG8_SCHED;
            PG8_LDB(B0, 1, 0); PG8_LDB(B1, 1, 1); PG8_SCHED; PG8_LDA(At, 1, 0); PG8_STAGE(PG8_SA(0, 1), a2 + hstep, voffA);
            PG8_WAIT_V(8); PG8_WAIT_L(0); PG8_BAR; PG8_MMA(0, 0, At, B0); if constexpr (!DIAG) PG8_MMA(0, 1, At, B1); PG8_BAR; PG8_SCHED;
            PG8_LDA(At, 1, 1); PG8_STAGE(PG8_SB(1, 0), b3, voffB); PG8_STAGE(PG8_SB(1, 1), b3 + hstep, voffB); PG8_STAGE(PG8_SA(1, 0), a3, voffA);
            PG8_WAIT_V(8); PG8_WAIT_L(0); PG8_BAR; if constexpr (!DIAG) PG8_MMA(1, 0, At, B0); PG8_MMA(1, 1, At, B1); PG8_BAR; PG8_SCHED;
        }
        if constexpr (ALIGN_EPI) { if (wr == 0) PG8_BAR; }
        if constexpr (Epi::FUSED) E.fused(acc, cur, wr, wc, fr, fq, wid, lane); else E(acc, cur, wr, wc, fr, fq);
        if (!has_next) break;
#pragma unroll
        for (int a = 0; a < 2; ++a)
#pragma unroll
            for (int b = 0; b < 2; ++b)
#pragma unroll
                for (int m = 0; m < 4; ++m)
#pragma unroll
                    for (int n = 0; n < 2; ++n) acc[a][b][m][n] = (f32x4){0.f, 0.f, 0.f, 0.f};
        cur = nxt; cA = nA; cB = nB; ++ui;
        if constexpr (ALIGN_EPI) { if (wr == 1) PG8_BAR; }
    }
    PG8_WAIT_V(0);
    if constexpr (!ALIGN_EPI) { if (wr == 0) PG8_BAR; }
    PG8_BAR;
#undef PG8_SA
#undef PG8_SB
#undef PG8_STAGE
#undef PG8_LDA
#undef PG8_LDB
#undef PG8_MMA
#undef PG8_WAIT_V
#undef PG8_WAIT_L
#undef PG8_BAR
#undef PG8_SCHED
}
}

typedef float f32x4acc[2][2][4][2];
DEVI float fsilu(float v) { return v * __builtin_amdgcn_rcpf(1.f + __builtin_amdgcn_exp2f(-LOG2E * v)); }
DEVI float fsigm(float v) { return __builtin_amdgcn_rcpf(1.f + __builtin_amdgcn_exp2f(-LOG2E * v)); }
typedef float f32x2p __attribute__((ext_vector_type(2)));
DEVI f32x4 fsigm4(const f32x4& v) {
    const f32x2p nl = {-LOG2E, -LOG2E}, one = {1.f, 1.f};
    const f32x2p t0 = (f32x2p){v[0], v[1]} * nl, t1 = (f32x2p){v[2], v[3]} * nl;
    const f32x2p d0 = (f32x2p){__builtin_amdgcn_exp2f(t0.x), __builtin_amdgcn_exp2f(t0.y)} + one, d1 = (f32x2p){__builtin_amdgcn_exp2f(t1.x), __builtin_amdgcn_exp2f(t1.y)} + one;
    return (f32x4){__builtin_amdgcn_rcpf(d0.x), __builtin_amdgcn_rcpf(d0.y), __builtin_amdgcn_rcpf(d1.x), __builtin_amdgcn_rcpf(d1.y)};
}
DEVI f32x4 fsilu4(const f32x4& v) { return v * fsigm4(v); }
DEVI v4u pack8(const f32x4& a, const f32x4& b) { v4u w; w.x = pg8::cvt_pk_bf16(a[0], a[1]); w.y = pg8::cvt_pk_bf16(a[2], a[3]); w.z = pg8::cvt_pk_bf16(b[0], b[1]); w.w = pg8::cvt_pk_bf16(b[2], b[3]); return w; }

struct EpiIn0 {
    static constexpr bool PERM = true; static constexpr bool FUSED = false;
    bf16 *GLU, *Q0, *K0, *V0, *SZ; const float *qng, *kng, *rope;
    DEVI void operator()(const f32x4 (&acc)[2][2][4][2], const pg8::Unit& u, int wr, int wc, int fr, int fq) const {
        asm volatile("" : "+v"(fr), "+v"(fq));
        const int pn = u.pn + (u.kind ? 7 : 0), pm = u.pm + (u.kind == 2 ? 64 : 0); const bool isx = pm < 64;
        const int cw = 32 * wc + 8 * fq;
        float g8[2][8];
        if (pn >= 4 && pn < 7) { const float* gn = (pn < 6) ? qng : kng;
#pragma unroll
            for (int bj = 0; bj < 2; ++bj) { const f32x4 a = *(const f32x4*)(gn + 32 * bj + 8 * fq), b = *(const f32x4*)(gn + 32 * bj + 8 * fq + 4);
                g8[bj][0] = a[0]; g8[bj][1] = a[1]; g8[bj][2] = a[2]; g8[bj][3] = a[3]; g8[bj][4] = b[0]; g8[bj][5] = b[1]; g8[bj][6] = b[2]; g8[bj][7] = b[3]; } }
        const bool dorope = pn >= 4 && pn < 7 && isx && !((pn == 6) && (wc >= 2));
        f32x4 rpR[2][2], rpC[2];
        if (dorope) {
#pragma unroll
            for (int ai = 0; ai < 2; ++ai)
#pragma unroll
                for (int n = 0; n < 2; ++n) rpR[ai][n] = *(const f32x4*)(rope + ((size_t)((pm & 7) * 256 + 128 * ai + 64 * wr) * 32 + 4 * fq + 2 * n) * 2);
        }
#pragma unroll
        for (int m = 0; m < 4; ++m) {
            if (dorope) {
#pragma unroll
                for (int n = 0; n < 2; ++n) rpC[n] = *(const f32x4*)(rope + ((size_t)(16 * m + fr) * 32 + 16 + 4 * fq + 2 * n) * 2);
            }
#pragma unroll
            for (int ai = 0; ai < 2; ++ai) {
                const int lr = 128 * ai + 64 * wr + 16 * m + fr;
                const int row = 256 * pm + lr;
                if (pn < 4) {
                    f32x4 o0, o1;
#pragma unroll
                    for (int e = 0; e < 1; ++e) { o0 = acc[ai][0][m][0] * fsigm4(acc[ai][1][m][0]); o1 = acc[ai][0][m][1] * fsigm4(acc[ai][1][m][1]); }
                    *(v4u*)(GLU + (size_t)row * 512 + 128 * pn + cw) = pack8(o0, o1);
                } else if (pn < 7) {
                    const bool isv = (pn == 6) && (wc >= 2);
                    int b, key, l;
                    if (isx) { b = pm >> 3; l = (pm & 7) * 256 + lr; key = CTXL + l; } else { b = pm - 64; l = 0; key = lr; }
                    if (isv) {
#pragma unroll
                        for (int bj = 0; bj < 2; ++bj) *(v4u*)(V0 + ((size_t)b * NKEY0 + key) * 128 + (wc - 2) * 64 + 32 * bj + 8 * fq) = pack8(acc[ai][bj][m][0], acc[ai][bj][m][1]);
                    } else {
                        float ss = 0.f;
#pragma unroll
                        for (int bj = 0; bj < 2; ++bj)
#pragma unroll
                            for (int n = 0; n < 2; ++n) { const f32x4 x = acc[ai][bj][m][n]; ss += (x[0] * x[0] + x[1] * x[1]) + (x[2] * x[2] + x[3] * x[3]); }
                        ss = sum_fq(ss);
                        const float rinv = __builtin_amdgcn_rsqf(ss * (1.f / 64.f) + EPS);
                        const float osc = (pn < 6) ? C2 : 1.f;
#pragma unroll
                        for (int bj = 0; bj < 2; ++bj) {
                            f32x4 v[2];
#pragma unroll
                            for (int n = 0; n < 2; ++n)
#pragma unroll
                                for (int e = 0; e < 4; ++e) v[n][e] = acc[ai][bj][m][n][e] * rinv * g8[bj][4 * n + e];
                            if (isx) {
#pragma unroll
                                for (int n = 0; n < 2; ++n) { const f32x4 cs = bj ? rpC[n] : rpR[ai][n];
                                    const float a0 = v[n][0], b0 = v[n][1], a1 = v[n][2], b1 = v[n][3];
                                    v[n][0] = a0 * cs[0] - b0 * cs[1]; v[n][1] = a0 * cs[1] + b0 * cs[0]; v[n][2] = a1 * cs[2] - b1 * cs[3]; v[n][3] = a1 * cs[3] + b1 * cs[2]; } }
                            v[0] = v[0] * osc; v[1] = v[1] * osc;
                            if (pn < 6) *(v4u*)(Q0 + (size_t)row * 512 + (4 * (pn - 4) + wc) * 64 + 32 * bj + 8 * fq) = pack8(v[0], v[1]);
                            else *(v4u*)(K0 + ((size_t)b * NKEY0 + key) * 128 + wc * 64 + 32 * bj + 8 * fq) = pack8(v[0], v[1]);
                        }
                    }
                } else {
#pragma unroll
                    for (int bj = 0; bj < 2; ++bj) { f32x4 o0, o1;
#pragma unroll
                        for (int e = 0; e < 1; ++e) { o0 = fsilu4(acc[ai][bj][m][0]); o1 = fsilu4(acc[ai][bj][m][1]); }
                        *(v4u*)(SZ + (size_t)row * 1024 + 256 * (pn - 7) + 128 * bj + cw) = pack8(o0, o1); }
                }
            }
        }
    }
};
template <bool CTX>
DEVI void outproj0_epi(const f32x4 (&acc)[2][2][4][2], int pm, int pn, int wr, int wc, int fr, int fq, const float* xin, const float* ada0, const float* ada1, const float* ng1, _Float16* o_x, bf16* H, float* ssq) {
    const int r = CTX ? 8 : (pm >> 3); const size_t rowbase = (size_t)(CTX ? MX : 0) + 256 * pm;
    f32x4 gate[2][2], gp[2][2];
#pragma unroll
    for (int bj = 0; bj < 2; ++bj)
#pragma unroll
        for (int n = 0; n < 2; ++n) { const int col = 256 * pn + 128 * bj + 32 * wc + 8 * fq + 4 * n;
            gate[bj][n] = *(const f32x4*)(ada0 + r * 3072 + 2048 + col);
            gp[bj][n] = *(const f32x4*)(ng1 + col) * (*(const f32x4*)(ada1 + r * 3072 + 1024 + col) + 1.0f); }
#pragma unroll
    for (int ai = 0; ai < 2; ++ai)
#pragma unroll
        for (int mp = 0; mp < 4; mp += 2) {
            f32x4 xr[2][2][2];
#pragma unroll
            for (int mm = 0; mm < 2; ++mm) { const size_t xoff = (size_t)(256 * pm + 128 * ai + 64 * wr + 16 * (mp + mm) + fr) * DM;
#pragma unroll
                for (int bj = 0; bj < 2; ++bj)
#pragma unroll
                    for (int n = 0; n < 2; ++n) xr[mm][bj][n] = __builtin_nontemporal_load((const f32x4*)(xin + xoff + 256 * pn + 128 * bj + 32 * wc + 8 * fq + 4 * n)); }
            asm volatile("" ::: "memory");
#pragma unroll
            for (int mm = 0; mm < 2; ++mm) { const int m = mp + mm;
                const int lr = 128 * ai + 64 * wr + 16 * m + fr; const size_t row = rowbase + lr; const size_t xoff = (size_t)(256 * pm + lr) * DM;
                float ss = 0.f;
#pragma unroll
                for (int bj = 0; bj < 2; ++bj) { const int col8 = 256 * pn + 128 * bj + 32 * wc + 8 * fq; f32x4 xg[2];
#pragma unroll
                    for (int n = 0; n < 2; ++n) { const f32x4 x1 = xr[mm][bj][n] + gate[bj][n] * acc[ai][bj][m][n];
                        if (!CTX) { typedef _Float16 h4 __attribute__((ext_vector_type(4))); __builtin_nontemporal_store(__builtin_convertvector(x1, h4), (h4*)(o_x + xoff + col8 + 4 * n)); }
                        ss += (x1[0] * x1[0] + x1[1] * x1[1]) + (x1[2] * x1[2] + x1[3] * x1[3]); xg[n] = x1 * gp[bj][n]; }
                    *(v4u*)(H + row * DM + col8) = pack8(xg[0], xg[1]); }
                ss = sum_fq(ss);
                if (fq == 0) atomicAdd(ssq + row, ss);
            }
        }
}
struct EpiOutX {
    static constexpr bool PERM = true; static constexpr bool FUSED = false;
    const float *xin, *ada0, *ada1, *ng1; _Float16* o_x; bf16* H; float* ssq;
    DEVI void operator()(const f32x4 (&acc)[2][2][4][2], const pg8::Unit& u, int wr, int wc, int fr, int fq) const { outproj0_epi<false>(acc, u.pm, u.pn, wr, wc, fr, fq, xin, ada0, ada1, ng1, o_x, H, ssq); }
};
struct EpiOutF {
    static constexpr bool PERM = false; static constexpr bool FUSED = true;
    const float *ada, *gfin; const _Float16* x1h; float* o_x; float* ssq2; unsigned* cnt;
    DEVI void fused(f32x4 (&acc)[2][2][4][2], const pg8::Unit& u, int wr, int wc, int fr, int fq, int wid, int lane) const {
        typedef _Float16 h4 __attribute__((ext_vector_type(4))); typedef unsigned u32x2 __attribute__((ext_vector_type(2)));
        const int pm = __builtin_amdgcn_readfirstlane(u.pm), pn = __builtin_amdgcn_readfirstlane(u.pn); const int r = pm >> 3;
        const __amdgpu_buffer_rsrc_t rs_x = __builtin_amdgcn_make_buffer_rsrc((void*)x1h, 0, MX * DM * 2, 0x00020000);
        const __amdgpu_buffer_rsrc_t rs_o = __builtin_amdgcn_make_buffer_rsrc((void*)o_x, 0, MX * DM * 4, 0x00020000);
        const int e0 = (256 * pm + 64 * wr + fr) * DM + 256 * pn + 32 * wc + 4 * fq;
        f32x4 gv[2][2];
#pragma unroll
        for (int bj = 0; bj < 2; ++bj)
#pragma unroll
            for (int n = 0; n < 2; ++n) gv[bj][n] = *(const f32x4*)(ada + r * 3072 + 2048 + 256 * pn + 32 * wc + 4 * fq + 128 * bj + 16 * n);
#pragma unroll
        for (int ai = 0; ai < 2; ++ai) {
            u32x2 xh[4][2][2];
#pragma unroll
            for (int m = 0; m < 4; ++m)
#pragma unroll
                for (int bj = 0; bj < 2; ++bj)
#pragma unroll
                    for (int n = 0; n < 2; ++n) xh[m][bj][n] = __builtin_amdgcn_raw_buffer_load_b64(rs_x, (e0 + (128 * ai + 16 * m) * DM + 128 * bj + 16 * n) * 2, 0, 2  );
#pragma unroll
            for (int m = 0; m < 4; ++m) { const int lr = 128 * ai + 64 * wr + 16 * m + fr; float ss = 0.f;
#pragma unroll
                for (int bj = 0; bj < 2; ++bj)
#pragma unroll
                    for (int n = 0; n < 2; ++n) { const f32x4 x2 = __builtin_convertvector(__builtin_bit_cast(h4, xh[m][bj][n]), f32x4) + gv[bj][n] * acc[ai][bj][m][n]; acc[ai][bj][m][n] = x2;
                        ss += (x2[0] * x2[0] + x2[1] * x2[1]) + (x2[2] * x2[2] + x2[3] * x2[3]); }
                ss = sum_fq(ss);
                if (fq == 0) atomicAdd(ssq2 + 256 * pm + lr, ss); }
        }
        asm volatile("s_waitcnt vmcnt(0)" ::: "memory");
        __builtin_amdgcn_s_barrier(); asm volatile("" ::: "memory");
        if (wid == 0) {
            if (lane == 0) __hip_atomic_fetch_add(cnt + 64 * pm, 1u, __ATOMIC_RELAXED, __HIP_MEMORY_SCOPE_AGENT);
            unsigned sp = 0;
            while ((unsigned)__builtin_amdgcn_readfirstlane(__hip_atomic_load(cnt + 64 * pm, __ATOMIC_RELAXED, __HIP_MEMORY_SCOPE_AGENT)) < 4u) { __builtin_amdgcn_s_sleep(2); if (++sp > (1u << 22)) break; }
        }
        asm volatile("s_waitcnt vmcnt(0) lgkmcnt(0)" ::: "memory");
        __builtin_amdgcn_s_barrier(); asm volatile("" ::: "memory");
        f32x4 gf[2][2];
#pragma unroll
        for (int bj = 0; bj < 2; ++bj)
#pragma unroll
            for (int n = 0; n < 2; ++n) gf[bj][n] = *(const f32x4*)(gfin + 256 * pn + 32 * wc + 4 * fq + 128 * bj + 16 * n);
        float qs[2][4];
#pragma unroll
        for (int ai = 0; ai < 2; ++ai)
#pragma unroll
            for (int m = 0; m < 4; ++m) qs[ai][m] = __hip_atomic_load(ssq2 + 256 * pm + 128 * ai + 64 * wr + 16 * m + fr, __ATOMIC_RELAXED, __HIP_MEMORY_SCOPE_AGENT);
#pragma unroll
        for (int ai = 0; ai < 2; ++ai)
#pragma unroll
            for (int m = 0; m < 4; ++m) {
                const float ri = __builtin_amdgcn_rsqf(qs[ai][m] * (1.f / DM) + EPS);
#pragma unroll
                for (int bj = 0; bj < 2; ++bj)
#pragma unroll
                    for (int n = 0; n < 2; ++n) { const f32x4 o = acc[ai][bj][m][n] * ri * gf[bj][n];
                        __builtin_amdgcn_raw_buffer_store_b128(__builtin_bit_cast(v4u, o), rs_o, (e0 + (128 * ai + 16 * m) * DM + 128 * bj + 16 * n) * 4, 0, 2  ); } }
    }
    DEVI void operator()(const f32x4 (&)[2][2][4][2], const pg8::Unit&, int, int, int, int) const {}
};
struct EpiIn1 {
    static constexpr bool PERM = true; static constexpr bool FUSED = false;
    bf16 *PT, *Q1, *K1, *V1, *SZ1; const float *ssq, *sw;
    const float *ctx, *ada0, *ada1, *ng1; bf16* H; float* ssqw; int pt_pn0; unsigned* gate;
    DEVI void operator()(const f32x4 (&acc)[2][2][4][2], const pg8::Unit& u, int wr, int wc, int fr, int fq) const {
        asm volatile("" : "+v"(fr), "+v"(fq));
        const int pm = u.pm, kind = u.kind; const int cw = 32 * wc + 8 * fq;
        if (kind == 3) { outproj0_epi<true>(acc, pm, u.pn, wr, wc, fr, fq, ctx, ada0, ada1, ng1, nullptr, H, ssqw);
            asm volatile("s_waitcnt vmcnt(0)" ::: "memory"); __builtin_amdgcn_s_barrier(); asm volatile("" ::: "memory");
            if (wr == 0 && wc == 0) { __builtin_amdgcn_fence(__ATOMIC_RELEASE, "agent"); asm volatile("s_waitcnt vmcnt(0)" ::: "memory");
                if (fr == 0 && fq == 0) __hip_atomic_fetch_add(gate, 8u, __ATOMIC_RELAXED, __HIP_MEMORY_SCOPE_AGENT); }
            return; }
        if (kind == 2) {
            const int pn = u.pn + pt_pn0, b = pn >> 3;
            f32x4 ri[2][2];
#pragma unroll
            for (int bj = 0; bj < 2; ++bj)
#pragma unroll
                for (int n = 0; n < 2; ++n) { const f32x4 q = *(const f32x4*)(ssq + 256 * pn + 128 * bj + cw + 4 * n);
#pragma unroll
                    for (int e = 0; e < 4; ++e) ri[bj][n][e] = __builtin_amdgcn_rsqf(q[e] * (1.f / DM) + EPS); }
            float svs[2][4];
#pragma unroll
            for (int ai = 0; ai < 2; ++ai)
#pragma unroll
                for (int m = 0; m < 4; ++m) svs[ai][m] = sw[b * N1 + 256 * pm + 128 * ai + 64 * wr + 16 * m + fr];
            const __amdgpu_buffer_rsrc_t rs_p = __builtin_amdgcn_make_buffer_rsrc((void*)PT, 0, 4096 * 4096 * 2, 0x00020000);
#pragma unroll
            for (int ai = 0; ai < 2; ++ai)
#pragma unroll
                for (int m = 0; m < 4; ++m) { const int jj = 256 * pm + 128 * ai + 64 * wr + 16 * m + fr, cs = jj >> 9, jc = jj & 511; const float sv = svs[ai][m];
#pragma unroll
                    for (int bj = 0; bj < 2; ++bj) { const int tok = 256 * pn + 128 * bj + cw, l = tok & 2047; const int ng = b * 512 + jc;
                        __builtin_amdgcn_raw_buffer_store_b128(pack8(acc[ai][bj][m][0] * ri[bj][0] + sv, acc[ai][bj][m][1] * ri[bj][1] + sv), rs_p, ((((ng >> 7) * 2 + cs) * 128 + (ng & 127)) * 2048 + l) * 2, 0, 0); } }
            return;
        }
        const int pn = u.pn; const int r = (kind == 1) ? 8 : (pm >> 3); const int wcol0 = (kind == 1) ? 1536 : 1024;
        f32x4 sv[2][2];
#pragma unroll
        for (int bj = 0; bj < 2; ++bj)
#pragma unroll
            for (int n = 0; n < 2; ++n) sv[bj][n] = *(const f32x4*)(sw + r * N1 + wcol0 + 256 * pn + 128 * bj + cw + 4 * n);
        const int rowb = ((kind == 1) ? MX : 0) + 256 * pm + 64 * wr + fr;
        float qsv[2][4];
#pragma unroll
        for (int ai = 0; ai < 2; ++ai)
#pragma unroll
            for (int m = 0; m < 4; ++m) qsv[ai][m] = ssq[rowb + 128 * ai + 16 * m];
        bf16* dst; int pitch, colb; float osc = 1.f; bool act = false;
        if (kind == 1) { dst = (pn < 2) ? K1 : V1; pitch = 512; colb = 256 * (pn & 1); }
        else if (pn < 2) { dst = Q1; pitch = 512; colb = 256 * pn; osc = C2; }
        else if (pn < 4) { dst = K1; pitch = 512; colb = 256 * (pn - 2); }
        else if (pn < 6) { dst = V1; pitch = 512; colb = 256 * (pn - 4); }
        else { dst = SZ1; pitch = 1024; colb = 256 * (pn - 6); act = true; }
        const __amdgpu_buffer_rsrc_t rs_d = __builtin_amdgcn_make_buffer_rsrc((void*)dst, 0, MT * 1024 * 2, 0x00020000);
        const int ob = (rowb * pitch + colb + cw) * 2;
#pragma unroll
        for (int ai = 0; ai < 2; ++ai)
#pragma unroll
            for (int m = 0; m < 4; ++m) {
                const float ri = __builtin_amdgcn_rsqf(qsv[ai][m] * (1.f / DM) + EPS);
#pragma unroll
                for (int bj = 0; bj < 2; ++bj) {
                    f32x4 a0 = acc[ai][bj][m][0] * ri + sv[bj][0], a1 = acc[ai][bj][m][1] * ri + sv[bj][1];
                    if (act) {
#pragma unroll
                        for (int e = 0; e < 1; ++e) { a0 = fsilu4(a0); a1 = fsilu4(a1); } }
                    else { a0 = a0 * osc; a1 = a1 * osc; }
                    __builtin_amdgcn_raw_buffer_store_b128(pack8(a0, a1), rs_d, ob + ((128 * ai + 16 * m) * pitch + 128 * bj) * 2, 0, 0);
                }
            }
    }
};
struct EpiDft {
    static constexpr bool PERM = true; static constexpr bool FUSED = false;
    bf16* Y1; const bf16* SZ1;
    DEVI void operator()(const f32x4 (&acc)[2][2][4][2], const pg8::Unit& u, int wr, int wc, int fr, int fq) const {
        const int n = 128 * u.pn + 32 * wc + 8 * fq, b = n >> 9, j = n & 511;
        v4u zs[4][2];
#pragma unroll
        for (int m = 0; m < 4; ++m) { const int lp = 128 * u.pm + 64 * wr + 16 * m + fr;
            zs[m][0] = __builtin_nontemporal_load((const v4u*)(SZ1 + (size_t)(b * 2048 + lp) * 1024 + j));
            zs[m][1] = __builtin_nontemporal_load((const v4u*)(SZ1 + (size_t)(b * 2048 + ((2048 - lp) & 2047)) * 1024 + j)); }
#pragma unroll
        for (int m = 0; m < 4; ++m) { const int lp = 128 * u.pm + 64 * wr + 16 * m + fr;
            const f32x4 a0 = acc[0][0][m][0], a1 = acc[0][0][m][1], b0 = acc[1][1][m][0], b1 = acc[1][1][m][1];
            { const size_t off = (size_t)(b * 2048 + lp) * 1024 + j; const v4u z = zs[m][0];
              f32x4 o0 = a0 - b0, o1 = a1 - b1;
              o0[0] *= bflo(z.x); o0[1] *= bfhi(z.x); o0[2] *= bflo(z.y); o0[3] *= bfhi(z.y); o1[0] *= bflo(z.z); o1[1] *= bfhi(z.z); o1[2] *= bflo(z.w); o1[3] *= bfhi(z.w);
              *(v4u*)(Y1 + off) = pack8(o0, o1); }
            if (lp >= 1) { const size_t off = (size_t)(b * 2048 + 2048 - lp) * 1024 + j; const v4u z = zs[m][1];
              f32x4 o0 = a0 + b0, o1 = a1 + b1;
              o0[0] *= bflo(z.x); o0[1] *= bfhi(z.x); o0[2] *= bflo(z.y); o0[3] *= bfhi(z.y); o1[0] *= bflo(z.z); o1[1] *= bfhi(z.z); o1[2] *= bflo(z.w); o1[3] *= bfhi(z.w);
              *(v4u*)(Y1 + off) = pack8(o0, o1); }
        }
    }
};
DEVI void phase_nyquist(Frame& F) {
    const bf16* PT = wsb(F, WS_PT); const bf16* SZ1 = wsb(F, WS_SZ1); bf16* Y1 = wsb(F, WS_Y1);
    const int gw = F.bid * NWAVES + F.wave, NGW = F.G * NWAVES;
    for (int n0 = gw; n0 < 4096; n0 += 2 * NGW) {
        const int n1 = n0 + NGW; const bool has1 = n1 < 4096; const int n1c = has1 ? n1 : n0;
        const bf16* row0 = PT + ((size_t)((n0 >> 7) * 2) * 128 + (n0 & 127)) * 2048 + F.lane * 32;
        const bf16* row1 = PT + ((size_t)((n1c >> 7) * 2) * 128 + (n1c & 127)) * 2048 + F.lane * 32;
        const size_t off0 = (size_t)((n0 >> 9) * 2048 + 1024) * 1024 + (n0 & 511), off1 = (size_t)((n1c >> 9) * 2048 + 1024) * 1024 + (n1c & 511);
        v4u w0[4], w1[4];
#pragma unroll
        for (int q = 0; q < 4; ++q) { w0[q] = *(const v4u*)(row0 + 8 * q); w1[q] = *(const v4u*)(row1 + 8 * q); }
        const float z0 = bf2f(SZ1[off0]), z1 = bf2f(SZ1[off1]);
        float a0 = 0.f, a1 = 0.f;
#pragma unroll
        for (int q = 0; q < 4; ++q) {
            a0 += (bflo(w0[q].x) - bfhi(w0[q].x)) + (bflo(w0[q].y) - bfhi(w0[q].y)) + (bflo(w0[q].z) - bfhi(w0[q].z)) + (bflo(w0[q].w) - bfhi(w0[q].w));
            a1 += (bflo(w1[q].x) - bfhi(w1[q].x)) + (bflo(w1[q].y) - bfhi(w1[q].y)) + (bflo(w1[q].z) - bfhi(w1[q].z)) + (bflo(w1[q].w) - bfhi(w1[q].w)); }
        a0 = wave_sum_dpp(a0); a1 = wave_sum_dpp(a1);
        if (F.lane == 0) { Y1[off0] = (bf16)f2bf(a0 * z0); if (has1) Y1[off1] = (bf16)f2bf(a1 * z1); }
    }
}

namespace attn_body {
using bf16=__hip_bfloat16;
using bf16x8=__attribute__((ext_vector_type(8)))short;
using s16x4=__attribute__((ext_vector_type(4)))short;
using f32x16=__attribute__((ext_vector_type(16)))float;
using u32x4=__attribute__((ext_vector_type(4)))unsigned;
constexpr int D=64,NW=8,QBLK=32,QB=QBLK*NW,KVBLK=64;
constexpr int QP=512,YP=1024;
__device__ __forceinline__ int crow(int r,int hi){return (r&3)+8*(r>>2)+4*hi;}
#define SBAR() __builtin_amdgcn_sched_barrier(0)
constexpr int NSLOT=3, SLOTB=8192;
constexpr int LDS_K=0, LDS_V=NSLOT*SLOTB, LDS_WS=2*NSLOT*SLOTB, LDS_OST=LDS_WS+NW*64*4, LDS_BYTES=LDS_OST+NW*4096;
__device__ __forceinline__ void glds16(const void*gsrc,unsigned lds_dst){unsigned keep;
  asm volatile("s_mov_b32 %0, m0\n\ts_mov_b32 m0, %2\n\ts_nop 0\n\tglobal_load_lds_dwordx4 %1, off\n\ts_mov_b32 m0, %0":"=&s"(keep):"v"(gsrc),"s"(lds_dst):"memory");}
__device__ __forceinline__ float max3f(float a,float b,float c){float r;asm("v_max3_f32 %0, %1, %2, %3":"=v"(r):"v"(a),"v"(b),"v"(c));return r;}
__device__ __forceinline__ float max2f(float a,float b){float r;asm("v_max_f32_e32 %0, %1, %2":"=v"(r):"v"(a),"v"(b));return r;}
__device__ __forceinline__ float fadd_s(float a,float b){float r;asm("v_add_f32_e32 %0, %1, %2":"=v"(r):"v"(a),"v"(b));return r;}
__device__ __forceinline__ float fsub_s(float a,float b){float r;asm("v_sub_f32_e32 %0, %1, %2":"=v"(r):"v"(a),"v"(b));return r;}
typedef float f32x2_t __attribute__((ext_vector_type(2))); typedef __bf16 bf16x2_t __attribute__((ext_vector_type(2)));
__device__ __forceinline__ unsigned cvtpk_s(float lo,float hi){f32x2_t v={lo,hi};bf16x2_t b=__builtin_convertvector(v,bf16x2_t);return __builtin_bit_cast(unsigned,b);}
#define WAIT_BAR(N) asm volatile("s_waitcnt vmcnt(" #N ") lgkmcnt(0)\n\ts_barrier":::"memory")
__device__ __forceinline__ void qkt(f32x16&p0,f32x16&p1,const char*Kslot,const bf16x8*qr,const f32x16&negm,int r32,int hi){
  const char*kb=Kslot+hi*1024+r32*16;
  #pragma unroll
  for(int d0=0;d0<4;++d0){
    const bf16x8 b0=*reinterpret_cast<const bf16x8*>(kb+d0*2048);
    const bf16x8 b1=*reinterpret_cast<const bf16x8*>(kb+d0*2048+512);
    if(d0==0){p0=__builtin_amdgcn_mfma_f32_32x32x16_bf16(b0,qr[0],negm,0,0,0);p1=__builtin_amdgcn_mfma_f32_32x32x16_bf16(b1,qr[0],negm,0,0,0);}
    else{p0=__builtin_amdgcn_mfma_f32_32x32x16_bf16(b0,qr[d0],p0,0,0,0);p1=__builtin_amdgcn_mfma_f32_32x32x16_bf16(b1,qr[d0],p1,0,0,0);}}
}
typedef __attribute__((address_space(3))) const char* lds_cptr;
typedef short v4i16_t __attribute__((ext_vector_type(4)));
__device__ __forceinline__ void kload8(bf16x8*kf,lds_cptr kp){
  kf[0]=*(const __attribute__((address_space(3))) bf16x8*)(kp);      kf[1]=*(const __attribute__((address_space(3))) bf16x8*)(kp+512);
  kf[2]=*(const __attribute__((address_space(3))) bf16x8*)(kp+2048); kf[3]=*(const __attribute__((address_space(3))) bf16x8*)(kp+2560);
  kf[4]=*(const __attribute__((address_space(3))) bf16x8*)(kp+4096); kf[5]=*(const __attribute__((address_space(3))) bf16x8*)(kp+4608);
  kf[6]=*(const __attribute__((address_space(3))) bf16x8*)(kp+6144); kf[7]=*(const __attribute__((address_space(3))) bf16x8*)(kp+6656);
}
__device__ __forceinline__ void kload2(bf16x8*kf,lds_cptr kp,int j){ kf[2*j]=*(const __attribute__((address_space(3))) bf16x8*)(kp+j*2048); kf[2*j+1]=*(const __attribute__((address_space(3))) bf16x8*)(kp+j*2048+512); }
__device__ __forceinline__ s16x4 vtr(lds_cptr p){ return __builtin_bit_cast(s16x4,__builtin_amdgcn_ds_read_tr16_b64_v4i16((__attribute__((address_space(3))) v4i16_t*)p)); }
__device__ __forceinline__ float rowmax(const f32x16&p0,const f32x16&p1){
  float a=max3f(p0[0],p0[1],p1[0]),b=max3f(p0[2],p0[3],p1[1]);a=max3f(a,p1[2],p1[3]);
  #pragma unroll
  for(int r=4;r<16;r+=4){a=max3f(a,p0[r],p0[r+1]);b=max3f(b,p0[r+2],p0[r+3]);a=max3f(a,p1[r],p1[r+1]);b=max3f(b,p1[r+2],p1[r+3]);}
  const float m=max2f(a,b);
  auto rr=__builtin_amdgcn_permlane32_swap(__float_as_uint(m),__float_as_uint(m),false,false);
  return max2f(__uint_as_float(rr[0]),__uint_as_float(rr[1]));
}
__device__ __forceinline__ void pv(f32x16*o,int vb,bf16x8 pa0,bf16x8 pa1,bf16x8 pa2,bf16x8 pa3){
  #pragma unroll
  for(int d0=0;d0<2;++d0){s16x4 lo[4],hi[4];
    #pragma unroll
    for(int ks=0;ks<4;++ks){
      asm volatile("ds_read_b64_tr_b16 %0,%1 offset:%c2":"=&v"(lo[ks]):"v"(vb),"i"(d0*4096+ks*1024):"memory");
      asm volatile("ds_read_b64_tr_b16 %0,%1 offset:%c2":"=&v"(hi[ks]):"v"(vb),"i"(d0*4096+ks*1024+512):"memory");}
    asm volatile("s_waitcnt lgkmcnt(0)":::"memory");SBAR();
    #define PK(k) (bf16x8){lo[k][0],lo[k][1],lo[k][2],lo[k][3],hi[k][0],hi[k][1],hi[k][2],hi[k][3]}
    o[d0]=__builtin_amdgcn_mfma_f32_32x32x16_bf16(pa0,PK(0),o[d0],0,0,0);
    o[d0]=__builtin_amdgcn_mfma_f32_32x32x16_bf16(pa1,PK(1),o[d0],0,0,0);
    o[d0]=__builtin_amdgcn_mfma_f32_32x32x16_bf16(pa2,PK(2),o[d0],0,0,0);
    o[d0]=__builtin_amdgcn_mfma_f32_32x32x16_bf16(pa3,PK(3),o[d0],0,0,0);
    #undef PK
  }
}
template<int THRL,bool NAT,int KVP> __device__ __forceinline__ void attn_unit(const bf16*Qu,const bf16*__restrict__ Kh,const bf16*__restrict__ Vh,const int NT,bf16*Yu,const bf16*Zu,char*shm,
    const long ctxoff=0,const long winoff=0,const int kr0=0,const int rq0=0,const float*btab=nullptr){
  const int tid=threadIdx.x,lane=tid&63,r32=lane&31,hi=lane>>5; const int wid=__builtin_amdgcn_readfirstlane(tid>>6);
  const bf16*Qw=Qu+(long)(wid*QBLK)*QP;
  const unsigned lds0=(unsigned)(uintptr_t)shm;
  float*wsf=(float*)(shm+LDS_WS)+wid*64;
  const bf16*ksrc=Kh+(long)lane*KVP+wid*8;
  const bf16*vsrc=Vh+(long)(16*(wid&3)+(lane>>2))*KVP+(wid>>2)*32+(lane&3)*8;
  const unsigned kdst=lds0+LDS_K+wid*1024, vdst=lds0+LDS_V+wid*1024;
  #define TOFF(t) (NAT ? (((t)<4) ? (ctxoff+(long)(t)*KVBLK)*KVP : (winoff+(long)((t)-4)*KVBLK)*KVP) : (long)(t)*KVBLK*KVP)
  #define DMA_K(t,slot) glds16(ksrc+TOFF(t),(unsigned)__builtin_amdgcn_readfirstlane(kdst+(slot)))
  #define DMA_V(t,slot) glds16(vsrc+TOFF(t),(unsigned)__builtin_amdgcn_readfirstlane(vdst+(slot)))
  const int nq_r=rq0+(wid>>1), nq_c=32*(wid&1)+r32;
  const int nq_rs=min(max(nq_r-4,0),24), nq_cs=min(max(nq_c-8,0),48);
  const int nq_vb=4*hi-nq_cs, nq_lb=48+15+4*hi-nq_c;
  #define BIASMASK(C0,C1,t) do{ if(NAT && (t)>=4){ const int kr_=kr0+(t)-4; const bool rowok_=(unsigned)(kr_-nq_rs)<8u; const int dr_=min(max(kr_-nq_r+7,0),14); \
      const float*tb_=btab+dr_*31+nq_lb; \
      _Pragma("unroll") for(int rb=0;rb<16;rb+=4){ float b0_[4],b1_[4]; \
        _Pragma("unroll") for(int r=0;r<4;++r){ const int kc_=((rb+r)&3)+8*((rb+r)>>2); b0_[r]=tb_[kc_]; b1_[r]=tb_[kc_+32]; } \
        _Pragma("unroll") for(int r=0;r<4;++r){ const int kc_=((rb+r)&3)+8*((rb+r)>>2); \
          const bool v0_=rowok_&&((unsigned)(kc_+nq_vb)<16u), v1_=rowok_&&((unsigned)(kc_+32+nq_vb)<16u); \
          C0[rb+r]=v0_?C0[rb+r]+b0_[r]:-1e30f; C1[rb+r]=v1_?C1[rb+r]+b1_[r]:-1e30f; } \
        SBAR(); } } }while(0)
  const int vb0=(int)(lds0+LDS_V)+((lane>>4)&1)*32+(lane&3)*8+(4*hi+((lane&15)>>2))*64;
  const char*Kbase=shm+LDS_K; bf16x8 kf[8];
  const lds_cptr shm3=(lds_cptr)shm; const lds_cptr kp0=shm3+LDS_K+hi*1024+r32*16; const lds_cptr vp0=shm3+LDS_V+((lane>>4)&1)*32+(lane&3)*8+(4*hi+((lane&15)>>2))*64;
  DMA_K(0,0);DMA_V(0,0);DMA_K(1,SLOTB);
  bf16x8 qr[4];
  #pragma unroll
  for(int d0=0;d0<4;++d0)qr[d0]=*reinterpret_cast<const bf16x8*>(&Qw[(long)r32*QP+d0*16+hi*8]);
  float mhat=0.f,l_reg=0.f;f32x16 o[2];o[0]=f32x16{};o[1]=f32x16{};float zin_;asm volatile("v_mov_b32 %0, 0":"=v"(zin_));f32x16 negm;
  _Pragma("unroll") for(int r=0;r<16;++r)negm[r]=zin_; asm volatile("":"+v"(negm));
  bool resc=false;
  #define START(P0,P1) do{ const float rm=rowmax(P0,P1); resc=false; \
    { const float dl=rm; mhat=fadd_s(mhat,dl); \
      _Pragma("unroll") for(int r=0;r<16;++r){P0[r]=fsub_s(P0[r],dl);P1[r]=fsub_s(P1[r],dl);} \
      _Pragma("unroll") for(int r=0;r<16;++r)negm[r]=-mhat; asm volatile("":"+v"(negm)); } \
    _Pragma("unroll") for(int r=0;r<16;++r)P0[r]=__builtin_amdgcn_exp2f(P0[r]); }while(0)
  #define RESC() do{ if(resc){ asm volatile("s_waitcnt lgkmcnt(0)":::"memory"); \
      _Pragma("unroll") for(int d_=0;d_<2;++d_) _Pragma("unroll") for(int r=0;r<16;++r)o[d_][r]*=wsf[crow(r,hi)]; } }while(0)
  f32x16 pA0,pA1,pB0,pB1;
  int sl_prev=0,sl_cur=0,sl_next=SLOTB;
  #define ROT() do{sl_prev=sl_cur;sl_cur=sl_next;sl_next=(sl_next==(NSLOT-1)*SLOTB)?0:sl_next+SLOTB;}while(0)
  DMA_K(2,2*SLOTB);
  WAIT_BAR(3);
  qkt(pA0,pA1,Kbase,qr,negm,r32,hi);asm volatile("s_nop 15\n\ts_nop 7":"+v"(pA0),"+v"(pA1));
  START(pA0,pA1);
  _Pragma("unroll") for(int r=0;r<16;++r)pA1[r]=__builtin_amdgcn_exp2f(pA1[r]);
  WAIT_BAR(0);
  DMA_K(3,0);DMA_V(1,SLOTB);
  ROT();
  kload8(kf,kp0+sl_cur);
  WAIT_BAR(2);
  s16x4 vlo[8],vhi[8]; u32x4 pw0,pw1,pw2,pw3;
  #define PKW(P,B) cvtpk_s(P[B],P[B+1])
  #define PAF(k) __builtin_bit_cast(bf16x8,pw##k)
  #define VFR(i) (bf16x8){vlo[i][0],vlo[i][1],vlo[i][2],vlo[i][3],vhi[i][0],vhi[i][1],vhi[i][2],vhi[i][3]}
  #define PIN(x) asm volatile("":"+v"(x))
  #define MX3(a,b,c) __builtin_fmaxf(__builtin_fmaxf((a),(b)),(c))
  #define GAPA(MF,A0,A1,A2,A3,W0,W1,PW) do{ MF; sacc+=A0; sacc+=A1; sacc+=A2; sacc+=A3; PIN(sacc); W0; W1; PIN(PW); SBAR(); }while(0)
  #define EX(v) __builtin_amdgcn_exp2f(v)
  #define GAPB(MF,X,B) do{ MF; X[B]=EX(X[B]); X[B+1]=EX(X[B+1]); X[B+2]=EX(X[B+2]); X[B+3]=EX(X[B+3]); PIN(X); SBAR(); }while(0)
  #define VRD(i) do{ vlo[i]=vtr(vp_+(((i)>>2)*4096+((i)&3)*1024)); vhi[i]=vtr(vp_+(((i)>>2)*4096+((i)&3)*1024+512)); }while(0)
  #define KRD(G,j) do{ if(G){ kload2(kf,kp0+sl_next,j); SBAR(); } }while(0)
  bf16*Yw=Yu+(long)(wid*QBLK)*YP; const bf16*Zw=Zu+(long)(wid*QBLK)*YP;
  u32x4 zq[4];
  #define STEP(C0,C1,P0,P1,t,GK,GV,GL,ZL) do{ SBAR(); \
    const lds_cptr vp_=vp0+sl_prev; \
    VRD(0); SBAR(); float sacc=(P0[0]+P0[1]); \
    GAPA(C0=__builtin_amdgcn_mfma_f32_32x32x16_bf16(kf[0],qr[0],negm,0,0,0), P0[2],P0[3],P0[4],P0[5],     pw0[0]=PKW(P0,0), pw0[1]=PKW(P0,2), pw0); \
    VRD(4); SBAR(); GAPA(C1=__builtin_amdgcn_mfma_f32_32x32x16_bf16(kf[1],qr[0],negm,0,0,0), P0[6],P0[7],P0[8],P0[9],     pw0[2]=PKW(P0,4), pw0[3]=PKW(P0,6), pw0); \
    VRD(1); SBAR(); GAPA(C0=__builtin_amdgcn_mfma_f32_32x32x16_bf16(kf[2],qr[1],C0,0,0,0),   P0[10],P0[11],P0[12],P0[13], pw1[0]=PKW(P0,8), pw1[1]=PKW(P0,10), pw1); \
    VRD(5); SBAR(); GAPA(C1=__builtin_amdgcn_mfma_f32_32x32x16_bf16(kf[3],qr[1],C1,0,0,0),   P0[14],P0[15],P1[0],P1[1],   pw1[2]=PKW(P0,12),pw1[3]=PKW(P0,14), pw1); \
    VRD(2); SBAR(); GAPA(C0=__builtin_amdgcn_mfma_f32_32x32x16_bf16(kf[4],qr[2],C0,0,0,0),   P1[2],P1[3],P1[4],P1[5],     pw2[0]=PKW(P1,0), pw2[1]=PKW(P1,2), pw2); \
    VRD(6); SBAR(); GAPA(C1=__builtin_amdgcn_mfma_f32_32x32x16_bf16(kf[5],qr[2],C1,0,0,0),   P1[6],P1[7],P1[8],P1[9],     pw2[2]=PKW(P1,4), pw2[3]=PKW(P1,6), pw2); \
    VRD(3); SBAR(); GAPA(C0=__builtin_amdgcn_mfma_f32_32x32x16_bf16(kf[6],qr[3],C0,0,0,0),   P1[10],P1[11],P1[12],P1[13], pw3[0]=PKW(P1,8), pw3[1]=PKW(P1,10), pw3); \
    VRD(7); SBAR(); GAPA(C1=__builtin_amdgcn_mfma_f32_32x32x16_bf16(kf[7],qr[3],C1,0,0,0),   P1[14],P1[15],0.f,0.f,       pw3[2]=PKW(P1,12),pw3[3]=PKW(P1,14), pw3); \
    l_reg+=sacc; \
    if(GK){DMA_K((t)+3,sl_cur);} if(GV){DMA_V((t)+1,sl_next);} \
    if(ZL){ _Pragma("unroll") for(int i=0;i<4;++i)zq[i]=__builtin_nontemporal_load((const u32x4*)(Zw+(long)(i*8+(lane>>3))*YP+(lane&7)*8)); } \
    BIASMASK(C0,C1,t); \
    { float a=MX3(C0[0],C0[1],C1[0]),b=MX3(C0[2],C0[3],C1[1]); a=MX3(a,C1[2],C1[3]); \
      _Pragma("unroll") for(int r=4;r<16;r+=4){a=MX3(a,C0[r],C0[r+1]);b=MX3(b,C0[r+2],C0[r+3]);a=MX3(a,C1[r],C1[r+1]);b=MX3(b,C1[r+2],C1[r+3]);} \
      float rm=__builtin_fmaxf(a,b); { auto rr=__builtin_amdgcn_permlane32_swap(__float_as_uint(rm),__float_as_uint(rm),false,false); rm=__builtin_fmaxf(__uint_as_float(rr[0]),__uint_as_float(rr[1])); } \
      resc=false; \
      if(__builtin_expect(__any(rm>(float)THRL),0)){ const float dl=__builtin_fmaxf(rm,0.f); mhat+=dl; \
        _Pragma("unroll") for(int r=0;r<16;++r){C0[r]-=dl;C1[r]-=dl;} \
        _Pragma("unroll") for(int r=0;r<16;++r)negm[r]=-mhat; asm volatile("":"+v"(negm)); \
        const float f=__builtin_amdgcn_exp2f(-dl); l_reg*=f; if(hi==0)wsf[r32]=f; resc=true; } } \
    SBAR(); \
    GAPB(o[0]=__builtin_amdgcn_mfma_f32_32x32x16_bf16(PAF(0),VFR(0),o[0],0,0,0), C0,0); \
    GAPB(o[1]=__builtin_amdgcn_mfma_f32_32x32x16_bf16(PAF(0),VFR(4),o[1],0,0,0), C0,4); \
    KRD(GL,0); GAPB(o[0]=__builtin_amdgcn_mfma_f32_32x32x16_bf16(PAF(1),VFR(1),o[0],0,0,0), C0,8); \
    KRD(GL,1); GAPB(o[1]=__builtin_amdgcn_mfma_f32_32x32x16_bf16(PAF(1),VFR(5),o[1],0,0,0), C0,12); \
    KRD(GL,2); GAPB(o[0]=__builtin_amdgcn_mfma_f32_32x32x16_bf16(PAF(2),VFR(2),o[0],0,0,0), C1,0); \
    KRD(GL,3); GAPB(o[1]=__builtin_amdgcn_mfma_f32_32x32x16_bf16(PAF(2),VFR(6),o[1],0,0,0), C1,4); \
    GAPB(o[0]=__builtin_amdgcn_mfma_f32_32x32x16_bf16(PAF(3),VFR(3),o[0],0,0,0), C1,8); \
    GAPB(o[1]=__builtin_amdgcn_mfma_f32_32x32x16_bf16(PAF(3),VFR(7),o[1],0,0,0), C1,12); \
    }while(0)
  int t=1;
  for(;t+5<NT;t+=2){
    STEP(pB0,pB1,pA0,pA1,t,true,true,true,false);     WAIT_BAR(2); RESC(); ROT();
    STEP(pA0,pA1,pB0,pB1,t+1,true,true,true,false);   WAIT_BAR(2); RESC(); ROT();
  }
  #define ENDW(tt) do{ if((tt)+3<NT){WAIT_BAR(2);} else if((tt)+2<NT){WAIT_BAR(1);} else {WAIT_BAR(0);} }while(0)
  for(;t+1<NT;t+=2){
    STEP(pB0,pB1,pA0,pA1,t,(t+3<NT),(t+1<NT),(t+1<NT),false);       ENDW(t);   RESC(); ROT();
    STEP(pA0,pA1,pB0,pB1,t+1,(t+4<NT),(t+2<NT),(t+2<NT),false);     ENDW(t+1); RESC(); ROT();
  }
  STEP(pB0,pB1,pA0,pA1,NT-1,false,false,false,true); RESC();
  { float sacc=pB0[0]+pB0[1]; _Pragma("unroll") for(int r=2;r<16;++r)sacc+=pB0[r]; _Pragma("unroll") for(int r=0;r<16;++r)sacc+=pB1[r]; l_reg+=sacc;
    pw0=(u32x4){PKW(pB0,0),PKW(pB0,2),PKW(pB0,4),PKW(pB0,6)};pw1=(u32x4){PKW(pB0,8),PKW(pB0,10),PKW(pB0,12),PKW(pB0,14)};pw2=(u32x4){PKW(pB1,0),PKW(pB1,2),PKW(pB1,4),PKW(pB1,6)};pw3=(u32x4){PKW(pB1,8),PKW(pB1,10),PKW(pB1,12),PKW(pB1,14)};
    SBAR(); pv(o,vb0+sl_cur,PAF(0),PAF(1),PAF(2),PAF(3)); }
  #undef PKW
  #undef PAF
  #undef VFR
  #undef PIN
  #undef MX3
  #undef GAPA
  #undef GAPB
  #undef EX
  #undef VRD
  #undef KRD
  #undef STEP
  #undef ENDW
  {auto rr=__builtin_amdgcn_permlane32_swap(__float_as_uint(l_reg),__float_as_uint(l_reg),false,false);l_reg=__uint_as_float(rr[0])+__uint_as_float(rr[1]);}
  if(hi==0)wsf[32+r32]=l_reg;asm volatile("s_waitcnt lgkmcnt(0)":::"memory");
  float rli[16];
  #pragma unroll
  for(int r=0;r<16;++r)rli[r]=__builtin_amdgcn_rcpf(wsf[32+crow(r,hi)]);
  { bf16*stg=(bf16*)(shm+LDS_OST)+wid*2048;
    #pragma unroll
    for(int r=0;r<16;++r){const int orow=crow(r,hi);
      #pragma unroll
      for(int d0=0;d0<2;++d0)stg[orow*64+d0*32+r32]=__float2bfloat16(o[d0][r]*rli[r]);}
    asm volatile("s_waitcnt lgkmcnt(0)":::"memory");
    #pragma unroll
    for(int i=0;i<4;++i){const int row=i*8+(lane>>3),ch=lane&7; const u32x4 v=*(const u32x4*)(stg+row*64+ch*8); const u32x4 z=zq[i]; u32x4 w;
      w.x=cvtpk_s(__uint_as_float(v.x<<16)*__uint_as_float(z.x<<16),__uint_as_float(v.x&0xffff0000u)*__uint_as_float(z.x&0xffff0000u));
      w.y=cvtpk_s(__uint_as_float(v.y<<16)*__uint_as_float(z.y<<16),__uint_as_float(v.y&0xffff0000u)*__uint_as_float(z.y&0xffff0000u));
      w.z=cvtpk_s(__uint_as_float(v.z<<16)*__uint_as_float(z.z<<16),__uint_as_float(v.z&0xffff0000u)*__uint_as_float(z.z&0xffff0000u));
      w.w=cvtpk_s(__uint_as_float(v.w<<16)*__uint_as_float(z.w<<16),__uint_as_float(v.w&0xffff0000u)*__uint_as_float(z.w&0xffff0000u));
      *(u32x4*)(Yw+(long)row*YP+ch*8)=w;} }
  asm volatile("s_waitcnt lgkmcnt(0)\n\ts_barrier":::"memory");
  #undef DMA_K
  #undef DMA_V
  #undef TOFF
  #undef BIASMASK
  #undef START
  #undef RESC
  #undef ROT
}
constexpr int NA_SLOTB=16384, NA_LDS_K=0, NA_LDS_V=3*NA_SLOTB, NA_LDS_WS=6*NA_SLOTB, NA_LDS_OST=NA_LDS_WS+NW*64*4, NA_LDS_BYTES=NA_LDS_OST+NW*4096;
template<int THRL> __device__ __forceinline__ void na_attn_unit(const bf16*Qu,const bf16*__restrict__ Kh,const bf16*__restrict__ Vh,const int NT,bf16*Yu,const bf16*Zu,char*shm,
    const long ctxoff,const long winoff,const int kr0,const int rq0,const float*btab){
  constexpr int KVP=512;
  const int tid=threadIdx.x,lane=tid&63,r32=lane&31,hi=lane>>5; const int wid=__builtin_amdgcn_readfirstlane(tid>>6);
  const int wi=wid>>2, wj=wid&3;
  const int c0=(wj==0)?0:(wj==1)?8:(wj==2)?24:32;
  const int qtok=(2*wi+(r32>>4))*64+16*wj+(r32&15);
  const unsigned lds0=(unsigned)(uintptr_t)shm;
  float*wsf=(float*)(shm+NA_LDS_WS)+wid*64;
  const bf16*ksrc=Kh+(long)lane*KVP+wid*8;
  const bf16*vsrc=Vh+(long)(16*(wid&3)+(lane>>2))*KVP+(wid>>2)*32+(lane&3)*8;
  const unsigned kdst=lds0+NA_LDS_K+wid*1024, vdst=lds0+NA_LDS_V+wid*1024;
  #define DMA_K(t,slot) do{ if((t)<4){ glds16(ksrc+(ctxoff+(long)(t)*KVBLK)*KVP,(unsigned)__builtin_amdgcn_readfirstlane(kdst+(slot))); } \
      else { glds16(ksrc+(winoff+(long)(2*((t)-4))*KVBLK)*KVP,(unsigned)__builtin_amdgcn_readfirstlane(kdst+(slot))); glds16(ksrc+(winoff+(long)(2*((t)-4)+1)*KVBLK)*KVP,(unsigned)__builtin_amdgcn_readfirstlane(kdst+(slot)+8192)); } }while(0)
  #define DMA_V(t,slot) do{ if((t)<4){ glds16(vsrc+(ctxoff+(long)(t)*KVBLK)*KVP,(unsigned)__builtin_amdgcn_readfirstlane(vdst+(slot))); } \
      else { glds16(vsrc+(winoff+(long)(2*((t)-4))*KVBLK)*KVP,(unsigned)__builtin_amdgcn_readfirstlane(vdst+(slot))); glds16(vsrc+(winoff+(long)(2*((t)-4)+1)*KVBLK)*KVP,(unsigned)__builtin_amdgcn_readfirstlane(vdst+(slot)+8192)); } }while(0)
  const int nq_r=rq0+2*wi+(r32>>4), nq_c=16*wj+(r32&15);
  const int nq_rs=min(max(nq_r-4,0),24), nq_cs=min(max(nq_c-8,0),48);
  const int nq_vb=c0+4*hi-nq_cs, nq_lb=48+15+c0+4*hi-nq_c;
  const char*Kbase=shm+NA_LDS_K; bf16x8 kf[8];
  const lds_cptr shm3=(lds_cptr)shm; const lds_cptr kp0=shm3+NA_LDS_K+hi*1024+r32*16; const lds_cptr vp0=shm3+NA_LDS_V+((lane>>4)&1)*32+(lane&3)*8+(4*hi+((lane&15)>>2))*64;
  const lds_cptr kpw=kp0+c0*16, vpw=vp0+c0*64;
  const int vbw=(int)(lds0+NA_LDS_V)+((lane>>4)&1)*32+(lane&3)*8+(4*hi+((lane&15)>>2))*64+c0*64;
  DMA_K(0,0);DMA_V(0,0);DMA_K(1,NA_SLOTB);
  bf16x8 qr[4];
  #pragma unroll
  for(int d0=0;d0<4;++d0)qr[d0]=*reinterpret_cast<const bf16x8*>(&Qu[(long)qtok*QP+d0*16+hi*8]);
  float mhat=0.f,l_reg=0.f;f32x16 o[2];o[0]=f32x16{};o[1]=f32x16{};float zin_;asm volatile("v_mov_b32 %0, 0":"=v"(zin_));f32x16 negm;
  _Pragma("unroll") for(int r=0;r<16;++r)negm[r]=zin_; asm volatile("":"+v"(negm));
  bool resc=false;
  #define RESC() do{ if(resc){ asm volatile("s_waitcnt lgkmcnt(0)":::"memory"); \
      _Pragma("unroll") for(int d_=0;d_<2;++d_) _Pragma("unroll") for(int r=0;r<16;++r)o[d_][r]*=wsf[crow(r,hi)]; } }while(0)
  f32x16 pA0,pA1,pB0,pB1;
  int sl_prev=0,sl_cur=0,sl_next=NA_SLOTB;
  #define ROT() do{sl_prev=sl_cur;sl_cur=sl_next;sl_next=(sl_next==2*NA_SLOTB)?0:sl_next+NA_SLOTB;}while(0)
  DMA_K(2,2*NA_SLOTB);
  WAIT_BAR(3);
  qkt(pA0,pA1,Kbase,qr,negm,r32,hi);asm volatile("s_nop 15\n\ts_nop 7":"+v"(pA0),"+v"(pA1));
  { const float rm=rowmax(pA0,pA1); mhat=fadd_s(mhat,rm);
    _Pragma("unroll") for(int r=0;r<16;++r){pA0[r]=fsub_s(pA0[r],rm);pA1[r]=fsub_s(pA1[r],rm);}
    _Pragma("unroll") for(int r=0;r<16;++r)negm[r]=-mhat; asm volatile("":"+v"(negm));
    _Pragma("unroll") for(int r=0;r<16;++r)pA0[r]=__builtin_amdgcn_exp2f(pA0[r]);
    _Pragma("unroll") for(int r=0;r<16;++r)pA1[r]=__builtin_amdgcn_exp2f(pA1[r]); }
  WAIT_BAR(0);
  DMA_K(3,0);DMA_V(1,NA_SLOTB);
  ROT();
  kload8(kf,kp0+sl_cur);
  WAIT_BAR(2);
  s16x4 vlo[8],vhi[8]; u32x4 pw0,pw1,pw2,pw3;
  #define PKW(P,B) cvtpk_s(P[B],P[B+1])
  #define PAF(k) __builtin_bit_cast(bf16x8,pw##k)
  #define VFR(i) (bf16x8){vlo[i][0],vlo[i][1],vlo[i][2],vlo[i][3],vhi[i][0],vhi[i][1],vhi[i][2],vhi[i][3]}
  #define PIN(x) asm volatile("":"+v"(x))
  #define MX3(a,b,c) __builtin_fmaxf(__builtin_fmaxf((a),(b)),(c))
  #define MFMA(a,b,c) __builtin_amdgcn_mfma_f32_32x32x16_bf16(a,b,c,0,0,0)
  #define GAPA(MF,A0,A1,A2,A3,W0,W1,PW) do{ MF; sacc+=A0; sacc+=A1; sacc+=A2; sacc+=A3; PIN(sacc); W0; W1; PIN(PW); SBAR(); }while(0)
  #define EX(v) __builtin_amdgcn_exp2f(v)
  #define GAPB(MF,X,B) do{ MF; X[B]=EX(X[B]); X[B+1]=EX(X[B+1]); X[B+2]=EX(X[B+2]); X[B+3]=EX(X[B+3]); PIN(X); SBAR(); }while(0)
  #define VRD(i,PW) do{ if(PW){ vlo[i]=vtr(vpw+sl_prev+((((i)&2)?8192:0)+((i)>>2)*4096+((i)&1)*1024)); vhi[i]=vtr(vpw+sl_prev+((((i)&2)?8192:0)+((i)>>2)*4096+((i)&1)*1024+512)); } \
      else { vlo[i]=vtr(vp0+sl_prev+(((i)>>2)*4096+((i)&3)*1024)); vhi[i]=vtr(vp0+sl_prev+(((i)>>2)*4096+((i)&3)*1024+512)); } }while(0)
  #define KRD(G,j,NW_) do{ if(G){ if(NW_){ kf[2*(j)]=*(const __attribute__((address_space(3))) bf16x8*)(kpw+sl_next+(j)*2048); kf[2*(j)+1]=*(const __attribute__((address_space(3))) bf16x8*)(kpw+sl_next+8192+(j)*2048); } \
      else { kload2(kf,kp0+sl_next,j); } SBAR(); } }while(0)
  #define COLV(r) ((unsigned)(((r)&3)+8*((r)>>2)+nq_vb)<16u)
  #define DECIDE2(C0,C1,WIN_) do{ float a=MX3(C0[0],C0[1],C1[0]),b=MX3(C0[2],C0[3],C1[1]); a=MX3(a,C1[2],C1[3]); \
      _Pragma("unroll") for(int r=4;r<16;r+=4){a=MX3(a,C0[r],C0[r+1]);b=MX3(b,C0[r+2],C0[r+3]);a=MX3(a,C1[r],C1[r+1]);b=MX3(b,C1[r+2],C1[r+3]);} \
      float rm=__builtin_fmaxf(a,b); { auto rr=__builtin_amdgcn_permlane32_swap(__float_as_uint(rm),__float_as_uint(rm),false,false); rm=__builtin_fmaxf(__uint_as_float(rr[0]),__uint_as_float(rr[1])); } \
      resc=false; \
      if(__builtin_expect(__any(rm>(float)THRL),0)){ const float dl=__builtin_fmaxf(rm,0.f); mhat+=dl; \
        _Pragma("unroll") for(int r=0;r<16;++r){C0[r]-=dl;C1[r]-=dl;} \
        _Pragma("unroll") for(int r=0;r<16;++r)negm[r]=((WIN_)&&!COLV(r))?-1e30f:-mhat; asm volatile("":"+v"(negm)); \
        const float f=__builtin_amdgcn_exp2f(-dl); l_reg*=f; if(hi==0)wsf[r32]=f; resc=true; } }while(0)
  #define NBIAS1(C,kr_) do{ const bool rowok_=(unsigned)((kr_)-nq_rs)<8u; const int dr_=min(max((kr_)-nq_r+7,0),14); \
      const float*tb_=btab+(rowok_?dr_*31+nq_lb:513); float b_[16]; \
      _Pragma("unroll") for(int r=0;r<16;++r){ const int kc_=(r&3)+8*(r>>2); b_[r]=tb_[kc_]; } \
      _Pragma("unroll") for(int r=0;r<16;++r){ C[r]+=b_[r]; } \
      SBAR(); }while(0)
  u32x4 zq[4];
  #define NSTEP(C0,C1,P0,P1,t,GK,GV,GL,WIN_,PW,NW_,ZL) do{ SBAR(); \
    VRD(0,PW); SBAR(); float sacc=(P0[0]+P0[1]); \
    GAPA(C0=MFMA(kf[0],qr[0],negm), P0[2],P0[3],P0[4],P0[5],     pw0[0]=PKW(P0,0), pw0[1]=PKW(P0,2), pw0); \
    VRD(4,PW); SBAR(); GAPA(C1=MFMA(kf[1],qr[0],negm), P0[6],P0[7],P0[8],P0[9],     pw0[2]=PKW(P0,4), pw0[3]=PKW(P0,6), pw0); \
    VRD(1,PW); SBAR(); GAPA(C0=MFMA(kf[2],qr[1],C0),   P0[10],P0[11],P0[12],P0[13], pw1[0]=PKW(P0,8), pw1[1]=PKW(P0,10), pw1); \
    VRD(5,PW); SBAR(); GAPA(C1=MFMA(kf[3],qr[1],C1),   P0[14],P0[15],P1[0],P1[1],   pw1[2]=PKW(P0,12),pw1[3]=PKW(P0,14), pw1); \
    VRD(2,PW); SBAR(); GAPA(C0=MFMA(kf[4],qr[2],C0),   P1[2],P1[3],P1[4],P1[5],     pw2[0]=PKW(P1,0), pw2[1]=PKW(P1,2), pw2); \
    VRD(6,PW); SBAR(); GAPA(C1=MFMA(kf[5],qr[2],C1),   P1[6],P1[7],P1[8],P1[9],     pw2[2]=PKW(P1,4), pw2[3]=PKW(P1,6), pw2); \
    VRD(3,PW); SBAR(); GAPA(C0=MFMA(kf[6],qr[3],C0),   P1[10],P1[11],P1[12],P1[13], pw3[0]=PKW(P1,8), pw3[1]=PKW(P1,10), pw3); \
    VRD(7,PW); SBAR(); GAPA(C1=MFMA(kf[7],qr[3],C1),   P1[14],P1[15],0.f,0.f,       pw3[2]=PKW(P1,12),pw3[3]=PKW(P1,14), pw3); \
    l_reg+=sacc; \
    if(GK){DMA_K((t)+3,sl_cur);} if(GV){DMA_V((t)+1,sl_next);} \
    if(ZL){ _Pragma("unroll") for(int i=0;i<4;++i){const int row=i*8+(lane>>3); const long tok=(2*wi+(row>>4))*64+16*wj+(row&15); zq[i]=__builtin_nontemporal_load((const u32x4*)(Zu+tok*YP+(lane&7)*8));} } \
    if(WIN_){ const int krA_=kr0+2*((t)-4); NBIAS1(C0,krA_); NBIAS1(C1,krA_+1); } \
    DECIDE2(C0,C1,WIN_); \
    SBAR(); \
    GAPB(o[0]=MFMA(PAF(0),VFR(0),o[0]), C0,0); \
    GAPB(o[1]=MFMA(PAF(0),VFR(4),o[1]), C0,4); \
    KRD(GL,0,NW_); GAPB(o[0]=MFMA(PAF(1),VFR(1),o[0]), C0,8); \
    KRD(GL,1,NW_); GAPB(o[1]=MFMA(PAF(1),VFR(5),o[1]), C0,12); \
    KRD(GL,2,NW_); GAPB(o[0]=MFMA(PAF(2),VFR(2),o[0]), C1,0); \
    KRD(GL,3,NW_); GAPB(o[1]=MFMA(PAF(2),VFR(6),o[1]), C1,4); \
    GAPB(o[0]=MFMA(PAF(3),VFR(3),o[0]), C1,8); \
    GAPB(o[1]=MFMA(PAF(3),VFR(7),o[1]), C1,12); \
    }while(0)
  #define ENDW(tt) do{ if((tt)+3<NT){WAIT_BAR(4);} else if((tt)+2<NT){WAIT_BAR(2);} else {WAIT_BAR(0);} }while(0)
  NSTEP(pB0,pB1,pA0,pA1,1,true,true,true,false,false,false,false); WAIT_BAR(3); RESC(); ROT();
  NSTEP(pA0,pA1,pB0,pB1,2,true,true,true,false,false,false,false); WAIT_BAR(3); RESC(); ROT();
  NSTEP(pB0,pB1,pA0,pA1,3,true,true,true,false,false,true,false);  WAIT_BAR(4); RESC(); ROT();
  _Pragma("unroll") for(int r=0;r<16;++r)negm[r]=COLV(r)?negm[r]:-1e30f; asm volatile("":"+v"(negm));
  NSTEP(pA0,pA1,pB0,pB1,4,(7<NT),true,true,true,false,true,false); ENDW(4);     RESC(); ROT();
  int t=5;
  for(;t+2<NT;t+=2){
    NSTEP(pB0,pB1,pA0,pA1,t,(t+3<NT),(t+1<NT),(t+1<NT),true,true,true,false);     ENDW(t);   RESC(); ROT();
    NSTEP(pA0,pA1,pB0,pB1,t+1,(t+4<NT),(t+2<NT),(t+2<NT),true,true,true,false);   ENDW(t+1); RESC(); ROT();
  }
  NSTEP(pB0,pB1,pA0,pA1,NT-1,false,false,false,true,true,true,true); RESC();
  { float sacc=pB0[0]+pB0[1]; _Pragma("unroll") for(int r=2;r<16;++r)sacc+=pB0[r]; _Pragma("unroll") for(int r=0;r<16;++r)sacc+=pB1[r]; l_reg+=sacc;
    pw0=(u32x4){PKW(pB0,0),PKW(pB0,2),PKW(pB0,4),PKW(pB0,6)};pw1=(u32x4){PKW(pB0,8),PKW(pB0,10),PKW(pB0,12),PKW(pB0,14)};pw2=(u32x4){PKW(pB1,0),PKW(pB1,2),PKW(pB1,4),PKW(pB1,6)};pw3=(u32x4){PKW(pB1,8),PKW(pB1,10),PKW(pB1,12),PKW(pB1,14)};
    SBAR();
    const int vb=vbw+sl_cur;
    #pragma unroll
    for(int d0=0;d0<2;++d0){s16x4 lo[4],hh[4];
      #pragma unroll
      for(int ks=0;ks<4;++ks){
        asm volatile("ds_read_b64_tr_b16 %0,%1 offset:%c2":"=&v"(lo[ks]):"v"(vb),"i"(((ks&2)?8192:0)+d0*4096+(ks&1)*1024):"memory");
        asm volatile("ds_read_b64_tr_b16 %0,%1 offset:%c2":"=&v"(hh[ks]):"v"(vb),"i"(((ks&2)?8192:0)+d0*4096+(ks&1)*1024+512):"memory");}
      asm volatile("s_waitcnt lgkmcnt(0)":::"memory");SBAR();
      #define PK(k) (bf16x8){lo[k][0],lo[k][1],lo[k][2],lo[k][3],hh[k][0],hh[k][1],hh[k][2],hh[k][3]}
      o[d0]=MFMA(PAF(0),PK(0),o[d0]);
      o[d0]=MFMA(PAF(1),PK(1),o[d0]);
      o[d0]=MFMA(PAF(2),PK(2),o[d0]);
      o[d0]=MFMA(PAF(3),PK(3),o[d0]);
      #undef PK
    } }
  #undef PKW
  #undef PAF
  #undef VFR
  #undef PIN
  #undef MX3
  #undef MFMA
  #undef GAPA
  #undef GAPB
  #undef EX
  #undef VRD
  #undef KRD
  #undef DECIDE2
  #undef COLV
  #undef NBIAS1
  #undef NSTEP
  #undef ENDW
  {auto rr=__builtin_amdgcn_permlane32_swap(__float_as_uint(l_reg),__float_as_uint(l_reg),false,false);l_reg=__uint_as_float(rr[0])+__uint_as_float(rr[1]);}
  if(hi==0)wsf[32+r32]=l_reg;asm volatile("s_waitcnt lgkmcnt(0)":::"memory");
  float rli[16];
  #pragma unroll
  for(int r=0;r<16;++r)rli[r]=__builtin_amdgcn_rcpf(wsf[32+crow(r,hi)]);
  { bf16*stg=(bf16*)(shm+NA_LDS_OST)+wid*2048;
    #pragma unroll
    for(int r=0;r<16;++r){const int orow=crow(r,hi);
      #pragma unroll
      for(int d0=0;d0<2;++d0)stg[orow*64+d0*32+r32]=__float2bfloat16(o[d0][r]*rli[r]);}
    asm volatile("s_waitcnt lgkmcnt(0)":::"memory");
    #pragma unroll
    for(int i=0;i<4;++i){const int row=i*8+(lane>>3),ch=lane&7; const long tok=(2*wi+(row>>4))*64+16*wj+(row&15);
      const u32x4 v=*(const u32x4*)(stg+row*64+ch*8); const u32x4 z=zq[i]; u32x4 w;
      w.x=cvtpk_s(__uint_as_float(v.x<<16)*__uint_as_float(z.x<<16),__uint_as_float(v.x&0xffff0000u)*__uint_as_float(z.x&0xffff0000u));
      w.y=cvtpk_s(__uint_as_float(v.y<<16)*__uint_as_float(z.y<<16),__uint_as_float(v.y&0xffff0000u)*__uint_as_float(z.y&0xffff0000u));
      w.z=cvtpk_s(__uint_as_float(v.z<<16)*__uint_as_float(z.z<<16),__uint_as_float(v.z&0xffff0000u)*__uint_as_float(z.z&0xffff0000u));
      w.w=cvtpk_s(__uint_as_float(v.w<<16)*__uint_as_float(z.w<<16),__uint_as_float(v.w&0xffff0000u)*__uint_as_float(z.w&0xffff0000u));
      *(u32x4*)(Yu+tok*YP+ch*8)=w;} }
  asm volatile("s_waitcnt lgkmcnt(0)\n\ts_barrier":::"memory");
  #undef DMA_K
  #undef DMA_V
  #undef RESC
  #undef ROT
}
#undef SBAR
#undef WAIT_BAR
}

DEVI int p3_rank(const Frame& F) { const int vcu = (F.bid & 7) * (F.G >> 3) + (F.bid >> 3); return ((vcu & 31) < 4) ? -1 : vcu - 4 * ((vcu >> 5) + 1); }
DEVI void p3_wait_deferred(Frame& F) {
    if (F.wave == 0) { unsigned* gate = (unsigned*)(F.ws + WS_PCNT) + 64 * 67; unsigned sp = 0;
        while ((unsigned)__builtin_amdgcn_readfirstlane(__hip_atomic_load(gate, __ATOMIC_RELAXED, __HIP_MEMORY_SCOPE_AGENT)) < 32u) { __builtin_amdgcn_s_sleep(8); if (++sp > (1u << 20)) break; }
        __builtin_amdgcn_fence(__ATOMIC_ACQUIRE, "agent"); }
    asm volatile("s_waitcnt vmcnt(0)" ::: "memory");
    __syncthreads();
}
DEVI void phase_attn0(Frame& F, char* lds_generic) {
    using abf = attn_body::bf16;
    const abf* Q0 = (const abf*)wsb(F, WS_Q0); const abf* K0 = (const abf*)wsb(F, WS_K0); const abf* V0 = (const abf*)wsb(F, WS_V0);
    const abf* SZ = (const abf*)wsb(F, WS_SZ0); abf* Y = (abf*)wsb(F, WS_Y0);
    const int vcu = (F.bid & 7) * (F.G >> 3) + (F.bid >> 3);
    const int rk = p3_rank(F);
    for (int k = 0; k < 3; ++k) {
        int id;
        if (k < 2) id = vcu + k * F.G; else { if (rk < 160) break; id = 512 + (rk - 160); p3_wait_deferred(F); }
        int b, head, NT; size_t row0;
        if (id < 512) { const int qb = id & 7, g = (id >> 3) & 3, kvh = (id >> 5) & 1; b = id >> 6; head = kvh * 4 + g; row0 = (size_t)b * SEQ + qb * 256; NT = NKEY0 / 64; }
        else { const int j = id - 512; b = j >> 3; head = j & 7; row0 = (size_t)MX + b * CTXL; NT = CTXL / 64; }
        const size_t kvoff = (size_t)b * NKEY0 * 128 + (head >> 2) * 64;
        attn_body::attn_unit<8, false, 128>(Q0 + row0 * 512 + head * 64, K0 + kvoff, V0 + kvoff, NT, Y + row0 * 1024 + 512 + head * 64, SZ + row0 * 1024 + 512 + head * 64, lds_generic);
    }
}

DEVI void phase_conv(Frame& F) {
    LAS float* red = (LAS float*)F.lds;
    const bf16* GLU = wsb(F, WS_GLU); const bf16* SZ = wsb(F, WS_SZ0); bf16* Y = wsb(F, WS_Y0);
    const int half = F.wave >> 2, wq = F.wave & 3, c2 = wq * 128 + F.lane * 2;
    typedef float f32x2v __attribute__((ext_vector_type(2)));
    f32x2v wt[31];
#pragma unroll
    for (int t = 0; t < 31; ++t) wt[t] = *(const f32x2v*)(F.in[I_AB_CONVW] + t * 512 + c2);
    const float2 cb = *(const float2*)(F.in[I_AB_CONVB] + c2), lg = *(const float2*)(F.in[I_AB_LNG] + c2), lb = *(const float2*)(F.in[I_AB_LNB] + c2);
    constexpr int NCH = MT / 16;
    const int rk = p3_rank(F);
    bool waited = rk >= 160;
    for (int it = rk; rk >= 0 && it * 2 < NCH; it += 224) {
        if (it * 32 >= MX && !waited) { p3_wait_deferred(F); waited = true; }
        const int ch = it * 2 + half;
        const int row0 = ch * 16;
        int base, len, pos0;
        if (row0 < MX) { base = row0 & ~2047; len = SEQ; pos0 = row0 & 2047; } else { const int rc = row0 - MX; base = MX + (rc & ~255); len = CTXL; pos0 = rc & 255; }
        unsigned gin[46];
#pragma unroll
        for (int pi = 0; pi < 46; ++pi) { const int p = pos0 - 15 + pi, pc = min(max(p, 0), len - 1); gin[pi] = *(const unsigned*)(GLU + (size_t)(base + pc) * 512 + c2); }
#pragma unroll
        for (int pi = 0; pi < 46; ++pi) { const int p = pos0 - 15 + pi; gin[pi] = (p >= 0 && p < len) ? gin[pi] : 0u; }
        unsigned zin[16];
#pragma unroll
        for (int li = 0; li < 16; ++li) zin[li] = __builtin_nontemporal_load((const unsigned*)(SZ + (size_t)(row0 + li) * 1024 + c2));
        f32x2v av[16];
#pragma unroll
        for (int li = 0; li < 16; ++li) av[li] = (f32x2v){cb.x, cb.y};
#pragma unroll
        for (int pi = 0; pi < 46; ++pi) { const f32x2v g = (f32x2v){bflo(gin[pi]), bfhi(gin[pi])};
#pragma unroll
            for (int li = 0; li < 16; ++li) { const int t = pi - li; if (t >= 0 && t <= 30) av[li] = __builtin_elementwise_fma(g, wt[t], av[li]); } }
        float a0[16], a1[16];
#pragma unroll
        for (int li = 0; li < 16; ++li) { a0[li] = av[li].x; a1[li] = av[li].y; }
        float st[32];
#pragma unroll
        for (int li = 0; li < 16; ++li) { st[li] = a0[li] + a1[li]; st[16 + li] = a0[li] * a0[li] + a1[li] * a1[li]; }
#define WS_STEP(ctrl, rmask) _Pragma("unroll") for (int j = 0; j < 32; ++j) st[j] += __builtin_bit_cast(float, __builtin_amdgcn_update_dpp(0, __builtin_bit_cast(int, st[j]), ctrl, rmask, 0xf, true))
        WS_STEP(0xB1, 0xf); WS_STEP(0x4E, 0xf); WS_STEP(0x141, 0xf); WS_STEP(0x140, 0xf); WS_STEP(0x142, 0xa); WS_STEP(0x143, 0xc);
#undef WS_STEP
#pragma unroll
        for (int j = 0; j < 32; ++j) st[j] = __builtin_bit_cast(float, __builtin_amdgcn_readlane(__builtin_bit_cast(int, st[j]), 63));
        __syncthreads();
        if (F.lane < 32) { float v = st[0];
#pragma unroll
            for (int j = 1; j < 32; ++j) v = (F.lane == j) ? st[j] : v;
            red[(half * 4 + wq) * 32 + F.lane] = v; }
        __syncthreads();
#pragma unroll
        for (int li = 0; li < 16; ++li) {
            const LAS float* rp = red + half * 128;
            const float sm = (rp[li] + rp[32 + li]) + (rp[64 + li] + rp[96 + li]), sq = (rp[16 + li] + rp[48 + li]) + (rp[80 + li] + rp[112 + li]);
            const float mean = sm * (1.f / 512.f), var = fmaxf(sq * (1.f / 512.f) - mean * mean, 0.f), rstd = __builtin_amdgcn_rsqf(var + EPS);
            const float y0 = fsilu((a0[li] - mean) * rstd * lg.x + lb.x) * bflo(zin[li]), y1 = fsilu((a1[li] - mean) * rstd * lg.y + lb.y) * bfhi(zin[li]);
            *(unsigned*)(Y + (size_t)(row0 + li) * 1024 + c2) = pk2(y0, y1);
        }
    }
    __syncthreads();
}

constexpr int NA_BTAB_OFF = 133120;
DEVI void na_fill_table(Frame& F, int h) {
    LAS float* bt = (LAS float*)(F.lds + NA_BTAB_OFF);
    const float* rpb = F.in[I_CD_RPB] + h * 15 * 31;
    for (int i = F.tid; i < 544; i += NTHR) bt[i] = (i < 48) ? 0.f : (i < 48 + 465) ? rpb[i - 48] * LOG2E : -1e30f;
}
DEVI void na_unit(Frame& F, char* lds_generic, int id, int& cur_h) {
    using abf = attn_body::bf16;
    const abf* Q1 = (const abf*)wsb(F, WS_Q1); const abf* K1 = (const abf*)wsb(F, WS_K1); const abf* V1 = (const abf*)wsb(F, WS_V1);
    const abf* SZ1 = (const abf*)wsb(F, WS_SZ1); abf* Y1 = (abf*)wsb(F, WS_Y1);
    const int rg = id & 7, h = (id >> 3) & 7, b = id >> 6;
    const int r0 = 4 * rg, kr0 = min(max(r0 - 4, 0), 24), nwin = (rg == 0 || rg == 7) ? 8 : 12;
    if (h != cur_h) { na_fill_table(F, h); cur_h = h; }
    const size_t row0 = (size_t)b * SEQ + r0 * 64;
    attn_body::na_attn_unit<8>(Q1 + row0 * 512 + h * 64, K1 + h * 64, V1 + h * 64, 4 + nwin / 2, Y1 + row0 * 1024 + 512 + h * 64, SZ1 + row0 * 1024 + 512 + h * 64, lds_generic,
                                       (long)MX + b * CTXL, (long)b * SEQ + kr0 * 64, kr0, r0, (const float*)(lds_generic + NA_BTAB_OFF));
}
DEVI void phase_shiftw(Frame& F) {
    LAS float* sh = (LAS float*)F.lds;
    __syncthreads();
    const float* ada1 = wsf(F, WS_ADA) + 9 * 3072;
    for (int i = F.tid; i < 9 * 1024; i += NTHR) sh[i] = ada1[(i >> 10) * 3072 + (i & 1023)];
    __syncthreads();
    const bf16* WT = wsb(F, WS_WIN1); float* sw = wsf(F, WS_SW);
    const int rk = p3_rank(F); const bool light = rk >= 128 && rk < 160;
    const int gw = light ? 1792 + (rk - 128) * NWAVES + F.wave : ((rk < 0) ? F.bid : (rk < 128 ? 32 + rk : rk)) * NWAVES + F.wave;
    const int NGW = 256, nend = light ? N1 : gw + 1;
    for (int n = gw; n < nend; n += NGW) {
        const v4u w0 = *(const v4u*)(WT + (size_t)n * DM + F.lane * 16), w1 = *(const v4u*)(WT + (size_t)n * DM + F.lane * 16 + 8);
        float wv[16] = {bflo(w0.x), bfhi(w0.x), bflo(w0.y), bfhi(w0.y), bflo(w0.z), bfhi(w0.z), bflo(w0.w), bfhi(w0.w), bflo(w1.x), bfhi(w1.x), bflo(w1.y), bfhi(w1.y), bflo(w1.z), bfhi(w1.z), bflo(w1.w), bfhi(w1.w)};
        float a[9];
#pragma unroll
        for (int r = 0; r < 9; ++r) { a[r] = 0.f;
#pragma unroll
            for (int q = 0; q < 4; ++q) { const f32x4 sv = *(const LAS f32x4*)(sh + r * 1024 + F.lane * 16 + 4 * q); a[r] += sv.x * wv[4 * q] + sv.y * wv[4 * q + 1] + sv.z * wv[4 * q + 2] + sv.w * wv[4 * q + 3]; } }
#define WS_STEP(ctrl, rmask) _Pragma("unroll") for (int r = 0; r < 9; ++r) a[r] += __builtin_bit_cast(float, __builtin_amdgcn_update_dpp(0, __builtin_bit_cast(int, a[r]), ctrl, rmask, 0xf, true))
        WS_STEP(0xB1, 0xf); WS_STEP(0x4E, 0xf); WS_STEP(0x141, 0xf); WS_STEP(0x140, 0xf); WS_STEP(0x142, 0xa); WS_STEP(0x143, 0xc);
#undef WS_STEP
        if (F.lane == 63) {
#pragma unroll
            for (int r = 0; r < 9; ++r) sw[r * N1 + n] = a[r]; }
    }
    __syncthreads();
}
__global__ void __launch_bounds__(NTHR, 2) mk_fwd(Args args) {
    extern __shared__ __attribute__((aligned(16))) unsigned char lds[];
    Frame F;
    F.lds = (LAS unsigned char*)lds;
    F.tid = threadIdx.x; F.lane = F.tid & 63; F.wave = __builtin_amdgcn_readfirstlane(F.tid >> 6);
    F.G = gridDim.x; F.bid = blockIdx.x;
#pragma unroll
    for (int i = 0; i < 23; ++i) F.in[i] = args.in[i];
    F.out = args.out; F.ws = args.ws;
    volatile LAS unsigned* MISC = (volatile LAS unsigned*)(F.lds + MISC_OFF);
    if (F.tid < 32) MISC[F.tid] = 0u;
    __syncthreads();
    unsigned* ctl = (unsigned*)(F.ws + WS_CTL);
    XcdBarrier bar; bar.bar = ctl + CW_BAR; bar.x = 0; bar.st = nullptr;
    if (MK_N_LAUNCHES == 1) bar = xcd_barrier_post(ctl + CW_BAR, MISC + 8);
    const int lo = args.ph_lo, hi = args.ph_hi;
#define IN(k) (lo <= (k) && (k) < hi)
    volatile LAS unsigned long long* TS = (volatile LAS unsigned long long*)(F.lds + 146432);
#define STAMP(k) do { if (PROBE_PHASE >= 0 && F.bid == 0 && F.tid == 0) TS[k] = __builtin_amdgcn_s_memrealtime(); } while (0)
#define SEAM(k) do { if (IN(k) && IN((k) + 1)) xcd_barrier(bar); STAMP((k) + 1); } while (0)
    STAMP(0);

    {
        f32x4 xpf[XPF][4];
        if (IN(0)) { p0_prologue(F, xpf); } SEAM(0);
        if (IN(1)) { phase_modnorm(F, 0, xpf); } SEAM(1);
    }
    if (IN(2)) {
        EpiIn0 E{wsb(F, WS_GLU), wsb(F, WS_Q0), wsb(F, WS_K0), wsb(F, WS_V0), wsb(F, WS_SZ0), F.in[I_AB_QNG], F.in[I_AB_KNG], wsf(F, WS_ROPE)};
        pg8::SegOrder S; S.init(pg8::Seg{wsb(F, WS_H), wsb(F, WS_WIN0), 72, 7, 0}, pg8::Seg{wsb(F, WS_H), wsb(F, WS_WIN0) + (size_t)7 * 256 * DM, 64, 4, 1}, pg8::Seg{nullptr, nullptr, 0, 0, 0}, DM, F.G, F.bid);
        pg8::gemm_phase<EpiIn0, pg8::SegOrder>(F.lds, DM, S, E);
        p2_fill_fold(F);
    } SEAM(2);
    if (IN(3)) {
        if (F.bid < 32) {
            EpiIn0 E{wsb(F, WS_GLU), wsb(F, WS_Q0), wsb(F, WS_K0), wsb(F, WS_V0), wsb(F, WS_SZ0), F.in[I_AB_QNG], F.in[I_AB_KNG], wsf(F, WS_ROPE)};
            pg8::SegOrder S; S.init(pg8::Seg{wsb(F, WS_H) + (size_t)64 * 256 * DM, wsb(F, WS_WIN0) + (size_t)7 * 256 * DM, 8, 4, 2}, pg8::Seg{nullptr, nullptr, 0, 0, 0}, pg8::Seg{nullptr, nullptr, 0, 0, 0}, DM, F.G, F.bid);
            pg8::gemm_phase<EpiIn0, pg8::SegOrder>(F.lds, DM, S, E);
            if (F.tid == 0) { __builtin_amdgcn_fence(__ATOMIC_RELEASE, "agent"); asm volatile("s_waitcnt vmcnt(0)" ::: "memory");
                __hip_atomic_fetch_add((unsigned*)(F.ws + WS_PCNT) + 64 * 67, 1u, __ATOMIC_RELAXED, __HIP_MEMORY_SCOPE_AGENT); }
        }
        phase_attn0(F, (char*)lds); STAMP(11); phase_conv(F); phase_shiftw(F); } SEAM(3);
    if (IN(4)) {
        EpiOutX E{F.in[I_X], wsf(F, WS_ADA), wsf(F, WS_ADA) + 9 * 3072, F.in[I_CD_NORMG], (_Float16*)(F.ws + WS_X1H), wsb(F, WS_H), wsf(F, WS_SSQ)};
        pg8::SegOrder S; S.init(pg8::Seg{wsb(F, WS_Y0), wsb(F, WS_WOUT0), 64, 4, 0}, pg8::Seg{nullptr, nullptr, 0, 0, 0}, pg8::Seg{nullptr, nullptr, 0, 0, 0}, DM, F.G, F.bid);
        pg8::gemm_phase<EpiOutX, pg8::SegOrder>(F.lds, DM, S, E);
    } SEAM(4);
    if (IN(5)) {
        EpiIn1 E{wsb(F, WS_PT), wsb(F, WS_Q1), wsb(F, WS_K1), wsb(F, WS_V1), wsb(F, WS_SZ1), wsf(F, WS_SSQ), wsf(F, WS_SW),
                 F.in[I_CTX], wsf(F, WS_ADA), wsf(F, WS_ADA) + 9 * 3072, F.in[I_CD_NORMG], wsb(F, WS_H), wsf(F, WS_SSQ), 0, (unsigned*)(F.ws + WS_PCNT) + 64 * 64};
        pg8::SegOrder S; S.init(pg8::Seg{wsb(F, WS_Y0) + (size_t)MX * DM, wsb(F, WS_WOUT0), 8, 4, 3},
                                pg8::Seg{wsb(F, WS_H), wsb(F, WS_WIN1) + (size_t)1024 * DM, 64, 10, 0},
                                pg8::Seg{wsb(F, WS_WIN1), wsb(F, WS_H), 4, 24, 2}, DM, F.G, F.bid);
        pg8::gemm_phase<EpiIn1, pg8::SegOrder>(F.lds, DM, S, E);
    }
    if (IN(5) && IN(6)) {
        const int c6 = (F.bid + 224) & 255;
        if (c6 >= 160 && c6 < 192) {
            if (F.wave == 0) { unsigned* gate = (unsigned*)(F.ws + WS_PCNT) + 64 * 64; unsigned sp = 0;
                while ((unsigned)__builtin_amdgcn_readfirstlane(__hip_atomic_load(gate, __ATOMIC_RELAXED, __HIP_MEMORY_SCOPE_AGENT)) < 256u) { __builtin_amdgcn_s_sleep(2); if (++sp > (1u << 22)) break; }
                __builtin_amdgcn_fence(__ATOMIC_ACQUIRE, "agent"); }
            asm volatile("s_waitcnt vmcnt(0)" ::: "memory");
            __syncthreads();
        }
    } STAMP(6);
    if (IN(6)) {
        EpiIn1 E{wsb(F, WS_PT), wsb(F, WS_Q1), wsb(F, WS_K1), wsb(F, WS_V1), wsb(F, WS_SZ1), wsf(F, WS_SSQ), wsf(F, WS_SW),
                 F.in[I_CTX], wsf(F, WS_ADA), wsf(F, WS_ADA) + 9 * 3072, F.in[I_CD_NORMG], wsb(F, WS_H), wsf(F, WS_SSQ), 24, (unsigned*)(F.ws + WS_PCNT) + 64 * 64};
        pg8::SegOrder S; S.init(pg8::Seg{wsb(F, WS_WIN1), wsb(F, WS_H) + (size_t)24 * 256 * DM, 4, 40, 2},
                                pg8::Seg{wsb(F, WS_H) + (size_t)MX * DM, wsb(F, WS_WIN1) + (size_t)1536 * DM, 8, 4, 1}, pg8::Seg{nullptr, nullptr, 0, 0, 0}, DM, F.G, (F.bid + 224) & 255);
        pg8::gemm_phase<EpiIn1, pg8::SegOrder>(F.lds, DM, S, E);
        if (((F.bid + 224) & 255) >= 192) p6_filler(F, ((F.bid + 224) & 255) - 192, F.G - 192);
    } SEAM(6);
    if (IN(7)) {
        EpiDft E{wsb(F, WS_Y1), wsb(F, WS_SZ1)};
        pg8::SegOrder S; S.init(pg8::Seg{wsb(F, WS_DFT), wsb(F, WS_PT), 8, 32, 0}, pg8::Seg{nullptr, nullptr, 0, 0, 0}, pg8::Seg{nullptr, nullptr, 0, 0, 0}, 2048, F.G, F.bid);
        pg8::gemm_phase<EpiDft, pg8::SegOrder, true, true>(F.lds, 2048, S, E); STAMP(12);
        phase_nyquist(F);
        {
            const int vcu = (F.bid & 7) * (F.G >> 3) + (F.bid >> 3);
            int cur_h = -1;
            for (int id = vcu; id < 512; id += F.G) na_unit(F, (char*)lds, id, cur_h);
        }
    } SEAM(7);
    if (IN(8)) {
        EpiOutF E{wsf(F, WS_ADA) + 9 * 3072, F.in[I_FNG], (const _Float16*)(F.ws + WS_X1H), F.out, wsf(F, WS_SSQ2), (unsigned*)(F.ws + WS_PCNT)};
        pg8::SegOrder S; S.init(pg8::Seg{wsb(F, WS_Y1), wsb(F, WS_WOUT1), 64, 4, 0}, pg8::Seg{nullptr, nullptr, 0, 0, 0}, pg8::Seg{nullptr, nullptr, 0, 0, 0}, DM, F.G, F.bid);
        if (F.G == 256) pg8::gemm_phase<EpiOutF, pg8::SegOrder>(F.lds, DM, S, E);
    }
    if (PROBE_PHASE >= 0) { STAMP(10); __syncthreads(); if (F.bid == 0 && F.tid == 0) F.out[0] += (float)(TS[PROBE_B] - TS[PROBE_A]) * 0.01f; }
#undef IN
#undef SEAM
}

extern "C" void kernel_launch(void* const* d_in, const int* in_sizes, int n_in, void* d_out, int out_size, void* d_ws, size_t ws_size, hipStream_t stream) {
    static int grid = 0;
    if (grid == 0) {
        if (n_in != 23 || out_size != MX * DM || ws_size < WS_X1H + (size_t)MX * DM * 2) { fprintf(stderr, "kernel_launch: unexpected shapes (n_in %d out %d ws %zu)\n", n_in, out_size, ws_size); grid = -1; return; }
        int dev = 0, cus = 0, per_cu = 0;
        if (hipGetDevice(&dev) != hipSuccess || hipDeviceGetAttribute(&cus, hipDeviceAttributeMultiprocessorCount, dev) != hipSuccess) { grid = -1; return; }
        if (hipFuncSetAttribute((const void*)mk_fwd, hipFuncAttributeMaxDynamicSharedMemorySize, LDS_BYTES) != hipSuccess) { fprintf(stderr, "kernel_launch: hipFuncSetAttribute failed\n"); grid = -1; return; }
        if (hipOccupancyMaxActiveBlocksPerMultiprocessor(&per_cu, (const void*)mk_fwd, NTHR, LDS_BYTES) != hipSuccess || per_cu < 1) { fprintf(stderr, "kernel_launch: occupancy query says %d\n", per_cu); per_cu = 1; }
        (void)hipGetLastError();
        grid = cus;
    }
    if (grid < 0) return;
    if (hipMemsetAsync((char*)d_ws + WS_CTL, 0, CTL_ZERO_BYTES, stream) != hipSuccess) { fprintf(stderr, "kernel_launch: memset failed\n"); return; }
    Args a{};
    for (int i = 0; i < 23; ++i) a.in[i] = (const float*)d_in[i];
    a.out = (float*)d_out; a.ws = (unsigned char*)d_ws;
    for (int li = 0; li < MK_N_LAUNCHES; ++li) {
        if (MK_N_LAUNCHES == 1) { a.ph_lo = 0; a.ph_hi = NPHASES; } else { a.ph_lo = li; a.ph_hi = li + 1; }
        a.li = li;
        hipLaunchKernelGGL(mk_fwd, dim3(grid), dim3(NTHR), LDS_BYTES, stream, a);
        const hipError_t le = hipPeekAtLastError();
        if (le != hipSuccess) { fprintf(stderr, "kernel_launch: launch %d failed: %s\n", li, hipGetErrorName(le)); break; }
    }
}
```

```cpp
#include <hip/hip_runtime.h>
#include <cstdio>
#include <cstdint>
#include <hip/hip_bf16.h>

#ifndef PROBE_PHASE
#define PROBE_PHASE -1
#define PROBE_A 0
#define PROBE_B 1
#endif
#ifndef MK_N_LAUNCHES
#define MK_N_LAUNCHES 1
#endif

#define GAS __attribute__((address_space(1)))
#define LAS __attribute__((address_space(3)))
typedef unsigned short bf16;
typedef unsigned v4u __attribute__((ext_vector_type(4)));
typedef float f32x4 __attribute__((ext_vector_type(4)));
typedef GAS unsigned gu32;
#define RLX_AGENT __ATOMIC_RELAXED, __HIP_MEMORY_SCOPE_AGENT
#define LDS_WAIT() asm volatile("s_waitcnt lgkmcnt(0)" ::: "memory")
#define DEVI __device__ __forceinline__

constexpr int NB = 8, SEQ = 2048, DM = 1024, CTXL = 256, GRIDW = 64;
constexpr int MX = NB * SEQ, MC = NB * CTXL, MT = MX + MC;
constexpr int AB_IN = 2816, CD_IN = 3072, N1 = 3584;
constexpr int NKEY0 = CTXL + SEQ;
constexpr float EPS = 1e-6f;
constexpr float LOG2E = 1.4426950408889634f, C2 = 0.125f * LOG2E;
constexpr int NWAVES = 8, NTHR = 512;
constexpr int NPHASES = 10;

constexpr size_t MiB = 1u << 20;
constexpr size_t WS_CTL = 0, CTL_ZERO_BYTES = 1 * MiB;
constexpr size_t WS_ADA = 256 * 1024;
constexpr size_t WS_SSQ = 512 * 1024;
constexpr size_t WS_SSQ2 = 640 * 1024;
constexpr size_t WS_PCNT = 768 * 1024;
constexpr size_t WS_SW = 2 * MiB;
constexpr size_t WS_ROPE = 1 * MiB;
constexpr size_t WS_MCS = 1 * MiB + 512 * 1024;
constexpr size_t WS_WIN0 = 3 * MiB, WS_WOUT0 = 9 * MiB, WS_WIN1 = 11 * MiB, WS_WOUT1 = 18 * MiB;
constexpr size_t WS_DFT = 20 * MiB;
constexpr size_t WS_H = 36 * MiB;
constexpr size_t WS_R = 72 * MiB;
constexpr size_t WS_X1H = 224 * MiB;
constexpr size_t WS_GLU = WS_R, WS_Q0 = WS_R + 18 * MiB, WS_K0 = WS_R + 36 * MiB, WS_V0 = WS_K0 + 4608 * 1024, WS_SZ0 = WS_R + 45 * MiB;
constexpr size_t WS_Y0 = WS_R + 116 * MiB;
constexpr size_t WS_PT = WS_R, WS_Q1 = WS_R + 32 * MiB, WS_K1 = WS_R + 48 * MiB, WS_V1 = WS_R + 66 * MiB, WS_SZ1 = WS_R + 84 * MiB, WS_Y1 = WS_R + 116 * MiB;
constexpr size_t WS_END = WS_R + 152 * MiB;
static_assert(WS_END <= WS_X1H && WS_X1H + (size_t)MX * DM * 2 <= 256 * MiB, "d_ws map");
constexpr int CW_BAR = 4096;

constexpr int LDS_BYTES = 147456;
constexpr int MISC_OFF = 145408;

DEVI unsigned f2bf(float f) { unsigned u = __builtin_bit_cast(unsigned, f); return (u + 0x7fffu + ((u >> 16) & 1u)) >> 16; }
DEVI unsigned pk2(float lo, float hi) { return f2bf(lo) | (f2bf(hi) << 16); }
DEVI float bf2f(unsigned b) { return __builtin_bit_cast(float, (b & 0xffffu) << 16); }
DEVI float bflo(unsigned w) { return __builtin_bit_cast(float, w << 16); }
DEVI float bfhi(unsigned w) { return __builtin_bit_cast(float, w & 0xffff0000u); }
DEVI float siluf(float v) { return v / (1.f + expf(-v)); }
DEVI float sigmf(float v) { return 1.f / (1.f + expf(-v)); }
DEVI float wave_sum_dpp(float v) {
#define WS_DPP(ctrl, rmask) v += __builtin_bit_cast(float, __builtin_amdgcn_update_dpp(0, __builtin_bit_cast(int, v), ctrl, rmask, 0xf, true))
    WS_DPP(0xB1, 0xf);
    WS_DPP(0x4E, 0xf);
    WS_DPP(0x141, 0xf);
    WS_DPP(0x140, 0xf);
    WS_DPP(0x142, 0xa);
    WS_DPP(0x143, 0xc);
#undef WS_DPP
    return __builtin_bit_cast(float, __builtin_amdgcn_readlane(__builtin_bit_cast(int, v), 63));
}
DEVI float sum_fq(float v) {
    { auto r = __builtin_amdgcn_permlane16_swap(__float_as_uint(v), __float_as_uint(v), false, false); v = __uint_as_float(r[0]) + __uint_as_float(r[1]); }
    { auto r = __builtin_amdgcn_permlane32_swap(__float_as_uint(v), __float_as_uint(v), false, false); v = __uint_as_float(r[0]) + __uint_as_float(r[1]); }
    return v;
}
DEVI float wave_sum(float v) {
#pragma unroll
    for (int o = 1; o < 64; o <<= 1) v += __shfl_xor(v, o);
    return v;
}

#define XB_TMO      128
#define XB_XCNT(j)  (256  + 64 * (j))
#define XB_XSUB(j)  (1280 + 64 * (j))
#define XB_XGEN(j)  (2304 + 64 * (j))
#define XB_TOP      3328
#define XB_TOPGEN   3392
#define XCD_BAR_WORDS 3456
#define XB_SPIN_CAP (1u << 22)
DEVI unsigned xb_ld(unsigned* p)              { return __hip_atomic_load(p, __ATOMIC_RELAXED, __HIP_MEMORY_SCOPE_AGENT); }
DEVI unsigned xb_add(unsigned* p, unsigned v) { return __hip_atomic_fetch_add(p, v, __ATOMIC_RELAXED, __HIP_MEMORY_SCOPE_AGENT); }
DEVI unsigned xb_xcc_id() { return (unsigned)__builtin_amdgcn_s_getreg((3 << 11) | 20) & 0xFu; }
#define XB_SPIN(cond, bar) do { unsigned _sp = 0; while (cond) { __builtin_amdgcn_s_sleep(1); \
    if ((++_sp & 255u) == 0u) { if (xb_ld(&(bar)[XB_TMO])) break; if (_sp > XB_SPIN_CAP) { atomicAdd(&(bar)[XB_TMO], 1u); break; } } } } while (0)
struct XcdBarrier { unsigned* bar; unsigned x; volatile LAS unsigned* st; };
DEVI XcdBarrier xcd_barrier_post(unsigned* bar, volatile LAS unsigned* st) {
    XcdBarrier b; b.bar = bar; b.x = xb_xcc_id(); b.st = st;
    if (threadIdx.x == 0) (void)xb_add(&bar[XB_XCNT(b.x)], 1u);
    return b;
}
DEVI void xcd_barrier_complete(unsigned* bar, unsigned x, unsigned& nloc, unsigned& nx) {
    const unsigned G = gridDim.x * gridDim.y * gridDim.z;
    unsigned sum, cnt, mine, sp = 0u;
    for (;;) {
        sum = 0u; cnt = 0u; mine = 0u;
#pragma unroll
        for (unsigned j = 0; j < 16; ++j) { const unsigned c = xb_ld(&bar[XB_XCNT(j)]); sum += c; cnt += (c > 0u) ? 1u : 0u; mine = (j == x) ? c : mine; }
        if (sum == G) break;
        __builtin_amdgcn_s_sleep(1);
        if ((++sp & 255u) == 0u) { if (xb_ld(&bar[XB_TMO])) break; if (sp > XB_SPIN_CAP) { atomicAdd(&bar[XB_TMO], 1u); break; } }
    }
    nloc = mine > 0u ? mine : 1u; nx = cnt > 0u ? cnt : 1u;
}
DEVI void xcd_barrier(const XcdBarrier& b) {
    asm volatile("s_waitcnt vmcnt(0)" ::: "memory");
    __syncthreads();
    if (threadIdx.x == 0) {
        unsigned* bar = b.bar;
        __builtin_amdgcn_s_waitcnt(0);
        unsigned nloc = b.st[0], nx = b.st[1];
        if (nloc == 0u) { xcd_barrier_complete(bar, b.x, nloc, nx); b.st[0] = nloc; b.st[1] = nx; }
        const unsigned old = xb_add(&bar[XB_XSUB(b.x)], 1u);
        const unsigned gen = old / nloc;
        if (old + 1u == (gen + 1u) * nloc) {
            asm volatile("buffer_inv sc1" ::: "memory");
            __builtin_amdgcn_fence(__ATOMIC_RELEASE, "agent");
            asm volatile("s_waitcnt vmcnt(0)" ::: "memory");
            const unsigned og = xb_add(&bar[XB_TOP], 1u);
            const unsigned tg = og / nx;
            if (og + 1u == (tg + 1u) * nx) xb_add(&bar[XB_TOPGEN], 1u);
            else XB_SPIN(xb_ld(&bar[XB_TOPGEN]) == tg, bar);
            xb_add(&bar[XB_XGEN(b.x)], 1u);
            asm volatile("s_waitcnt vmcnt(0)" ::: "memory");
        } else {
            asm volatile("buffer_inv sc1" ::: "memory");
            XB_SPIN(xb_ld(&bar[XB_XGEN(b.x)]) == gen, bar);
            asm volatile("s_waitcnt vmcnt(0)" ::: "memory");
        }
    }
    __syncthreads();
}

struct Args { const float* in[23]; float* out; unsigned char* ws; int ph_lo, ph_hi, li, pad; };
enum { I_X = 0, I_C, I_CTX, I_CCTX, I_AB_WADA, I_AB_BADA, I_AB_NORMG, I_AB_WIN, I_AB_CONVW, I_AB_CONVB, I_AB_LNG, I_AB_LNB, I_AB_QNG, I_AB_KNG, I_AB_WOUT,
       I_CD_WADA, I_CD_BADA, I_CD_NORMG, I_CD_WIN, I_CD_WF, I_CD_RPB, I_CD_WOUT, I_FNG };

struct Frame {
    LAS unsigned char* lds;
    int tid, lane, wave, G, bid;
    const float* in[23]; float* out; unsigned char* ws;
};
DEVI bf16* wsb(const Frame& F, size_t off) { return (bf16*)(F.ws + off); }
DEVI float* wsf(const Frame& F, size_t off) { return (float*)(F.ws + off); }

DEVI float block_sum(float v, LAS float* red, int lane, int wave) {
    v = wave_sum(v);
    __syncthreads();
    if (lane == 0) red[wave] = v;
    __syncthreads();
    float s = 0.f;
#pragma unroll
    for (int i = 0; i < NWAVES; ++i) s += red[i];
    return s;
}

DEVI void transpose_load(float (&tv)[32], const float* W, int ldw, int c0, int ncols, int item, int lane) {
    const int nblk = ncols / 32, kb = item / nblk, nb = item % nblk, k0 = 64 * kb, n0 = 32 * nb;
#pragma unroll
    for (int i = 0; i < 32; ++i) { const int kk = 2 * i + (lane >> 5); tv[i] = __builtin_nontemporal_load(W + (size_t)(k0 + kk) * ldw + c0 + n0 + (lane & 31)); }
}
template <class Map>
DEVI void transpose_store(const float (&tv)[32], int ncols, int K, bf16* WT, Map map32, LAS float* scr, int item, int lane) {
    const int nblk = ncols / 32, kb = item / nblk, nb = item % nblk, k0 = 64 * kb;
#pragma unroll
    for (int i = 0; i < 32; ++i) { const int kk = 2 * i + (lane >> 5); scr[kk * 33 + (lane & 31)] = tv[i]; }
    LDS_WAIT(); asm volatile("" ::: "memory");
    const int c = lane & 7;
    const int drow0 = map32(nb) * 32;
#pragma unroll
    for (int j = 0; j < 4; ++j) { const int n = (lane >> 3) + 8 * j; const LAS float* s = scr + (8 * c) * 33 + n;
        v4u o; o.x = pk2(s[0 * 33], s[1 * 33]); o.y = pk2(s[2 * 33], s[3 * 33]); o.z = pk2(s[4 * 33], s[5 * 33]); o.w = pk2(s[6 * 33], s[7 * 33]);
        *(v4u*)(WT + (size_t)(drow0 + n) * K + k0 + 8 * c) = o; }
    LDS_WAIT(); asm volatile("" ::: "memory");
}
template <class Map>
DEVI void transpose_item(const float* W, int ldw, int c0, int ncols, int K, bf16* WT, Map map32, LAS float* scr, int item, int lane) {
    float tv[32];
    transpose_load(tv, W, ldw, c0, ncols, item, lane);
    transpose_store(tv, ncols, K, WT, map32, scr, item, lane);
}
struct MapId { int off; DEVI int operator()(int nb) const { return nb + off; } };
struct MapIn0 { DEVI int operator()(int sb) const {
    if (sb < 16) return 8 * (sb >> 2) + (sb & 3);
    if (sb < 32) { const int cb = sb - 16; return 8 * (cb >> 2) + 4 + (cb & 3); }
    if (sb < 48) { const int qb = sb - 32, head = qb >> 1, bj = qb & 1; return 8 * (4 + (head >> 2)) + 4 * bj + (head & 3); }
    if (sb < 52) { const int kb = sb - 48; return 48 + 4 * (kb & 1) + (kb >> 1); }
    if (sb < 56) { const int vb = sb - 52; return 48 + 4 * (vb & 1) + 2 + (vb >> 1); }
    return sb; } };

DEVI void ada_item_load(const Frame& F, int it, float (&w)[64]) {
    const int l = it / 768, rem = it % 768, cc = rem >> 4, kc = rem & 15;
    const float* W = l ? F.in[I_CD_WADA] : F.in[I_AB_WADA];
    const float* rowp = W + (size_t)(kc * 64) * 3072 + cc * 64;
#pragma unroll
    for (int k = 0; k < 64; ++k) w[k] = __builtin_nontemporal_load(rowp + (size_t)k * 3072 + F.lane);
}
DEVI void ada_item_finish(const Frame& F, int it, const float (&w)[64], const LAS float* sl) {
    const int l = it / 768, rem = it % 768, cc = rem >> 4, kc = rem & 15;
    const float* bb = l ? F.in[I_CD_BADA] : F.in[I_AB_BADA];
    const int col = cc * 64 + F.lane;
    const float bv = (kc == 0) ? bb[col] : 0.f;
    float s[9];
#pragma unroll
    for (int r = 0; r < 9; ++r) s[r] = 0.f;
#pragma unroll
    for (int k4 = 0; k4 < 64; k4 += 4) {
#pragma unroll
        for (int r = 0; r < 9; ++r) { const f32x4 sv = *(const LAS f32x4*)(sl + r * 1024 + kc * 64 + k4); s[r] += sv.x * w[k4] + sv.y * w[k4 + 1] + sv.z * w[k4 + 2] + sv.w * w[k4 + 3]; }
    }
    float* ada = wsf(F, WS_ADA);
#pragma unroll
    for (int r = 0; r < 9; ++r) atomicAdd(&ada[(l * 9 + r) * 3072 + col], s[r] + bv);
}
constexpr int XPF = 5;
DEVI const float* modnorm_rowptr(const Frame& F, int m) { return (m < MX) ? F.in[I_X] + (size_t)m * DM : F.in[I_CTX] + (size_t)(m - MX) * DM; }
DEVI void p0_prologue(Frame& F, f32x4 (&xpf)[XPF][4]) {
    LAS float* sl = (LAS float*)F.lds;
    LAS float* scr = (LAS float*)(F.lds + 40960 + F.wave * 8448);
    const int gw = F.bid * NWAVES + F.wave, NGW = F.G * NWAVES;
    constexpr int N_ADA = 2 * 48 * 16, N_TR = 16 * (AB_IN / 32);
    float cv[18];
#pragma unroll
    for (int j = 0; j < 16; ++j) cv[j] = F.in[I_C][F.tid + 512 * j];
    cv[16] = F.in[I_CCTX][F.tid]; cv[17] = F.in[I_CCTX][F.tid + 512];
    const int it_a = min(gw, N_ADA - 1), it_t = min(gw, N_TR - 1), it_m = min(F.bid, 255);
    float w[64]; ada_item_load(F, it_a, w);
    float tv[32]; transpose_load(tv, F.in[I_AB_WIN], AB_IN, 0, AB_IN, it_t, F.lane);
    const float* wf = F.in[I_CD_WF];
    f32x4 wfv[8];
#pragma unroll
    for (int j = 0; j < 8; ++j) wfv[j] = *(const f32x4*)(wf + (size_t)((it_m >> 5) & 3) * 128 * 128 + 4 * (F.tid + 512 * j));
#pragma unroll
    for (int j = 0; j < 18; ++j) sl[F.tid + 512 * j] = siluf(cv[j]);
    __syncthreads();
    if (gw < N_ADA) ada_item_finish(F, gw, w, sl);
    for (int it = gw + NGW; it < N_ADA; it += NGW) { float w2[64]; ada_item_load(F, it, w2); ada_item_finish(F, it, w2, sl); }
#pragma unroll
    for (int k = 0; k < XPF; ++k) { const float* xr = modnorm_rowptr(F, min(gw * 9 + k, MT - 1));
#pragma unroll
        for (int j = 0; j < 4; ++j) xpf[k][j] = __builtin_nontemporal_load((const f32x4*)(xr + 4 * F.lane + 256 * j)); }
    if (gw < N_TR) transpose_store(tv, AB_IN, DM, wsb(F, WS_WIN0), MapIn0{}, scr, gw, F.lane);
    for (int it = gw + NGW; it < N_TR; it += NGW) transpose_item(F.in[I_AB_WIN], AB_IN, 0, AB_IN, DM, wsb(F, WS_WIN0), MapIn0{}, scr, it, F.lane);
    {
        float* rope = wsf(F, WS_ROPE);
        for (int i = gw * 64 + F.lane; i < SEQ * 32; i += NGW * 64) {
            const int t = i >> 5, p = i & 31; const int fi = p & 15;
            const float inv = exp2f(-(float)fi * (13.287712379549449f / 16.0f));
            const float pos = (float)((p < 16) ? (t / GRIDW) : (t % GRIDW));
            const float ang = pos * inv; float sn, cs; sincosf(ang, &sn, &cs);
            rope[2 * i] = cs; rope[2 * i + 1] = sn;
        }
    }
    __syncthreads();
    {
        LAS float* t128 = (LAS float*)F.lds;
        LAS float* wl = t128 + 256;
        if (F.tid < 128) { t128[F.tid] = cospif((float)F.tid * (1.f / 64.f)); t128[128 + F.tid] = sinpif((float)F.tid * (1.f / 64.f)); }
        float* mcs = wsf(F, WS_MCS);
        bool first = true;
        for (int it = F.bid; it < 2 * 4 * 32; it += F.G) {
            const int c4 = it & 31, g = (it >> 5) & 3, cs = it >> 7;
            if (first) {
#pragma unroll
                for (int j = 0; j < 8; ++j) *(LAS f32x4*)(wl + 4 * (F.tid + 512 * j)) = wfv[j];
            } else {
                __syncthreads();
                for (int i = F.tid; i < 128 * 128 / 4; i += NTHR) *(LAS f32x4*)(wl + 4 * i) = *(const f32x4*)(wf + (size_t)g * 128 * 128 + 4 * i);
            }
            first = false;
            __syncthreads();
            const int e = F.tid & 127, c = c4 * 4 + (F.tid >> 7);
            float sacc = 0.f;
#pragma unroll 8
            for (int cp = 0; cp < 128; ++cp) sacc += t128[cs * 128 + ((c * cp) & 127)] * wl[cp * 128 + e];
            mcs[((size_t)(cs * 4 + g) * 128 + c) * 128 + e] = sacc * (1.f / 512.f);
        }
        __syncthreads();
    }
}
DEVI void p2_filler(Frame& F, int ib, int nib) {
    LAS float* scr = (LAS float*)(F.lds + F.wave * 16384);
    const int gw = ib * NWAVES + F.wave, NGW = nib * NWAVES;
    constexpr int I1 = 16 * 32, I2 = 16 * ((CD_IN - 512) / 32);
    for (int it = gw; it < I1 + I2; it += NGW) {
        if (it < I1) transpose_item(F.in[I_AB_WOUT], DM, 0, DM, DM, wsb(F, WS_WOUT0), MapId{0}, scr, it, F.lane);
        else transpose_item(F.in[I_CD_WIN], CD_IN, 512, CD_IN - 512, DM, wsb(F, WS_WIN1), MapId{32}, scr, it - I1, F.lane);
    }
    __syncthreads();
}
DEVI void p6_filler(Frame& F, int ib, int nib) {
    LAS float* scr = (LAS float*)(F.lds + F.wave * 16384);
    const int gw = ib * NWAVES + F.wave, NGW = nib * NWAVES;
    for (int it = gw; it < 16 * 32; it += NGW) transpose_item(F.in[I_CD_WOUT], DM, 0, DM, DM, wsb(F, WS_WOUT1), MapId{0}, scr, it, F.lane);
    __syncthreads();
    {
        LAS float* t2k = (LAS float*)F.lds;
        for (int i = F.tid; i < 2048; i += NTHR) { t2k[i] = cospif((float)i * (1.f / 1024.f)); t2k[2048 + i] = sinpif((float)i * (1.f / 1024.f)); }
        __syncthreads();
        bf16* A = wsb(F, WS_DFT);
        for (int i = ib * NTHR + F.tid; i < 2048 * 256; i += nib * NTHR) {
            const int row = i >> 8, k0 = (i & 255) * 8; const int pm = row >> 8, rr = row & 255, lp = 128 * pm + (rr & 127), tsel = (rr >> 7) * 2048; float v[8];
#pragma unroll
            for (int j = 0; j < 8; ++j) v[j] = t2k[tsel + ((lp * (k0 + j)) & 2047)];
            v4u o; o.x = pk2(v[0], v[1]); o.y = pk2(v[2], v[3]); o.z = pk2(v[4], v[5]); o.w = pk2(v[6], v[7]);
            *(v4u*)(A + (size_t)row * 2048 + k0) = o;
        }
        __syncthreads();
    }
}

DEVI void modnorm_row(const float* xrow, bf16* orow, const float* g, const float* shift, const float* scale, int lane) {
    f32x4 v[4]; float ss = 0.f;
#pragma unroll
    for (int j = 0; j < 4; ++j) { v[j] = *(const f32x4*)(xrow + 4 * lane + 256 * j); ss += (v[j].x * v[j].x + v[j].y * v[j].y) + (v[j].z * v[j].z + v[j].w * v[j].w); }
    const float rinv = 1.0f / sqrtf(wave_sum(ss) * (1.f / DM) + EPS);
#pragma unroll
    for (int j = 0; j < 4; ++j) {
        const int c = 4 * lane + 256 * j;
        const f32x4 gg = *(const f32x4*)(g + c), sh = *(const f32x4*)(shift + c), sc = *(const f32x4*)(scale + c);
        const float o0 = v[j].x * rinv * gg.x * (1.f + sc.x) + sh.x, o1 = v[j].y * rinv * gg.y * (1.f + sc.y) + sh.y;
        const float o2 = v[j].z * rinv * gg.z * (1.f + sc.z) + sh.z, o3 = v[j].w * rinv * gg.w * (1.f + sc.w) + sh.w;
        *(unsigned long long*)(orow + c) = (unsigned long long)pk2(o0, o1) | ((unsigned long long)pk2(o2, o3) << 32);
    }
}
DEVI void phase_modnorm(Frame& F, int layer, const f32x4 (&xpf)[XPF][4]) {
    const int gw = F.bid * NWAVES + F.wave;
    const float* ada = wsf(F, WS_ADA) + layer * 9 * 3072;
    const float* g = layer ? F.in[I_CD_NORMG] : F.in[I_AB_NORMG];
    bf16* H = wsb(F, WS_H);
    constexpr int RPW = MT / (256 * NWAVES);
    const int m0 = gw * RPW;
    f32x4 gm[4], sh[4];
    int rcur = (m0 < MX) ? (m0 >> 11) : 8;
    { const float* shift = ada + rcur * 3072; const float* scale = shift + 1024;
#pragma unroll
      for (int j = 0; j < 4; ++j) { const int c = 4 * F.lane + 256 * j; gm[j] = *(const f32x4*)(g + c) * (*(const f32x4*)(scale + c) + 1.0f); sh[j] = *(const f32x4*)(shift + c); } }
    f32x4 rest[RPW - XPF][4];
#pragma unroll
    for (int k = XPF; k < RPW; ++k) { const float* xr = modnorm_rowptr(F, m0 + k);
#pragma unroll
        for (int j = 0; j < 4; ++j) rest[k - XPF][j] = __builtin_nontemporal_load((const f32x4*)(xr + 4 * F.lane + 256 * j)); }
#pragma unroll
    for (int k = 0; k < RPW; ++k) {
        const int m = m0 + k;
        f32x4 v[4];
#pragma unroll
        for (int j = 0; j < 4; ++j) v[j] = (k < XPF) ? xpf[k < XPF ? k : 0][j] : rest[k < XPF ? 0 : k - XPF][j];
        const int r = (m < MX) ? (m >> 11) : 8;
        if (r != rcur) { rcur = r; const float* shift = ada + r * 3072; const float* scale = shift + 1024;
#pragma unroll
            for (int j = 0; j < 4; ++j) { const int c = 4 * F.lane + 256 * j; gm[j] = *(const f32x4*)(g + c) * (*(const f32x4*)(scale + c) + 1.0f); sh[j] = *(const f32x4*)(shift + c); } }
        float ss = 0.f;
#pragma unroll
        for (int j = 0; j < 4; ++j) ss += (v[j].x * v[j].x + v[j].y * v[j].y) + (v[j].z * v[j].z + v[j].w * v[j].w);
        const float rinv = __builtin_amdgcn_rsqf(wave_sum_dpp(ss) * (1.f / DM) + EPS);
        bf16* orow = H + (size_t)m * DM;
#pragma unroll
        for (int j = 0; j < 4; ++j) {
            const int c = 4 * F.lane + 256 * j;
            const f32x4 o = v[j] * rinv * gm[j] + sh[j];
            __builtin_nontemporal_store((unsigned long long)pk2(o[0], o[1]) | ((unsigned long long)pk2(o[2], o[3]) << 32), (unsigned long long*)(orow + c));
        }
    }
}
DEVI void phase_fold(Frame& F, int ib, int nib) {
    const float* mcs = wsf(F, WS_MCS); const float* W = F.in[I_CD_WIN]; bf16* WT = wsb(F, WS_WIN1);
    LAS float* Ms = (LAS float*)F.lds;
    LAS float* Ws = Ms + 128 * 128;
    for (int it = ib; it < 8 * 32; it += nib) {
        const int kc = it & 31, g = (it >> 5) & 3, cs = it >> 7, k0 = kc * 32;
        __syncthreads();
        const float* mp = mcs + (size_t)(cs * 4 + g) * 128 * 128;
        for (int i = F.tid; i < 128 * 128 / 4; i += NTHR) *(LAS f32x4*)(Ms + 4 * i) = *(const f32x4*)(mp + 4 * i);
        for (int i = F.tid; i < 32 * 128; i += NTHR) { const int k = i >> 7, c = i & 127; Ws[c * 32 + k] = W[(size_t)(k0 + k) * CD_IN + g * 128 + c]; }
        __syncthreads();
        const int e = F.tid & 127, kq = F.tid >> 7;
        float acc[8];
#pragma unroll
        for (int j = 0; j < 8; ++j) acc[j] = 0.f;
#pragma unroll 4
        for (int c = 0; c < 128; ++c) { const float mv = Ms[c * 128 + e]; const f32x4 w0 = *(const LAS f32x4*)(Ws + c * 32 + kq * 8), w1 = *(const LAS f32x4*)(Ws + c * 32 + kq * 8 + 4);
            acc[0] += mv * w0.x; acc[1] += mv * w0.y; acc[2] += mv * w0.z; acc[3] += mv * w0.w; acc[4] += mv * w1.x; acc[5] += mv * w1.y; acc[6] += mv * w1.z; acc[7] += mv * w1.w; }
        v4u o; o.x = pk2(acc[0], acc[1]); o.y = pk2(acc[2], acc[3]); o.z = pk2(acc[4], acc[5]); o.w = pk2(acc[6], acc[7]);
        *(v4u*)(WT + (size_t)(cs * 512 + g * 128 + e) * DM + k0 + kq * 8) = o;
    }
    __syncthreads();
}

DEVI void p2_fill_fold(Frame& F) {
    LAS float* scr = (LAS float*)(F.lds + F.wave * 16384);
    const int gw = F.bid * NWAVES + F.wave, NGW = F.G * NWAVES;
    constexpr int I1 = 16 * 32, I2 = 16 * ((CD_IN - 512) / 32), NI = I1 + I2;
    const float* mcs = wsf(F, WS_MCS); const float* W = F.in[I_CD_WIN]; bf16* WT = wsb(F, WS_WIN1);
    const int it_t = min(gw, NI - 1), it_f = min(F.bid, 255);
    float tv[32];
    if (it_t < I1) transpose_load(tv, F.in[I_AB_WOUT], DM, 0, DM, it_t, F.lane); else transpose_load(tv, F.in[I_CD_WIN], CD_IN, 512, CD_IN - 512, it_t - I1, F.lane);
    const int kc = it_f & 31, g = (it_f >> 5) & 3, cs = it_f >> 7, k0 = kc * 32;
    f32x4 mv8[8]; float wv8[8];
    { const float* mp = mcs + (size_t)(cs * 4 + g) * 128 * 128;
#pragma unroll
      for (int j = 0; j < 8; ++j) mv8[j] = *(const f32x4*)(mp + 4 * (F.tid + 512 * j));
#pragma unroll
      for (int j = 0; j < 8; ++j) { const int i = F.tid + 512 * j, k = i >> 7, c = i & 127; wv8[j] = W[(size_t)(k0 + k) * CD_IN + g * 128 + c]; } }
    if (gw < NI) { if (gw < I1) transpose_store(tv, DM, DM, wsb(F, WS_WOUT0), MapId{0}, scr, gw, F.lane); else transpose_store(tv, CD_IN - 512, DM, wsb(F, WS_WIN1), MapId{32}, scr, gw - I1, F.lane); }
    for (int it = gw + NGW; it < NI; it += NGW) {
        if (it < I1) transpose_item(F.in[I_AB_WOUT], DM, 0, DM, DM, wsb(F, WS_WOUT0), MapId{0}, scr, it, F.lane);
        else transpose_item(F.in[I_CD_WIN], CD_IN, 512, CD_IN - 512, DM, wsb(F, WS_WIN1), MapId{32}, scr, it - I1, F.lane);
    }
    __syncthreads();
    LAS float* Ms = (LAS float*)F.lds;
    LAS float* Ws = Ms + 128 * 128;
    bool first = true;
    for (int it = F.bid; it < 8 * 32; it += F.G) {
        const int kc2 = it & 31, g2 = (it >> 5) & 3, cs2 = it >> 7, k02 = kc2 * 32;
        if (first) {
#pragma unroll
            for (int j = 0; j < 8; ++j) *(LAS f32x4*)(Ms + 4 * (F.tid + 512 * j)) = mv8[j];
#pragma unroll
            for (int j = 0; j < 8; ++j) { const int i = F.tid + 512 * j, k = i >> 7, c = i & 127; Ws[c * 32 + k] = wv8[j]; }
        } else {
            __syncthreads();
            const float* mp = mcs + (size_t)(cs2 * 4 + g2) * 128 * 128;
            for (int i = F.tid; i < 128 * 128 / 4; i += NTHR) *(LAS f32x4*)(Ms + 4 * i) = *(const f32x4*)(mp + 4 * i);
            for (int i = F.tid; i < 32 * 128; i += NTHR) { const int k = i >> 7, c = i & 127; Ws[c * 32 + k] = W[(size_t)(k02 + k) * CD_IN + g2 * 128 + c]; }
        }
        first = false;
        __syncthreads();
        const int e = F.tid & 127, kq = F.tid >> 7;
        float acc[8];
#pragma unroll
        for (int j = 0; j < 8; ++j) acc[j] = 0.f;
#pragma unroll 4
        for (int c = 0; c < 128; ++c) { const float mv = Ms[c * 128 + e]; const f32x4 w0 = *(const LAS f32x4*)(Ws + c * 32 + kq * 8), w1 = *(const LAS f32x4*)(Ws + c * 32 + kq * 8 + 4);
            acc[0] += mv * w0.x; acc[1] += mv * w0.y; acc[2] += mv * w0.z; acc[3] += mv * w0.w; acc[4] += mv * w1.x; acc[5] += mv * w1.y; acc[6] += mv * w1.z; acc[7] += mv * w1.w; }
        v4u o; o.x = pk2(acc[0], acc[1]); o.y = pk2(acc[2], acc[3]); o.z = pk2(acc[4], acc[5]); o.w = pk2(acc[6], acc[7]);
        *(v4u*)(WT + (size_t)(cs2 * 512 + g2 * 128 + e) * DM + k02 + kq * 8) = o;
    }
    __syncthreads();
}

namespace pg8 {
#define PG8_LAS __attribute__((address_space(3)))
typedef unsigned short bf16_t;
typedef short bf16x8 __attribute__((ext_vector_type(8)));
typedef unsigned u32x4 __attribute__((ext_vector_type(4)));
constexpr int BM = 256, BK = 64, HALF = 128, HTB = HALF * BK * 2, STAGE_BYTES = 8 * HTB, NXCD = 8, WGM = 8;
__host__ __device__ __forceinline__ int lds_byte(int r, int c) { const int st = (r >> 4) * 2 + (c >> 5), rr = r & 15, cc = c & 31, ob = rr * 64 + cc * 2; return st * 1024 + (ob ^ (((ob >> 9) & 1) << 5)); }
__host__ __device__ __forceinline__ void stage_rc(int b, int& R, int& C) { const int st = b / 1024, sb = b % 1024, swz = sb ^ (((sb >> 9) & 1) << 5); R = (st >> 1) * 16 + swz / 64; C = (st & 1) * 32 + (swz % 64) / 2; }
__host__ __device__ __forceinline__ int perm32(int rho) { const int n = rho >> 4, i = rho & 15; return 8 * (i >> 2) + 4 * n + (i & 3); }

struct Unit { int pm, pn, kind; const char* A; const char* B; };

struct Seg { const bf16_t* A; const bf16_t* Bt; int nM, nN, kind; };
struct SegOrder {
    Seg s0, s1, s2; int n0, n1, n2, G, c; size_t tstep;
    __device__ __forceinline__ void init(const Seg& a, const Seg& b, const Seg& d, int K, int G_, int c_) { s0 = a; s1 = b; s2 = d; n0 = a.nM * a.nN; n1 = b.nM * b.nN; n2 = d.nM * d.nN; G = G_; c = c_; tstep = (size_t)BM * K * 2; }
    __device__ __forceinline__ void map(const Seg& s, int nwg, int wgid, Unit& u) const {
        { const int q = nwg / NXCD, xcd = wgid % NXCD, off = wgid / NXCD; wgid = xcd * q + off; }
        const int nig = WGM * s.nN, gid = wgid / nig, fm = gid * WGM, gsz = (s.nM - fm) < WGM ? (s.nM - fm) : WGM;
        u.pm = fm + ((wgid % nig) % gsz); u.pn = (wgid % nig) / gsz; u.kind = s.kind;
        u.A = (const char*)s.A + (size_t)u.pm * tstep; u.B = (const char*)s.Bt + (size_t)u.pn * tstep;
    }
    __device__ __forceinline__ bool next(int i, Unit& u) const {
        int L = i * G + c;
        if (L < n0) { map(s0, n0, L, u); return true; } L -= n0;
        if (L < n1) { map(s1, n1, L, u); return true; } L -= n1;
        if (L < n2) { map(s2, n2, L, u); return true; }
        return false;
    }
};

__device__ __forceinline__ unsigned cvt_pk_bf16(float lo, float hi) { unsigned r; asm volatile("v_cvt_pk_bf16_f32 %0, %1, %2" : "=v"(r) : "v"(lo), "v"(hi)); return r; }

template <class Epi, class Sched, bool ALIGN_EPI = true, bool DIAG = false>
__device__ __forceinline__ void gemm_phase(PG8_LAS unsigned char* lds, const int K, const Sched& S, const Epi& E) {
    const int tid = threadIdx.x, wid = __builtin_amdgcn_readfirstlane(tid >> 6), lane = tid & 63, wr = wid >> 2, wc = wid & 3, fr = lane & 15, fq = lane >> 4;
    const int nt = K / BK;
    unsigned voffA[2], voffB[2];
#pragma unroll
    for (int i = 0; i < 2; ++i) { int R, C; stage_rc(tid * 16 + i * 8192, R, C); const int Rb = Epi::PERM ? ((R & ~31) + perm32(R & 31)) : R;
        voffA[i] = (unsigned)(R * K + C) * 2u; voffB[i] = (unsigned)(Rb * K + C) * 2u; }
    const size_t kstep = (size_t)(BK * 2);
    const size_t hstep = (size_t)HALF * K * 2;
    const unsigned ldsw = (unsigned)wid * 1024u;
    const int aoff = lds_byte(wr * 64 + fr, fq * 8), boff = lds_byte(wc * 32 + fr, fq * 8);
#define PG8_SA(b, h) (((b) * 2 + (h)) * HTB)
#define PG8_SB(b, h) ((4 + (b) * 2 + (h)) * HTB)
#define PG8_STAGE(bufoff, gbase, voff) do { _Pragma("unroll") for (int _i = 0; _i < 2; ++_i) \
        __builtin_amdgcn_global_load_lds((const unsigned*)((const char*)(gbase) + (voff)[_i]), (PG8_LAS unsigned*)(lds + (bufoff) + ldsw + _i * 8192), 16, 0, 0); } while (0)
#define PG8_LDA(dst, b, h) do { _Pragma("unroll") for (int m = 0; m < 4; ++m) _Pragma("unroll") for (int k = 0; k < 2; ++k) dst[m][k] = *(const PG8_LAS bf16x8*)(lds + PG8_SA(b, h) + aoff + m * 2048 + k * 1024); } while (0)
#define PG8_LDB(dst, b, h) do { _Pragma("unroll") for (int n = 0; n < 2; ++n) _Pragma("unroll") for (int k = 0; k < 2; ++k) dst[n][k] = *(const PG8_LAS bf16x8*)(lds + PG8_SB(b, h) + boff + n * 2048 + k * 1024); } while (0)
#define PG8_MMA(ai, bj, At, Bt) do { __builtin_amdgcn_s_setprio(1); _Pragma("unroll") for (int m = 0; m < 4; ++m) _Pragma("unroll") for (int n = 0; n < 2; ++n) _Pragma("unroll") for (int k = 0; k < 2; ++k) \
        acc[ai][bj][m][n] = __builtin_amdgcn_mfma_f32_16x16x32_bf16(Bt[n][k], At[m][k], acc[ai][bj][m][n], 0, 0, 0); __builtin_amdgcn_s_setprio(0); } while (0)
#define PG8_WAIT_V(n) asm volatile("s_waitcnt vmcnt(" #n ")" ::: "memory")
#define PG8_WAIT_L(n) asm volatile("s_waitcnt lgkmcnt(" #n ")" ::: "memory")
#define PG8_BAR __builtin_amdgcn_s_barrier()
#define PG8_SCHED __builtin_amdgcn_sched_barrier(0)
    Unit cur, nxt; int ui = 0;
    if (!S.next(0, cur)) return;
    f32x4 acc[2][2][4][2];
#pragma unroll
    for (int a = 0; a < 2; ++a)
#pragma unroll
        for (int b = 0; b < 2; ++b)
#pragma unroll
            for (int m = 0; m < 4; ++m)
#pragma unroll
                for (int n = 0; n < 2; ++n) acc[a][b][m][n] = (f32x4){0.f, 0.f, 0.f, 0.f};
    bf16x8 At[4][2], B0[2][2], B1[2][2];
    const char* cA = cur.A; const char* cB = cur.B;
    PG8_STAGE(PG8_SB(0, 0), cB, voffB); PG8_STAGE(PG8_SB(0, 1), cB + hstep, voffB); PG8_STAGE(PG8_SA(0, 0), cA, voffA); PG8_STAGE(PG8_SA(0, 1), cA + hstep, voffA);
    if (wr == 1) PG8_BAR;
    PG8_WAIT_V(2); PG8_BAR;
    PG8_STAGE(PG8_SB(1, 0), cB + kstep, voffB); PG8_STAGE(PG8_SA(1, 0), cA + kstep, voffA); PG8_STAGE(PG8_SB(1, 1), cB + hstep + kstep, voffB);
    PG8_WAIT_V(6); PG8_BAR;
    for (;;) {
        const bool has_next = S.next(ui + 1, nxt);
        const char* nA = has_next ? nxt.A : cA; const char* nB = has_next ? nxt.B : cB;
        for (int t = 0; t < nt; t += 2) {
            const bool last = (t == nt - 2);
            const char* a1 = cA + (size_t)(t + 1) * kstep;
            const char* a2 = last ? nA : cA + (size_t)(t + 2) * kstep; const char* b2 = last ? nB : cB + (size_t)(t + 2) * kstep;
            const char* a3 = a2 + kstep; const char* b3 = b2 + kstep;
            PG8_LDB(B0, 0, 0); PG8_LDB(B1, 0, 1); PG8_SCHED; PG8_LDA(At, 0, 0); PG8_STAGE(PG8_SA(1, 1), a1 + hstep, voffA);
            PG8_WAIT_V(8); PG8_WAIT_L(0); PG8_BAR; PG8_MMA(0, 0, At, B0); if constexpr (!DIAG) PG8_MMA(0, 1, At, B1); PG8_BAR; PG8_SCHED;
            PG8_LDA(At, 0, 1); PG8_STAGE(PG8_SB(0, 0), b2, voffB); PG8_STAGE(PG8_SB(0, 1), b2 + hstep, voffB); PG8_STAGE(PG8_SA(0, 0), a2, voffA);
            PG8_WAIT_V(8); PG8_WAIT_L(0); PG8_BAR; if constexpr (!DIAG) PG8_MMA(1, 0, At, B0); PG8_MMA(1, 1, At, B1); PG8_BAR; PG8_SCHED;
            PG8_LDB(B0, 1, 0); PG8_LDB(B1, 1, 1); PG8_SCHED; PG8_LDA(At, 1, 0); PG8_STAGE(PG8_SA(0, 1), a2 + hstep, voffA);
            PG8_WAIT_V(8); PG8_WAIT_L(0); PG8_BAR; PG8_MMA(0, 0, At, B0); if constexpr (!DIAG) PG8_MMA(0, 1, At, B1); PG8_BAR; PG8_SCHED;
            PG8_LDA(At, 1, 1); PG8_STAGE(PG8_SB(1, 0), b3, voffB); PG8_STAGE(PG8_SB(1, 1), b3 + hstep, voffB); PG8_STAGE(PG8_SA(1, 0), a3, voffA);
            PG8_WAIT_V(8); PG8_WAIT_L(0); PG8_BAR; if constexpr (!DIAG) PG8_MMA(1, 0, At, B0); PG8_MMA(1, 1, At, B1); PG8_BAR; PG8_SCHED;
        }
        if constexpr (ALIGN_EPI) { if (wr == 0) PG8_BAR; }
        if constexpr (Epi::FUSED) E.fused(acc, cur, wr, wc, fr, fq, wid, lane); else E(acc, cur, wr, wc, fr, fq);
        if (!has_next) break;
#pragma unroll
        for (int a = 0; a < 2; ++a)
#pragma unroll
            for (int b = 0; b < 2; ++b)
#pragma unroll
                for (int m = 0; m < 4; ++m)
#pragma unroll
                    for (int n = 0; n < 2; ++n) acc[a][b][m][n] = (f32x4){0.f, 0.f, 0.f, 0.f};
        cur = nxt; cA = nA; cB = nB; ++ui;
        if constexpr (ALIGN_EPI) { if (wr == 1) PG8_BAR; }
    }
    PG8_WAIT_V(0);
    if constexpr (!ALIGN_EPI) { if (wr == 0) PG8_BAR; }
    PG8_BAR;
#undef PG8_SA
#undef PG8_SB
#undef PG8_STAGE
#undef PG8_LDA
#undef PG8_LDB
#undef PG8_MMA
#undef PG8_WAIT_V
#undef PG8_WAIT_L
#undef PG8_BAR
#undef PG8_SCHED
}
}

typedef float f32x4acc[2][2][4][2];
DEVI float fsilu(float v) { return v * __builtin_amdgcn_rcpf(1.f + __builtin_amdgcn_exp2f(-LOG2E * v)); }
DEVI float fsigm(float v) { return __builtin_amdgcn_rcpf(1.f + __builtin_amdgcn_exp2f(-LOG2E * v)); }
typedef float f32x2p __attribute__((ext_vector_type(2)));
DEVI f32x4 fsigm4(const f32x4& v) {
    const f32x2p nl = {-LOG2E, -LOG2E}, one = {1.f, 1.f};
    const f32x2p t0 = (f32x2p){v[0], v[1]} * nl, t1 = (f32x2p){v[2], v[3]} * nl;
    const f32x2p d0 = (f32x2p){__builtin_amdgcn_exp2f(t0.x), __builtin_amdgcn_exp2f(t0.y)} + one, d1 = (f32x2p){__builtin_amdgcn_exp2f(t1.x), __builtin_amdgcn_exp2f(t1.y)} + one;
    return (f32x4){__builtin_amdgcn_rcpf(d0.x), __builtin_amdgcn_rcpf(d0.y), __builtin_amdgcn_rcpf(d1.x), __builtin_amdgcn_rcpf(d1.y)};
}
DEVI f32x4 fsilu4(const f32x4& v) { return v * fsigm4(v); }
DEVI v4u pack8(const f32x4& a, const f32x4& b) { v4u w; w.x = pg8::cvt_pk_bf16(a[0], a[1]); w.y = pg8::cvt_pk_bf16(a[2], a[3]); w.z = pg8::cvt_pk_bf16(b[0], b[1]); w.w = pg8::cvt_pk_bf16(b[2], b[3]); return w; }

struct EpiIn0 {
    static constexpr bool PERM = true; static constexpr bool FUSED = false;
    bf16 *GLU, *Q0, *K0, *V0, *SZ; const float *qng, *kng, *rope;
    DEVI void operator()(const f32x4 (&acc)[2][2][4][2], const pg8::Unit& u, int wr, int wc, int fr, int fq) const {
        asm volatile("" : "+v"(fr), "+v"(fq));
        const int pn = u.pn + (u.kind ? 7 : 0), pm = u.pm + (u.kind == 2 ? 64 : 0); const bool isx = pm < 64;
        const int cw = 32 * wc + 8 * fq;
        float g8[2][8];
        if (pn >= 4 && pn < 7) { const float* gn = (pn < 6) ? qng : kng;
#pragma unroll
            for (int bj = 0; bj < 2; ++bj) { const f32x4 a = *(const f32x4*)(gn + 32 * bj + 8 * fq), b = *(const f32x4*)(gn + 32 * bj + 8 * fq + 4);
                g8[bj][0] = a[0]; g8[bj][1] = a[1]; g8[bj][2] = a[2]; g8[bj][3] = a[3]; g8[bj][4] = b[0]; g8[bj][5] = b[1]; g8[bj][6] = b[2]; g8[bj][7] = b[3]; } }
        const bool dorope = pn >= 4 && pn < 7 && isx && !((pn == 6) && (wc >= 2));
        f32x4 rpR[2][2], rpC[2];
        if (dorope) {
#pragma unroll
            for (int ai = 0; ai < 2; ++ai)
#pragma unroll
                for (int n = 0; n < 2; ++n) rpR[ai][n] = *(const f32x4*)(rope + ((size_t)((pm & 7) * 256 + 128 * ai + 64 * wr) * 32 + 4 * fq + 2 * n) * 2);
        }
#pragma unroll
        for (int m = 0; m < 4; ++m) {
            if (dorope) {
#pragma unroll
                for (int n = 0; n < 2; ++n) rpC[n] = *(const f32x4*)(rope + ((size_t)(16 * m + fr) * 32 + 16 + 4 * fq + 2 * n) * 2);
            }
#pragma unroll
            for (int ai = 0; ai < 2; ++ai) {
                const int lr = 128 * ai + 64 * wr + 16 * m + fr;
                const int row = 256 * pm + lr;
                if (pn < 4) {
                    f32x4 o0, o1;
#pragma unroll
                    for (int e = 0; e < 1; ++e) { o0 = acc[ai][0][m][0] * fsigm4(acc[ai][1][m][0]); o1 = acc[ai][0][m][1] * fsigm4(acc[ai][1][m][1]); }
                    *(v4u*)(GLU + (size_t)row * 512 + 128 * pn + cw) = pack8(o0, o1);
                } else if (pn < 7) {
                    const bool isv = (pn == 6) && (wc >= 2);
                    int b, key, l;
                    if (isx) { b = pm >> 3; l = (pm & 7) * 256 + lr; key = CTXL + l; } else { b = pm - 64; l = 0; key = lr; }
                    if (isv) {
#pragma unroll
                        for (int bj = 0; bj < 2; ++bj) *(v4u*)(V0 + ((size_t)b * NKEY0 + key) * 128 + (wc - 2) * 64 + 32 * bj + 8 * fq) = pack8(acc[ai][bj][m][0], acc[ai][bj][m][1]);
                    } else {
                        float ss = 0.f;
#pragma unroll
                        for (int bj = 0; bj < 2; ++bj)
#pragma unroll
                            for (int n = 0; n < 2; ++n) { const f32x4 x = acc[ai][bj][m][n]; ss += (x[0] * x[0] + x[1] * x[1]) + (x[2] * x[2] + x[3] * x[3]); }
                        ss = sum_fq(ss);
                        const float rinv = __builtin_amdgcn_rsqf(ss * (1.f / 64.f) + EPS);
                        const float osc = (pn < 6) ? C2 : 1.f;
#pragma unroll
                        for (int bj = 0; bj < 2; ++bj) {
                            f32x4 v[2];
#pragma unroll
                            for (int n = 0; n < 2; ++n)
#pragma unroll
                                for (int e = 0; e < 4; ++e) v[n][e] = acc[ai][bj][m][n][e] * rinv * g8[bj][4 * n + e];
                            if (isx) {
#pragma unroll
                                for (int n = 0; n < 2; ++n) { const f32x4 cs = bj ? rpC[n] : rpR[ai][n];
                                    const float a0 = v[n][0], b0 = v[n][1], a1 = v[n][2], b1 = v[n][3];
                                    v[n][0] = a0 * cs[0] - b0 * cs[1]; v[n][1] = a0 * cs[1] + b0 * cs[0]; v[n][2] = a1 * cs[2] - b1 * cs[3]; v[n][3] = a1 * cs[3] + b1 * cs[2]; } }
                            v[0] = v[0] * osc; v[1] = v[1] * osc;
                            if (pn < 6) *(v4u*)(Q0 + (size_t)row * 512 + (4 * (pn - 4) + wc) * 64 + 32 * bj + 8 * fq) = pack8(v[0], v[1]);
                            else *(v4u*)(K0 + ((size_t)b * NKEY0 + key) * 128 + wc * 64 + 32 * bj + 8 * fq) = pack8(v[0], v[1]);
                        }
                    }
                } else {
#pragma unroll
                    for (int bj = 0; bj < 2; ++bj) { f32x4 o0, o1;
#pragma unroll
                        for (int e = 0; e < 1; ++e) { o0 = fsilu4(acc[ai][bj][m][0]); o1 = fsilu4(acc[ai][bj][m][1]); }
                        *(v4u*)(SZ + (size_t)row * 1024 + 256 * (pn - 7) + 128 * bj + cw) = pack8(o0, o1); }
                }
            }
        }
    }
};
template <bool CTX>
DEVI void outproj0_epi(const f32x4 (&acc)[2][2][4][2], int pm, int pn, int wr, int wc, int fr, int fq, const float* xin, const float* ada0, const float* ada1, const float* ng1, _Float16* o_x, bf16* H, float* ssq) {
    const int r = CTX ? 8 : (pm >> 3); const size_t rowbase = (size_t)(CTX ? MX : 0) + 256 * pm;
    f32x4 gate[2][2], gp[2][2];
#pragma unroll
    for (int bj = 0; bj < 2; ++bj)
#pragma unroll
        for (int n = 0; n < 2; ++n) { const int col = 256 * pn + 128 * bj + 32 * wc + 8 * fq + 4 * n;
            gate[bj][n] = *(const f32x4*)(ada0 + r * 3072 + 2048 + col);
            gp[bj][n] = *(const f32x4*)(ng1 + col) * (*(const f32x4*)(ada1 + r * 3072 + 1024 + col) + 1.0f); }
#pragma unroll
    for (int ai = 0; ai < 2; ++ai)
#pragma unroll
        for (int mp = 0; mp < 4; mp += 2) {
            f32x4 xr[2][2][2];
#pragma unroll
            for (int mm = 0; mm < 2; ++mm) { const size_t xoff = (size_t)(256 * pm + 128 * ai + 64 * wr + 16 * (mp + mm) + fr) * DM;
#pragma unroll
                for (int bj = 0; bj < 2; ++bj)
#pragma unroll
                    for (int n = 0; n < 2; ++n) xr[mm][bj][n] = __builtin_nontemporal_load((const f32x4*)(xin + xoff + 256 * pn + 128 * bj + 32 * wc + 8 * fq + 4 * n)); }
            asm volatile("" ::: "memory");
#pragma unroll
            for (int mm = 0; mm < 2; ++mm) { const int m = mp + mm;
                const int lr = 128 * ai + 64 * wr + 16 * m + fr; const size_t row = rowbase + lr; const size_t xoff = (size_t)(256 * pm + lr) * DM;
                float ss = 0.f;
#pragma unroll
                for (int bj = 0; bj < 2; ++bj) { const int col8 = 256 * pn + 128 * bj + 32 * wc + 8 * fq; f32x4 xg[2];
#pragma unroll
                    for (int n = 0; n < 2; ++n) { const f32x4 x1 = xr[mm][bj][n] + gate[bj][n] * acc[ai][bj][m][n];
                        if (!CTX) { typedef _Float16 h4 __attribute__((ext_vector_type(4))); __builtin_nontemporal_store(__builtin_convertvector(x1, h4), (h4*)(o_x + xoff + col8 + 4 * n)); }
                        ss += (x1[0] * x1[0] + x1[1] * x1[1]) + (x1[2] * x1[2] + x1[3] * x1[3]); xg[n] = x1 * gp[bj][n]; }
                    *(v4u*)(H + row * DM + col8) = pack8(xg[0], xg[1]); }
                ss = sum_fq(ss);
                if (fq == 0) atomicAdd(ssq + row, ss);
            }
        }
}
struct EpiOutX {
    static constexpr bool PERM = true; static constexpr bool FUSED = false;
    const float *xin, *ada0, *ada1, *ng1; _Float16* o_x; bf16* H; float* ssq;
    DEVI void operator()(const f32x4 (&acc)[2][2][4][2], const pg8::Unit& u, int wr, int wc, int fr, int fq) const { outproj0_epi<false>(acc, u.pm, u.pn, wr, wc, fr, fq, xin, ada0, ada1, ng1, o_x, H, ssq); }
};
struct EpiOutF {
    static constexpr bool PERM = false; static constexpr bool FUSED = true;
    const float *ada, *gfin; const _Float16* x1h; float* o_x; float* ssq2; unsigned* cnt;
    DEVI void fused(f32x4 (&acc)[2][2][4][2], const pg8::Unit& u, int wr, int wc, int fr, int fq, int wid, int lane) const {
        typedef _Float16 h4 __attribute__((ext_vector_type(4))); typedef unsigned u32x2 __attribute__((ext_vector_type(2)));
        const int pm = __builtin_amdgcn_readfirstlane(u.pm), pn = __builtin_amdgcn_readfirstlane(u.pn); const int r = pm >> 3;
        const __amdgpu_buffer_rsrc_t rs_x = __builtin_amdgcn_make_buffer_rsrc((void*)x1h, 0, MX * DM * 2, 0x00020000);
        const __amdgpu_buffer_rsrc_t rs_o = __builtin_amdgcn_make_buffer_rsrc((void*)o_x, 0, MX * DM * 4, 0x00020000);
        const int e0 = (256 * pm + 64 * wr + fr) * DM + 256 * pn + 32 * wc + 4 * fq;
        f32x4 gv[2][2];
#pragma unroll
        for (int bj = 0; bj < 2; ++bj)
#pragma unroll
            for (int n = 0; n < 2; ++n) gv[bj][n] = *(const f32x4*)(ada + r * 3072 + 2048 + 256 * pn + 32 * wc + 4 * fq + 128 * bj + 16 * n);
#pragma unroll
        for (int ai = 0; ai < 2; ++ai) {
            u32x2 xh[4][2][2];
#pragma unroll
            for (int m = 0; m < 4; ++m)
#pragma unroll
                for (int bj = 0; bj < 2; ++bj)
#pragma unroll
                    for (int n = 0; n < 2; ++n) xh[m][bj][n] = __builtin_amdgcn_raw_buffer_load_b64(rs_x, (e0 + (128 * ai + 16 * m) * DM + 128 * bj + 16 * n) * 2, 0, 2  );
#pragma unroll
            for (int m = 0; m < 4; ++m) { const int lr = 128 * ai + 64 * wr + 16 * m + fr; float ss = 0.f;
#pragma unroll
                for (int bj = 0; bj < 2; ++bj)
#pragma unroll
                    for (int n = 0; n < 2; ++n) { const f32x4 x2 = __builtin_convertvector(__builtin_bit_cast(h4, xh[m][bj][n]), f32x4) + gv[bj][n] * acc[ai][bj][m][n]; acc[ai][bj][m][n] = x2;
                        ss += (x2[0] * x2[0] + x2[1] * x2[1]) + (x2[2] * x2[2] + x2[3] * x2[3]); }
                ss = sum_fq(ss);
                if (fq == 0) atomicAdd(ssq2 + 256 * pm + lr, ss); }
        }
        asm volatile("s_waitcnt vmcnt(0)" ::: "memory");
        __builtin_amdgcn_s_barrier(); asm volatile("" ::: "memory");
        if (wid == 0) {
            if (lane == 0) __hip_atomic_fetch_add(cnt + 64 * pm, 1u, __ATOMIC_RELAXED, __HIP_MEMORY_SCOPE_AGENT);
            unsigned sp = 0;
            while ((unsigned)__builtin_amdgcn_readfirstlane(__hip_atomic_load(cnt + 64 * pm, __ATOMIC_RELAXED, __HIP_MEMORY_SCOPE_AGENT)) < 4u) { __builtin_amdgcn_s_sleep(2); if (++sp > (1u << 22)) break; }
        }
        asm volatile("s_waitcnt vmcnt(0) lgkmcnt(0)" ::: "memory");
        __builtin_amdgcn_s_barrier(); asm volatile("" ::: "memory");
        f32x4 gf[2][2];
#pragma unroll
        for (int bj = 0; bj < 2; ++bj)
#pragma unroll
            for (int n = 0; n < 2; ++n) gf[bj][n] = *(const f32x4*)(gfin + 256 * pn + 32 * wc + 4 * fq + 128 * bj + 16 * n);
        float qs[2][4];
#pragma unroll
        for (int ai = 0; ai < 2; ++ai)
#pragma unroll
            for (int m = 0; m < 4; ++m) qs[ai][m] = __hip_atomic_load(ssq2 + 256 * pm + 128 * ai + 64 * wr + 16 * m + fr, __ATOMIC_RELAXED, __HIP_MEMORY_SCOPE_AGENT);
#pragma unroll
        for (int ai = 0; ai < 2; ++ai)
#pragma unroll
            for (int m = 0; m < 4; ++m) {
                const float ri = __builtin_amdgcn_rsqf(qs[ai][m] * (1.f / DM) + EPS);
#pragma unroll
                for (int bj = 0; bj < 2; ++bj)
#pragma unroll
                    for (int n = 0; n < 2; ++n) { const f32x4 o = acc[ai][bj][m][n] * ri * gf[bj][n];
                        __builtin_amdgcn_raw_buffer_store_b128(__builtin_bit_cast(v4u, o), rs_o, (e0 + (128 * ai + 16 * m) * DM + 128 * bj + 16 * n) * 4, 0, 2  ); } }
    }
    DEVI void operator()(const f32x4 (&)[2][2][4][2], const pg8::Unit&, int, int, int, int) const {}
};
struct EpiIn1 {
    static constexpr bool PERM = true; static constexpr bool FUSED = false;
    bf16 *PT, *Q1, *K1, *V1, *SZ1; const float *ssq, *sw;
    const float *ctx, *ada0, *ada1, *ng1; bf16* H; float* ssqw; int pt_pn0; unsigned* gate;
    DEVI void operator()(const f32x4 (&acc)[2][2][4][2], const pg8::Unit& u, int wr, int wc, int fr, int fq) const {
        asm volatile("" : "+v"(fr), "+v"(fq));
        const int pm = u.pm, kind = u.kind; const int cw = 32 * wc + 8 * fq;
        if (kind == 3) { outproj0_epi<true>(acc, pm, u.pn, wr, wc, fr, fq, ctx, ada0, ada1, ng1, nullptr, H, ssqw);
            asm volatile("s_waitcnt vmcnt(0)" ::: "memory"); __builtin_amdgcn_s_barrier(); asm volatile("" ::: "memory");
            if (wr == 0 && wc == 0) { __builtin_amdgcn_fence(__ATOMIC_RELEASE, "agent"); asm volatile("s_waitcnt vmcnt(0)" ::: "memory");
                if (fr == 0 && fq == 0) __hip_atomic_fetch_add(gate, 8u, __ATOMIC_RELAXED, __HIP_MEMORY_SCOPE_AGENT); }
            return; }
        if (kind == 2) {
            const int pn = u.pn + pt_pn0, b = pn >> 3;
            f32x4 ri[2][2];
#pragma unroll
            for (int bj = 0; bj < 2; ++bj)
#pragma unroll
                for (int n = 0; n < 2; ++n) { const f32x4 q = *(const f32x4*)(ssq + 256 * pn + 128 * bj + cw + 4 * n);
#pragma unroll
                    for (int e = 0; e < 4; ++e) ri[bj][n][e] = __builtin_amdgcn_rsqf(q[e] * (1.f / DM) + EPS); }
            float svs[2][4];
#pragma unroll
            for (int ai = 0; ai < 2; ++ai)
#pragma unroll
                for (int m = 0; m < 4; ++m) svs[ai][m] = sw[b * N1 + 256 * pm + 128 * ai + 64 * wr + 16 * m + fr];
            const __amdgpu_buffer_rsrc_t rs_p = __builtin_amdgcn_make_buffer_rsrc((void*)PT, 0, 4096 * 4096 * 2, 0x00020000);
#pragma unroll
            for (int ai = 0; ai < 2; ++ai)
#pragma unroll
                for (int m = 0; m < 4; ++m) { const int jj = 256 * pm + 128 * ai + 64 * wr + 16 * m + fr, cs = jj >> 9, jc = jj & 511; const float sv = svs[ai][m];
#pragma unroll
                    for (int bj = 0; bj < 2; ++bj) { const int tok = 256 * pn + 128 * bj + cw, l = tok & 2047; const int ng = b * 512 + jc;
                        __builtin_amdgcn_raw_buffer_store_b128(pack8(acc[ai][bj][m][0] * ri[bj][0] + sv, acc[ai][bj][m][1] * ri[bj][1] + sv), rs_p, ((((ng >> 7) * 2 + cs) * 128 + (ng & 127)) * 2048 + l) * 2, 0, 0); } }
            return;
        }
        const int pn = u.pn; const int r = (kind == 1) ? 8 : (pm >> 3); const int wcol0 = (kind == 1) ? 1536 : 1024;
        f32x4 sv[2][2];
#pragma unroll
        for (int bj = 0; bj < 2; ++bj)
#pragma unroll
            for (int n = 0; n < 2; ++n) sv[bj][n] = *(const f32x4*)(sw + r * N1 + wcol0 + 256 * pn + 128 * bj + cw + 4 * n);
        const int rowb = ((kind == 1) ? MX : 0) + 256 * pm + 64 * wr + fr;
        float qsv[2][4];
#pragma unroll
        for (int ai = 0; ai < 2; ++ai)
#pragma unroll
            for (int m = 0; m < 4; ++m) qsv[ai][m] = ssq[rowb + 128 * ai + 16 * m];
        bf16* dst; int pitch, colb; float osc = 1.f; bool act = false;
        if (kind == 1) { dst = (pn < 2) ? K1 : V1; pitch = 512; colb = 256 * (pn & 1); }
        else if (pn < 2) { dst = Q1; pitch = 512; colb = 256 * pn; osc = C2; }
        else if (pn < 4) { dst = K1; pitch = 512; colb = 256 * (pn - 2); }
        else if (pn < 6) { dst = V1; pitch = 512; colb = 256 * (pn - 4); }
        else { dst = SZ1; pitch = 1024; colb = 256 * (pn - 6); act = true; }
        const __amdgpu_buffer_rsrc_t rs_d = __builtin_amdgcn_make_buffer_rsrc((void*)dst, 0, MT * 1024 * 2, 0x00020000);
        const int ob = (rowb * pitch + colb + cw) * 2;
#pragma unroll
        for (int ai = 0; ai < 2; ++ai)
#pragma unroll
            for (int m = 0; m < 4; ++m) {
                const float ri = __builtin_amdgcn_rsqf(qsv[ai][m] * (1.f / DM) + EPS);
#pragma unroll
                for (int bj = 0; bj < 2; ++bj) {
                    f32x4 a0 = acc[ai][bj][m][0] * ri + sv[bj][0], a1 = acc[ai][bj][m][1] * ri + sv[bj][1];
                    if (act) {
#pragma unroll
                        for (int e = 0; e < 1; ++e) { a0 = fsilu4(a0); a1 = fsilu4(a1); } }
                    else { a0 = a0 * osc; a1 = a1 * osc; }
                    __builtin_amdgcn_raw_buffer_store_b128(pack8(a0, a1), rs_d, ob + ((128 * ai + 16 * m) * pitch + 128 * bj) * 2, 0, 0);
                }
            }
    }
};
struct EpiDft {
    static constexpr bool PERM = true; static constexpr bool FUSED = false;
    bf16* Y1; const bf16* SZ1;
    DEVI void operator()(const f32x4 (&acc)[2][2][4][2], const pg8::Unit& u, int wr, int wc, int fr, int fq) const {
        const int n = 128 * u.pn + 32 * wc + 8 * fq, b = n >> 9, j = n & 511;
        v4u zs[4][2];
#pragma unroll
        for (int m = 0; m < 4; ++m) { const int lp = 128 * u.pm + 64 * wr + 16 * m + fr;
            zs[m][0] = __builtin_nontemporal_load((const v4u*)(SZ1 + (size_t)(b * 2048 + lp) * 1024 + j));
            zs[m][1] = __builtin_nontemporal_load((const v4u*)(SZ1 + (size_t)(b * 2048 + ((2048 - lp) & 2047)) * 1024 + j)); }
#pragma unroll
        for (int m = 0; m < 4; ++m) { const int lp = 128 * u.pm + 64 * wr + 16 * m + fr;
            const f32x4 a0 = acc[0][0][m][0], a1 = acc[0][0][m][1], b0 = acc[1][1][m][0], b1 = acc[1][1][m][1];
            { const size_t off = (size_t)(b * 2048 + lp) * 1024 + j; const v4u z = zs[m][0];
              f32x4 o0 = a0 - b0, o1 = a1 - b1;
              o0[0] *= bflo(z.x); o0[1] *= bfhi(z.x); o0[2] *= bflo(z.y); o0[3] *= bfhi(z.y); o1[0] *= bflo(z.z); o1[1] *= bfhi(z.z); o1[2] *= bflo(z.w); o1[3] *= bfhi(z.w);
              *(v4u*)(Y1 + off) = pack8(o0, o1); }
            if (lp >= 1) { const size_t off = (size_t)(b * 2048 + 2048 - lp) * 1024 + j; const v4u z = zs[m][1];
              f32x4 o0 = a0 + b0, o1 = a1 + b1;
              o0[0] *= bflo(z.x); o0[1] *= bfhi(z.x); o0[2] *= bflo(z.y); o0[3] *= bfhi(z.y); o1[0] *= bflo(z.z); o1[1] *= bfhi(z.z); o1[2] *= bflo(z.w); o1[3] *= bfhi(z.w);
              *(v4u*)(Y1 + off) = pack8(o0, o1); }
        }
    }
};
DEVI void phase_nyquist(Frame& F) {
    const bf16* PT = wsb(F, WS_PT); const bf16* SZ1 = wsb(F, WS_SZ1); bf16* Y1 = wsb(F, WS_Y1);
    const int gw = F.bid * NWAVES + F.wave, NGW = F.G * NWAVES;
    for (int n0 = gw; n0 < 4096; n0 += 2 * NGW) {
        const int n1 = n0 + NGW; const bool has1 = n1 < 4096; const int n1c = has1 ? n1 : n0;
        const bf16* row0 = PT + ((size_t)((n0 >> 7) * 2) * 128 + (n0 & 127)) * 2048 + F.lane * 32;
        const bf16* row1 = PT + ((size_t)((n1c >> 7) * 2) * 128 + (n1c & 127)) * 2048 + F.lane * 32;
        const size_t off0 = (size_t)((n0 >> 9) * 2048 + 1024) * 1024 + (n0 & 511), off1 = (size_t)((n1c >> 9) * 2048 + 1024) * 1024 + (n1c & 511);
        v4u w0[4], w1[4];
#pragma unroll
        for (int q = 0; q < 4; ++q) { w0[q] = *(const v4u*)(row0 + 8 * q); w1[q] = *(const v4u*)(row1 + 8 * q); }
        const float z0 = bf2f(SZ1[off0]), z1 = bf2f(SZ1[off1]);
        float a0 = 0.f, a1 = 0.f;
#pragma unroll
        for (int q = 0; q < 4; ++q) {
            a0 += (bflo(w0[q].x) - bfhi(w0[q].x)) + (bflo(w0[q].y) - bfhi(w0[q].y)) + (bflo(w0[q].z) - bfhi(w0[q].z)) + (bflo(w0[q].w) - bfhi(w0[q].w));
            a1 += (bflo(w1[q].x) - bfhi(w1[q].x)) + (bflo(w1[q].y) - bfhi(w1[q].y)) + (bflo(w1[q].z) - bfhi(w1[q].z)) + (bflo(w1[q].w) - bfhi(w1[q].w)); }
        a0 = wave_sum_dpp(a0); a1 = wave_sum_dpp(a1);
        if (F.lane == 0) { Y1[off0] = (bf16)f2bf(a0 * z0); if (has1) Y1[off1] = (bf16)f2bf(a1 * z1); }
    }
}

namespace attn_body {
using bf16=__hip_bfloat16;
using bf16x8=__attribute__((ext_vector_type(8)))short;
using s16x4=__attribute__((ext_vector_type(4)))short;
using f32x16=__attribute__((ext_vector_type(16)))float;
using u32x4=__attribute__((ext_vector_type(4)))unsigned;
constexpr int D=64,NW=8,QBLK=32,QB=QBLK*NW,KVBLK=64;
constexpr int QP=512,YP=1024;
__device__ __forceinline__ int crow(int r,int hi){return (r&3)+8*(r>>2)+4*hi;}
#define SBAR() __builtin_amdgcn_sched_barrier(0)
constexpr int NSLOT=3, SLOTB=8192;
constexpr int LDS_K=0, LDS_V=NSLOT*SLOTB, LDS_WS=2*NSLOT*SLOTB, LDS_OST=LDS_WS+NW*64*4, LDS_BYTES=LDS_OST+NW*4096;
__device__ __forceinline__ void glds16(const void*gsrc,unsigned lds_dst){unsigned keep;
  asm volatile("s_mov_b32 %0, m0\n\ts_mov_b32 m0, %2\n\ts_nop 0\n\tglobal_load_lds_dwordx4 %1, off\n\ts_mov_b32 m0, %0":"=&s"(keep):"v"(gsrc),"s"(lds_dst):"memory");}
__device__ __forceinline__ float max3f(float a,float b,float c){float r;asm("v_max3_f32 %0, %1, %2, %3":"=v"(r):"v"(a),"v"(b),"v"(c));return r;}
__device__ __forceinline__ float max2f(float a,float b){float r;asm("v_max_f32_e32 %0, %1, %2":"=v"(r):"v"(a),"v"(b));return r;}
__device__ __forceinline__ float fadd_s(float a,float b){float r;asm("v_add_f32_e32 %0, %1, %2":"=v"(r):"v"(a),"v"(b));return r;}
__device__ __forceinline__ float fsub_s(float a,float b){float r;asm("v_sub_f32_e32 %0, %1, %2":"=v"(r):"v"(a),"v"(b));return r;}
typedef float f32x2_t __attribute__((ext_vector_type(2))); typedef __bf16 bf16x2_t __attribute__((ext_vector_type(2)));
__device__ __forceinline__ unsigned cvtpk_s(float lo,float hi){f32x2_t v={lo,hi};bf16x2_t b=__builtin_convertvector(v,bf16x2_t);return __builtin_bit_cast(unsigned,b);}
#define WAIT_BAR(N) asm volatile("s_waitcnt vmcnt(" #N ") lgkmcnt(0)\n\ts_barrier":::"memory")
__device__ __forceinline__ void qkt(f32x16&p0,f32x16&p1,const char*Kslot,const bf16x8*qr,const f32x16&negm,int r32,int hi){
  const char*kb=Kslot+hi*1024+r32*16;
  #pragma unroll
  for(int d0=0;d0<4;++d0){
    const bf16x8 b0=*reinterpret_cast<const bf16x8*>(kb+d0*2048);
    const bf16x8 b1=*reinterpret_cast<const bf16x8*>(kb+d0*2048+512);
    if(d0==0){p0=__builtin_amdgcn_mfma_f32_32x32x16_bf16(b0,qr[0],negm,0,0,0);p1=__builtin_amdgcn_mfma_f32_32x32x16_bf16(b1,qr[0],negm,0,0,0);}
    else{p0=__builtin_amdgcn_mfma_f32_32x32x16_bf16(b0,qr[d0],p0,0,0,0);p1=__builtin_amdgcn_mfma_f32_32x32x16_bf16(b1,qr[d0],p1,0,0,0);}}
}
typedef __attribute__((address_space(3))) const char* lds_cptr;
typedef short v4i16_t __attribute__((ext_vector_type(4)));
__device__ __forceinline__ void kload8(bf16x8*kf,lds_cptr kp){
  kf[0]=*(const __attribute__((address_space(3))) bf16x8*)(kp);      kf[1]=*(const __attribute__((address_space(3))) bf16x8*)(kp+512);
  kf[2]=*(const __attribute__((address_space(3))) bf16x8*)(kp+2048); kf[3]=*(const __attribute__((address_space(3))) bf16x8*)(kp+2560);
  kf[4]=*(const __attribute__((address_space(3))) bf16x8*)(kp+4096); kf[5]=*(const __attribute__((address_space(3))) bf16x8*)(kp+4608);
  kf[6]=*(const __attribute__((address_space(3))) bf16x8*)(kp+6144); kf[7]=*(const __attribute__((address_space(3))) bf16x8*)(kp+6656);
}
__device__ __forceinline__ void kload2(bf16x8*kf,lds_cptr kp,int j){ kf[2*j]=*(const __attribute__((address_space(3))) bf16x8*)(kp+j*2048); kf[2*j+1]=*(const __attribute__((address_space(3))) bf16x8*)(kp+j*2048+512); }
__device__ __forceinline__ s16x4 vtr(lds_cptr p){ return __builtin_bit_cast(s16x4,__builtin_amdgcn_ds_read_tr16_b64_v4i16((__attribute__((address_space(3))) v4i16_t*)p)); }
__device__ __forceinline__ float rowmax(const f32x16&p0,const f32x16&p1){
  float a=max3f(p0[0],p0[1],p1[0]),b=max3f(p0[2],p0[3],p1[1]);a=max3f(a,p1[2],p1[3]);
  #pragma unroll
  for(int r=4;r<16;r+=4){a=max3f(a,p0[r],p0[r+1]);b=max3f(b,p0[r+2],p0[r+3]);a=max3f(a,p1[r],p1[r+1]);b=max3f(b,p1[r+2],p1[r+3]);}
  const float m=max2f(a,b);
  auto rr=__builtin_amdgcn_permlane32_swap(__float_as_uint(m),__float_as_uint(m),false,false);
  return max2f(__uint_as_float(rr[0]),__uint_as_float(rr[1]));
}
__device__ __forceinline__ void pv(f32x16*o,int vb,bf16x8 pa0,bf16x8 pa1,bf16x8 pa2,bf16x8 pa3){
  #pragma unroll
  for(int d0=0;d0<2;++d0){s16x4 lo[4],hi[4];
    #pragma unroll
    for(int ks=0;ks<4;++ks){
      asm volatile("ds_read_b64_tr_b16 %0,%1 offset:%c2":"=&v"(lo[ks]):"v"(vb),"i"(d0*4096+ks*1024):"memory");
      asm volatile("ds_read_b64_tr_b16 %0,%1 offset:%c2":"=&v"(hi[ks]):"v"(vb),"i"(d0*4096+ks*1024+512):"memory");}
    asm volatile("s_waitcnt lgkmcnt(0)":::"memory");SBAR();
    #define PK(k) (bf16x8){lo[k][0],lo[k][1],lo[k][2],lo[k][3],hi[k][0],hi[k][1],hi[k][2],hi[k][3]}
    o[d0]=__builtin_amdgcn_mfma_f32_32x32x16_bf16(pa0,PK(0),o[d0],0,0,0);
    o[d0]=__builtin_amdgcn_mfma_f32_32x32x16_bf16(pa1,PK(1),o[d0],0,0,0);
    o[d0]=__builtin_amdgcn_mfma_f32_32x32x16_bf16(pa2,PK(2),o[d0],0,0,0);
    o[d0]=__builtin_amdgcn_mfma_f32_32x32x16_bf16(pa3,PK(3),o[d0],0,0,0);
    #undef PK
  }
}
template<int THRL,bool NAT,int KVP> __device__ __forceinline__ void attn_unit(const bf16*Qu,const bf16*__restrict__ Kh,const bf16*__restrict__ Vh,const int NT,bf16*Yu,const bf16*Zu,char*shm,
    const long ctxoff=0,const long winoff=0,const int kr0=0,const int rq0=0,const float*btab=nullptr){
  const int tid=threadIdx.x,lane=tid&63,r32=lane&31,hi=lane>>5; const int wid=__builtin_amdgcn_readfirstlane(tid>>6);
  const bf16*Qw=Qu+(long)(wid*QBLK)*QP;
  const unsigned lds0=(unsigned)(uintptr_t)shm;
  float*wsf=(float*)(shm+LDS_WS)+wid*64;
  const bf16*ksrc=Kh+(long)lane*KVP+wid*8;
  const bf16*vsrc=Vh+(long)(16*(wid&3)+(lane>>2))*KVP+(wid>>2)*32+(lane&3)*8;
  const unsigned kdst=lds0+LDS_K+wid*1024, vdst=lds0+LDS_V+wid*1024;
  #define TOFF(t) (NAT ? (((t)<4) ? (ctxoff+(long)(t)*KVBLK)*KVP : (winoff+(long)((t)-4)*KVBLK)*KVP) : (long)(t)*KVBLK*KVP)
  #define DMA_K(t,slot) glds16(ksrc+TOFF(t),(unsigned)__builtin_amdgcn_readfirstlane(kdst+(slot)))
  #define DMA_V(t,slot) glds16(vsrc+TOFF(t),(unsigned)__builtin_amdgcn_readfirstlane(vdst+(slot)))
  const int nq_r=rq0+(wid>>1), nq_c=32*(wid&1)+r32;
  const int nq_rs=min(max(nq_r-4,0),24), nq_cs=min(max(nq_c-8,0),48);
  const int nq_vb=4*hi-nq_cs, nq_lb=48+15+4*hi-nq_c;
  #define BIASMASK(C0,C1,t) do{ if(NAT && (t)>=4){ const int kr_=kr0+(t)-4; const bool rowok_=(unsigned)(kr_-nq_rs)<8u; const int dr_=min(max(kr_-nq_r+7,0),14); \
      const float*tb_=btab+dr_*31+nq_lb; \
      _Pragma("unroll") for(int rb=0;rb<16;rb+=4){ float b0_[4],b1_[4]; \
        _Pragma("unroll") for(int r=0;r<4;++r){ const int kc_=((rb+r)&3)+8*((rb+r)>>2); b0_[r]=tb_[kc_]; b1_[r]=tb_[kc_+32]; } \
        _Pragma("unroll") for(int r=0;r<4;++r){ const int kc_=((rb+r)&3)+8*((rb+r)>>2); \
          const bool v0_=rowok_&&((unsigned)(kc_+nq_vb)<16u), v1_=rowok_&&((unsigned)(kc_+32+nq_vb)<16u); \
          C0[rb+r]=v0_?C0[rb+r]+b0_[r]:-1e30f; C1[rb+r]=v1_?C1[rb+r]+b1_[r]:-1e30f; } \
        SBAR(); } } }while(0)
  const int vb0=(int)(lds0+LDS_V)+((lane>>4)&1)*32+(lane&3)*8+(4*hi+((lane&15)>>2))*64;
  const char*Kbase=shm+LDS_K; bf16x8 kf[8];
  const lds_cptr shm3=(lds_cptr)shm; const lds_cptr kp0=shm3+LDS_K+hi*1024+r32*16; const lds_cptr vp0=shm3+LDS_V+((lane>>4)&1)*32+(lane&3)*8+(4*hi+((lane&15)>>2))*64;
  DMA_K(0,0);DMA_V(0,0);DMA_K(1,SLOTB);
  bf16x8 qr[4];
  #pragma unroll
  for(int d0=0;d0<4;++d0)qr[d0]=*reinterpret_cast<const bf16x8*>(&Qw[(long)r32*QP+d0*16+hi*8]);
  float mhat=0.f,l_reg=0.f;f32x16 o[2];o[0]=f32x16{};o[1]=f32x16{};float zin_;asm volatile("v_mov_b32 %0, 0":"=v"(zin_));f32x16 negm;
  _Pragma("unroll") for(int r=0;r<16;++r)negm[r]=zin_; asm volatile("":"+v"(negm));
  bool resc=false;
  #define START(P0,P1) do{ const float rm=rowmax(P0,P1); resc=false; \
    { const float dl=rm; mhat=fadd_s(mhat,dl); \
      _Pragma("unroll") for(int r=0;r<16;++r){P0[r]=fsub_s(P0[r],dl);P1[r]=fsub_s(P1[r],dl);} \
      _Pragma("unroll") for(int r=0;r<16;++r)negm[r]=-mhat; asm volatile("":"+v"(negm)); } \
    _Pragma("unroll") for(int r=0;r<16;++r)P0[r]=__builtin_amdgcn_exp2f(P0[r]); }while(0)
  #define RESC() do{ if(resc){ asm volatile("s_waitcnt lgkmcnt(0)":::"memory"); \
      _Pragma("unroll") for(int d_=0;d_<2;++d_) _Pragma("unroll") for(int r=0;r<16;++r)o[d_][r]*=wsf[crow(r,hi)]; } }while(0)
  f32x16 pA0,pA1,pB0,pB1;
  int sl_prev=0,sl_cur=0,sl_next=SLOTB;
  #define ROT() do{sl_prev=sl_cur;sl_cur=sl_next;sl_next=(sl_next==(NSLOT-1)*SLOTB)?0:sl_next+SLOTB;}while(0)
  DMA_K(2,2*SLOTB);
  WAIT_BAR(3);
  qkt(pA0,pA1,Kbase,qr,negm,r32,hi);asm volatile("s_nop 15\n\ts_nop 7":"+v"(pA0),"+v"(pA1));
  START(pA0,pA1);
  _Pragma("unroll") for(int r=0;r<16;++r)pA1[r]=__builtin_amdgcn_exp2f(pA1[r]);
  WAIT_BAR(0);
  DMA_K(3,0);DMA_V(1,SLOTB);
  ROT();
  kload8(kf,kp0+sl_cur);
  WAIT_BAR(2);
  s16x4 vlo[8],vhi[8]; u32x4 pw0,pw1,pw2,pw3;
  #define PKW(P,B) cvtpk_s(P[B],P[B+1])
  #define PAF(k) __builtin_bit_cast(bf16x8,pw##k)
  #define VFR(i) (bf16x8){vlo[i][0],vlo[i][1],vlo[i][2],vlo[i][3],vhi[i][0],vhi[i][1],vhi[i][2],vhi[i][3]}
  #define PIN(x) asm volatile("":"+v"(x))
  #define MX3(a,b,c) __builtin_fmaxf(__builtin_fmaxf((a),(b)),(c))
  #define GAPA(MF,A0,A1,A2,A3,W0,W1,PW) do{ MF; sacc+=A0; sacc+=A1; sacc+=A2; sacc+=A3; PIN(sacc); W0; W1; PIN(PW); SBAR(); }while(0)
  #define EX(v) __builtin_amdgcn_exp2f(v)
  #define GAPB(MF,X,B) do{ MF; X[B]=EX(X[B]); X[B+1]=EX(X[B+1]); X[B+2]=EX(X[B+2]); X[B+3]=EX(X[B+3]); PIN(X); SBAR(); }while(0)
  #define VRD(i) do{ vlo[i]=vtr(vp_+(((i)>>2)*4096+((i)&3)*1024)); vhi[i]=vtr(vp_+(((i)>>2)*4096+((i)&3)*1024+512)); }while(0)
  #define KRD(G,j) do{ if(G){ kload2(kf,kp0+sl_next,j); SBAR(); } }while(0)
  bf16*Yw=Yu+(long)(wid*QBLK)*YP; const bf16*Zw=Zu+(long)(wid*QBLK)*YP;
  u32x4 zq[4];
  #define STEP(C0,C1,P0,P1,t,GK,GV,GL,ZL) do{ SBAR(); \
    const lds_cptr vp_=vp0+sl_prev; \
    VRD(0); SBAR(); float sacc=(P0[0]+P0[1]); \
    GAPA(C0=__builtin_amdgcn_mfma_f32_32x32x16_bf16(kf[0],qr[0],negm,0,0,0), P0[2],P0[3],P0[4],P0[5],     pw0[0]=PKW(P0,0), pw0[1]=PKW(P0,2), pw0); \
    VRD(4); SBAR(); GAPA(C1=__builtin_amdgcn_mfma_f32_32x32x16_bf16(kf[1],qr[0],negm,0,0,0), P0[6],P0[7],P0[8],P0[9],     pw0[2]=PKW(P0,4), pw0[3]=PKW(P0,6), pw0); \
    VRD(1); SBAR(); GAPA(C0=__builtin_amdgcn_mfma_f32_32x32x16_bf16(kf[2],qr[1],C0,0,0,0),   P0[10],P0[11],P0[12],P0[13], pw1[0]=PKW(P0,8), pw1[1]=PKW(P0,10), pw1); \
    VRD(5); SBAR(); GAPA(C1=__builtin_amdgcn_mfma_f32_32x32x16_bf16(kf[3],qr[1],C1,0,0,0),   P0[14],P0[15],P1[0],P1[1],   pw1[2]=PKW(P0,12),pw1[3]=PKW(P0,14), pw1); \
    VRD(2); SBAR(); GAPA(C0=__builtin_amdgcn_mfma_f32_32x32x16_bf16(kf[4],qr[2],C0,0,0,0),   P1[2],P1[3],P1[4],P1[5],     pw2[0]=PKW(P1,0), pw2[1]=PKW(P1,2), pw2); \
    VRD(6); SBAR(); GAPA(C1=__builtin_amdgcn_mfma_f32_32x32x16_bf16(kf[5],qr[2],C1,0,0,0),   P1[6],P1[7],P1[8],P1[9],     pw2[2]=PKW(P1,4), pw2[3]=PKW(P1,6), pw2); \
    VRD(3); SBAR(); GAPA(C0=__builtin_amdgcn_mfma_f32_32x32x16_bf16(kf[6],qr[3],C0,0,0,0),   P1[10],P1[11],P1[12],P1[13], pw3[0]=PKW(P1,8), pw3[1]=PKW(P1,10), pw3); \
    VRD(7); SBAR(); GAPA(C1=__builtin_amdgcn_mfma_f32_32x32x16_bf16(kf[7],qr[3],C1,0,0,0),   P1[14],P1[15],0.f,0.f,       pw3[2]=PKW(P1,12),pw3[3]=PKW(P1,14), pw3); \
    l_reg+=sacc; \
    if(GK){DMA_K((t)+3,sl_cur);} if(GV){DMA_V((t)+1,sl_next);} \
    if(ZL){ _Pragma("unroll") for(int i=0;i<4;++i)zq[i]=__builtin_nontemporal_load((const u32x4*)(Zw+(long)(i*8+(lane>>3))*YP+(lane&7)*8)); } \
    BIASMASK(C0,C1,t); \
    { float a=MX3(C0[0],C0[1],C1[0]),b=MX3(C0[2],C0[3],C1[1]); a=MX3(a,C1[2],C1[3]); \
      _Pragma("unroll") for(int r=4;r<16;r+=4){a=MX3(a,C0[r],C0[r+1]);b=MX3(b,C0[r+2],C0[r+3]);a=MX3(a,C1[r],C1[r+1]);b=MX3(b,C1[r+2],C1[r+3]);} \
      float rm=__builtin_fmaxf(a,b); { auto rr=__builtin_amdgcn_permlane32_swap(__float_as_uint(rm),__float_as_uint(rm),false,false); rm=__builtin_fmaxf(__uint_as_float(rr[0]),__uint_as_float(rr[1])); } \
      resc=false; \
      if(__builtin_expect(__any(rm>(float)THRL),0)){ const float dl=__builtin_fmaxf(rm,0.f); mhat+=dl; \
        _Pragma("unroll") for(int r=0;r<16;++r){C0[r]-=dl;C1[r]-=dl;} \
        _Pragma("unroll") for(int r=0;r<16;++r)negm[r]=-mhat; asm volatile("":"+v"(negm)); \
        const float f=__builtin_amdgcn_exp2f(-dl); l_reg*=f; if(hi==0)wsf[r32]=f; resc=true; } } \
    SBAR(); \
    GAPB(o[0]=__builtin_amdgcn_mfma_f32_32x32x16_bf16(PAF(0),VFR(0),o[0],0,0,0), C0,0); \
    GAPB(o[1]=__builtin_amdgcn_mfma_f32_32x32x16_bf16(PAF(0),VFR(4),o[1],0,0,0), C0,4); \
    KRD(GL,0); GAPB(o[0]=__builtin_amdgcn_mfma_f32_32x32x16_bf16(PAF(1),VFR(1),o[0],0,0,0), C0,8); \
    KRD(GL,1); GAPB(o[1]=__builtin_amdgcn_mfma_f32_32x32x16_bf16(PAF(1),VFR(5),o[1],0,0,0), C0,12); \
    KRD(GL,2); GAPB(o[0]=__builtin_amdgcn_mfma_f32_32x32x16_bf16(PAF(2),VFR(2),o[0],0,0,0), C1,0); \
    KRD(GL,3); GAPB(o[1]=__builtin_amdgcn_mfma_f32_32x32x16_bf16(PAF(2),VFR(6),o[1],0,0,0), C1,4); \
    GAPB(o[0]=__builtin_amdgcn_mfma_f32_32x32x16_bf16(PAF(3),VFR(3),o[0],0,0,0), C1,8); \
    GAPB(o[1]=__builtin_amdgcn_mfma_f32_32x32x16_bf16(PAF(3),VFR(7),o[1],0,0,0), C1,12); \
    }while(0)
  int t=1;
  for(;t+5<NT;t+=2){
    STEP(pB0,pB1,pA0,pA1,t,true,true,true,false);     WAIT_BAR(2); RESC(); ROT();
    STEP(pA0,pA1,pB0,pB1,t+1,true,true,true,false);   WAIT_BAR(2); RESC(); ROT();
  }
  #define ENDW(tt) do{ if((tt)+3<NT){WAIT_BAR(2);} else if((tt)+2<NT){WAIT_BAR(1);} else {WAIT_BAR(0);} }while(0)
  for(;t+1<NT;t+=2){
    STEP(pB0,pB1,pA0,pA1,t,(t+3<NT),(t+1<NT),(t+1<NT),false);       ENDW(t);   RESC(); ROT();
    STEP(pA0,pA1,pB0,pB1,t+1,(t+4<NT),(t+2<NT),(t+2<NT),false);     ENDW(t+1); RESC(); ROT();
  }
  STEP(pB0,pB1,pA0,pA1,NT-1,false,false,false,true); RESC();
  { float sacc=pB0[0]+pB0[1]; _Pragma("unroll") for(int r=2;r<16;++r)sacc+=pB0[r]; _Pragma("unroll") for(int r=0;r<16;++r)sacc+=pB1[r]; l_reg+=sacc;
    pw0=(u32x4){PKW(pB0,0),PKW(pB0,2),PKW(pB0,4),PKW(pB0,6)};pw1=(u32x4){PKW(pB0,8),PKW(pB0,10),PKW(pB0,12),PKW(pB0,14)};pw2=(u32x4){PKW(pB1,0),PKW(pB1,2),PKW(pB1,4),PKW(pB1,6)};pw3=(u32x4){PKW(pB1,8),PKW(pB1,10),PKW(pB1,12),PKW(pB1,14)};
    SBAR(); pv(o,vb0+sl_cur,PAF(0),PAF(1),PAF(2),PAF(3)); }
  #undef PKW
  #undef PAF
  #undef VFR
  #undef PIN
  #undef MX3
  #undef GAPA
  #undef GAPB
  #undef EX
  #undef VRD
  #undef KRD
  #undef STEP
  #undef ENDW
  {auto rr=__builtin_amdgcn_permlane32_swap(__float_as_uint(l_reg),__float_as_uint(l_reg),false,false);l_reg=__uint_as_float(rr[0])+__uint_as_float(rr[1]);}
  if(hi==0)wsf[32+r32]=l_reg;asm volatile("s_waitcnt lgkmcnt(0)":::"memory");
  float rli[16];
  #pragma unroll
  for(int r=0;r<16;++r)rli[r]=__builtin_amdgcn_rcpf(wsf[32+crow(r,hi)]);
  { bf16*stg=(bf16*)(shm+LDS_OST)+wid*2048;
    #pragma unroll
    for(int r=0;r<16;++r){const int orow=crow(r,hi);
      #pragma unroll
      for(int d0=0;d0<2;++d0)stg[orow*64+d0*32+r32]=__float2bfloat16(o[d0][r]*rli[r]);}
    asm volatile("s_waitcnt lgkmcnt(0)":::"memory");
    #pragma unroll
    for(int i=0;i<4;++i){const int row=i*8+(lane>>3),ch=lane&7; const u32x4 v=*(const u32x4*)(stg+row*64+ch*8); const u32x4 z=zq[i]; u32x4 w;
      w.x=cvtpk_s(__uint_as_float(v.x<<16)*__uint_as_float(z.x<<16),__uint_as_float(v.x&0xffff0000u)*__uint_as_float(z.x&0xffff0000u));
      w.y=cvtpk_s(__uint_as_float(v.y<<16)*__uint_as_float(z.y<<16),__uint_as_float(v.y&0xffff0000u)*__uint_as_float(z.y&0xffff0000u));
      w.z=cvtpk_s(__uint_as_float(v.z<<16)*__uint_as_float(z.z<<16),__uint_as_float(v.z&0xffff0000u)*__uint_as_float(z.z&0xffff0000u));
      w.w=cvtpk_s(__uint_as_float(v.w<<16)*__uint_as_float(z.w<<16),__uint_as_float(v.w&0xffff0000u)*__uint_as_float(z.w&0xffff0000u));
      *(u32x4*)(Yw+(long)row*YP+ch*8)=w;} }
  asm volatile("s_waitcnt lgkmcnt(0)\n\ts_barrier":::"memory");
  #undef DMA_K
  #undef DMA_V
  #undef TOFF
  #undef BIASMASK
  #undef START
  #undef RESC
  #undef ROT
}
constexpr int NA_SLOTB=16384, NA_LDS_K=0, NA_LDS_V=3*NA_SLOTB, NA_LDS_WS=6*NA_SLOTB, NA_LDS_OST=NA_LDS_WS+NW*64*4, NA_LDS_BYTES=NA_LDS_OST+NW*4096;
template<int THRL> __device__ __forceinline__ void na_attn_unit(const bf16*Qu,const bf16*__restrict__ Kh,const bf16*__restrict__ Vh,const int NT,bf16*Yu,const bf16*Zu,char*shm,
    const long ctxoff,const long winoff,const int kr0,const int rq0,const float*btab){
  constexpr int KVP=512;
  const int tid=threadIdx.x,lane=tid&63,r32=lane&31,hi=lane>>5; const int wid=__builtin_amdgcn_readfirstlane(tid>>6);
  const int wi=wid>>2, wj=wid&3;
  const int c0=(wj==0)?0:(wj==1)?8:(wj==2)?24:32;
  const int qtok=(2*wi+(r32>>4))*64+16*wj+(r32&15);
  const unsigned lds0=(unsigned)(uintptr_t)shm;
  float*wsf=(float*)(shm+NA_LDS_WS)+wid*64;
  const bf16*ksrc=Kh+(long)lane*KVP+wid*8;
  const bf16*vsrc=Vh+(long)(16*(wid&3)+(lane>>2))*KVP+(wid>>2)*32+(lane&3)*8;
  const unsigned kdst=lds0+NA_LDS_K+wid*1024, vdst=lds0+NA_LDS_V+wid*1024;
  #define DMA_K(t,slot) do{ if((t)<4){ glds16(ksrc+(ctxoff+(long)(t)*KVBLK)*KVP,(unsigned)__builtin_amdgcn_readfirstlane(kdst+(slot))); } \
      else { glds16(ksrc+(winoff+(long)(2*((t)-4))*KVBLK)*KVP,(unsigned)__builtin_amdgcn_readfirstlane(kdst+(slot))); glds16(ksrc+(winoff+(long)(2*((t)-4)+1)*KVBLK)*KVP,(unsigned)__builtin_amdgcn_readfirstlane(kdst+(slot)+8192)); } }while(0)
  #define DMA_V(t,slot) do{ if((t)<4){ glds16(vsrc+(ctxoff+(long)(t)*KVBLK)*KVP,(unsigned)__builtin_amdgcn_readfirstlane(vdst+(slot))); } \
      else { glds16(vsrc+(winoff+(long)(2*((t)-4))*KVBLK)*KVP,(unsigned)__builtin_amdgcn_readfirstlane(vdst+(slot))); glds16(vsrc+(winoff+(long)(2*((t)-4)+1)*KVBLK)*KVP,(unsigned)__builtin_amdgcn_readfirstlane(vdst+(slot)+8192)); } }while(0)
  const int nq_r=rq0+2*wi+(r32>>4), nq_c=16*wj+(r32&15);
  const int nq_rs=min(max(nq_r-4,0),24), nq_cs=min(max(nq_c-8,0),48);
  const int nq_vb=c0+4*hi-nq_cs, nq_lb=48+15+c0+4*hi-nq_c;
  const char*Kbase=shm+NA_LDS_K; bf16x8 kf[8];
  const lds_cptr shm3=(lds_cptr)shm; const lds_cptr kp0=shm3+NA_LDS_K+hi*1024+r32*16; const lds_cptr vp0=shm3+NA_LDS_V+((lane>>4)&1)*32+(lane&3)*8+(4*hi+((lane&15)>>2))*64;
  const lds_cptr kpw=kp0+c0*16, vpw=vp0+c0*64;
  const int vbw=(int)(lds0+NA_LDS_V)+((lane>>4)&1)*32+(lane&3)*8+(4*hi+((lane&15)>>2))*64+c0*64;
  DMA_K(0,0);DMA_V(0,0);DMA_K(1,NA_SLOTB);
  bf16x8 qr[4];
  #pragma unroll
  for(int d0=0;d0<4;++d0)qr[d0]=*reinterpret_cast<const bf16x8*>(&Qu[(long)qtok*QP+d0*16+hi*8]);
  float mhat=0.f,l_reg=0.f;f32x16 o[2];o[0]=f32x16{};o[1]=f32x16{};float zin_;asm volatile("v_mov_b32 %0, 0":"=v"(zin_));f32x16 negm;
  _Pragma("unroll") for(int r=0;r<16;++r)negm[r]=zin_; asm volatile("":"+v"(negm));
  bool resc=false;
  #define RESC() do{ if(resc){ asm volatile("s_waitcnt lgkmcnt(0)":::"memory"); \
      _Pragma("unroll") for(int d_=0;d_<2;++d_) _Pragma("unroll") for(int r=0;r<16;++r)o[d_][r]*=wsf[crow(r,hi)]; } }while(0)
  f32x16 pA0,pA1,pB0,pB1;
  int sl_prev=0,sl_cur=0,sl_next=NA_SLOTB;
  #define ROT() do{sl_prev=sl_cur;sl_cur=sl_next;sl_next=(sl_next==2*NA_SLOTB)?0:sl_next+NA_SLOTB;}while(0)
  DMA_K(2,2*NA_SLOTB);
  WAIT_BAR(3);
  qkt(pA0,pA1,Kbase,qr,negm,r32,hi);asm volatile("s_nop 15\n\ts_nop 7":"+v"(pA0),"+v"(pA1));
  { const float rm=rowmax(pA0,pA1); mhat=fadd_s(mhat,rm);
    _Pragma("unroll") for(int r=0;r<16;++r){pA0[r]=fsub_s(pA0[r],rm);pA1[r]=fsub_s(pA1[r],rm);}
    _Pragma("unroll") for(int r=0;r<16;++r)negm[r]=-mhat; asm volatile("":"+v"(negm));
    _Pragma("unroll") for(int r=0;r<16;++r)pA0[r]=__builtin_amdgcn_exp2f(pA0[r]);
    _Pragma("unroll") for(int r=0;r<16;++r)pA1[r]=__builtin_amdgcn_exp2f(pA1[r]); }
  WAIT_BAR(0);
  DMA_K(3,0);DMA_V(1,NA_SLOTB);
  ROT();
  kload8(kf,kp0+sl_cur);
  WAIT_BAR(2);
  s16x4 vlo[8],vhi[8]; u32x4 pw0,pw1,pw2,pw3;
  #define PKW(P,B) cvtpk_s(P[B],P[B+1])
  #define PAF(k) __builtin_bit_cast(bf16x8,pw##k)
  #define VFR(i) (bf16x8){vlo[i][0],vlo[i][1],vlo[i][2],vlo[i][3],vhi[i][0],vhi[i][1],vhi[i][2],vhi[i][3]}
  #define PIN(x) asm volatile("":"+v"(x))
  #define MX3(a,b,c) __builtin_fmaxf(__builtin_fmaxf((a),(b)),(c))
  #define MFMA(a,b,c) __builtin_amdgcn_mfma_f32_32x32x16_bf16(a,b,c,0,0,0)
  #define GAPA(MF,A0,A1,A2,A3,W0,W1,PW) do{ MF; sacc+=A0; sacc+=A1; sacc+=A2; sacc+=A3; PIN(sacc); W0; W1; PIN(PW); SBAR(); }while(0)
  #define EX(v) __builtin_amdgcn_exp2f(v)
  #define GAPB(MF,X,B) do{ MF; X[B]=EX(X[B]); X[B+1]=EX(X[B+1]); X[B+2]=EX(X[B+2]); X[B+3]=EX(X[B+3]); PIN(X); SBAR(); }while(0)
  #define VRD(i,PW) do{ if(PW){ vlo[i]=vtr(vpw+sl_prev+((((i)&2)?8192:0)+((i)>>2)*4096+((i)&1)*1024)); vhi[i]=vtr(vpw+sl_prev+((((i)&2)?8192:0)+((i)>>2)*4096+((i)&1)*1024+512)); } \
      else { vlo[i]=vtr(vp0+sl_prev+(((i)>>2)*4096+((i)&3)*1024)); vhi[i]=vtr(vp0+sl_prev+(((i)>>2)*4096+((i)&3)*1024+512)); } }while(0)
  #define KRD(G,j,NW_) do{ if(G){ if(NW_){ kf[2*(j)]=*(const __attribute__((address_space(3))) bf16x8*)(kpw+sl_next+(j)*2048); kf[2*(j)+1]=*(const __attribute__((address_space(3))) bf16x8*)(kpw+sl_next+8192+(j)*2048); } \
      else { kload2(kf,kp0+sl_next,j); } SBAR(); } }while(0)
  #define COLV(r) ((unsigned)(((r)&3)+8*((r)>>2)+nq_vb)<16u)
  #define DECIDE2(C0,C1,WIN_) do{ float a=MX3(C0[0],C0[1],C1[0]),b=MX3(C0[2],C0[3],C1[1]); a=MX3(a,C1[2],C1[3]); \
      _Pragma("unroll") for(int r=4;r<16;r+=4){a=MX3(a,C0[r],C0[r+1]);b=MX3(b,C0[r+2],C0[r+3]);a=MX3(a,C1[r],C1[r+1]);b=MX3(b,C1[r+2],C1[r+3]);} \
      float rm=__builtin_fmaxf(a,b); { auto rr=__builtin_amdgcn_permlane32_swap(__float_as_uint(rm),__float_as_uint(rm),false,false); rm=__builtin_fmaxf(__uint_as_float(rr[0]),__uint_as_float(rr[1])); } \
      resc=false; \
      if(__builtin_expect(__any(rm>(float)THRL),0)){ const float dl=__builtin_fmaxf(rm,0.f); mhat+=dl; \
        _Pragma("unroll") for(int r=0;r<16;++r){C0[r]-=dl;C1[r]-=dl;} \
        _Pragma("unroll") for(int r=0;r<16;++r)negm[r]=((WIN_)&&!COLV(r))?-1e30f:-mhat; asm volatile("":"+v"(negm)); \
        const float f=__builtin_amdgcn_exp2f(-dl); l_reg*=f; if(hi==0)wsf[r32]=f; resc=true; } }while(0)
  #define NBIAS1(C,kr_) do{ const bool rowok_=(unsigned)((kr_)-nq_rs)<8u; const int dr_=min(max((kr_)-nq_r+7,0),14); \
      const float*tb_=btab+(rowok_?dr_*31+nq_lb:513); float b_[16]; \
      _Pragma("unroll") for(int r=0;r<16;++r){ const int kc_=(r&3)+8*(r>>2); b_[r]=tb_[kc_]; } \
      _Pragma("unroll") for(int r=0;r<16;++r){ C[r]+=b_[r]; } \
      SBAR(); }while(0)
  u32x4 zq[4];
  #define NSTEP(C0,C1,P0,P1,t,GK,GV,GL,WIN_,PW,NW_,ZL) do{ SBAR(); \
    VRD(0,PW); SBAR(); float sacc=(P0[0]+P0[1]); \
    GAPA(C0=MFMA(kf[0],qr[0],negm), P0[2],P0[3],P0[4],P0[5],     pw0[0]=PKW(P0,0), pw0[1]=PKW(P0,2), pw0); \
    VRD(4,PW); SBAR(); GAPA(C1=MFMA(kf[1],qr[0],negm), P0[6],P0[7],P0[8],P0[9],     pw0[2]=PKW(P0,4), pw0[3]=PKW(P0,6), pw0); \
    VRD(1,PW); SBAR(); GAPA(C0=MFMA(kf[2],qr[1],C0),   P0[10],P0[11],P0[12],P0[13], pw1[0]=PKW(P0,8), pw1[1]=PKW(P0,10), pw1); \
    VRD(5,PW); SBAR(); GAPA(C1=MFMA(kf[3],qr[1],C1),   P0[14],P0[15],P1[0],P1[1],   pw1[2]=PKW(P0,12),pw1[3]=PKW(P0,14), pw1); \
    VRD(2,PW); SBAR(); GAPA(C0=MFMA(kf[4],qr[2],C0),   P1[2],P1[3],P1[4],P1[5],     pw2[0]=PKW(P1,0), pw2[1]=PKW(P1,2), pw2); \
    VRD(6,PW); SBAR(); GAPA(C1=MFMA(kf[5],qr[2],C1),   P1[6],P1[7],P1[8],P1[9],     pw2[2]=PKW(P1,4), pw2[3]=PKW(P1,6), pw2); \
    VRD(3,PW); SBAR(); GAPA(C0=MFMA(kf[6],qr[3],C0),   P1[10],P1[11],P1[12],P1[13], pw3[0]=PKW(P1,8), pw3[1]=PKW(P1,10), pw3); \
    VRD(7,PW); SBAR(); GAPA(C1=MFMA(kf[7],qr[3],C1),   P1[14],P1[15],0.f,0.f,       pw3[2]=PKW(P1,12),pw3[3]=PKW(P1,14), pw3); \
    l_reg+=sacc; \
    if(GK){DMA_K((t)+3,sl_cur);} if(GV){DMA_V((t)+1,sl_next);} \
    if(ZL){ _Pragma("unroll") for(int i=0;i<4;++i){const int row=i*8+(lane>>3); const long tok=(2*wi+(row>>4))*64+16*wj+(row&15); zq[i]=__builtin_nontemporal_load((const u32x4*)(Zu+tok*YP+(lane&7)*8));} } \
    if(WIN_){ const int krA_=kr0+2*((t)-4); NBIAS1(C0,krA_); NBIAS1(C1,krA_+1); } \
    DECIDE2(C0,C1,WIN_); \
    SBAR(); \
    GAPB(o[0]=MFMA(PAF(0),VFR(0),o[0]), C0,0); \
    GAPB(o[1]=MFMA(PAF(0),VFR(4),o[1]), C0,4); \
    KRD(GL,0,NW_); GAPB(o[0]=MFMA(PAF(1),VFR(1),o[0]), C0,8); \
    KRD(GL,1,NW_); GAPB(o[1]=MFMA(PAF(1),VFR(5),o[1]), C0,12); \
    KRD(GL,2,NW_); GAPB(o[0]=MFMA(PAF(2),VFR(2),o[0]), C1,0); \
    KRD(GL,3,NW_); GAPB(o[1]=MFMA(PAF(2),VFR(6),o[1]), C1,4); \
    GAPB(o[0]=MFMA(PAF(3),VFR(3),o[0]), C1,8); \
    GAPB(o[1]=MFMA(PAF(3),VFR(7),o[1]), C1,12); \
    }while(0)
  #define ENDW(tt) do{ if((tt)+3<NT){WAIT_BAR(4);} else if((tt)+2<NT){WAIT_BAR(2);} else {WAIT_BAR(0);} }while(0)
  NSTEP(pB0,pB1,pA0,pA1,1,true,true,true,false,false,false,false); WAIT_BAR(3); RESC(); ROT();
  NSTEP(pA0,pA1,pB0,pB1,2,true,true,true,false,false,false,false); WAIT_BAR(3); RESC(); ROT();
  NSTEP(pB0,pB1,pA0,pA1,3,true,true,true,false,false,true,false);  WAIT_BAR(4); RESC(); ROT();
  _Pragma("unroll") for(int r=0;r<16;++r)negm[r]=COLV(r)?negm[r]:-1e30f; asm volatile("":"+v"(negm));
  NSTEP(pA0,pA1,pB0,pB1,4,(7<NT),true,true,true,false,true,false); ENDW(4);     RESC(); ROT();
  int t=5;
  for(;t+2<NT;t+=2){
    NSTEP(pB0,pB1,pA0,pA1,t,(t+3<NT),(t+1<NT),(t+1<NT),true,true,true,false);     ENDW(t);   RESC(); ROT();
    NSTEP(pA0,pA1,pB0,pB1,t+1,(t+4<NT),(t+2<NT),(t+2<NT),true,true,true,false);   ENDW(t+1); RESC(); ROT();
  }
  NSTEP(pB0,pB1,pA0,pA1,NT-1,false,false,false,true,true,true,true); RESC();
  { float sacc=pB0[0]+pB0[1]; _Pragma("unroll") for(int r=2;r<16;++r)sacc+=pB0[r]; _Pragma("unroll") for(int r=0;r<16;++r)sacc+=pB1[r]; l_reg+=sacc;
    pw0=(u32x4){PKW(pB0,0),PKW(pB0,2),PKW(pB0,4),PKW(pB0,6)};pw1=(u32x4){PKW(pB0,8),PKW(pB0,10),PKW(pB0,12),PKW(pB0,14)};pw2=(u32x4){PKW(pB1,0),PKW(pB1,2),PKW(pB1,4),PKW(pB1,6)};pw3=(u32x4){PKW(pB1,8),PKW(pB1,10),PKW(pB1,12),PKW(pB1,14)};
    SBAR();
    const int vb=vbw+sl_cur;
    #pragma unroll
    for(int d0=0;d0<2;++d0){s16x4 lo[4],hh[4];
      #pragma unroll
      for(int ks=0;ks<4;++ks){
        asm volatile("ds_read_b64_tr_b16 %0,%1 offset:%c2":"=&v"(lo[ks]):"v"(vb),"i"(((ks&2)?8192:0)+d0*4096+(ks&1)*1024):"memory");
        asm volatile("ds_read_b64_tr_b16 %0,%1 offset:%c2":"=&v"(hh[ks]):"v"(vb),"i"(((ks&2)?8192:0)+d0*4096+(ks&1)*1024+512):"memory");}
      asm volatile("s_waitcnt lgkmcnt(0)":::"memory");SBAR();
      #define PK(k) (bf16x8){lo[k][0],lo[k][1],lo[k][2],lo[k][3],hh[k][0],hh[k][1],hh[k][2],hh[k][3]}
      o[d0]=MFMA(PAF(0),PK(0),o[d0]);
      o[d0]=MFMA(PAF(1),PK(1),o[d0]);
      o[d0]=MFMA(PAF(2),PK(2),o[d0]);
      o[d0]=MFMA(PAF(3),PK(3),o[d0]);
      #undef PK
    } }
  #undef PKW
  #undef PAF
  #undef VFR
  #undef PIN
  #undef MX3
  #undef MFMA
  #undef GAPA
  #undef GAPB
  #undef EX
  #undef VRD
  #undef KRD
  #undef DECIDE2
  #undef COLV
  #undef NBIAS1
  #undef NSTEP
  #undef ENDW
  {auto rr=__builtin_amdgcn_permlane32_swap(__float_as_uint(l_reg),__float_as_uint(l_reg),false,false);l_reg=__uint_as_float(rr[0])+__uint_as_float(rr[1]);}
  if(hi==0)wsf[32+r32]=l_reg;asm volatile("s_waitcnt lgkmcnt(0)":::"memory");
  float rli[16];
  #pragma unroll
  for(int r=0;r<16;++r)rli[r]=__builtin_amdgcn_rcpf(wsf[32+crow(r,hi)]);
  { bf16*stg=(bf16*)(shm+NA_LDS_OST)+wid*2048;
    #pragma unroll
    for(int r=0;r<16;++r){const int orow=crow(r,hi);
      #pragma unroll
      for(int d0=0;d0<2;++d0)stg[orow*64+d0*32+r32]=__float2bfloat16(o[d0][r]*rli[r]);}
    asm volatile("s_waitcnt lgkmcnt(0)":::"memory");
    #pragma unroll
    for(int i=0;i<4;++i){const int row=i*8+(lane>>3),ch=lane&7; const long tok=(2*wi+(row>>4))*64+16*wj+(row&15);
      const u32x4 v=*(const u32x4*)(stg+row*64+ch*8); const u32x4 z=zq[i]; u32x4 w;
      w.x=cvtpk_s(__uint_as_float(v.x<<16)*__uint_as_float(z.x<<16),__uint_as_float(v.x&0xffff0000u)*__uint_as_float(z.x&0xffff0000u));
      w.y=cvtpk_s(__uint_as_float(v.y<<16)*__uint_as_float(z.y<<16),__uint_as_float(v.y&0xffff0000u)*__uint_as_float(z.y&0xffff0000u));
      w.z=cvtpk_s(__uint_as_float(v.z<<16)*__uint_as_float(z.z<<16),__uint_as_float(v.z&0xffff0000u)*__uint_as_float(z.z&0xffff0000u));
      w.w=cvtpk_s(__uint_as_float(v.w<<16)*__uint_as_float(z.w<<16),__uint_as_float(v.w&0xffff0000u)*__uint_as_float(z.w&0xffff0000u));
      *(u32x4*)(Yu+tok*YP+ch*8)=w;} }
  asm volatile("s_waitcnt lgkmcnt(0)\n\ts_barrier":::"memory");
  #undef DMA_K
  #undef DMA_V
  #undef RESC
  #undef ROT
}
#undef SBAR
#undef WAIT_BAR
}

DEVI int p3_rank(const Frame& F) { const int vcu = (F.bid & 7) * (F.G >> 3) + (F.bid >> 3); return ((vcu & 31) < 4) ? -1 : vcu - 4 * ((vcu >> 5) + 1); }
DEVI void p3_wait_deferred(Frame& F) {
    if (F.wave == 0) { unsigned* gate = (unsigned*)(F.ws + WS_PCNT) + 64 * 67; unsigned sp = 0;
        while ((unsigned)__builtin_amdgcn_readfirstlane(__hip_atomic_load(gate, __ATOMIC_RELAXED, __HIP_MEMORY_SCOPE_AGENT)) < 32u) { __builtin_amdgcn_s_sleep(8); if (++sp > (1u << 20)) break; }
        __builtin_amdgcn_fence(__ATOMIC_ACQUIRE, "agent"); }
    asm volatile("s_waitcnt vmcnt(0)" ::: "memory");
    __syncthreads();
}
DEVI void phase_attn0(Frame& F, char* lds_generic) {
    using abf = attn_body::bf16;
    const abf* Q0 = (const abf*)wsb(F, WS_Q0); const abf* K0 = (const abf*)wsb(F, WS_K0); const abf* V0 = (const abf*)wsb(F, WS_V0);
    const abf* SZ = (const abf*)wsb(F, WS_SZ0); abf* Y = (abf*)wsb(F, WS_Y0);
    const int vcu = (F.bid & 7) * (F.G >> 3) + (F.bid >> 3);
    const int rk = p3_rank(F);
    for (int k = 0; k < 3; ++k) {
        int id;
        if (k < 2) id = vcu + k * F.G; else { if (rk < 160) break; id = 512 + (rk - 160); p3_wait_deferred(F); }
        int b, head, NT; size_t row0;
        if (id < 512) { const int qb = id & 7, g = (id >> 3) & 3, kvh = (id >> 5) & 1; b = id >> 6; head = kvh * 4 + g; row0 = (size_t)b * SEQ + qb * 256; NT = NKEY0 / 64; }
        else { const int j = id - 512; b = j >> 3; head = j & 7; row0 = (size_t)MX + b * CTXL; NT = CTXL / 64; }
        const size_t kvoff = (size_t)b * NKEY0 * 128 + (head >> 2) * 64;
        attn_body::attn_unit<8, false, 128>(Q0 + row0 * 512 + head * 64, K0 + kvoff, V0 + kvoff, NT, Y + row0 * 1024 + 512 + head * 64, SZ + row0 * 1024 + 512 + head * 64, lds_generic);
    }
}

DEVI void phase_conv(Frame& F) {
    LAS float* red = (LAS float*)F.lds;
    const bf16* GLU = wsb(F, WS_GLU); const bf16* SZ = wsb(F, WS_SZ0); bf16* Y = wsb(F, WS_Y0);
    const int half = F.wave >> 2, wq = F.wave & 3, c2 = wq * 128 + F.lane * 2;
    typedef float f32x2v __attribute__((ext_vector_type(2)));
    f32x2v wt[31];
#pragma unroll
    for (int t = 0; t < 31; ++t) wt[t] = *(const f32x2v*)(F.in[I_AB_CONVW] + t * 512 + c2);
    const float2 cb = *(const float2*)(F.in[I_AB_CONVB] + c2), lg = *(const float2*)(F.in[I_AB_LNG] + c2), lb = *(const float2*)(F.in[I_AB_LNB] + c2);
    constexpr int NCH = MT / 16;
    const int rk = p3_rank(F);
    bool waited = rk >= 160;
    for (int it = rk; rk >= 0 && it * 2 < NCH; it += 224) {
        if (it * 32 >= MX && !waited) { p3_wait_deferred(F); waited = true; }
        const int ch = it * 2 + half;
        const int row0 = ch * 16;
        int base, len, pos0;
        if (row0 < MX) { base = row0 & ~2047; len = SEQ; pos0 = row0 & 2047; } else { const int rc = row0 - MX; base = MX + (rc & ~255); len = CTXL; pos0 = rc & 255; }
        unsigned gin[46];
#pragma unroll
        for (int pi = 0; pi < 46; ++pi) { const int p = pos0 - 15 + pi, pc = min(max(p, 0), len - 1); gin[pi] = *(const unsigned*)(GLU + (size_t)(base + pc) * 512 + c2); }
#pragma unroll
        for (int pi = 0; pi < 46; ++pi) { const int p = pos0 - 15 + pi; gin[pi] = (p >= 0 && p < len) ? gin[pi] : 0u; }
        unsigned zin[16];
#pragma unroll
        for (int li = 0; li < 16; ++li) zin[li] = __builtin_nontemporal_load((const unsigned*)(SZ + (size_t)(row0 + li) * 1024 + c2));
        f32x2v av[16];
#pragma unroll
        for (int li = 0; li < 16; ++li) av[li] = (f32x2v){cb.x, cb.y};
#pragma unroll
        for (int pi = 0; pi < 46; ++pi) { const f32x2v g = (f32x2v){bflo(gin[pi]), bfhi(gin[pi])};
#pragma unroll
            for (int li = 0; li < 16; ++li) { const int t = pi - li; if (t >= 0 && t <= 30) av[li] = __builtin_elementwise_fma(g, wt[t], av[li]); } }
        float a0[16], a1[16];
#pragma unroll
        for (int li = 0; li < 16; ++li) { a0[li] = av[li].x; a1[li] = av[li].y; }
        float st[32];
#pragma unroll
        for (int li = 0; li < 16; ++li) { st[li] = a0[li] + a1[li]; st[16 + li] = a0[li] * a0[li] + a1[li] * a1[li]; }
#define WS_STEP(ctrl, rmask) _Pragma("unroll") for (int j = 0; j < 32; ++j) st[j] += __builtin_bit_cast(float, __builtin_amdgcn_update_dpp(0, __builtin_bit_cast(int, st[j]), ctrl, rmask, 0xf, true))
        WS_STEP(0xB1, 0xf); WS_STEP(0x4E, 0xf); WS_STEP(0x141, 0xf); WS_STEP(0x140, 0xf); WS_STEP(0x142, 0xa); WS_STEP(0x143, 0xc);
#undef WS_STEP
#pragma unroll
        for (int j = 0; j < 32; ++j) st[j] = __builtin_bit_cast(float, __builtin_amdgcn_readlane(__builtin_bit_cast(int, st[j]), 63));
        __syncthreads();
        if (F.lane < 32) { float v = st[0];
#pragma unroll
            for (int j = 1; j < 32; ++j) v = (F.lane == j) ? st[j] : v;
            red[(half * 4 + wq) * 32 + F.lane] = v; }
        __syncthreads();
#pragma unroll
        for (int li = 0; li < 16; ++li) {
            const LAS float* rp = red + half * 128;
            const float sm = (rp[li] + rp[32 + li]) + (rp[64 + li] + rp[96 + li]), sq = (rp[16 + li] + rp[48 + li]) + (rp[80 + li] + rp[112 + li]);
            const float mean = sm * (1.f / 512.f), var = fmaxf(sq * (1.f / 512.f) - mean * mean, 0.f), rstd = __builtin_amdgcn_rsqf(var + EPS);
            const float y0 = fsilu((a0[li] - mean) * rstd * lg.x + lb.x) * bflo(zin[li]), y1 = fsilu((a1[li] - mean) * rstd * lg.y + lb.y) * bfhi(zin[li]);
            *(unsigned*)(Y + (size_t)(row0 + li) * 1024 + c2) = pk2(y0, y1);
        }
    }
    __syncthreads();
}

constexpr int NA_BTAB_OFF = 133120;
DEVI void na_fill_table(Frame& F, int h) {
    LAS float* bt = (LAS float*)(F.lds + NA_BTAB_OFF);
    const float* rpb = F.in[I_CD_RPB] + h * 15 * 31;
    for (int i = F.tid; i < 544; i += NTHR) bt[i] = (i < 48) ? 0.f : (i < 48 + 465) ? rpb[i - 48] * LOG2E : -1e30f;
}
DEVI void na_unit(Frame& F, char* lds_generic, int id, int& cur_h) {
    using abf = attn_body::bf16;
    const abf* Q1 = (const abf*)wsb(F, WS_Q1); const abf* K1 = (const abf*)wsb(F, WS_K1); const abf* V1 = (const abf*)wsb(F, WS_V1);
    const abf* SZ1 = (const abf*)wsb(F, WS_SZ1); abf* Y1 = (abf*)wsb(F, WS_Y1);
    const int rg = id & 7, h = (id >> 3) & 7, b = id >> 6;
    const int r0 = 4 * rg, kr0 = min(max(r0 - 4, 0), 24), nwin = (rg == 0 || rg == 7) ? 8 : 12;
    if (h != cur_h) { na_fill_table(F, h); cur_h = h; }
    const size_t row0 = (size_t)b * SEQ + r0 * 64;
    attn_body::na_attn_unit<8>(Q1 + row0 * 512 + h * 64, K1 + h * 64, V1 + h * 64, 4 + nwin / 2, Y1 + row0 * 1024 + 512 + h * 64, SZ1 + row0 * 1024 + 512 + h * 64, lds_generic,
                                       (long)MX + b * CTXL, (long)b * SEQ + kr0 * 64, kr0, r0, (const float*)(lds_generic + NA_BTAB_OFF));
}
DEVI void phase_shiftw(Frame& F) {
    LAS float* sh = (LAS float*)F.lds;
    __syncthreads();
    const float* ada1 = wsf(F, WS_ADA) + 9 * 3072;
    for (int i = F.tid; i < 9 * 1024; i += NTHR) sh[i] = ada1[(i >> 10) * 3072 + (i & 1023)];
    __syncthreads();
    const bf16* WT = wsb(F, WS_WIN1); float* sw = wsf(F, WS_SW);
    const int rk = p3_rank(F); const bool light = rk >= 128 && rk < 160;
    const int gw = light ? 1792 + (rk - 128) * NWAVES + F.wave : ((rk < 0) ? F.bid : (rk < 128 ? 32 + rk : rk)) * NWAVES + F.wave;
    const int NGW = 256, nend = light ? N1 : gw + 1;
    for (int n = gw; n < nend; n += NGW) {
        const v4u w0 = *(const v4u*)(WT + (size_t)n * DM + F.lane * 16), w1 = *(const v4u*)(WT + (size_t)n * DM + F.lane * 16 + 8);
        float wv[16] = {bflo(w0.x), bfhi(w0.x), bflo(w0.y), bfhi(w0.y), bflo(w0.z), bfhi(w0.z), bflo(w0.w), bfhi(w0.w), bflo(w1.x), bfhi(w1.x), bflo(w1.y), bfhi(w1.y), bflo(w1.z), bfhi(w1.z), bflo(w1.w), bfhi(w1.w)};
        float a[9];
#pragma unroll
        for (int r = 0; r < 9; ++r) { a[r] = 0.f;
#pragma unroll
            for (int q = 0; q < 4; ++q) { const f32x4 sv = *(const LAS f32x4*)(sh + r * 1024 + F.lane * 16 + 4 * q); a[r] += sv.x * wv[4 * q] + sv.y * wv[4 * q + 1] + sv.z * wv[4 * q + 2] + sv.w * wv[4 * q + 3]; } }
#define WS_STEP(ctrl, rmask) _Pragma("unroll") for (int r = 0; r < 9; ++r) a[r] += __builtin_bit_cast(float, __builtin_amdgcn_update_dpp(0, __builtin_bit_cast(int, a[r]), ctrl, rmask, 0xf, true))
        WS_STEP(0xB1, 0xf); WS_STEP(0x4E, 0xf); WS_STEP(0x141, 0xf); WS_STEP(0x140, 0xf); WS_STEP(0x142, 0xa); WS_STEP(0x143, 0xc);
#undef WS_STEP
        if (F.lane == 63) {
#pragma unroll
            for (int r = 0; r < 9; ++r) sw[r * N1 + n] = a[r]; }
    }
    __syncthreads();
}
__global__ void __launch_bounds__(NTHR, 2) mk_fwd(Args args) {
    extern __shared__ __attribute__((aligned(16))) unsigned char lds[];
    Frame F;
    F.lds = (LAS unsigned char*)lds;
    F.tid = threadIdx.x; F.lane = F.tid & 63; F.wave = __builtin_amdgcn_readfirstlane(F.tid >> 6);
    F.G = gridDim.x; F.bid = blockIdx.x;
#pragma unroll
    for (int i = 0; i < 23; ++i) F.in[i] = args.in[i];
    F.out = args.out; F.ws = args.ws;
    volatile LAS unsigned* MISC = (volatile LAS unsigned*)(F.lds + MISC_OFF);
    if (F.tid < 32) MISC[F.tid] = 0u;
    __syncthreads();
    unsigned* ctl = (unsigned*)(F.ws + WS_CTL);
    XcdBarrier bar; bar.bar = ctl + CW_BAR; bar.x = 0; bar.st = nullptr;
    if (MK_N_LAUNCHES == 1) bar = xcd_barrier_post(ctl + CW_BAR, MISC + 8);
    const int lo = args.ph_lo, hi = args.ph_hi;
#define IN(k) (lo <= (k) && (k) < hi)
    volatile LAS unsigned long long* TS = (volatile LAS unsigned long long*)(F.lds + 146432);
#define STAMP(k) do { if (PROBE_PHASE >= 0 && F.bid == 0 && F.tid == 0) TS[k] = __builtin_amdgcn_s_memrealtime(); } while (0)
#define SEAM(k) do { if (IN(k) && IN((k) + 1)) xcd_barrier(bar); STAMP((k) + 1); } while (0)
    STAMP(0);

    {
        f32x4 xpf[XPF][4];
        if (IN(0)) { p0_prologue(F, xpf); } SEAM(0);
        if (IN(1)) { phase_modnorm(F, 0, xpf); } SEAM(1);
    }
    if (IN(2)) {
        EpiIn0 E{wsb(F, WS_GLU), wsb(F, WS_Q0), wsb(F, WS_K0), wsb(F, WS_V0), wsb(F, WS_SZ0), F.in[I_AB_QNG], F.in[I_AB_KNG], wsf(F, WS_ROPE)};
        pg8::SegOrder S; S.init(pg8::Seg{wsb(F, WS_H), wsb(F, WS_WIN0), 72, 7, 0}, pg8::Seg{wsb(F, WS_H), wsb(F, WS_WIN0) + (size_t)7 * 256 * DM, 64, 4, 1}, pg8::Seg{nullptr, nullptr, 0, 0, 0}, DM, F.G, F.bid);
        pg8::gemm_phase<EpiIn0, pg8::SegOrder>(F.lds, DM, S, E);
        p2_fill_fold(F);
    } SEAM(2);
    if (IN(3)) {
        if (F.bid < 32) {
            EpiIn0 E{wsb(F, WS_GLU), wsb(F, WS_Q0), wsb(F, WS_K0), wsb(F, WS_V0), wsb(F, WS_SZ0), F.in[I_AB_QNG], F.in[I_AB_KNG], wsf(F, WS_ROPE)};
            pg8::SegOrder S; S.init(pg8::Seg{wsb(F, WS_H) + (size_t)64 * 256 * DM, wsb(F, WS_WIN0) + (size_t)7 * 256 * DM, 8, 4, 2}, pg8::Seg{nullptr, nullptr, 0, 0, 0}, pg8::Seg{nullptr, nullptr, 0, 0, 0}, DM, F.G, F.bid);
            pg8::gemm_phase<EpiIn0, pg8::SegOrder>(F.lds, DM, S, E);
            if (F.tid == 0) { __builtin_amdgcn_fence(__ATOMIC_RELEASE, "agent"); asm volatile("s_waitcnt vmcnt(0)" ::: "memory");
                __hip_atomic_fetch_add((unsigned*)(F.ws + WS_PCNT) + 64 * 67, 1u, __ATOMIC_RELAXED, __HIP_MEMORY_SCOPE_AGENT); }
        }
        phase_attn0(F, (char*)lds); STAMP(11); phase_conv(F); phase_shiftw(F); } SEAM(3);
    if (IN(4)) {
        EpiOutX E{F.in[I_X], wsf(F, WS_ADA), wsf(F, WS_ADA) + 9 * 3072, F.in[I_CD_NORMG], (_Float16*)(F.ws + WS_X1H), wsb(F, WS_H), wsf(F, WS_SSQ)};
        pg8::SegOrder S; S.init(pg8::Seg{wsb(F, WS_Y0), wsb(F, WS_WOUT0), 64, 4, 0}, pg8::Seg{nullptr, nullptr, 0, 0, 0}, pg8::Seg{nullptr, nullptr, 0, 0, 0}, DM, F.G, F.bid);
        pg8::gemm_phase<EpiOutX, pg8::SegOrder>(F.lds, DM, S, E);
    } SEAM(4);
    if (IN(5)) {
        EpiIn1 E{wsb(F, WS_PT), wsb(F, WS_Q1), wsb(F, WS_K1), wsb(F, WS_V1), wsb(F, WS_SZ1), wsf(F, WS_SSQ), wsf(F, WS_SW),
                 F.in[I_CTX], wsf(F, WS_ADA), wsf(F, WS_ADA) + 9 * 3072, F.in[I_CD_NORMG], wsb(F, WS_H), wsf(F, WS_SSQ), 0, (unsigned*)(F.ws + WS_PCNT) + 64 * 64};
        pg8::SegOrder S; S.init(pg8::Seg{wsb(F, WS_Y0) + (size_t)MX * DM, wsb(F, WS_WOUT0), 8, 4, 3},
                                pg8::Seg{wsb(F, WS_H), wsb(F, WS_WIN1) + (size_t)1024 * DM, 64, 10, 0},
                                pg8::Seg{wsb(F, WS_WIN1), wsb(F, WS_H), 4, 24, 2}, DM, F.G, F.bid);
        pg8::gemm_phase<EpiIn1, pg8::SegOrder>(F.lds, DM, S, E);
    }
    if (IN(5) && IN(6)) {
        const int c6 = (F.bid + 224) & 255;
        if (c6 >= 160 && c6 < 192) {
            if (F.wave == 0) { unsigned* gate = (unsigned*)(F.ws + WS_PCNT) + 64 * 64; unsigned sp = 0;
                while ((unsigned)__builtin_amdgcn_readfirstlane(__hip_atomic_load(gate, __ATOMIC_RELAXED, __HIP_MEMORY_SCOPE_AGENT)) < 256u) { __builtin_amdgcn_s_sleep(2); if (++sp > (1u << 22)) break; }
                __builtin_amdgcn_fence(__ATOMIC_ACQUIRE, "agent"); }
            asm volatile("s_waitcnt vmcnt(0)" ::: "memory");
            __syncthreads();
        }
    } STAMP(6);
    if (IN(6)) {
        EpiIn1 E{wsb(F, WS_PT), wsb(F, WS_Q1), wsb(F, WS_K1), wsb(F, WS_V1), wsb(F, WS_SZ1), wsf(F, WS_SSQ), wsf(F, WS_SW),
                 F.in[I_CTX], wsf(F, WS_ADA), wsf(F, WS_ADA) + 9 * 3072, F.in[I_CD_NORMG], wsb(F, WS_H), wsf(F, WS_SSQ), 24, (unsigned*)(F.ws + WS_PCNT) + 64 * 64};
        pg8::SegOrder S; S.init(pg8::Seg{wsb(F, WS_WIN1), wsb(F, WS_H) + (size_t)24 * 256 * DM, 4, 40, 2},
                                pg8::Seg{wsb(F, WS_H) + (size_t)MX * DM, wsb(F, WS_WIN1) + (size_t)1536 * DM, 8, 4, 1}, pg8::Seg{nullptr, nullptr, 0, 0, 0}, DM, F.G, (F.bid + 224) & 255);
        pg8::gemm_phase<EpiIn1, pg8::SegOrder>(F.lds, DM, S, E);
        if (((F.bid + 224) & 255) >= 192) p6_filler(F, ((F.bid + 224) & 255) - 192, F.G - 192);
    } SEAM(6);
    if (IN(7)) {
        EpiDft E{wsb(F, WS_Y1), wsb(F, WS_SZ1)};
        pg8::SegOrder S; S.init(pg8::Seg{wsb(F, WS_DFT), wsb(F, WS_PT), 8, 32, 0}, pg8::Seg{nullptr, nullptr, 0, 0, 0}, pg8::Seg{nullptr, nullptr, 0, 0, 0}, 2048, F.G, F.bid);
        pg8::gemm_phase<EpiDft, pg8::SegOrder, true, true>(F.lds, 2048, S, E); STAMP(12);
        phase_nyquist(F);
        {
            const int vcu = (F.bid & 7) * (F.G >> 3) + (F.bid >> 3);
            int cur_h = -1;
            for (int id = vcu; id < 512; id += F.G) na_unit(F, (char*)lds, id, cur_h);
        }
    } SEAM(7);
    if (IN(8)) {
        EpiOutF E{wsf(F, WS_ADA) + 9 * 3072, F.in[I_FNG], (const _Float16*)(F.ws + WS_X1H), F.out, wsf(F, WS_SSQ2), (unsigned*)(F.ws + WS_PCNT)};
        pg8::SegOrder S; S.init(pg8::Seg{wsb(F, WS_Y1), wsb(F, WS_WOUT1), 64, 4, 0}, pg8::Seg{nullptr, nullptr, 0, 0, 0}, pg8::Seg{nullptr, nullptr, 0, 0, 0}, DM, F.G, F.bid);
        if (F.G == 256) pg8::gemm_phase<EpiOutF, pg8::SegOrder>(F.lds, DM, S, E);
    }
    if (PROBE_PHASE >= 0) { STAMP(10); __syncthreads(); if (F.bid == 0 && F.tid == 0) F.out[0] += (float)(TS[PROBE_B] - TS[PROBE_A]) * 0.01f; }
#undef IN
#undef SEAM
}

extern "C" void kernel_launch(void* const* d_in, const int* in_sizes, int n_in, void* d_out, int out_size, void* d_ws, size_t ws_size, hipStream_t stream) {
    static int grid = 0;
    if (grid == 0) {
        if (n_in != 23 || out_size != MX * DM || ws_size < WS_X1H + (size_t)MX * DM * 2) { fprintf(stderr, "kernel_launch: unexpected shapes (n_in %d out %d ws %zu)\n", n_in, out_size, ws_size); grid = -1; return; }
        int dev = 0, cus = 0, per_cu = 0;
        if (hipGetDevice(&dev) != hipSuccess || hipDeviceGetAttribute(&cus, hipDeviceAttributeMultiprocessorCount, dev) != hipSuccess) { grid = -1; return; }
        if (hipFuncSetAttribute((const void*)mk_fwd, hipFuncAttributeMaxDynamicSharedMemorySize, LDS_BYTES) != hipSuccess) { fprintf(stderr, "kernel_launch: hipFuncSetAttribute failed\n"); grid = -1; return; }
        if (hipOccupancyMaxActiveBlocksPerMultiprocessor(&per_cu, (const void*)mk_fwd, NTHR, LDS_BYTES) != hipSuccess || per_cu < 1) { fprintf(stderr, "kernel_launch: occupancy query says %d\n", per_cu); per_cu = 1; }
        (void)hipGetLastError();
        grid = cus;
    }
    if (grid < 0) return;
    if (hipMemsetAsync((char*)d_ws + WS_CTL, 0, CTL_ZERO_BYTES, stream) != hipSuccess) { fprintf(stderr, "kernel_launch: memset failed\n"); return; }
    Args a{};
    for (int i = 0; i < 23; ++i) a.in[i] = (const float*)d_in[i];
    a.out = (float*)d_out; a.ws = (unsigned char*)d_ws;
    for (int li = 0; li < MK_N_LAUNCHES; ++li) {
        if (MK_N_LAUNCHES == 1) { a.ph_lo = 0; a.ph_hi = NPHASES; } else { a.ph_lo = li; a.ph_hi = li + 1; }
        a.li = li;
        hipLaunchKernelGGL(mk_fwd, dim3(grid), dim3(NTHR), LDS_BYTES, stream, a);
        const hipError_t le = hipPeekAtLastError();
        if (le != hipSuccess) { fprintf(stderr, "kernel_launch: launch %d failed: %s\n", li, hipGetErrorName(le)); break; }
    }
}
```
